# Optimizing an MI355X kernel written in HIP

```python
import math
import jax, jax.numpy as jnp
from jax import lax
import numpy as np

D_MODEL = 1024
BATCH = 8
SEQ = 2048
DEPTH = 2
DEC_BATCH = 128
DEC_SEQ = 8
PAST_LEN = 16384
PAGE_SIZE = 128

EPS = 1e-6
D_FF = 2816
C_POOL = D_MODEL // 4
C_GLA = D_MODEL // 4
C_HGRN = D_MODEL // 4
C_SSM = D_MODEL // 4
POOL_WINDOWS = (2, 4, 8, 16)
POOL_GC = C_POOL // 4
POOL_PAST = 16 - 1
GLA_H = 4
GLA_DV = C_GLA // GLA_H
GLA_DK = GLA_DV // 2
GLA_RANK = 16
GLA_TAU = 16.0
GLA_CHUNK = 64
HG_H = 4
HG_DV = C_HGRN // HG_H
HG_DK = 64
HG_CHUNK = 64
SSM_P = 64
SSM_H = C_SSM // SSM_P
SSM_G = 2
SSM_HG = SSM_H // SSM_G
SSM_N = 128
SSM_CONV = 4
SSM_CONV_DIM = C_SSM + 2 * SSM_G * SSM_N
SSM_CHUNK = 64
IN_SIZES = (C_POOL,
            GLA_H * GLA_DK, GLA_H * GLA_DK, C_GLA, C_GLA, GLA_RANK,
            HG_H * HG_DK, HG_H * HG_DK, C_HGRN, C_HGRN,
            C_SSM, SSM_CONV_DIM, SSM_H)
N_IN = sum(IN_SIZES)

kernel_name = 'hybrid_pool_gla_hgrn2_ssd_macaron_step'


def rms_norm(x, g, eps=EPS):
    xf = x.astype(jnp.float32)
    y = xf * lax.rsqrt(jnp.mean(xf * xf, axis=-1, keepdims=True) + eps)
    return (y * g.astype(jnp.float32)).astype(x.dtype)


def swiglu(x, w_gate, w_up, w_down):
    return (jax.nn.silu(x @ w_gate) * (x @ w_up)) @ w_down


def _pad_time(a, t_pad):
    return jnp.pad(a, [(0, 0), (0, t_pad - a.shape[1])] + [(0, 0)] * (a.ndim - 2))


def pool_mixer(xp, buf, pos0, pool_w, pool_scale):
    B, T, C = xp.shape
    xe = jnp.concatenate([buf.astype(xp.dtype), xp], axis=1)
    cs = jnp.cumsum(xe.astype(jnp.float32), axis=1)
    cs = jnp.concatenate([jnp.zeros((B, 1, C), jnp.float32), cs], axis=1)
    pos = pos0 + jnp.arange(T)
    upper = cs[:, POOL_PAST + 1:POOL_PAST + 1 + T]
    diffs = []
    for gi, w in enumerate(POOL_WINDOWS):
        sl = slice(gi * POOL_GC, (gi + 1) * POOL_GC)
        lower = cs[:, POOL_PAST + 1 - w:POOL_PAST + 1 - w + T, sl]
        cnt = jnp.minimum(pos + 1, w).astype(jnp.float32)[None, :, None]
        diffs.append(((upper[..., sl] - lower) / cnt).astype(xp.dtype) - xp[..., sl])
    d = jnp.stack(diffs, axis=2)
    y = jnp.einsum('btgc,gcd->btgd', d, pool_w).reshape(B, T, C) * pool_scale
    return y, xe[:, -POOL_PAST:]


def chunked_gla(q, k, v, log_a, s0, chunk):
    B, T, H, K = q.shape
    V = v.shape[-1]
    L = min(chunk, T)
    n = -(-T // L)
    Tp = n * L

    def prep(a):
        a = _pad_time(a.astype(jnp.float32), Tp)
        return a.reshape((B, n, L) + a.shape[2:]).swapaxes(0, 1)

    causal = jnp.tril(jnp.ones((L, L), dtype=bool))[None, :, :, None, None]

    def step(S, inp):
        qc, kc, vc, gc = inp
        b = jnp.cumsum(gc, axis=1)
        o = jnp.einsum('blhk,bhkv->blhv', qc * jnp.exp(b), S)
        dec = jnp.exp(jnp.where(causal, b[:, :, None] - b[:, None, :], -jnp.inf))
        att = jnp.einsum('bihk,bjhk,bijhk->bijh', qc, kc, dec)
        o = o + jnp.einsum('bijh,bjhv->bihv', att, vc)
        w_end = jnp.exp(b[:, -1:] - b)
        S = S * jnp.exp(b[:, -1])[..., None] + jnp.einsum('bjhk,bjhv->bhkv', kc * w_end, vc)
        return S, o

    S, o = lax.scan(step, s0.astype(jnp.float32), (prep(q), prep(k), prep(v), prep(log_a)))
    o = o.swapaxes(0, 1).reshape(B, Tp, H, V)[:, :T]
    return o.astype(q.dtype), S.astype(s0.dtype)


def chunked_ssd(x, dt, A, Bm, Cm, s0, chunk):
    B, T, G, Hg, P = x.shape
    L = min(chunk, T)
    n = -(-T // L)
    Tp = n * L
    dt = dt.astype(jnp.float32)
    log_a = dt * A.astype(jnp.float32)
    xdt = x.astype(jnp.float32) * dt[..., None]

    def prep(a):
        a = _pad_time(a.astype(jnp.float32), Tp)
        return a.reshape((B, n, L) + a.shape[2:]).swapaxes(0, 1)

    causal = jnp.tril(jnp.ones((L, L), dtype=bool))[None, :, :, None, None]

    def step(S, inp):
        xc, ac, bc, cc = inp
        cum = jnp.cumsum(ac, axis=1)
        decay = jnp.exp(jnp.where(causal, cum[:, :, None] - cum[:, None, :], -jnp.inf))
        cb = jnp.einsum('bign,bjgn->bijg', cc, bc)
        y = jnp.einsum('bijg,bijgh,bjghp->bighp', cb, decay, xc)
        y = y + jnp.einsum('bign,bghpn->bighp', cc, S) * jnp.exp(cum)[..., None]
        w_end = jnp.exp(cum[:, -1:] - cum)
        S = S * jnp.exp(cum[:, -1])[..., None, None] + jnp.einsum('bjgn,bjgh,bjghp->bghpn', bc, w_end, xc)
        return S, y

    S, y = lax.scan(step, s0.astype(jnp.float32), (prep(xdt), prep(log_a), prep(Bm), prep(Cm)))
    y = y.swapaxes(0, 1).reshape(B, Tp, G, Hg, P)[:, :T]
    return y, S.astype(s0.dtype)


def run_layer(x, pool_buf, gla_s, hgrn_s, ssm_s, conv_buf, pos0, lb,
              ffn1_norm, ffn1_w_gate, ffn1_w_up, ffn1_w_down, mix_norm, w_in, pool_w, pool_scale,
              gla_w_gate, gla_gate_bias, gla_norm, hgrn_norm, ssm_conv_w, ssm_conv_b, ssm_dt_bias,
              ssm_A_log, ssm_D, ssm_norm, w_out, ffn2_norm, ffn2_w_gate, ffn2_w_up, ffn2_w_down):
    B, T, _ = x.shape
    x = x + 0.5 * swiglu(rms_norm(x, ffn1_norm), ffn1_w_gate, ffn1_w_up, ffn1_w_down)
    h = rms_norm(x, mix_norm)
    proj = h @ w_in
    split_at = np.cumsum(IN_SIZES)[:-1].tolist()
    (p_x, g_q, g_k, g_v, g_r, g_lr, r_q, r_f, r_i, r_g,
     s_z, s_xbc, s_dt) = jnp.split(proj, split_at, axis=-1)

    o_pool, new_pool = pool_mixer(p_x, pool_buf, pos0, pool_w, pool_scale)

    q = g_q.reshape(B, T, GLA_H, GLA_DK) * (GLA_DK ** -0.5)
    k = g_k.reshape(B, T, GLA_H, GLA_DK)
    v = g_v.reshape(B, T, GLA_H, GLA_DV)
    gate_logit = (g_lr @ gla_w_gate + gla_gate_bias).astype(jnp.float32)
    log_alpha = (jax.nn.log_sigmoid(gate_logit) / GLA_TAU).reshape(B, T, GLA_H, GLA_DK)
    o, new_gla = chunked_gla(q, k, v, log_alpha, gla_s, GLA_CHUNK)
    o_gla = (rms_norm(o, gla_norm) * jax.nn.silu(g_r.reshape(B, T, GLA_H, GLA_DV))).reshape(B, T, C_GLA)

    hq = jax.nn.silu(r_q).reshape(B, T, HG_H, HG_DK)
    lbh = lb.reshape(HG_H, HG_DK)
    zf = r_f.astype(jnp.float32).reshape(B, T, HG_H, HG_DK)
    log_f = jnp.logaddexp(jnp.log(lbh), jnp.log1p(-lbh) + jax.nn.log_sigmoid(zf))
    hk = -jnp.expm1(log_f)
    hi = r_i.reshape(B, T, HG_H, HG_DV)
    o, new_hgrn = chunked_gla(hq, hk, hi, log_f, hgrn_s, HG_CHUNK)
    o_hgrn = (rms_norm(o, hgrn_norm) * jax.nn.silu(r_g.reshape(B, T, HG_H, HG_DV))).reshape(B, T, C_HGRN)

    xe = jnp.concatenate([conv_buf.astype(s_xbc.dtype), s_xbc], axis=1)
    conv = lax.conv_general_dilated(xe, ssm_conv_w[:, None, :].astype(xe.dtype), window_strides=(1,),
                                    padding='VALID', dimension_numbers=('NWC', 'WIO', 'NWC'),
                                    feature_group_count=SSM_CONV_DIM)
    conv = jax.nn.silu(conv + ssm_conv_b)
    new_conv = xe[:, -(SSM_CONV - 1):]
    xs, Bm, Cm = jnp.split(conv, [C_SSM, C_SSM + SSM_G * SSM_N], axis=-1)
    xs = xs.reshape(B, T, SSM_G, SSM_HG, SSM_P)
    Bm = Bm.reshape(B, T, SSM_G, SSM_N)
    Cm = Cm.reshape(B, T, SSM_G, SSM_N)
    dt = jax.nn.softplus(s_dt.astype(jnp.float32) + ssm_dt_bias.astype(jnp.float32)).reshape(B, T, SSM_G, SSM_HG)
    A = -jnp.exp(ssm_A_log.astype(jnp.float32)).reshape(SSM_G, SSM_HG)
    y, new_ssm = chunked_ssd(xs, dt, A, Bm, Cm, ssm_s.reshape(B, SSM_G, SSM_HG, SSM_P, SSM_N), SSM_CHUNK)
    y = y + ssm_D.astype(jnp.float32).reshape(SSM_G, SSM_HG, 1) * xs.astype(jnp.float32)
    y = y.reshape(B, T, C_SSM).astype(x.dtype) * jax.nn.silu(s_z)
    o_ssm = rms_norm(y.reshape(B, T, SSM_G, C_SSM // SSM_G),
                     ssm_norm.reshape(SSM_G, C_SSM // SSM_G)).reshape(B, T, C_SSM)
    new_ssm = new_ssm.reshape(B, SSM_H, SSM_P, SSM_N)

    mix = jnp.concatenate([o_pool, o_gla, o_hgrn, o_ssm], axis=-1) @ w_out
    x = x + mix
    x = x + 0.5 * swiglu(rms_norm(x, ffn2_norm), ffn2_w_gate, ffn2_w_up, ffn2_w_down)
    return x, new_pool, new_gla, new_hgrn, new_ssm, new_conv


def setup_inputs(seed: int = 0) -> dict:
    key = jax.random.key(seed)
    ks = list(jax.random.split(key, 48))

    def nrm(shape, s):
        return jax.random.normal(ks.pop(), shape, jnp.float32) * s

    def gain(shape):
        return 1.0 + nrm(shape, 0.02)

    inp = {}
    inp['x_prompt'] = nrm((BATCH, SEQ, D_MODEL), 1.0)
    inp['x_sample'] = nrm((DEC_BATCH, DEC_SEQ, D_MODEL), 1.0)
    inp['state_pool'] = nrm((DEPTH, DEC_BATCH, POOL_PAST, C_POOL), 1.0)
    inp['state_gla'] = nrm((DEPTH, DEC_BATCH, GLA_H, GLA_DK, GLA_DV), 0.5)
    inp['state_hgrn'] = nrm((DEPTH, DEC_BATCH, HG_H, HG_DK, HG_DV), 0.5)
    inp['state_ssm'] = nrm((DEPTH, DEC_BATCH, SSM_H, SSM_P, SSM_N), 0.3)
    inp['state_conv'] = nrm((DEPTH, DEC_BATCH, SSM_CONV - 1, SSM_CONV_DIM), 1.0)
    inp['ffn1_norm'] = gain((DEPTH, D_MODEL))
    inp['ffn1_w_gate'] = nrm((DEPTH, D_MODEL, D_FF), D_MODEL ** -0.5)
    inp['ffn1_w_up'] = nrm((DEPTH, D_MODEL, D_FF), D_MODEL ** -0.5)
    inp['ffn1_w_down'] = nrm((DEPTH, D_FF, D_MODEL), D_FF ** -0.5)
    inp['mix_norm'] = gain((DEPTH, D_MODEL))
    inp['w_in'] = nrm((DEPTH, D_MODEL, N_IN), D_MODEL ** -0.5)
    inp['pool_w'] = nrm((DEPTH, len(POOL_WINDOWS), POOL_GC, POOL_GC), POOL_GC ** -0.5)
    inp['pool_scale'] = gain((DEPTH, C_POOL))
    inp['gla_w_gate'] = nrm((DEPTH, GLA_RANK, GLA_H * GLA_DK), GLA_RANK ** -0.5)
    inp['gla_gate_bias'] = nrm((DEPTH, GLA_H * GLA_DK), 0.1)
    inp['gla_norm'] = gain((DEPTH, GLA_DV))
    inp['hgrn_lb_logits'] = nrm((DEPTH, HG_H * HG_DK), 0.5)
    inp['hgrn_norm'] = gain((DEPTH, HG_DV))
    inp['ssm_conv_w'] = nrm((DEPTH, SSM_CONV, SSM_CONV_DIM), 0.5)
    inp['ssm_conv_b'] = nrm((DEPTH, SSM_CONV_DIM), 0.02)
    dt0 = jnp.exp(jax.random.uniform(ks.pop(), (DEPTH, SSM_H), jnp.float32,
                                     minval=math.log(1e-3), maxval=math.log(1e-1)))
    inp['ssm_dt_bias'] = dt0 + jnp.log(-jnp.expm1(-dt0))
    inp['ssm_A_log'] = jnp.log(jax.random.uniform(ks.pop(), (DEPTH, SSM_H), jnp.float32, minval=1.0, maxval=16.0))
    inp['ssm_D'] = gain((DEPTH, SSM_H))
    inp['ssm_norm'] = gain((DEPTH, C_SSM))
    inp['w_out'] = nrm((DEPTH, D_MODEL, D_MODEL), D_MODEL ** -0.5)
    inp['ffn2_norm'] = gain((DEPTH, D_MODEL))
    inp['ffn2_w_gate'] = nrm((DEPTH, D_MODEL, D_FF), D_MODEL ** -0.5)
    inp['ffn2_w_up'] = nrm((DEPTH, D_MODEL, D_FF), D_MODEL ** -0.5)
    inp['ffn2_w_down'] = nrm((DEPTH, D_FF, D_MODEL), D_FF ** -0.5)
    inp['final_norm'] = gain((D_MODEL,))
    return inp


def reference(x_prompt, x_sample, state_pool, state_gla, state_hgrn, state_ssm, state_conv,
              ffn1_norm, ffn1_w_gate, ffn1_w_up, ffn1_w_down, mix_norm, w_in, pool_w, pool_scale,
              gla_w_gate, gla_gate_bias, gla_norm, hgrn_lb_logits, hgrn_norm,
              ssm_conv_w, ssm_conv_b, ssm_dt_bias, ssm_A_log, ssm_D, ssm_norm, w_out,
              ffn2_norm, ffn2_w_gate, ffn2_w_up, ffn2_w_down, final_norm):
    lb_cum = jnp.cumsum(jax.nn.softmax(hgrn_lb_logits.astype(jnp.float32), axis=0), axis=0)
    lower_bounds = lb_cum - lb_cum[0:1]

    bp = x_prompt.shape[0]
    hp, hs = x_prompt, x_sample
    pp, ps, gp, gs, rp, rs, sp, ss, cp, cs = ([] for _ in range(10))
    for l in range(DEPTH):
        lw = (ffn1_norm[l], ffn1_w_gate[l], ffn1_w_up[l], ffn1_w_down[l], mix_norm[l], w_in[l],
              pool_w[l], pool_scale[l], gla_w_gate[l], gla_gate_bias[l], gla_norm[l], hgrn_norm[l],
              ssm_conv_w[l], ssm_conv_b[l], ssm_dt_bias[l], ssm_A_log[l], ssm_D[l], ssm_norm[l], w_out[l],
              ffn2_norm[l], ffn2_w_gate[l], ffn2_w_up[l], ffn2_w_down[l])
        hp, a, b, c, d, e = run_layer(
            hp,
            jnp.zeros((bp, POOL_PAST, C_POOL), state_pool.dtype),
            jnp.zeros((bp, GLA_H, GLA_DK, GLA_DV), state_gla.dtype),
            jnp.zeros((bp, HG_H, HG_DK, HG_DV), state_hgrn.dtype),
            jnp.zeros((bp, SSM_H, SSM_P, SSM_N), state_ssm.dtype),
            jnp.zeros((bp, SSM_CONV - 1, SSM_CONV_DIM), state_conv.dtype),
            0, lower_bounds[l], *lw)
        pp.append(a); gp.append(b); rp.append(c); sp.append(d); cp.append(e)
        hs, a, b, c, d, e = run_layer(
            hs, state_pool[l], state_gla[l], state_hgrn[l], state_ssm[l], state_conv[l],
            PAST_LEN, lower_bounds[l], *lw)
        ps.append(a); gs.append(b); rs.append(c); ss.append(d); cs.append(e)

    y_prompt = rms_norm(hp, final_norm)
    y_sample = rms_norm(hs, final_norm)
    return (y_prompt, y_sample,
            jnp.stack(pp), jnp.stack(ps),
            jnp.stack(gp), jnp.stack(gs),
            jnp.stack(rp), jnp.stack(rs),
            jnp.stack(sp), jnp.stack(ss),
            jnp.stack(cp), jnp.stack(cs))
```

```cpp
#include <hip/hip_runtime.h>
#include <cstdio>
#include <cstdint>
namespace pg8 {
#define PG8_LAS __attribute__((address_space(3)))
typedef unsigned short bf16_t;
typedef short bf16x8 __attribute__((ext_vector_type(8)));
typedef float f32x4 __attribute__((ext_vector_type(4)));
typedef unsigned u32x4 __attribute__((ext_vector_type(4)));
constexpr int BM = 256, BK = 64, HALF = 128, HTB = HALF * BK * 2  , STAGE_BYTES = 8 * HTB, NXCD = 8, WGM = 8;

__host__ __device__ __forceinline__ int lds_byte(int r, int c) { const int st = (r >> 4) * 2 + (c >> 5), rr = r & 15, cc = c & 31, ob = rr * 64 + cc * 2; return st * 1024 + (ob ^ (((ob >> 9) & 1) << 5)); }
__host__ __device__ __forceinline__ void stage_rc(int b, int& R, int& C) { const int st = b / 1024, sb = b % 1024, swz = sb ^ (((sb >> 9) & 1) << 5); R = (st >> 1) * 16 + swz / 64; C = (st & 1) * 32 + (swz % 64) / 2; }
__host__ __device__ __forceinline__ int perm32(int rho) { const int n = rho >> 4, i = rho & 15; return 8 * (i >> 2) + 4 * n + (i & 3); }

struct Unit { int pm, pn; };
struct Gemm { const bf16_t* A; const bf16_t* Bt; int M, N, K; };

struct StaticOrder {
    int nM, nN, nwg, G, c;
    __host__ __device__ void init(int M, int N, int G_, int c_) { nM = M / BM; nN = N / BM; nwg = nM * nN; G = G_; c = c_; }
    __host__ __device__ bool next(int i, Unit& u) const {
        const long L = (long)i * G + c; if (L >= nwg) return false;
        int wgid = (int)L; { const int q = nwg / NXCD, r = nwg % NXCD, xcd = wgid % NXCD, off = wgid / NXCD; wgid = (xcd < r ? xcd * (q + 1) : r * (q + 1) + (xcd - r) * q) + off; }
        const int nig = WGM * nN, gid = wgid / nig, fm = gid * WGM, gsz = (nM - fm) < WGM ? (nM - fm) : WGM;
        u.pm = fm + ((wgid % nig) % gsz); u.pn = (wgid % nig) / gsz; return true;
    }
    __device__ __forceinline__ void a_ready(const Unit&) const {}
    __device__ __forceinline__ void done(const Unit&) const {}
};
__device__ __forceinline__ unsigned cvt_pk_bf16(float lo, float hi) { unsigned r; asm volatile("v_cvt_pk_bf16_f32 %0, %1, %2" : "=v"(r) : "v"(lo), "v"(hi)); return r; }
template <class Epi, class Sched, bool ALIGN_EPI = false, bool SP2 = false>
__device__ __forceinline__ void gemm_phase(PG8_LAS unsigned char* lds, const Gemm g, const Sched& S, const Epi& E, const int tid_in) {
    const int tid = tid_in, wid = __builtin_amdgcn_readfirstlane(tid >> 6), lane = tid & 63, wr = wid >> 2, wc = wid & 3, fr = lane & 15, fq = lane >> 4;
    const int K = g.K, nt = K / BK;
    unsigned voffA[2], voffB[2];
#pragma unroll
    for (int i = 0; i < 2; ++i) { int R, C; stage_rc(tid * 16 + i * 8192, R, C); const int Rb = Epi::PERM ? ((R & ~31) + perm32(R & 31)) : R;
        voffA[i] = (unsigned)(R * K + C) * 2u; voffB[i] = (unsigned)(Rb * K + C) * 2u; }
    const size_t kstep = (size_t)(BK * 2);
    const size_t hstep = (size_t)HALF * K * 2;
    const size_t tstep = 2 * hstep;
    const unsigned ldsw = (unsigned)wid * 1024u;
    const int aoff = lds_byte(wr * 64 + fr, fq * 8), boff = lds_byte(wc * 32 + fr, fq * 8);
#define PG8_SA(b, h) (((b) * 2 + (h)) * HTB)
#define PG8_SB(b, h) ((4 + (b) * 2 + (h)) * HTB)
#define PG8_STAGE(bufoff, gbase, voff) do { _Pragma("unroll") for (int _i = 0; _i < 2; ++_i) \
        __builtin_amdgcn_global_load_lds((const unsigned*)((const char*)(gbase) + (voff)[_i]), (PG8_LAS unsigned*)(lds + (bufoff) + ldsw + _i * 8192), 16, 0, 0); } while (0)
#define PG8_LDA(dst, b, h) do { _Pragma("unroll") for (int m = 0; m < 4; ++m) _Pragma("unroll") for (int k = 0; k < 2; ++k) dst[m][k] = *(const PG8_LAS bf16x8*)(lds + PG8_SA(b, h) + aoff + m * 2048 + k * 1024); } while (0)
#define PG8_LDB(dst, b, h) do { _Pragma("unroll") for (int n = 0; n < 2; ++n) _Pragma("unroll") for (int k = 0; k < 2; ++k) dst[n][k] = *(const PG8_LAS bf16x8*)(lds + PG8_SB(b, h) + boff + n * 2048 + k * 1024); } while (0)
#define PG8_MMA(ai, bj, At, Bt) do { __builtin_amdgcn_s_setprio(1); _Pragma("unroll") for (int m = 0; m < 4; ++m) _Pragma("unroll") for (int n = 0; n < 2; ++n) _Pragma("unroll") for (int k = 0; k < 2; ++k) \
        acc[ai][bj][m][n] = __builtin_amdgcn_mfma_f32_16x16x32_bf16(Bt[n][k], At[m][k], acc[ai][bj][m][n], 0, 0, 0); __builtin_amdgcn_s_setprio(0); } while (0)
#define PG8_WAIT_V(n) asm volatile("s_waitcnt vmcnt(" #n ")" ::: "memory")
#define PG8_WAIT_L(n) asm volatile("s_waitcnt lgkmcnt(" #n ")" ::: "memory")
#define PG8_BAR __builtin_amdgcn_s_barrier()
#define PG8_SCHED __builtin_amdgcn_sched_barrier(0)
    Unit cur, nxt; int ui = 0;
    if (!S.next(0, cur)) return;
    f32x4 acc[2][2][4][2];
#pragma unroll
    for (int a = 0; a < 2; ++a)
#pragma unroll
        for (int b = 0; b < 2; ++b)
#pragma unroll
            for (int m = 0; m < 4; ++m)
#pragma unroll
                for (int n = 0; n < 2; ++n) acc[a][b][m][n] = (f32x4){0.f, 0.f, 0.f, 0.f};
    bf16x8 At[4][2], B0[2][2], B1[2][2];
    const char* cA = (const char*)g.A + (size_t)cur.pm * tstep; const char* cB = (const char*)g.Bt + (size_t)cur.pn * tstep;
    S.a_ready(cur);
    if constexpr (SP2) {
        PG8_STAGE(PG8_SB(0, 0), cB, voffB); PG8_STAGE(PG8_SB(0, 1), cB + hstep, voffB); PG8_STAGE(PG8_SA(0, 0), cA, voffA); PG8_STAGE(PG8_SA(0, 1), cA + hstep, voffA);
        if (wr == 1) PG8_BAR;
        PG8_WAIT_V(2); PG8_BAR;
        PG8_STAGE(PG8_SB(1, 0), cB + kstep, voffB); PG8_STAGE(PG8_SA(1, 0), cA + kstep, voffA); PG8_STAGE(PG8_SB(1, 1), cB + hstep + kstep, voffB);
        PG8_WAIT_V(6); PG8_BAR;
    } else {
        PG8_STAGE(PG8_SB(0, 0), cB, voffB); PG8_STAGE(PG8_SA(0, 0), cA, voffA); PG8_STAGE(PG8_SB(0, 1), cB + hstep, voffB); PG8_STAGE(PG8_SA(0, 1), cA + hstep, voffA);
        if (wr == 1) PG8_BAR;
        PG8_WAIT_V(4); PG8_BAR;
        PG8_STAGE(PG8_SB(1, 0), cB + kstep, voffB); PG8_STAGE(PG8_SA(1, 0), cA + kstep, voffA); PG8_STAGE(PG8_SB(1, 1), cB + hstep + kstep, voffB);
        PG8_WAIT_V(6); PG8_BAR;
    }
    for (;;) {
        const bool has_next = S.next(ui + 1, nxt);
        const char* nA = has_next ? (const char*)g.A + (size_t)nxt.pm * tstep : cA; const char* nB = has_next ? (const char*)g.Bt + (size_t)nxt.pn * tstep : cB;
        for (int t = 0; t < nt; t += 2) {
            const bool last = (t == nt - 2);
            const char* a1 = cA + (size_t)(t + 1) * kstep;
            const char* a2 = last ? nA : cA + (size_t)(t + 2) * kstep; const char* b2 = last ? nB : cB + (size_t)(t + 2) * kstep;
            const char* a3 = a2 + kstep; const char* b3 = b2 + kstep;
            if (last && has_next) S.a_ready(nxt);
            if constexpr (SP2) {
            PG8_LDB(B0, 0, 0); PG8_LDB(B1, 0, 1); PG8_SCHED; PG8_LDA(At, 0, 0); PG8_STAGE(PG8_SA(1, 1), a1 + hstep, voffA);
            PG8_WAIT_V(8); PG8_WAIT_L(0); PG8_BAR; PG8_MMA(0, 0, At, B0); PG8_MMA(0, 1, At, B1); PG8_BAR; PG8_SCHED;
            PG8_LDA(At, 0, 1); PG8_STAGE(PG8_SB(0, 0), b2, voffB); PG8_STAGE(PG8_SB(0, 1), b2 + hstep, voffB); PG8_STAGE(PG8_SA(0, 0), a2, voffA);
            PG8_WAIT_V(8); PG8_WAIT_L(0); PG8_BAR; PG8_MMA(1, 0, At, B0); PG8_MMA(1, 1, At, B1); PG8_BAR; PG8_SCHED;
            PG8_LDB(B0, 1, 0); PG8_LDB(B1, 1, 1); PG8_SCHED; PG8_LDA(At, 1, 0); PG8_STAGE(PG8_SA(0, 1), a2 + hstep, voffA);
            PG8_WAIT_V(8); PG8_WAIT_L(0); PG8_BAR; PG8_MMA(0, 0, At, B0); PG8_MMA(0, 1, At, B1); PG8_BAR; PG8_SCHED;
            PG8_LDA(At, 1, 1); PG8_STAGE(PG8_SB(1, 0), b3, voffB); PG8_STAGE(PG8_SB(1, 1), b3 + hstep, voffB); PG8_STAGE(PG8_SA(1, 0), a3, voffA);
            PG8_WAIT_V(8); PG8_WAIT_L(0); PG8_BAR; PG8_MMA(1, 0, At, B0); PG8_MMA(1, 1, At, B1); PG8_BAR; PG8_SCHED;
            } else {
            PG8_LDB(B0, 0, 0); PG8_SCHED; PG8_LDA(At, 0, 0); PG8_STAGE(PG8_SA(1, 1), a1 + hstep, voffA);
            PG8_WAIT_L(8); PG8_BAR; PG8_WAIT_L(0); PG8_MMA(0, 0, At, B0); PG8_BAR; PG8_SCHED;
            PG8_LDB(B1, 0, 1); PG8_STAGE(PG8_SB(0, 0), b2, voffB);
            PG8_BAR; PG8_WAIT_L(0); PG8_MMA(0, 1, At, B1); PG8_BAR;
            PG8_LDA(At, 0, 1); PG8_STAGE(PG8_SA(0, 0), a2, voffA);
            PG8_BAR; PG8_WAIT_L(0); PG8_MMA(1, 0, At, B0); PG8_BAR; PG8_SCHED;
            PG8_STAGE(PG8_SB(0, 1), b2 + hstep, voffB);
            PG8_WAIT_V(6); PG8_BAR; PG8_MMA(1, 1, At, B1); PG8_BAR;
            PG8_LDB(B0, 1, 0); PG8_SCHED; PG8_LDA(At, 1, 0); PG8_STAGE(PG8_SA(0, 1), a2 + hstep, voffA);
            PG8_WAIT_L(8); PG8_BAR; PG8_WAIT_L(0); PG8_MMA(0, 0, At, B0); PG8_BAR; PG8_SCHED;
            PG8_LDB(B1, 1, 1); PG8_STAGE(PG8_SB(1, 0), b3, voffB);
            PG8_BAR; PG8_WAIT_L(0); PG8_MMA(0, 1, At, B1); PG8_BAR;
            PG8_LDA(At, 1, 1); PG8_STAGE(PG8_SA(1, 0), a3, voffA);
            PG8_BAR; PG8_WAIT_L(0); PG8_MMA(1, 0, At, B0); PG8_BAR; PG8_SCHED;
            PG8_STAGE(PG8_SB(1, 1), b3 + hstep, voffB);
            PG8_WAIT_V(6); PG8_BAR; PG8_MMA(1, 1, At, B1); PG8_BAR;
            }
        }
        if constexpr (ALIGN_EPI) { if (wr == 0) PG8_BAR; }
        if constexpr (!Epi::AFTER_DRAIN) { E.run(acc, cur, wr, wc, fr, fq, !has_next); S.done(cur); }
        if (!has_next) break;
#pragma unroll
        for (int a = 0; a < 2; ++a)
#pragma unroll
            for (int b = 0; b < 2; ++b)
#pragma unroll
                for (int m = 0; m < 4; ++m)
#pragma unroll
                    for (int n = 0; n < 2; ++n) acc[a][b][m][n] = (f32x4){0.f, 0.f, 0.f, 0.f};
        cur = nxt; cA = nA; cB = nB; ++ui;
        if constexpr (ALIGN_EPI) { if (wr == 1) PG8_BAR; }
    }
    PG8_WAIT_V(0);
    if constexpr (!ALIGN_EPI) { if (wr == 0) PG8_BAR; }
    PG8_BAR;
    if constexpr (Epi::AFTER_DRAIN) { E.fused(acc, cur, wr, wc, fr, fq, lds, wid, lane); S.done(cur); }
#undef PG8_SA
#undef PG8_SB
#undef PG8_STAGE
#undef PG8_LDA
#undef PG8_LDB
#undef PG8_MMA
#undef PG8_WAIT_V
#undef PG8_WAIT_L
#undef PG8_BAR
#undef PG8_SCHED
}
}

#ifndef PG8_SP2
#define PG8_SP2 true
#endif
#ifndef PG8_ALIGN
#define PG8_ALIGN true
#endif
namespace pg8 {
constexpr float RMS_EPS = 1e-6f;
__device__ __forceinline__ float silu_f(float x) { return x * __builtin_amdgcn_rcpf(1.0f + __expf(-x)); }
typedef float f32x2n __attribute__((ext_vector_type(2)));
typedef __bf16 bf16x2n __attribute__((ext_vector_type(2)));
__device__ __forceinline__ unsigned cvt2_bf16(float lo, float hi) { const f32x2n v = {lo, hi}; return __builtin_bit_cast(unsigned, __builtin_convertvector(v, bf16x2n)); }

#ifndef MK_WT
#define MK_WT 16
#endif
__device__ __forceinline__ __amdgpu_buffer_rsrc_t wt_rsrc(const void* base, unsigned bytes) { return __builtin_amdgcn_make_buffer_rsrc(const_cast<void*>(base), 0, (int)bytes, 0x00020000); }
__device__ __forceinline__ void st16_wt(const bool wt, const __amdgpu_buffer_rsrc_t rs, unsigned byte_off, const u32x4 v) { if (wt) __builtin_amdgcn_raw_buffer_store_b128(v, rs, byte_off, 0, MK_WT); else __builtin_amdgcn_raw_buffer_store_b128(v, rs, byte_off, 0, 0); }

struct EpiSwiGLU {
    static constexpr bool PERM = true, AFTER_DRAIN = false;
    bf16_t* H; int ldh; const float* rowss; bool dry;
    __device__ __forceinline__ void run(const f32x4 (&acc)[2][2][4][2], const Unit& u, int wr, int wc, int fr, int fq, const bool wt) const {
        if (dry) { asm volatile("" :: "v"(acc[0][0][0][0]), "v"(acc[1][1][3][1])); return; }
        const int row0 = u.pm * BM + wr * 64 + fr, col0 = u.pn * HALF + wc * 32 + 8 * fq;
        const __amdgpu_buffer_rsrc_t hrs = wt_rsrc(H, 17408u * 2816u * 2u);
        float rs[2][4];
#pragma unroll
        for (int ai = 0; ai < 2; ++ai)
#pragma unroll
            for (int m = 0; m < 4; ++m) rs[ai][m] = rowss[row0 + ai * HALF + m * 16];
#pragma unroll
        for (int ai = 0; ai < 2; ++ai)
#pragma unroll
            for (int m = 0; m < 4; ++m) {
                const int row = row0 + ai * HALF + m * 16;
                const float ms = rs[ai][m] * (1.0f / 1024.0f) + RMS_EPS, c1 = -1.4426950408889634f * rsqrtf(ms);
                const f32x4 g0 = acc[ai][0][m][0], g1 = acc[ai][0][m][1], u0 = acc[ai][1][m][0], u1 = acc[ai][1][m][1];
                const f32x4 t0 = g0 * c1, t1 = g1 * c1; f32x4 e0, e1, i0, i1;
#pragma unroll
                for (int e = 0; e < 4; ++e) { e0[e] = __builtin_amdgcn_exp2f(t0[e]); e1[e] = __builtin_amdgcn_exp2f(t1[e]); }
                const f32x4 d0 = e0 * ms + ms, d1 = e1 * ms + ms;
#pragma unroll
                for (int e = 0; e < 4; ++e) { i0[e] = __builtin_amdgcn_rcpf(d0[e]); i1[e] = __builtin_amdgcn_rcpf(d1[e]); }
                const f32x4 h0 = (g0 * u0) * i0, h1 = (g1 * u1) * i1;
                u32x4 w; w.x = cvt2_bf16(h0[0], h0[1]); w.y = cvt2_bf16(h0[2], h0[3]); w.z = cvt2_bf16(h1[0], h1[1]); w.w = cvt2_bf16(h1[2], h1[3]);
                st16_wt(wt, hrs, (unsigned)(row * ldh + col0) * 2u, w);
            }
    }
};
struct EpiResid {
    static constexpr bool PERM = true, AFTER_DRAIN = false;
    bf16_t* xb; float* rowss; float scale; bool fin;
    __device__ __forceinline__ void run(const f32x4 (&acc)[2][2][4][2], const Unit& u, int wr, int wc, int fr, int fq, const bool wt) const {
        const int row0 = u.pm * BM + wr * 64 + fr, col0 = u.pn * BM + wc * 32 + 8 * fq;
        const __amdgpu_buffer_rsrc_t xrs = wt_rsrc(xb, 17408u * 1024u * 2u);
        u32x4 xv[2][4][2];
#pragma unroll
        for (int ai = 0; ai < 2; ++ai)
#pragma unroll
            for (int m = 0; m < 4; ++m)
#pragma unroll
                for (int bj = 0; bj < 2; ++bj) xv[ai][m][bj] = *(const u32x4*)(xb + (size_t)(row0 + ai * HALF + m * 16) * 1024 + col0 + bj * HALF);
        float ssv[2][4];
#pragma unroll
        for (int ai = 0; ai < 2; ++ai)
#pragma unroll
            for (int m = 0; m < 4; ++m) {
                const int row = row0 + ai * HALF + m * 16;
                float ss = 0.f;
#pragma unroll
                for (int bj = 0; bj < 2; ++bj) {
                    const u32x4 xo = xv[ai][m][bj]; u32x4 w;
#pragma unroll
                    for (int k = 0; k < 4; ++k) {
                        const float a0 = __uint_as_float(xo[k] << 16) + acc[ai][bj][m][k >> 1][(k & 1) * 2] * scale, a1 = __uint_as_float(xo[k] & 0xffff0000u) + acc[ai][bj][m][k >> 1][(k & 1) * 2 + 1] * scale;
                        const unsigned p = cvt_pk_bf16(a0, a1); w[k] = p;
                        const float r0 = __uint_as_float(p << 16), r1 = __uint_as_float(p & 0xffff0000u); ss += r0 * r0 + r1 * r1;
                    }
                    st16_wt(wt, xrs, (unsigned)(row * 1024 + col0 + bj * HALF) * 2u, w);
                }
                ssv[ai][m] = ss;
            }
#pragma unroll
        for (int ai = 0; ai < 2; ++ai)
#pragma unroll
            for (int m = 0; m < 4; ++m) ssv[ai][m] += __shfl_xor(ssv[ai][m], 16);
#pragma unroll
        for (int ai = 0; ai < 2; ++ai)
#pragma unroll
            for (int m = 0; m < 4; ++m) ssv[ai][m] += __shfl_xor(ssv[ai][m], 32);
        if (fq == 0 && fin) {
#pragma unroll
            for (int ai = 0; ai < 2; ++ai)
#pragma unroll
                for (int m = 0; m < 4; ++m) unsafeAtomicAdd(rowss + row0 + ai * HALF + m * 16, ssv[ai][m]);
        }
    }
};
struct EpiProj {
    static constexpr bool PERM = true, AFTER_DRAIN = false;
    bf16_t* P; int ldp; const float* rowss;
    __device__ __forceinline__ void run(const f32x4 (&acc)[2][2][4][2], const Unit& u, int wr, int wc, int fr, int fq, const bool wt) const {
        const int row0 = u.pm * BM + wr * 64 + fr, col0 = u.pn * BM + wc * 32 + 8 * fq;
        const __amdgpu_buffer_rsrc_t prs = wt_rsrc(P, 17408u * 3328u * 2u);
        const bool act = (u.pn == 3) || (u.pn == 4) || (u.pn == 7) || (u.pn == 8);
        float rs[2][4];
#pragma unroll
        for (int ai = 0; ai < 2; ++ai)
#pragma unroll
            for (int m = 0; m < 4; ++m) rs[ai][m] = rowss[row0 + ai * HALF + m * 16];
#pragma unroll
        for (int ai = 0; ai < 2; ++ai)
#pragma unroll
            for (int m = 0; m < 4; ++m) {
                const int row = row0 + ai * HALF + m * 16;
                const float r = rsqrtf(rs[ai][m] * (1.0f / 1024.0f) + RMS_EPS);
#pragma unroll
                for (int bj = 0; bj < 2; ++bj) {
                    f32x4 a = acc[ai][bj][m][0] * r, b = acc[ai][bj][m][1] * r;
                    if (act) {
#pragma unroll
                        for (int e = 0; e < 4; ++e) { a[e] = silu_f(a[e]); b[e] = silu_f(b[e]); }
                    }
                    u32x4 w; w.x = cvt_pk_bf16(a[0], a[1]); w.y = cvt_pk_bf16(a[2], a[3]); w.z = cvt_pk_bf16(b[0], b[1]); w.w = cvt_pk_bf16(b[2], b[3]);
                    st16_wt(wt, prs, (unsigned)(row * ldp + col0 + bj * HALF) * 2u, w);
                }
            }
    }
};
}

constexpr int NWAVES = 8, NTHREADS = 512;
#ifndef MK_N_LAUNCHES
#define MK_N_LAUNCHES 1
#endif
constexpr int N_PHASES = 18;
constexpr int N_LAUNCHES = MK_N_LAUNCHES;

constexpr int D = 1024, FF = 2816, NGU = 2 * FF, NIN = 3092, NINP = 3328, DEPTH = 2;
constexpr int BP = 8, TP = 2048, BS = 128, TS = 8, PAST_LEN = 16384;
constexpr int MP = BP * TP, MS = BS * TS, M = MP + MS;
static_assert(M % 256 == 0 && NGU % 256 == 0 && NINP % 256 == 0 && FF % 128 == 0, "GEMM tiling");
static_assert(DEPTH == 2, "the HGRN2 lower bounds (cumulative softmax over layers minus its first term) are written out for two layers: 0 and softmax(logits)[1] = sigmoid(l1 - l0)");
constexpr int PC_PX = 0, PC_GQ = 256, PC_GK = 384, PC_GV = 512, PC_GR = 768, PC_RQ = 1024, PC_RF = 1280, PC_RI = 1536, PC_RG = 1792, PC_SZ = 2048, PC_XBC = 2304, PC_LR = 3072, PC_DT = 3088;
constexpr int MC_POOL = 0, MC_GLA = 256, MC_HGRN = 512, MC_SSM = 768;
enum { I_XP = 0, I_XS, I_SPOOL, I_SGLA, I_SHGRN, I_SSSM, I_SCONV, I_F1N, I_F1G, I_F1U, I_F1D, I_MIXN, I_WIN, I_POOLW, I_POOLS, I_GLAWG, I_GLAB, I_GLAN,
       I_LBL, I_HGN, I_CONVW, I_CONVB, I_DTB, I_ALOG, I_SSMD, I_SSMN, I_WOUT, I_F2N, I_F2G, I_F2U, I_F2D, I_FINALN, N_INPUTS };
constexpr size_t O_YP = 0, O_YS = O_YP + (size_t)MP * D, O_POOLP = O_YS + (size_t)MS * D, O_POOLS = O_POOLP + (size_t)DEPTH * BP * 15 * 256,
    O_GLAP = O_POOLS + (size_t)DEPTH * BS * 15 * 256, O_GLAS = O_GLAP + (size_t)DEPTH * BP * 4 * 32 * 64, O_HGP = O_GLAS + (size_t)DEPTH * BS * 4 * 32 * 64,
    O_HGS = O_HGP + (size_t)DEPTH * BP * 4 * 64 * 64, O_SSMP = O_HGS + (size_t)DEPTH * BS * 4 * 64 * 64, O_SSMS = O_SSMP + (size_t)DEPTH * BP * 4 * 64 * 128,
    O_CONVP = O_SSMS + (size_t)DEPTH * BS * 4 * 64 * 128, O_CONVS = O_CONVP + (size_t)DEPTH * BP * 3 * 768, O_END = O_CONVS + (size_t)DEPTH * BS * 3 * 768;
static_assert(O_END == 35094528, "output size");

constexpr size_t KiB = 1024, MiB = 1u << 20;
constexpr size_t WS_CTL = 0, CTL_ZERO_BYTES = 1 * MiB;
constexpr size_t WS_RSS = 512 * KiB;
static_assert(WS_RSS + 7 * (size_t)M * 4 <= CTL_ZERO_BYTES, "rowss inside the memset region");
constexpr size_t WS_W = 1 * MiB, W_LAYER = 41 * MiB + 512 * KiB;
constexpr size_t WO_GU1 = 0, WO_D1 = 11 * MiB, WO_IN = 16 * MiB + 512 * KiB, WO_OUT = 23 * MiB, WO_GU2 = 25 * MiB, WO_D2 = 36 * MiB;
static_assert((size_t)NGU * D * 2 == 11 * MiB && (size_t)D * FF * 2 == 5 * MiB + 512 * KiB && (size_t)NINP * D * 2 == 6 * MiB + 512 * KiB && WO_D2 + 5 * MiB + 512 * KiB == W_LAYER, "weight map");
constexpr size_t WS_XB = WS_W + 2 * W_LAYER;
constexpr size_t WS_MIX = WS_XB + 34 * MiB;
constexpr size_t WS_HP = WS_MIX + 34 * MiB;
constexpr size_t WS_END = WS_HP + (size_t)M * NINP * 2;
static_assert((size_t)M * D * 2 == 34 * MiB && WS_END == 262 * MiB + 512 * KiB, "d_ws map");
constexpr int CW_BAR = 4096;
constexpr int CW_SUB = 8192;
constexpr int RING_OFF = 0, RING_BYTES = 131072;
constexpr int LDSCTL_OFF = RING_BYTES, MISC_OFF = LDSCTL_OFF + 320;
constexpr int LDS_BYTES = 147456;

#define GAS __attribute__((address_space(1)))
#define LAS __attribute__((address_space(3)))
typedef unsigned short bf16;
typedef unsigned v4u __attribute__((ext_vector_type(4)));
typedef unsigned v2u __attribute__((ext_vector_type(2)));
typedef float f32x4 __attribute__((ext_vector_type(4)));
typedef GAS unsigned gu32;
#define RLX_AGENT __ATOMIC_RELAXED, __HIP_MEMORY_SCOPE_AGENT
#define LDS_WAIT() asm volatile("s_waitcnt lgkmcnt(0)" ::: "memory")
#define VM_WAIT() asm volatile("s_waitcnt vmcnt(0)" ::: "memory")
__device__ __forceinline__ unsigned f2bf(float f) { unsigned u = __builtin_bit_cast(unsigned, f); return (u + 0x7fffu + ((u >> 16) & 1u)) >> 16; }
__device__ __forceinline__ unsigned pk2(float lo, float hi) { return f2bf(lo) | (f2bf(hi) << 16); }
__device__ __forceinline__ float bf2f(bf16 b) { return __builtin_bit_cast(float, (unsigned)b << 16); }
__device__ __forceinline__ float sigmoid_f(float x) { return __builtin_amdgcn_rcpf(1.0f + __expf(-x)); }
__device__ __forceinline__ float silu_f(float x) { return x * __builtin_amdgcn_rcpf(1.0f + __expf(-x)); }
__device__ __forceinline__ float softplus_f(float x) { return x > 20.f ? x : log1pf(__expf(x)); }
__device__ __forceinline__ float logsigmoid_f(float x) { return fminf(x, 0.f) - log1pf(__expf(-fabsf(x))); }
typedef float f32x2v __attribute__((ext_vector_type(2)));
typedef __bf16 bf16x2v __attribute__((ext_vector_type(2)));
__device__ __forceinline__ unsigned cvtpk(float lo, float hi) { const f32x2v v = {lo, hi}; return __builtin_bit_cast(unsigned, __builtin_convertvector(v, bf16x2v)); }
#define XB_TMO      128
#define XB_XCNT(j)  (256  + 64 * (j))
#define XB_XSUB(j)  (1280 + 64 * (j))
#define XB_XGEN(j)  (2304 + 64 * (j))
#define XB_TOP      3328
#define XB_TOPGEN   3392
#define XCD_BAR_WORDS 3456
#define XB_SPIN_CAP (1u << 18)

__device__ __forceinline__ unsigned xb_ld(unsigned* p)              { return __hip_atomic_load(p, __ATOMIC_RELAXED, __HIP_MEMORY_SCOPE_AGENT); }
__device__ __forceinline__ unsigned xb_add(unsigned* p, unsigned v) { return __hip_atomic_fetch_add(p, v, __ATOMIC_RELAXED, __HIP_MEMORY_SCOPE_AGENT); }
__device__ __forceinline__ unsigned xb_xcc_id() { return (unsigned)__builtin_amdgcn_s_getreg((3 << 11) | 20) & 0xFu; }
#define XB_SPIN(cond, bar) do { unsigned _sp = 0; while (cond) { __builtin_amdgcn_s_sleep(1); \
    if ((++_sp & 255u) == 0u) { if (xb_ld(&(bar)[XB_TMO])) break; if (_sp > XB_SPIN_CAP) { atomicAdd(&(bar)[XB_TMO], 1u); break; } } } } while (0)

struct XcdBarrier {
    unsigned* bar; unsigned x;
    volatile LAS unsigned* st;
};

__device__ __forceinline__ XcdBarrier xcd_barrier_post(unsigned* bar, volatile LAS unsigned* st) {
    XcdBarrier b; b.bar = bar; b.x = xb_xcc_id(); b.st = st;
    if (threadIdx.x == 0) (void)xb_add(&bar[XB_XCNT(b.x)], 1u);
    return b;
}
__device__ __forceinline__ void xcd_barrier_complete(unsigned* bar, unsigned x, unsigned& nloc, unsigned& nx) {
    const unsigned G = gridDim.x * gridDim.y * gridDim.z;
    unsigned sum, cnt, mine, sp = 0u;
    for (;;) {
        sum = 0u; cnt = 0u; mine = 0u;
#pragma unroll
        for (unsigned j = 0; j < 16; ++j) { const unsigned c = xb_ld(&bar[XB_XCNT(j)]); sum += c; cnt += (c > 0u) ? 1u : 0u; mine = (j == x) ? c : mine; }
        if (sum == G) break;
        __builtin_amdgcn_s_sleep(1);
        if ((++sp & 255u) == 0u) { if (xb_ld(&bar[XB_TMO])) break; if (sp > XB_SPIN_CAP) { atomicAdd(&bar[XB_TMO], 1u); break; } }
    }
    nloc = mine > 0u ? mine : 1u; nx = cnt > 0u ? cnt : 1u;
}

__device__ __forceinline__ void xcd_barrier(const XcdBarrier& b) {
    asm volatile("s_waitcnt vmcnt(0)" ::: "memory");
    __syncthreads();
    if (threadIdx.x == 0) {
        unsigned* bar = b.bar;
        __builtin_amdgcn_s_waitcnt(0);
        unsigned nloc = b.st[0], nx = b.st[1];
        if (nloc == 0u) { xcd_barrier_complete(bar, b.x, nloc, nx); b.st[0] = nloc; b.st[1] = nx; }
        const unsigned old = xb_add(&bar[XB_XSUB(b.x)], 1u);
        const unsigned gen = old / nloc;
        if (old + 1u == (gen + 1u) * nloc) {
            __builtin_amdgcn_fence(__ATOMIC_RELEASE, "agent");
            asm volatile("s_waitcnt vmcnt(0)" ::: "memory");
            const unsigned og = xb_add(&bar[XB_TOP], 1u);
            const unsigned tg = og / nx;
            if (og + 1u == (tg + 1u) * nx) xb_add(&bar[XB_TOPGEN], 1u);
            else XB_SPIN(xb_ld(&bar[XB_TOPGEN]) == tg, bar);
            __builtin_amdgcn_fence(__ATOMIC_ACQUIRE, "agent");
            xb_add(&bar[XB_XGEN(b.x)], 1u);
            asm volatile("s_waitcnt vmcnt(0)" ::: "memory");
        } else {
            XB_SPIN(xb_ld(&bar[XB_XGEN(b.x)]) == gen, bar);
            __builtin_amdgcn_fence(__ATOMIC_ACQUIRE, "agent");
            asm volatile("s_waitcnt vmcnt(0)" ::: "memory");
        }
    }
    __syncthreads();
}

struct Args { const float* in[N_INPUTS]; float* out; unsigned char* ws; int ph_lo, ph_hi; };
static_assert(sizeof(Args) == 34 * 8 + 8, "Args has no holes");

__device__ __forceinline__ float wave_sum(float v) {
#pragma unroll
    for (int o = 1; o < 64; o <<= 1) v += __shfl_xor(v, o);
    return v;
}

template <int KIND>
__device__ __forceinline__ void p0_item(const float* W0, const float* W1, int K, int Nsrc, const float* gain, bf16* WT, LAS float* scr, int item, int nblk, int lane) {
    const int kb = item / nblk, nb = item % nblk, k0 = 64 * kb, n0 = 32 * nb;
    if (KIND == 2 && n0 >= 3072) {
        const int np = n0 + (lane & 31);
        int col = 0; bool valid = true;
        if (np < 3088) col = 1024 + (np - 3072); else if (np < NIN) col = np; else valid = false;
        float vv[32];
#pragma unroll
        for (int i = 0; i < 32; ++i) vv[i] = W0[(size_t)(k0 + 2 * i + (lane >> 5)) * Nsrc + col];
#pragma unroll
        for (int i = 0; i < 32; ++i) { const int kk = 2 * i + (lane >> 5); float v = valid ? vv[i] : 0.f; if (gain) v *= gain[k0 + kk]; scr[kk * 33 + (lane & 31)] = v; }
    } else {
        const float* W = W0; int col0 = n0;
        if (KIND == 0) { const int pn = n0 >> 8, bj = (n0 >> 7) & 1, jj = n0 & 127; W = bj ? W1 : W0; col0 = pn * 128 + jj; }
        if (KIND == 2) col0 = (n0 < 1024) ? n0 : n0 + 16;
        const int kr = lane >> 3, nq = lane & 7;
        f32x4 vv[8]; float gv[8];
#pragma unroll
        for (int i = 0; i < 8; ++i) vv[i] = *(const f32x4*)(W + (size_t)(k0 + 8 * i + kr) * Nsrc + col0 + 4 * nq);
#pragma unroll
        for (int i = 0; i < 8; ++i) gv[i] = gain ? gain[k0 + 8 * i + kr] : 1.0f;
#pragma unroll
        for (int i = 0; i < 8; ++i) { LAS float* sp = scr + (8 * i + kr) * 33 + 4 * nq; const f32x4 v = vv[i] * gv[i]; sp[0] = v[0]; sp[1] = v[1]; sp[2] = v[2]; sp[3] = v[3]; }
    }
    LDS_WAIT(); asm volatile("" ::: "memory");
    const int c = lane & 7;
#pragma unroll
    for (int j = 0; j < 4; ++j) { const int n = (lane >> 3) + 8 * j; const LAS float* s = scr + (8 * c) * 33 + n;
        v4u o; o.x = cvtpk(s[0 * 33], s[1 * 33]); o.y = cvtpk(s[2 * 33], s[3 * 33]); o.z = cvtpk(s[4 * 33], s[5 * 33]); o.w = cvtpk(s[6 * 33], s[7 * 33]);
        *(v4u*)(WT + (size_t)(n0 + n) * K + k0 + 8 * c) = o; }
    LDS_WAIT(); asm volatile("" ::: "memory");
}
constexpr int IT_GU = (D / 64) * (NGU / 32), IT_D = (FF / 64) * (D / 32), IT_IN = (D / 64) * (NINP / 32), IT_OUT = (D / 64) * (D / 32);
constexpr int IT_LAYER = 2 * IT_GU + 2 * IT_D + IT_IN + IT_OUT;

__device__ __forceinline__ void convert_weights(const Args& A, LAS unsigned char* ldsl, int wave, int lane, int it_lo, int it_hi, int gw, int NGW) {
    LAS float* scr = (LAS float*)(ldsl + RING_OFF + wave * 16384);
    unsigned char* ws = A.ws;
    for (int it = it_lo + gw; it < it_hi; it += NGW) {
        const int l = it / IT_LAYER; int r = it % IT_LAYER;
        unsigned char* wl = ws + WS_W + (size_t)l * W_LAYER;
        if (r < IT_GU) { p0_item<0>(A.in[I_F1G] + (size_t)l * D * FF, A.in[I_F1U] + (size_t)l * D * FF, D, FF, A.in[I_F1N] + l * D, (bf16*)(wl + WO_GU1), scr, r, NGU / 32, lane); continue; } r -= IT_GU;
        if (r < IT_D) { p0_item<1>(A.in[I_F1D] + (size_t)l * D * FF, nullptr, FF, D, nullptr, (bf16*)(wl + WO_D1), scr, r, D / 32, lane); continue; } r -= IT_D;
        if (r < IT_IN) { p0_item<2>(A.in[I_WIN] + (size_t)l * D * NIN, nullptr, D, NIN, A.in[I_MIXN] + l * D, (bf16*)(wl + WO_IN), scr, r, NINP / 32, lane); continue; } r -= IT_IN;
        if (r < IT_OUT) { p0_item<1>(A.in[I_WOUT] + (size_t)l * D * D, nullptr, D, D, nullptr, (bf16*)(wl + WO_OUT), scr, r, D / 32, lane); continue; } r -= IT_OUT;
        if (r < IT_GU) { p0_item<0>(A.in[I_F2G] + (size_t)l * D * FF, A.in[I_F2U] + (size_t)l * D * FF, D, FF, A.in[I_F2N] + l * D, (bf16*)(wl + WO_GU2), scr, r, NGU / 32, lane); continue; } r -= IT_GU;
        p0_item<1>(A.in[I_F2D] + (size_t)l * D * FF, nullptr, FF, D, nullptr, (bf16*)(wl + WO_D2), scr, r, D / 32, lane);
    }
}
constexpr int IT_EARLY = DEPTH * IT_LAYER;
__device__ __forceinline__ void p0_prologue(const Args& A, LAS unsigned char* ldsl, int wave, int lane, int G) {
    const int gw = blockIdx.x * NWAVES + wave, NGW = G * NWAVES;
    unsigned char* ws = A.ws;
    convert_weights(A, ldsl, wave, lane, 0, IT_EARLY, gw, NGW);
    bf16* xb = (bf16*)(ws + WS_XB); float* rss = (float*)(ws + WS_RSS);
    for (int m = gw; m < M; m += NGW) {
        const float* src = (m < MP) ? A.in[I_XP] + (size_t)m * D : A.in[I_XS] + (size_t)(m - MP) * D;
        const f32x4* xr = (const f32x4*)src + lane; f32x4 v[4]; float s = 0.f;
#pragma unroll
        for (int j = 0; j < 4; ++j) v[j] = xr[64 * j];
        v2u* bo = (v2u*)(xb + (size_t)m * D) + lane;
#pragma unroll
        for (int j = 0; j < 4; ++j) { v2u w; w.x = pk2(v[j].x, v[j].y); w.y = pk2(v[j].z, v[j].w); bo[64 * j] = w;
            const float r0 = __builtin_bit_cast(float, w.x << 16), r1 = __builtin_bit_cast(float, w.x & 0xffff0000u), r2 = __builtin_bit_cast(float, w.y << 16), r3 = __builtin_bit_cast(float, w.y & 0xffff0000u);
            s += (r0 * r0 + r1 * r1) + (r2 * r2 + r3 * r3); }
        s = wave_sum(s);
        if (lane == 0) rss[m] = s;
    }
}

#ifndef MK_REP_S1
#define MK_REP_S1 1
#endif
#ifndef MK_REP_S3
#define MK_REP_S3 1
#endif
#ifndef MK_REP_S2SMP
#define MK_REP_S2SMP 1
#endif
struct MixP {
    const bf16* P; bf16* mixb; float* out; int l; float* DS; float* ESC; unsigned* subc;
    bf16* XC;
    const float *s_pool, *s_gla, *s_hgrn, *s_ssm, *s_conv;
    const float *pool_w, *pool_scale, *gla_wg, *gla_b, *gla_n, *lbl, *hg_n, *conv_w, *conv_b, *dt_b, *a_log, *ssm_d, *ssm_n;
};
typedef short bf16x8 __attribute__((ext_vector_type(8)));
constexpr int MIX_CONST_OFF = 113664;
#define MFMA16(a, b, c) __builtin_amdgcn_mfma_f32_16x16x32_bf16((a), (b), (c), 0, 0, 0)
template <int CTRL> __device__ __forceinline__ float dpp_shr1(float x) { return __builtin_bit_cast(float, __builtin_amdgcn_update_dpp(0x3f800000, __builtin_bit_cast(int, x), CTRL, 0xf, 0xf, false)); }
__device__ __forceinline__ bf16x8 frag16(const LAS unsigned char* p) { return *(const LAS bf16x8*)p; }
__device__ __forceinline__ bf16x8 frag8x2(const LAS unsigned char* p0, const LAS unsigned char* p1) { const v2u a = *(const LAS v2u*)p0, b = *(const LAS v2u*)p1; v4u w; w.x = a.x; w.y = a.y; w.z = b.x; w.w = b.y; return __builtin_bit_cast(bf16x8, w); }
__device__ __forceinline__ bf16x8 pack_frag(const f32x4 a, const f32x4 b) { v4u w; w.x = cvtpk(a[0], a[1]); w.y = cvtpk(a[2], a[3]); w.z = cvtpk(b[0], b[1]); w.w = cvtpk(b[2], b[3]); return __builtin_bit_cast(bf16x8, w); }
__device__ __forceinline__ float bfe(const v4u w, const int e) { const unsigned x = w[e >> 1]; return __builtin_bit_cast(float, (e & 1) ? (x & 0xffff0000u) : (x << 16)); }
__device__ __forceinline__ float bfe2(const v2u w, const int e) { const unsigned x = w[e >> 1]; return __builtin_bit_cast(float, (e & 1) ? (x & 0xffff0000u) : (x << 16)); }
__device__ __forceinline__ unsigned short bfbits(const v4u w, const int e) { const unsigned x = w[e >> 1]; return (unsigned short)((e & 1) ? (x >> 16) : (x & 0xffffu)); }

template <int K> struct GHL { static constexpr int RS = K * 2 + 16, OFF_Q = 0, OFF_K = 32 * RS, OFF_KT = 64 * RS, OFF_VT = OFF_KT + K * 80, OFF_E = OFF_VT + 64 * 80, OFF_O = OFF_E + K * 4, UNIT = OFF_O + 32 * 272; };
static_assert(GHL<64>::UNIT == 28416 && 4 * GHL<64>::UNIT <= MIX_CONST_OFF, "GLA/HGRN LDS map");

template <int K>
__device__ __forceinline__ void s2_gh_unit(LAS unsigned char* U, f32x4 (&S)[K / 16], const int cs, const int lane) {
    typedef GHL<K> G; constexpr int NS = K / 32, KT = K / 16;
    const int q = lane >> 4, r16 = lane & 15, c = 16 * cs + r16;
    const f32x4 z4 = {0.f, 0.f, 0.f, 0.f};
    const LAS unsigned char* vrow = U + G::OFF_VT + c * 80;
    bf16x8 kf0[NS], kf1[NS], qf0[NS], qf1[NS], qp0[NS], qp1[NS], ktf[KT]; f32x4 e4[KT];
#pragma unroll
    for (int kt = 0; kt < KT; ++kt) { ktf[kt] = frag16(U + G::OFF_KT + (16 * kt + r16) * 80 + (8 * q) * 2); e4[kt] = *(const LAS f32x4*)(U + G::OFF_E + (16 * kt + 4 * q) * 4); }
    const bf16x8 vn = frag16(vrow + (8 * q) * 2);
#pragma unroll
    for (int s = 0; s < NS; ++s) {
        const LAS unsigned char* qr0 = U + G::OFF_Q + r16 * G::RS + (32 * s + 4 * q) * 2; const LAS unsigned char* qr1 = qr0 + 16 * G::RS;
        qp0[s] = frag8x2(qr0, qr0 + 32); qp1[s] = frag8x2(qr1, qr1 + 32);
    }
#pragma unroll
    for (int s = 0; s < NS; ++s) {
        const int kb = (32 * s + 8 * q) * 2;
        kf0[s] = frag16(U + G::OFF_K + r16 * G::RS + kb); kf1[s] = frag16(U + G::OFF_K + (16 + r16) * G::RS + kb);
        qf0[s] = frag16(U + G::OFF_Q + r16 * G::RS + kb); qf1[s] = frag16(U + G::OFF_Q + (16 + r16) * G::RS + kb);
    }
    const bf16x8 vb = frag8x2(vrow + (4 * q) * 2, vrow + (16 + 4 * q) * 2);
    bf16x8 sb[NS];
#pragma unroll
    for (int s = 0; s < NS; ++s) sb[s] = pack_frag(S[2 * s], S[2 * s + 1]);
#pragma unroll
    for (int kt = 0; kt < KT; ++kt) { S[kt] = MFMA16(ktf[kt], vn, S[kt]); S[kt] = S[kt] * e4[kt]; }
    f32x4 X00 = z4, X01 = z4, X11 = z4;
#pragma unroll
    for (int s = 0; s < NS; ++s) { X00 = MFMA16(kf0[s], qf0[s], X00); X01 = MFMA16(kf0[s], qf1[s], X01); X11 = MFMA16(kf1[s], qf1[s], X11); }
    f32x4 o0 = z4, o1 = z4;
#pragma unroll
    for (int s = 0; s < NS; ++s) { o0 = MFMA16(qp0[s], sb[s], o0); o1 = MFMA16(qp1[s], sb[s], o1); }
#pragma unroll
    for (int r = 0; r < 4; ++r) if (4 * q + r > r16) { X00[r] = 0.f; X11[r] = 0.f; }
    const bf16x8 a0 = pack_frag(X00, z4), a1 = pack_frag(X01, X11);
    o0 = MFMA16(a0, vb, o0); o1 = MFMA16(a1, vb, o1);
    LAS float* ob = (LAS float*)(U + G::OFF_O);
#pragma unroll
    for (int r = 0; r < 4; ++r) { ob[(4 * q + r) * 68 + c] = o0[r]; ob[(16 + 4 * q + r) * 68 + c] = o1[r]; }
}

template <int MT>
__device__ __forceinline__ void chain_gh(LAS unsigned char* L, const MixP& C, const int h, const int b0, const bool smp, const int tid) {
    constexpr int K = (MT == 0) ? 32 : 64, KT = K / 16, NK = K / 4;
    typedef GHL<K> G;
    const int w = __builtin_amdgcn_readfirstlane(tid >> 6), lane = tid & 63;
    const int u1 = tid >> 7, t1 = tid & 31, kg = (tid >> 5) & 3;
    LAS float* cst = (LAS float*)(L + MIX_CONST_OFF);
    if (MT == 0) { cst[tid] = C.gla_wg[(tid >> 5) * 128 + h * 32 + (tid & 31)]; if (tid < 32) cst[512 + tid] = C.gla_b[h * 32 + tid]; }
    if (tid >= 64 && tid < 128) cst[600 + tid - 64] = ((MT == 0) ? C.gla_n : C.hg_n)[tid - 64];
    if (MT == 1) { if (tid < 64) cst[tid] = (C.l == 0) ? 0.f : sigmoid_f(C.lbl[256 + h * 64 + tid] - C.lbl[h * 64 + tid]); }
    __syncthreads();
    const float* sin = (MT == 0) ? C.s_gla : C.s_hgrn;
    const size_t o_p = (MT == 0) ? O_GLAP : O_HGP, o_s = (MT == 0) ? O_GLAS : O_HGS;
    f32x4 S[KT];
#pragma unroll
    for (int kt = 0; kt < KT; ++kt) S[kt] = (f32x4){0.f, 0.f, 0.f, 0.f};
    const int nsc = smp ? 1 : TP / 128;
    v4u rw0, rw1, rw2, rw3, rw4, rw5;
#define GH_LOAD_RAW(SC) do { const bool valid_ = smp ? (t1 < TS) : true; \
        const int row_ = smp ? (MP + (b0 + u1) * TS + (valid_ ? t1 : 0)) : (b0 * TP + (SC) * 128 + u1 * 32 + t1); \
        const bf16* prow_ = C.P + (size_t)row_ * NINP; \
        if (MT == 0) { rw0 = *(const v4u*)(prow_ + PC_GQ + h * 32 + 8 * kg); rw1 = *(const v4u*)(prow_ + PC_GK + h * 32 + 8 * kg); rw2 = *(const v4u*)(prow_ + PC_LR); rw3 = *(const v4u*)(prow_ + PC_LR + 8); \
                       rw4 = *(const v4u*)(prow_ + PC_GV + h * 64 + 16 * kg); rw5 = *(const v4u*)(prow_ + PC_GV + h * 64 + 16 * kg + 8); } \
        else { rw0 = *(const v4u*)(prow_ + PC_RQ + h * 64 + 16 * kg); rw1 = *(const v4u*)(prow_ + PC_RQ + h * 64 + 16 * kg + 8); rw2 = *(const v4u*)(prow_ + PC_RF + h * 64 + 16 * kg); rw3 = *(const v4u*)(prow_ + PC_RF + h * 64 + 16 * kg + 8); \
               rw4 = *(const v4u*)(prow_ + PC_RI + h * 64 + 16 * kg); rw5 = *(const v4u*)(prow_ + PC_RI + h * 64 + 16 * kg + 8); } } while (0)
    GH_LOAD_RAW(0);
    for (int sc = 0; sc < nsc; ++sc) {
#pragma unroll 1
        for (int rep1 = 0; rep1 < MK_REP_S1; ++rep1) {
            const bool valid = smp ? (t1 < TS) : true;
            LAS unsigned char* U = L + u1 * G::UNIT;
            float f[NK], kk[NK], qq[NK]; v4u vraw0 = rw4, vraw1 = rw5;
            if (MT == 0) {
                const v4u gq = rw0, gk = rw1, lr0 = rw2, lr1 = rw3;
                float lg[NK];
#pragma unroll
                for (int e = 0; e < NK; ++e) lg[e] = cst[512 + 8 * kg + e];
#pragma unroll
                for (int j = 0; j < 16; ++j) { const float lv = (j < 8) ? bfe(lr0, j) : bfe(lr1, j - 8);
                    const f32x4 w0 = *(const LAS f32x4*)(cst + j * 32 + 8 * kg), w1 = *(const LAS f32x4*)(cst + j * 32 + 8 * kg + 4);
                    lg[0] += lv * w0[0]; lg[1] += lv * w0[1]; lg[2] += lv * w0[2]; lg[3] += lv * w0[3]; lg[4] += lv * w1[0]; lg[5] += lv * w1[1]; lg[6] += lv * w1[2]; lg[7] += lv * w1[3]; }
#pragma unroll
                for (int e = 0; e < NK; ++e) { f[e] = __expf(logsigmoid_f(lg[e]) * (1.0f / 16.0f)); kk[e] = bfe(gk, e); qq[e] = bfe(gq, e) * 0.17677669529663687f; }
            } else {
                const v4u rq0 = rw0, rq1 = rw1, rf0 = rw2, rf1 = rw3;
#pragma unroll
                for (int e = 0; e < NK; ++e) { const float z = (e < 8) ? bfe(rf0, e) : bfe(rf1, e - 8), qv = (e < 8) ? bfe(rq0, e) : bfe(rq1, e - 8);
                    const float lb = cst[16 * kg + e], sg = sigmoid_f(z);
                    f[e] = lb + (1.f - lb) * sg; kk[e] = (1.f - lb) * (1.f - sg); qq[e] = qv; }
            }
            if (!valid) {
#pragma unroll
                for (int e = 0; e < NK; ++e) { f[e] = 1.f; kk[e] = 0.f; qq[e] = 0.f; }
                vraw0 = (v4u){0u, 0u, 0u, 0u}; vraw1 = vraw0;
            }
#pragma unroll
            for (int e = 0; e < NK; ++e) {
                float p = f[e];
                p *= dpp_shr1<0x111>(p); p *= dpp_shr1<0x112>(p); p *= dpp_shr1<0x114>(p); p *= dpp_shr1<0x118>(p);
                const float up = __shfl(p, (lane & 32) | 15);
                if (t1 >= 16) p *= up;
                f[e] = p;
            }
            float qt[NK], kt_[NK];
#pragma unroll
            for (int e = 0; e < NK; ++e) { qt[e] = qq[e] * f[e]; kt_[e] = kk[e] * __builtin_amdgcn_rcpf(fmaxf(f[e], 1e-30f)); }
#pragma unroll
            for (int e8 = 0; e8 < NK; e8 += 8) {
                v4u wq, wk;
                wq.x = cvtpk(qt[e8 + 0], qt[e8 + 1]); wq.y = cvtpk(qt[e8 + 2], qt[e8 + 3]); wq.z = cvtpk(qt[e8 + 4], qt[e8 + 5]); wq.w = cvtpk(qt[e8 + 6], qt[e8 + 7]);
                wk.x = cvtpk(kt_[e8 + 0], kt_[e8 + 1]); wk.y = cvtpk(kt_[e8 + 2], kt_[e8 + 3]); wk.z = cvtpk(kt_[e8 + 4], kt_[e8 + 5]); wk.w = cvtpk(kt_[e8 + 6], kt_[e8 + 7]);
                *(LAS v4u*)(U + G::OFF_Q + t1 * G::RS + (NK * kg + e8) * 2) = wq;
                *(LAS v4u*)(U + G::OFF_K + t1 * G::RS + (NK * kg + e8) * 2) = wk;
#pragma unroll
                for (int e = 0; e < 8; ++e) *(LAS unsigned short*)(U + G::OFF_KT + (NK * kg + e8 + e) * 80 + t1 * 2) = bfbits(wk, e);
            }
#pragma unroll
            for (int e = 0; e < 16; ++e) *(LAS unsigned short*)(U + G::OFF_VT + (16 * kg + e) * 80 + t1 * 2) = (e < 8) ? bfbits(vraw0, e) : bfbits(vraw1, e - 8);
            if (t1 == 31) {
#pragma unroll
                for (int e = 0; e < NK; ++e) *(LAS float*)(U + G::OFF_E + (NK * kg + e) * 4) = f[e];
            }
        }
        __syncthreads();
        const int tok3 = tid >> 2, cq3 = tid & 3, u3 = tok3 >> 5, i3 = tok3 & 31;
        const bool valid3 = smp ? (i3 < TS) : true;
        const int row3 = smp ? (MP + (b0 + u3) * TS + (valid3 ? i3 : 0)) : (b0 * TP + sc * 128 + tok3);
        v4u gg0, gg1;
        { const bf16* grow = C.P + (size_t)row3 * NINP + ((MT == 0) ? PC_GR : PC_RG) + h * 64 + 16 * cq3; gg0 = *(const v4u*)grow; gg1 = *(const v4u*)(grow + 8); }
        GH_LOAD_RAW((sc + 1 < nsc) ? sc + 1 : sc);
        if (!smp) {
            if (w < 4) {
#pragma unroll 1
                for (int u = 0; u < 4; ++u) s2_gh_unit<K>(L + u * G::UNIT, S, w, lane);
            }
        } else {
#pragma unroll 1
            for (int job = w; job < 16; job += 8) {
                const int u = job >> 2, cs = job & 3, q = lane >> 4, c = 16 * cs + (lane & 15);
                const size_t sb = ((size_t)(b0 + u) * 4 + h) * K * 64;
#pragma unroll
                for (int kt = 0; kt < KT; ++kt)
#pragma unroll
                    for (int r = 0; r < 4; ++r) S[kt][r] = sin[sb + (size_t)(16 * kt + 4 * q + r) * 64 + c];
                s2_gh_unit<K>(L + u * G::UNIT, S, cs, lane);
                float* so = C.out + o_s + (((size_t)C.l * BS + b0 + u) * 4 + h) * K * 64;
#pragma unroll
                for (int kt = 0; kt < KT; ++kt)
#pragma unroll
                    for (int r = 0; r < 4; ++r) so[(size_t)(16 * kt + 4 * q + r) * 64 + c] = S[kt][r];
            }
        }
        __syncthreads();
#pragma unroll 1
        for (int rep3 = 0; rep3 < MK_REP_S3; ++rep3) {
            const LAS float* ob = (const LAS float*)(L + u3 * G::UNIT + G::OFF_O) + i3 * 68 + 16 * cq3;
            f32x4 o[4]; float ss = 0.f;
#pragma unroll
            for (int j = 0; j < 4; ++j) { o[j] = *(const LAS f32x4*)(ob + 4 * j); ss += (o[j][0] * o[j][0] + o[j][1] * o[j][1]) + (o[j][2] * o[j][2] + o[j][3] * o[j][3]); }
            ss += __shfl_xor(ss, 1); ss += __shfl_xor(ss, 2);
            const float r = rsqrtf(ss * (1.0f / 64.0f) + 1e-6f);
            float res[16], nwv[16];
#pragma unroll
            for (int j = 0; j < 4; ++j) { const f32x4 t = *(const LAS f32x4*)(cst + 600 + 16 * cq3 + 4 * j); nwv[4 * j] = t[0]; nwv[4 * j + 1] = t[1]; nwv[4 * j + 2] = t[2]; nwv[4 * j + 3] = t[3]; }
#pragma unroll
            for (int e = 0; e < 16; ++e) { const float gv = (e < 8) ? bfe(gg0, e) : bfe(gg1, e - 8); res[e] = o[e >> 2][e & 3] * r * nwv[e] * gv; }
            if (valid3) {
                v4u w0, w1;
                w0.x = cvtpk(res[0], res[1]); w0.y = cvtpk(res[2], res[3]); w0.z = cvtpk(res[4], res[5]); w0.w = cvtpk(res[6], res[7]);
                w1.x = cvtpk(res[8], res[9]); w1.y = cvtpk(res[10], res[11]); w1.z = cvtpk(res[12], res[13]); w1.w = cvtpk(res[14], res[15]);
                bf16* mo = C.mixb + (size_t)row3 * D + ((MT == 0) ? MC_GLA : MC_HGRN) + h * 64 + 16 * cq3;
                *(v4u*)mo = w0; *(v4u*)(mo + 8) = w1;
            }
        }
    }
#undef GH_LOAD_RAW
    if (!smp && w < 4) {
        const int q = lane >> 4, c = 16 * w + (lane & 15);
        float* so = C.out + o_p + (((size_t)C.l * BP + b0) * 4 + h) * K * 64;
#pragma unroll
        for (int kt = 0; kt < KT; ++kt)
#pragma unroll
            for (int r = 0; r < 4; ++r) so[(size_t)(16 * kt + 4 * q + r) * 64 + c] = S[kt][r];
    }
    __syncthreads();
}

namespace SL { constexpr int OFF_C = 0, OFF_B = 8704, OFF_BT = 17408, OFF_XT = 27648, OFF_TAB = 37888, OFF_Y = 39168, UNIT = 56064; }
static_assert(2 * SL::UNIT <= MIX_CONST_OFF, "SSD LDS map");

__device__ __forceinline__ void s2_ssd_unit(LAS unsigned char* U, f32x4 (&S)[8], const int hh, const int ps, const int lane, const float Dh) {
    const int q = lane >> 4, r16 = lane & 15, p = 16 * ps + r16;
    const f32x4 z4 = {0.f, 0.f, 0.f, 0.f};
    const LAS float* tab = (const LAS float*)(U + SL::OFF_TAB) + hh * 160;
    const LAS unsigned char* xrow = U + SL::OFF_XT + hh * 5120 + p * 80;
    bf16x8 btf[8];
#pragma unroll
    for (int nt = 0; nt < 8; ++nt) btf[nt] = frag16(U + SL::OFF_BT + (16 * nt + r16) * 80 + (8 * q) * 2);
    const v4u xn = *(const LAS v4u*)(xrow + (8 * q) * 2);
    const f32x4 w0 = *(const LAS f32x4*)(tab + 96 + 8 * q), w1 = *(const LAS f32x4*)(tab + 96 + 8 * q + 4);
    const float eL = tab[128];
    bf16x8 cp0[4], cp1[4];
#pragma unroll
    for (int s = 0; s < 4; ++s) { const LAS unsigned char* cr0 = U + SL::OFF_C + r16 * 272 + (32 * s + 4 * q) * 2; const LAS unsigned char* cr1 = cr0 + 16 * 272; cp0[s] = frag8x2(cr0, cr0 + 32); cp1[s] = frag8x2(cr1, cr1 + 32); }
    bf16x8 sb[4];
#pragma unroll
    for (int s = 0; s < 4; ++s) sb[s] = pack_frag(S[2 * s], S[2 * s + 1]);
    const f32x4 xa = {bfe(xn, 0) * w0[0], bfe(xn, 1) * w0[1], bfe(xn, 2) * w0[2], bfe(xn, 3) * w0[3]}, xc = {bfe(xn, 4) * w1[0], bfe(xn, 5) * w1[1], bfe(xn, 6) * w1[2], bfe(xn, 7) * w1[3]};
    const bf16x8 xh = pack_frag(xa, xc);
#pragma unroll
    for (int nt = 0; nt < 8; ++nt) S[nt] = MFMA16(btf[nt], xh, S[nt] * eL);
    f32x4 X00 = z4, X01 = z4, X11 = z4;
#pragma unroll
    for (int s = 0; s < 4; ++s) {
        const int nb = (32 * s + 8 * q) * 2;
        const bf16x8 b0 = frag16(U + SL::OFF_B + r16 * 272 + nb), b1 = frag16(U + SL::OFF_B + (16 + r16) * 272 + nb);
        const bf16x8 c0 = frag16(U + SL::OFF_C + r16 * 272 + nb), c1 = frag16(U + SL::OFF_C + (16 + r16) * 272 + nb);
        X00 = MFMA16(b0, c0, X00); X01 = MFMA16(b0, c1, X01); X11 = MFMA16(b1, c1, X11);
    }
    f32x4 y20 = z4, y21 = z4;
#pragma unroll
    for (int s = 0; s < 4; ++s) { y20 = MFMA16(cp0[s], sb[s], y20); y21 = MFMA16(cp1[s], sb[s], y21); }
    const float ci0 = tab[r16], ci1 = tab[16 + r16];
    const f32x4 cj0 = *(const LAS f32x4*)(tab + 4 * q), cj1 = *(const LAS f32x4*)(tab + 16 + 4 * q);
#pragma unroll
    for (int r = 0; r < 4; ++r) {
        X00[r] = (4 * q + r > r16) ? 0.f : X00[r] * __expf(fminf(ci0 - cj0[r], 0.f));
        X01[r] = X01[r] * __expf(fminf(ci1 - cj0[r], 0.f));
        X11[r] = (4 * q + r > r16) ? 0.f : X11[r] * __expf(fminf(ci1 - cj1[r], 0.f));
    }
    const bf16x8 a0 = pack_frag(X00, z4), a1 = pack_frag(X01, X11);
    bf16x8 xb; f32x4 ux0, ux1;
    { const v2u xl = *(const LAS v2u*)(xrow + (4 * q) * 2), xh_ = *(const LAS v2u*)(xrow + (16 + 4 * q) * 2);
      const f32x4 d0 = *(const LAS f32x4*)(tab + 64 + 4 * q), d1 = *(const LAS f32x4*)(tab + 64 + 16 + 4 * q);
      const f32x4 fa = {__builtin_bit_cast(float, xl.x << 16) * d0[0], __builtin_bit_cast(float, xl.x & 0xffff0000u) * d0[1], __builtin_bit_cast(float, xl.y << 16) * d0[2], __builtin_bit_cast(float, xl.y & 0xffff0000u) * d0[3]};
      const f32x4 fb = {__builtin_bit_cast(float, xh_.x << 16) * d1[0], __builtin_bit_cast(float, xh_.x & 0xffff0000u) * d1[1], __builtin_bit_cast(float, xh_.y << 16) * d1[2], __builtin_bit_cast(float, xh_.y & 0xffff0000u) * d1[3]};
      xb = pack_frag(fa, fb);
      ux0 = (f32x4){__builtin_bit_cast(float, xl.x << 16), __builtin_bit_cast(float, xl.x & 0xffff0000u), __builtin_bit_cast(float, xl.y << 16), __builtin_bit_cast(float, xl.y & 0xffff0000u)} * Dh;
      ux1 = (f32x4){__builtin_bit_cast(float, xh_.x << 16), __builtin_bit_cast(float, xh_.x & 0xffff0000u), __builtin_bit_cast(float, xh_.y << 16), __builtin_bit_cast(float, xh_.y & 0xffff0000u)} * Dh; }
    const f32x4 y10 = MFMA16(a0, xb, z4), y11 = MFMA16(a1, xb, z4);
    const f32x4 e0 = *(const LAS f32x4*)(tab + 32 + 4 * q), e1 = *(const LAS f32x4*)(tab + 32 + 16 + 4 * q);
    LAS float* yb = (LAS float*)(U + SL::OFF_Y);
#pragma unroll
    for (int r = 0; r < 4; ++r) { yb[(4 * q + r) * 132 + hh * 64 + p] = y10[r] + e0[r] * y20[r] + ux0[r]; yb[(16 + 4 * q + r) * 132 + hh * 64 + p] = y11[r] + e1[r] * y21[r] + ux1[r]; }
}

__device__ __forceinline__ void s2_ssd_state(LAS unsigned char* U, f32x4 (&S)[8], const int hh, const int ps, const int lane) {
    const int q = lane >> 4, r16 = lane & 15, p = 16 * ps + r16;
    const LAS float* tab = (const LAS float*)(U + SL::OFF_TAB) + hh * 160;
    const LAS unsigned char* xrow = U + SL::OFF_XT + hh * 5120 + p * 80;
    bf16x8 btf[8];
#pragma unroll
    for (int nt = 0; nt < 8; ++nt) btf[nt] = frag16(U + SL::OFF_BT + (16 * nt + r16) * 80 + (8 * q) * 2);
    const v4u xn = *(const LAS v4u*)(xrow + (8 * q) * 2);
    const f32x4 w0 = *(const LAS f32x4*)(tab + 96 + 8 * q), w1 = *(const LAS f32x4*)(tab + 96 + 8 * q + 4);
    const float eL = tab[128];
    const f32x4 xa = {bfe(xn, 0) * w0[0], bfe(xn, 1) * w0[1], bfe(xn, 2) * w0[2], bfe(xn, 3) * w0[3]}, xc = {bfe(xn, 4) * w1[0], bfe(xn, 5) * w1[1], bfe(xn, 6) * w1[2], bfe(xn, 7) * w1[3]};
    const bf16x8 xh = pack_frag(xa, xc);
#pragma unroll
    for (int nt = 0; nt < 8; ++nt) S[nt] = MFMA16(btf[nt], xh, S[nt] * eL);
}

__device__ __forceinline__ void conv_phase(const MixP& C, const int G, const int tid) {
    constexpr int NTASK = (M / 8) * 96;
    for (int task = blockIdx.x * NTHREADS + tid; task < NTASK; task += G * NTHREADS) {
        const int g8 = task / 96, bl = task - g8 * 96, ch0 = 8 * bl, row0 = 8 * g8;
        const bool smp = g8 >= MP / 8;
        const int bsm = smp ? g8 - MP / 8 : 0;
        const bool head = smp ? true : ((row0 & (TP - 1)) == 0);
#pragma unroll 1
        for (int hf = 0; hf < 2; ++hf) {
            const int chh = ch0 + 4 * hf;
            v2u xr[11];
#pragma unroll
            for (int i = 0; i < 11; ++i) { int r = row0 - 3 + i; if (head && i < 3) r = row0; xr[i] = *(const v2u*)(C.P + (size_t)r * NINP + PC_XBC + chh); }
            f32x4 st[3];
#pragma unroll
            for (int r = 0; r < 3; ++r) st[r] = (f32x4){0.f, 0.f, 0.f, 0.f};
            if (smp) {
#pragma unroll
                for (int r = 0; r < 3; ++r) st[r] = *(const f32x4*)(C.s_conv + ((size_t)bsm * 3 + r) * 768 + chh);
            }
            float wt[4][4], bs[4];
#pragma unroll
            for (int j = 0; j < 4; ++j) { const f32x4 wa = *(const f32x4*)(C.conv_w + j * 768 + chh);
#pragma unroll
                for (int c = 0; c < 4; ++c) wt[j][c] = wa[c]; }
            { const f32x4 wa = *(const f32x4*)(C.conv_b + chh);
#pragma unroll
              for (int c = 0; c < 4; ++c) bs[c] = wa[c]; }
            float p3[4], p2[4], p1[4];
#pragma unroll
            for (int c = 0; c < 4; ++c) { p3[c] = head ? st[0][c] : bfe2(xr[0], c); p2[c] = head ? st[1][c] : bfe2(xr[1], c); p1[c] = head ? st[2][c] : bfe2(xr[2], c); }
#pragma unroll
            for (int et = 0; et < 8; ++et) {
                float val[4];
#pragma unroll
                for (int c = 0; c < 4; ++c) { const float cur = bfe2(xr[et + 3], c);
                    val[c] = silu_f(bs[c] + wt[0][c] * p3[c] + wt[1][c] * p2[c] + wt[2][c] * p1[c] + wt[3][c] * cur); p3[c] = p2[c]; p2[c] = p1[c]; p1[c] = cur; }
                v2u wv; wv.x = cvtpk(val[0], val[1]); wv.y = cvtpk(val[2], val[3]);
                *(v2u*)(C.XC + (size_t)(row0 + et) * 768 + chh) = wv;
            }
        }
    }
}

__device__ __forceinline__ void chain_ssd(LAS unsigned char* L, const MixP& C, const int g, const int b0, const int mode, const int sc0, const int tid) {
    const bool smp = (mode == 1);
    const int w = __builtin_amdgcn_readfirstlane(tid >> 6), lane = tid & 63;
    const int hh2 = w >> 2, ps = w & 3, h2 = 2 * g + hh2;
    const float A0 = -__expf(C.a_log[2 * g]), A1 = -__expf(C.a_log[2 * g + 1]), dtb0 = C.dt_b[2 * g], dtb1 = C.dt_b[2 * g + 1], D0 = C.ssm_d[2 * g], D1 = C.ssm_d[2 * g + 1];
    f32x4 S[8];
#pragma unroll
    for (int nt = 0; nt < 8; ++nt) S[nt] = (f32x4){0.f, 0.f, 0.f, 0.f};
    const int cu1 = tid >> 8, ct = tid & 255;
    const int tg1 = ct / 48, bl1 = ct - tg1 * 48, lc01 = 8 * bl1;
    const int ch01 = (bl1 < 16) ? 128 * g + lc01 : (bl1 < 32) ? 256 + 128 * g + (lc01 - 128) : 512 + 128 * g + (lc01 - 256);
    const int tbase = smp ? 0 : sc0 * 64 + cu1 * 32;
    const int rowbase = smp ? MP + (b0 + cu1) * TS : b0 * TP;
    v4u xr[8]; bf16 sdraw = 0;
    if (ct < 192) { const bf16* xsrc = C.XC + (size_t)(rowbase + (smp ? 0 : tbase + 8 * tg1)) * 768 + ch01;
#pragma unroll
        for (int et = 0; et < 8; ++et) xr[et] = *(const v4u*)(xsrc + (size_t)et * 768); }
    else { const int t1 = ct & 31, hh = (ct - 192) >> 5; const bool valid = smp ? (t1 < TS) : true;
        sdraw = C.P[(size_t)(rowbase + tbase + (valid ? t1 : 0)) * NINP + PC_DT + 2 * g + hh]; }
    const int tok3 = tid >> 3, c83 = tid & 7, u3 = tok3 >> 5, i3 = tok3 & 31;
    const bool valid3 = smp ? (i3 < TS) : true;
    const int row3 = smp ? (MP + (b0 + u3) * TS + (valid3 ? i3 : 0)) : (b0 * TP + sc0 * 64 + tok3);
    v4u zz0, zz1;
    { const bf16* zrow = C.P + (size_t)row3 * NINP + PC_SZ + 128 * g + 16 * c83; zz0 = *(const v4u*)zrow; zz1 = *(const v4u*)(zrow + 8); }
    LAS float* cst = (LAS float*)(L + MIX_CONST_OFF);
    if (tid < 128) cst[tid] = C.ssm_n[128 * g + tid];
    {
        LAS unsigned char* U = L + cu1 * SL::UNIT;
        if (ct < 192) {
            const int tg = tg1, bl = bl1, lc0 = lc01;
            const bool tok_ok = smp ? (tg == 0) : true;
            if (!tok_ok) {
#pragma unroll
                for (int et = 0; et < 8; ++et) xr[et] = (v4u){0u, 0u, 0u, 0u};
            }
            if (bl >= 16) {
                LAS unsigned char* rb = U + ((bl < 32) ? SL::OFF_B + (lc0 - 128) * 2 : SL::OFF_C + (lc0 - 256) * 2) + (8 * tg) * 272;
#pragma unroll
                for (int et = 0; et < 8; ++et) *(LAS v4u*)(rb + et * 272) = xr[et];
            }
            if (bl < 32) {
                LAS unsigned char* tb = U + ((bl < 16) ? SL::OFF_XT + lc0 * 80 : SL::OFF_BT + (lc0 - 128) * 80) + 16 * tg;
#pragma unroll
                for (int c = 0; c < 8; ++c) { v4u o;
#pragma unroll
                    for (int k = 0; k < 4; ++k) { const unsigned a = xr[2 * k][c >> 1], b = xr[2 * k + 1][c >> 1]; o[k] = (c & 1) ? ((a >> 16) | (b & 0xffff0000u)) : ((a & 0xffffu) | (b << 16)); }
                    *(LAS v4u*)(tb + c * 80) = o; }
            }
        } else {
            const int t1 = ct & 31, hh = (ct - 192) >> 5;
            const bool valid = smp ? (t1 < TS) : true;
            const float dt = valid ? softplus_f(bf2f(sdraw) + ((hh == 0) ? dtb0 : dtb1)) : 0.f;
            float c0 = dt * ((hh == 0) ? A0 : A1);
#pragma unroll
            for (int d = 1; d < 32; d <<= 1) { const float a = __shfl_up(c0, d, 32); if (t1 >= d) c0 += a; }
            const float cl = __shfl(c0, 31, 32);
            LAS float* tab = (LAS float*)(U + SL::OFF_TAB) + hh * 160;
            tab[t1] = c0; tab[32 + t1] = __expf(c0); tab[64 + t1] = dt; tab[96 + t1] = dt * __expf(cl - c0);
            if (t1 == 31) tab[128] = __expf(cl);
        }
    }
    __syncthreads();
    const int q2 = lane >> 4, p2 = 16 * ps + (lane & 15);
    float* dsp = C.DS + ((((size_t)(b0 * 2 + g) * (TP / 64) + sc0) * 2 + hh2) * 64 + p2) * 128;
    if (mode == 2) {
#pragma unroll 1
        for (int u = 0; u < 2; ++u) s2_ssd_state(L + u * SL::UNIT, S, hh2, ps, lane);
#pragma unroll
        for (int nt = 0; nt < 8; ++nt) *(f32x4*)(dsp + 16 * nt + 4 * q2) = S[nt];
        if (ps == 0 && lane == 0) C.ESC[((size_t)(b0 * 2 + g) * (TP / 64) + sc0) * 2 + hh2] = ((const LAS float*)(L + SL::OFF_TAB))[hh2 * 160 + 128] * ((const LAS float*)(L + SL::UNIT + SL::OFF_TAB))[hh2 * 160 + 128];
    } else if (mode == 3) {
#pragma unroll
        for (int nt = 0; nt < 8; ++nt) S[nt] = *(const f32x4*)(dsp + 16 * nt + 4 * q2);
#pragma unroll 1
        for (int u = 0; u < 2; ++u) s2_ssd_unit(L + u * SL::UNIT, S, hh2, ps, lane, (hh2 == 0) ? D0 : D1);
    } else {
#pragma unroll 1
        for (int u = 0; u < 2; ++u) {
            const float* sp = C.s_ssm + (((size_t)(b0 + u) * 4 + h2) * 64 + p2) * 128;
#pragma unroll
            for (int nt = 0; nt < 8; ++nt) S[nt] = *(const f32x4*)(sp + 16 * nt + 4 * q2);
            s2_ssd_unit(L + u * SL::UNIT, S, hh2, ps, lane, (hh2 == 0) ? D0 : D1);
            float* so = C.out + O_SSMS + ((((size_t)C.l * BS + b0 + u) * 4 + h2) * 64 + p2) * 128;
#pragma unroll
            for (int nt = 0; nt < 8; ++nt) *(f32x4*)(so + 16 * nt + 4 * q2) = S[nt];
        }
    }
    __syncthreads();
    if (mode != 2) {
        const LAS float* yb = (const LAS float*)(L + u3 * SL::UNIT + SL::OFF_Y) + i3 * 132 + 16 * c83;
        float y[16]; float ss = 0.f;
#pragma unroll
        for (int j = 0; j < 4; ++j) { const f32x4 v = *(const LAS f32x4*)(yb + 4 * j);
#pragma unroll
            for (int e = 0; e < 4; ++e) { const int ee = 4 * j + e; const float zv = (ee < 8) ? bfe(zz0, ee) : bfe(zz1, ee - 8); y[ee] = v[e] * zv; ss += y[ee] * y[ee]; } }
        ss += __shfl_xor(ss, 1); ss += __shfl_xor(ss, 2); ss += __shfl_xor(ss, 4);
        const float r = rsqrtf(ss * (1.0f / 128.0f) + 1e-6f);
        if (valid3) {
            float nwv[16];
#pragma unroll
            for (int j = 0; j < 4; ++j) { const f32x4 t = *(const LAS f32x4*)(cst + 16 * c83 + 4 * j); nwv[4 * j] = t[0]; nwv[4 * j + 1] = t[1]; nwv[4 * j + 2] = t[2]; nwv[4 * j + 3] = t[3]; }
            v4u w0, w1;
            w0.x = cvtpk(y[0] * r * nwv[0], y[1] * r * nwv[1]); w0.y = cvtpk(y[2] * r * nwv[2], y[3] * r * nwv[3]); w0.z = cvtpk(y[4] * r * nwv[4], y[5] * r * nwv[5]); w0.w = cvtpk(y[6] * r * nwv[6], y[7] * r * nwv[7]);
            w1.x = cvtpk(y[8] * r * nwv[8], y[9] * r * nwv[9]); w1.y = cvtpk(y[10] * r * nwv[10], y[11] * r * nwv[11]); w1.z = cvtpk(y[12] * r * nwv[12], y[13] * r * nwv[13]); w1.w = cvtpk(y[14] * r * nwv[14], y[15] * r * nwv[15]);
            bf16* mo = C.mixb + (size_t)row3 * D + MC_SSM + 128 * g + 16 * c83;
            *(v4u*)mo = w0; *(v4u*)(mo + 8) = w1;
        }
    }
    __syncthreads();
}

__device__ __forceinline__ void ssd_scan(const MixP& C, const int wg, const int nwgs, const int tid) {
    constexpr int NSC = TP / 64, NEL = BP * 2 * 2 * 8192;
    for (int idx = wg * NTHREADS + tid; idx < NEL; idx += nwgs * NTHREADS) {
        const int e = idx & 8191, bgh = idx >> 13, hh = bgh & 1, bg = bgh >> 1;
        float* dp = C.DS + ((size_t)bg * NSC * 2 + hh) * 8192 + e;
        const float* ep = C.ESC + (size_t)bg * NSC * 2 + hh;
        float d[NSC], E[NSC];
#pragma unroll
        for (int sc = 0; sc < NSC; ++sc) { d[sc] = dp[(size_t)sc * 2 * 8192]; E[sc] = ep[sc * 2]; }
        float s = 0.f;
#pragma unroll
        for (int sc = 0; sc < NSC; ++sc) { dp[(size_t)sc * 2 * 8192] = s; s = E[sc] * s + d[sc]; }
        const int b = bg >> 1, g = bg & 1;
        C.out[O_SSMP + (((size_t)C.l * BP + b) * 4 + 2 * g + hh) * 8192 + e] = s;
    }
}

__device__ __forceinline__ void sub_barrier(unsigned* cnt, const unsigned nwg) {
    asm volatile("s_waitcnt vmcnt(0)" ::: "memory");
    __syncthreads();
    if (threadIdx.x == 0) {
        __builtin_amdgcn_fence(__ATOMIC_RELEASE, "agent");
        asm volatile("s_waitcnt vmcnt(0)" ::: "memory");
        (void)__hip_atomic_fetch_add(cnt, 1u, __ATOMIC_RELAXED, __HIP_MEMORY_SCOPE_AGENT);
        unsigned sp = 0;
        while (__hip_atomic_load(cnt, __ATOMIC_RELAXED, __HIP_MEMORY_SCOPE_AGENT) < nwg) { __builtin_amdgcn_s_sleep(2); if (++sp > (1u << 22)) break; }
        __builtin_amdgcn_fence(__ATOMIC_ACQUIRE, "agent");
        asm volatile("s_waitcnt vmcnt(0)" ::: "memory");
    }
    __syncthreads();
}
__device__ __forceinline__ void pool_item(LAS unsigned char* L, const MixP& C, const int tile, const int tid) {
    constexpr int DF_OFF = 40960, WT_OFF = 74752;
    const int m0 = tile * 64;
    {
        f32x4 wv[8];
#pragma unroll
        for (int i = 0; i < 8; ++i) { const int e4 = tid + NTHREADS * i; wv[i] = *(const f32x4*)(C.pool_w + (size_t)e4 * 4); }
#pragma unroll
        for (int i = 0; i < 8; ++i) { const int e4 = tid + NTHREADS * i, d0 = (e4 & 15) * 4, c = (e4 >> 4) & 63, g = e4 >> 10;
            LAS unsigned char* wp = L + WT_OFF + g * 9216 + d0 * 144 + c * 2;
            const unsigned p01 = cvtpk(wv[i][0], wv[i][1]), p23 = cvtpk(wv[i][2], wv[i][3]);
            *(LAS unsigned short*)(wp) = (unsigned short)(p01 & 0xffffu); *(LAS unsigned short*)(wp + 144) = (unsigned short)(p01 >> 16);
            *(LAS unsigned short*)(wp + 288) = (unsigned short)(p23 & 0xffffu); *(LAS unsigned short*)(wp + 432) = (unsigned short)(p23 >> 16); }
    }
    if (m0 < MP) {
        const int tt0 = m0 & (TP - 1);
#pragma unroll
        for (int idx = tid; idx < 79 * 32; idx += NTHREADS) {
            const int r = idx >> 5, c8 = idx & 31, tr = tt0 - 15 + r, trc = tr < 0 ? 0 : tr;
            const v4u ld = *(const v4u*)(C.P + (size_t)(m0 - tt0 + trc) * NINP + PC_PX + 8 * c8);
            *(LAS v4u*)(L + r * 512 + c8 * 16) = (tr >= 0) ? ld : (v4u){0u, 0u, 0u, 0u};
        }
        __syncthreads();
        {
            const int c = tid & 255, th = tid >> 8, g = c >> 6, w = 2 << g, tA = 32 * th;
            const LAS unsigned short* col = (const LAS unsigned short*)L + c;
            float s = 0.f;
            for (int j = 1; j < w; ++j) s += bf2f(col[(tA + 15 - j) * 256]);
            for (int t = tA; t < tA + 32; ++t) {
                const float x = bf2f(col[(t + 15) * 256]); s += x;
                const int tt = tt0 + t, cnt = (tt + 1 < w) ? tt + 1 : w;
                *(LAS unsigned short*)(L + DF_OFF + t * 528 + c * 2) = (unsigned short)(cvtpk(s * __builtin_amdgcn_rcpf((float)cnt) - x, 0.f) & 0xffffu);
                s -= bf2f(col[(t + 16 - w) * 256]);
            }
        }
    } else {
#pragma unroll 1
        for (int task = tid; task < 8 * 256; task += NTHREADS) {
            const int bb = task >> 8, c = task & 255, g = c >> 6, w = 2 << g, bg = (m0 - MP) / TS + bb;
            float xs[23];
#pragma unroll
            for (int r = 0; r < 15; ++r) xs[r] = C.s_pool[((size_t)bg * 15 + r) * 256 + c];
            bf16 xraw[8];
#pragma unroll
            for (int t = 0; t < 8; ++t) xraw[t] = C.P[(size_t)(m0 + bb * TS + t) * NINP + PC_PX + c];
#pragma unroll
            for (int t = 0; t < 8; ++t) xs[15 + t] = bf2f(xraw[t]);
            const float rw = __builtin_amdgcn_rcpf((float)w);
#pragma unroll
            for (int t = 0; t < 8; ++t) { float s = 0.f;
#pragma unroll
                for (int j = 0; j < 16; ++j) s += (j < w) ? xs[15 + t - j] : 0.f;
                *(LAS unsigned short*)(L + DF_OFF + (bb * TS + t) * 528 + c * 2) = (unsigned short)(cvtpk(s * rw - xs[15 + t], 0.f) & 0xffffu); }
        }
    }
    __syncthreads();
    {
        const int w8 = __builtin_amdgcn_readfirstlane(tid >> 6), lane = tid & 63, q = lane >> 4, r16 = lane & 15, g = w8 >> 1, dh = w8 & 1;
        f32x4 acc[2][4];
#pragma unroll
        for (int a = 0; a < 2; ++a)
#pragma unroll
            for (int b = 0; b < 4; ++b) acc[a][b] = (f32x4){0.f, 0.f, 0.f, 0.f};
#pragma unroll
        for (int ks = 0; ks < 2; ++ks) {
            bf16x8 wa[2], db[4];
#pragma unroll
            for (int a = 0; a < 2; ++a) wa[a] = frag16(L + WT_OFF + g * 9216 + (16 * (2 * dh + a) + r16) * 144 + (32 * ks + 8 * q) * 2);
#pragma unroll
            for (int b = 0; b < 4; ++b) db[b] = frag16(L + DF_OFF + (16 * b + r16) * 528 + (g * 64 + 32 * ks + 8 * q) * 2);
#pragma unroll
            for (int a = 0; a < 2; ++a)
#pragma unroll
                for (int b = 0; b < 4; ++b) acc[a][b] = MFMA16(wa[a], db[b], acc[a][b]);
        }
#pragma unroll
        for (int a = 0; a < 2; ++a) {
            const int d0 = g * 64 + 16 * (2 * dh + a) + 4 * q;
            const f32x4 sc = *(const f32x4*)(C.pool_scale + d0);
#pragma unroll
            for (int b = 0; b < 4; ++b) { const f32x4 v = acc[a][b] * sc; v2u o; o.x = cvtpk(v[0], v[1]); o.y = cvtpk(v[2], v[3]);
                *(v2u*)(C.mixb + (size_t)(m0 + 16 * b + r16) * D + MC_POOL + d0) = o; }
        }
    }
    __syncthreads();
}

constexpr int N_CP_PP = BP * 15 * 32, N_CP_PS = BS * 15 * 32, N_CP_CP = BP * 3 * 96, N_CP_CS = BS * 3 * 96, N_CP = N_CP_PP + N_CP_PS + N_CP_CP + N_CP_CS;
__device__ __forceinline__ void copy_states(const MixP& C, const int wg, const int nwgs, const int tid) {
    const int l = C.l;
    for (int i = wg * NTHREADS + tid; i < N_CP; i += nwgs * NTHREADS) {
        const bf16* src = nullptr; const float* fsrc = nullptr; float* dst;
        if (i < N_CP_PP) { const int b = i / 480, rem = i % 480, r = rem >> 5, c = (rem & 31) * 8;
            src = C.P + (size_t)(b * TP + TP - 15 + r) * NINP + PC_PX + c; dst = C.out + O_POOLP + ((size_t)(l * BP + b) * 15 + r) * 256 + c; }
        else if (i < N_CP_PP + N_CP_PS) { const int j = i - N_CP_PP, b = j / 480, rem = j % 480, r = rem >> 5, c = (rem & 31) * 8;
            if (r < 7) fsrc = C.s_pool + ((size_t)b * 15 + 8 + r) * 256 + c; else src = C.P + (size_t)(MP + b * TS + (r - 7)) * NINP + PC_PX + c;
            dst = C.out + O_POOLS + ((size_t)(l * BS + b) * 15 + r) * 256 + c; }
        else if (i < N_CP_PP + N_CP_PS + N_CP_CP) { const int j = i - N_CP_PP - N_CP_PS, b = j / 288, rem = j % 288, r = rem / 96, c = (rem % 96) * 8;
            src = C.P + (size_t)(b * TP + TP - 3 + r) * NINP + PC_XBC + c; dst = C.out + O_CONVP + ((size_t)(l * BP + b) * 3 + r) * 768 + c; }
        else { const int j = i - N_CP_PP - N_CP_PS - N_CP_CP, b = j / 288, rem = j % 288, r = rem / 96, c = (rem % 96) * 8;
            src = C.P + (size_t)(MP + b * TS + 5 + r) * NINP + PC_XBC + c; dst = C.out + O_CONVS + ((size_t)(l * BS + b) * 3 + r) * 768 + c; }
        f32x4 v0, v1;
        if (src) { const v4u w = *(const v4u*)src; v0 = (f32x4){bfe(w, 0), bfe(w, 1), bfe(w, 2), bfe(w, 3)}; v1 = (f32x4){bfe(w, 4), bfe(w, 5), bfe(w, 6), bfe(w, 7)}; }
        else { v0 = *(const f32x4*)fsrc; v1 = *(const f32x4*)(fsrc + 4); }
        *(f32x4*)dst = v0; *(f32x4*)(dst + 4) = v1;
    }
}

constexpr int NGH = BP * 8, N_SSD_IT = BP * 2 * (TP / 64), N_IT_SMP_GH = (BS / 4) * 4, N_IT_SMP_SSD = (BS / 2) * 2, N_IT_POOL = M / 64;
constexpr int IT_M3 = N_SSD_IT, IT_SGLA = 2 * N_SSD_IT, IT_SHG = IT_SGLA + N_IT_SMP_GH, IT_SSSD = IT_SHG + N_IT_SMP_GH, IT_POOL = IT_SSSD + N_IT_SMP_SSD, IT_GHP = IT_POOL + N_IT_POOL, IT_END = IT_GHP + NGH;
constexpr int N_IT_PROMPT = NGH;
__device__ __forceinline__ void mixer_phase(unsigned char* ldsg, LAS unsigned char* ldsl, const MixP& C, int G, const int tid) {
    const int bx = blockIdx.x;
    const int ngh = (G >= 2 * NGH) ? NGH : 0;
    const int nw = G - ngh;
    int it, step, lim; bool synced;
    if (bx < ngh) { it = IT_GHP + bx; step = 1 << 30; lim = IT_END; synced = true; }
    else { it = bx - ngh; step = nw; lim = (ngh > 0) ? IT_GHP : IT_END; synced = false; copy_states(C, bx - ngh, nw, tid); }
    int rep_it = 0;
    for (; it < lim; it += step) {
        if (!synced && it >= IT_M3) { sub_barrier(C.subc, (unsigned)nw); ssd_scan(C, bx - ngh, nw, tid); sub_barrier(C.subc + 64, (unsigned)nw); synced = true; }
        int tidl = tid; asm volatile("" : "+v"(tidl));
        int kind, a, b0, mode = 0, sc0 = 0; bool smp = true;
        if (it < IT_SGLA) { const int j = (it < IT_M3) ? it : it - IT_M3; kind = 2; mode = (it < IT_M3) ? 2 : 3; sc0 = j & (TP / 64 - 1); a = (j >> 5) & 1; b0 = j >> 6; }
        else if (it < IT_SHG) { const int j = it - IT_SGLA; kind = 0; a = j & 3; b0 = (j >> 2) * 4; }
        else if (it < IT_SSSD) { const int j = it - IT_SHG; kind = 1; a = j & 3; b0 = (j >> 2) * 4; }
        else if (it < IT_POOL) { const int j = it - IT_SSSD; kind = 2; mode = 1; a = j & 1; b0 = (j >> 1) * 2; }
        else if (it < IT_GHP) { kind = 3; a = it - IT_POOL; b0 = 0; }
        else { const int j = it - IT_GHP; smp = false; b0 = j >> 3; kind = ((j & 7) < 4) ? 0 : 1; a = j & 3; }
        if (kind == 0) {
#ifndef MK_NO_GLA
            chain_gh<0>(ldsl, C, a, b0, smp, tidl);
#endif
        } else if (kind == 1) {
#ifndef MK_NO_HGRN
            chain_gh<1>(ldsl, C, a, b0, smp, tidl);
#endif
        } else if (kind == 2) {
#ifndef MK_NO_SSD
            chain_ssd(ldsl, C, a, b0, mode, sc0, tidl);
#endif
        } else {
#ifndef MK_NO_POOL
            pool_item(ldsl, C, a, tidl);
#endif
        }
        int want = 1;
#ifdef MK_DUP_POOL
        if (kind == 3) want = 2;
#endif
#ifdef MK_DUP_SMPGH
        if (kind < 2 && smp) want = 2;
#endif
#ifdef MK_DUP_SMPSSD
        if (kind == 2 && mode == 1) want = 2;
#endif
#ifdef MK_DUP_GHP
        if (!smp) want = 2;
#endif
#ifdef MK_DUP_M3
        if (kind == 2 && mode == 3) want = 2;
#endif
        if (++rep_it < want) it -= step; else rep_it = 0;
    }
    if (!synced) { sub_barrier(C.subc, (unsigned)nw); ssd_scan(C, bx - ngh, nw, tid); sub_barrier(C.subc + 64, (unsigned)nw); }
}

__device__ __forceinline__ void srg_phase(LAS unsigned char* L, const bf16* Aop, const bf16* Bt, const int K, bf16* xb, float* rowss, const float scale, const bool fin, const int G, const int tid) {
    const int w = __builtin_amdgcn_readfirstlane(tid >> 6), lane = tid & 63, q = lane >> 4, r16 = lane & 15, wm = w >> 1, wn = w & 1;
    const int lr = tid >> 3, lc = (tid & 7) * 8;
    const int nt = K / 128;
    for (int tile = blockIdx.x; tile < 256; tile += G) {
        const int tm = tile >> 4, tn = tile & 15;
        const bf16* ag = Aop + (size_t)(MP + 64 * tm + lr) * K + lc;
        const bf16* bg = Bt + (size_t)(64 * tn + lr) * K + lc;
        f32x4 acc0 = {0.f, 0.f, 0.f, 0.f}, acc1 = acc0;
        v4u ra[2][2], rb[2][2];
#pragma unroll
        for (int i = 0; i < 2; ++i) { ra[i][0] = *(const v4u*)(ag + i * 128); ra[i][1] = *(const v4u*)(ag + i * 128 + 64); rb[i][0] = *(const v4u*)(bg + i * 128); rb[i][1] = *(const v4u*)(bg + i * 128 + 64); }
        LAS unsigned char* wr0 = L + lr * 272 + lc * 2;
        const LAS unsigned char* fa = L + (16 * wm + r16) * 272 + (8 * q) * 2;
        const LAS unsigned char* fb = L + 17408 + (32 * wn + r16) * 272 + (8 * q) * 2;
#pragma unroll 1
        for (int t = 0; t < nt; t += 2) {
#pragma unroll
            for (int i = 0; i < 2; ++i) {
                LAS unsigned char* wb_ = wr0 + i * 34816;
                *(LAS v4u*)(wb_) = ra[i][0]; *(LAS v4u*)(wb_ + 128) = ra[i][1]; *(LAS v4u*)(wb_ + 17408) = rb[i][0]; *(LAS v4u*)(wb_ + 17408 + 128) = rb[i][1];
                { const int tn2 = (t + 2 + i < nt) ? t + 2 + i : i; const bf16* a2 = ag + (size_t)tn2 * 128; const bf16* b2 = bg + (size_t)tn2 * 128;
                  ra[i][0] = *(const v4u*)a2; ra[i][1] = *(const v4u*)(a2 + 64); rb[i][0] = *(const v4u*)b2; rb[i][1] = *(const v4u*)(b2 + 64); }
                __syncthreads();
#pragma unroll
                for (int ks = 0; ks < 4; ++ks) {
                    const bf16x8 af = frag16(fa + i * 34816 + ks * 64), b0 = frag16(fb + i * 34816 + ks * 64), b1 = frag16(fb + i * 34816 + 16 * 272 + ks * 64);
                    acc0 = MFMA16(b0, af, acc0); acc1 = MFMA16(b1, af, acc1);
                }
            }
        }
        {
            const int row = MP + 64 * tm + 16 * wm + r16, col0 = 64 * tn + 32 * wn + 4 * q;
            bf16* px = xb + (size_t)row * D + col0;
            const v2u xa = *(const v2u*)px, xc = *(const v2u*)(px + 16);
            const float a0 = __builtin_bit_cast(float, xa.x << 16) + acc0[0] * scale, a1 = __builtin_bit_cast(float, xa.x & 0xffff0000u) + acc0[1] * scale, a2 = __builtin_bit_cast(float, xa.y << 16) + acc0[2] * scale, a3 = __builtin_bit_cast(float, xa.y & 0xffff0000u) + acc0[3] * scale;
            const float b0 = __builtin_bit_cast(float, xc.x << 16) + acc1[0] * scale, b1 = __builtin_bit_cast(float, xc.x & 0xffff0000u) + acc1[1] * scale, b2 = __builtin_bit_cast(float, xc.y << 16) + acc1[2] * scale, b3 = __builtin_bit_cast(float, xc.y & 0xffff0000u) + acc1[3] * scale;
            v2u wa, wb; wa.x = cvtpk(a0, a1); wa.y = cvtpk(a2, a3); wb.x = cvtpk(b0, b1); wb.y = cvtpk(b2, b3);
            *(v2u*)px = wa; *(v2u*)(px + 16) = wb;
            float ss = 0.f;
#pragma unroll
            for (int k = 0; k < 2; ++k) { const unsigned pa = wa[k], pb = wb[k]; const float r0 = __builtin_bit_cast(float, pa << 16), r1 = __builtin_bit_cast(float, pa & 0xffff0000u), r2 = __builtin_bit_cast(float, pb << 16), r3 = __builtin_bit_cast(float, pb & 0xffff0000u); ss += (r0 * r0 + r1 * r1) + (r2 * r2 + r3 * r3); }
            ss += __shfl_xor(ss, 16); ss += __shfl_xor(ss, 32);
            if (q == 0 && fin) unsafeAtomicAdd(rowss + row, ss);
        }
        __syncthreads();
    }
}

__device__ __forceinline__ void final_phase(const Args& A, int wave, int lane, int G) {
    const int gw = blockIdx.x * NWAVES + wave, NGW = G * NWAVES;
    const float* rss = (const float*)(A.ws + WS_RSS) + (size_t)6 * M; const f32x4* gn = (const f32x4*)A.in[I_FINALN] + lane; const bf16* xb = (const bf16*)(A.ws + WS_XB);
    for (int m = gw; m < M; m += NGW) {
        const float r = rsqrtf(rss[m] * (1.0f / 1024.0f) + 1e-6f);
        const v2u* xr = (const v2u*)(xb + (size_t)m * D) + lane; f32x4* yo = (f32x4*)(A.out + (size_t)m * D) + lane;
#pragma unroll
        for (int j = 0; j < 4; ++j) { const v2u w = xr[64 * j]; const f32x4 v = {__builtin_bit_cast(float, w.x << 16), __builtin_bit_cast(float, w.x & 0xffff0000u), __builtin_bit_cast(float, w.y << 16), __builtin_bit_cast(float, w.y & 0xffff0000u)};
            yo[64 * j] = v * r * gn[64 * j]; }
    }
}

__device__ __forceinline__ void side_convert(const Args& A, LAS unsigned char* ldsl, const int tidv, const int first, const int G, const int it_lo, const int it_hi) {
    const int wv = __builtin_amdgcn_readfirstlane(tidv >> 6);
    if (first > 0 && first < G) { if ((int)blockIdx.x >= first) convert_weights(A, ldsl, wv, tidv & 63, it_lo, it_hi, ((int)blockIdx.x - first) * NWAVES + wv, (G - first) * NWAVES); }
    else convert_weights(A, ldsl, wv, tidv & 63, it_lo, it_hi, (int)blockIdx.x * NWAVES + wv, G * NWAVES);
}
__device__ __forceinline__ int sub_of(int ph) { const int j = (ph - 1) & 7; return (j < 3) ? j : (j == 3 ? 7 : j - 1); }
__global__ void __launch_bounds__(NTHREADS, 2) mk_fwd(Args args) {
    extern __shared__ __attribute__((aligned(16))) unsigned char lds[];
    LAS unsigned char* ldsl = (LAS unsigned char*)lds;
    volatile LAS unsigned* MISC = (volatile LAS unsigned*)(ldsl + MISC_OFF);
    const int tid = threadIdx.x, lane = tid & 63, wave = __builtin_amdgcn_readfirstlane(tid >> 6), G = gridDim.x;
    unsigned char* ws = args.ws;
    gu32* ctl = (gu32*)(ws + WS_CTL);
    for (int u = tid; u < (LDS_BYTES - LDSCTL_OFF) / 4; u += NTHREADS) ((LAS unsigned*)(ldsl + LDSCTL_OFF))[u] = 0u;
    __syncthreads();
    const int lo = args.ph_lo, hi = args.ph_hi;
    XcdBarrier bar; bar.bar = (unsigned*)(ctl + CW_BAR); bar.x = 0; bar.st = nullptr;
    if (hi - lo > 1) bar = xcd_barrier_post((unsigned*)(ctl + CW_BAR), MISC + 8);

    bf16* xb = (bf16*)(ws + WS_XB); bf16* mixb = (bf16*)(ws + WS_MIX); bf16* hp = (bf16*)(ws + WS_HP);
    float* rss = (float*)(ws + WS_RSS);

    bool first = true;
    for (int si = 2 * lo; si < 2 * hi; ++si) {
        const int ph = si >> 1;
        if (si & 1) {
            bool dup = false;
#ifdef MK_DUP_P0
            dup = dup || (ph == 0);
#endif
#ifdef MK_DUP_MIX
            dup = dup || (ph >= 1 && ph < N_PHASES - 1 && sub_of(ph) == 3);
#endif
#ifdef MK_DUP_GU
            dup = dup || (ph >= 1 && ph < N_PHASES - 1 && (sub_of(ph) == 0 || sub_of(ph) == 5));
#endif
#ifdef MK_DUP_RESID
            dup = dup || (ph >= 1 && ph < N_PHASES - 1 && (sub_of(ph) == 1 || sub_of(ph) == 4 || sub_of(ph) == 6));
#endif
#ifdef MK_DUP_IN
            dup = dup || (ph >= 1 && ph < N_PHASES - 1 && sub_of(ph) == 2);
#endif
            if (!dup) continue;
        }
        if (!first) xcd_barrier(bar);
        first = false;
        int tidv = threadIdx.x; asm volatile("" : "+v"(tidv));
        if (ph == 0) {
#ifndef MK_NO_P0
            p0_prologue(args, ldsl, __builtin_amdgcn_readfirstlane(tidv >> 6), tidv & 63, G);
#endif
        }
        else if (ph == N_PHASES - 1) { final_phase(args, __builtin_amdgcn_readfirstlane(tidv >> 6), tidv & 63, G); }
        else {
            const int l = (ph - 1) / 8, s = sub_of(ph);
            const unsigned char* wl = ws + WS_W + (size_t)l * W_LAYER;
            if (s == 0 || s == 5) {
                pg8::Gemm g{xb, (const bf16*)(wl + (s == 0 ? WO_GU1 : WO_GU2)), M, NGU, D}; pg8::StaticOrder S; S.init(M, NGU, G, (int)blockIdx.x);
                bool gdry = false;
#ifdef MK_DRY_GU
                gdry = (si & 1) == 0;
#endif
                pg8::EpiSwiGLU E{hp, FF, rss + (size_t)(3 * l + (s == 0 ? 0 : 2)) * M, gdry};
#ifndef MK_NO_G1
                pg8::gemm_phase<pg8::EpiSwiGLU, pg8::StaticOrder, PG8_ALIGN, PG8_SP2>(ldsl + RING_OFF, g, S, E, tidv);
#endif
            } else if (s == 1 || s == 4 || s == 6) {
                const bf16* Aop = (s == 4) ? mixb : hp; const int K = (s == 4) ? D : FF;
                const size_t wo = (s == 1) ? WO_D1 : (s == 4) ? WO_OUT : WO_D2;
                pg8::Gemm g{Aop, (const bf16*)(wl + wo), MP, D, K}; pg8::StaticOrder S; S.init(MP, D, G, (int)blockIdx.x);
                float* rso = rss + (size_t)(3 * l + (s == 1 ? 1 : (s == 4 ? 2 : 3))) * M;
                const float rscale = (s == 4) ? 1.0f : 0.5f;
                float esc = rscale; bool efin = true;
#ifdef MK_DUP_RESID
                esc = 0.5f * rscale; efin = (si & 1) != 0;
#endif
                pg8::EpiResid E{xb, rso, esc, efin};
#ifndef MK_NO_G2
                const bool srg_first = (blockIdx.x & 1) != 0;
                if (srg_first) srg_phase(ldsl + RING_OFF, Aop, (const bf16*)(wl + wo), K, xb, rso, esc, efin, G, tidv);
                pg8::gemm_phase<pg8::EpiResid, pg8::StaticOrder, PG8_ALIGN, PG8_SP2>(ldsl + RING_OFF, g, S, E, tidv);
                if (!srg_first)
#ifdef MK_DUP_SRG
                srg_phase(ldsl + RING_OFF, Aop, (const bf16*)(wl + wo), K, xb, rso, 0.5f * esc, false, G, tidv);
                srg_phase(ldsl + RING_OFF, Aop, (const bf16*)(wl + wo), K, xb, rso, 0.5f * esc, efin, G, tidv);
#else
                srg_phase(ldsl + RING_OFF, Aop, (const bf16*)(wl + wo), K, xb, rso, esc, efin, G, tidv);
#endif
#endif
            } else if (s == 2) {
                pg8::Gemm g{xb, (const bf16*)(wl + WO_IN), M, NINP, D}; pg8::StaticOrder S; S.init(M, NINP, G, (int)blockIdx.x);
                pg8::EpiProj E{hp, NINP, rss + (size_t)(3 * l + 1) * M};
#ifndef MK_NO_G3
                pg8::gemm_phase<pg8::EpiProj, pg8::StaticOrder, PG8_ALIGN, PG8_SP2>(ldsl + RING_OFF, g, S, E, tidv);
#endif
            } else {
                MixP C;
                C.P = hp; C.mixb = mixb; C.out = args.out; C.l = l; C.XC = (bf16*)args.out;
                C.DS = args.out + 8388608; C.ESC = args.out + 16900000; C.subc = (unsigned*)(ctl + CW_SUB + 128 * l);
                C.s_pool = args.in[I_SPOOL] + (size_t)l * BS * 15 * 256; C.s_gla = args.in[I_SGLA] + (size_t)l * BS * 4 * 32 * 64; C.s_hgrn = args.in[I_SHGRN] + (size_t)l * BS * 4 * 64 * 64;
                C.s_ssm = args.in[I_SSSM] + (size_t)l * BS * 4 * 64 * 128; C.s_conv = args.in[I_SCONV] + (size_t)l * BS * 3 * 768;
                C.pool_w = args.in[I_POOLW] + (size_t)l * 4 * 64 * 64; C.pool_scale = args.in[I_POOLS] + l * 256; C.gla_wg = args.in[I_GLAWG] + l * 16 * 128; C.gla_b = args.in[I_GLAB] + l * 128;
                C.gla_n = args.in[I_GLAN] + l * 64; C.lbl = args.in[I_LBL]; C.hg_n = args.in[I_HGN] + l * 64; C.conv_w = args.in[I_CONVW] + l * 4 * 768; C.conv_b = args.in[I_CONVB] + l * 768;
                C.dt_b = args.in[I_DTB] + l * 4; C.a_log = args.in[I_ALOG] + l * 4; C.ssm_d = args.in[I_SSMD] + l * 4; C.ssm_n = args.in[I_SSMN] + l * 256;
#ifndef MK_NO_MIXER
                if (s == 7) conv_phase(C, G, tidv); else mixer_phase(lds + RING_OFF, ldsl + RING_OFF, C, G, tidv);
#endif
            }
        }
    }
}

extern "C" void kernel_launch(void* const* d_in, const int* in_sizes, int n_in, void* d_out, int out_size, void* d_ws, size_t ws_size, hipStream_t stream) {
    static int grid = 0;
    if (grid == 0) {
        if (n_in != N_INPUTS || in_sizes[0] != MP * D || (size_t)out_size != O_END || ws_size < WS_END) {
            fprintf(stderr, "kernel_launch: shape mismatch: n_in %d, in0 %d, out %d, ws %zu (need %zu); nothing launched\n", n_in, n_in > 0 ? in_sizes[0] : -1, out_size, ws_size, (size_t)WS_END); grid = -1; return; }
        int dev = 0, cus = 0, per_cu = 0;
        if (hipGetDevice(&dev) != hipSuccess || hipDeviceGetAttribute(&cus, hipDeviceAttributeMultiprocessorCount, dev) != hipSuccess) { fprintf(stderr, "kernel_launch: device query failed\n"); grid = -1; return; }
        if (hipFuncSetAttribute((const void*)mk_fwd, hipFuncAttributeMaxDynamicSharedMemorySize, LDS_BYTES) != hipSuccess) { fprintf(stderr, "kernel_launch: hipFuncSetAttribute failed\n"); grid = -1; return; }
        if (hipOccupancyMaxActiveBlocksPerMultiprocessor(&per_cu, (const void*)mk_fwd, NTHREADS, LDS_BYTES) != hipSuccess || per_cu < 1) {
            fprintf(stderr, "kernel_launch: occupancy query reports %d workgroups per CU; nothing launched\n", per_cu); (void)hipGetLastError(); grid = -1; return; }
        grid = cus;
    }
    if (grid < 0) return;
    if (hipMemsetAsync((char*)d_ws + WS_CTL, 0, CTL_ZERO_BYTES, stream) != hipSuccess) { fprintf(stderr, "kernel_launch: hipMemsetAsync failed\n"); return; }
    Args a{};
    for (int i = 0; i < N_INPUTS; ++i) a.in[i] = (const float*)d_in[i];
    a.out = (float*)d_out; a.ws = (unsigned char*)d_ws;
    for (int li = 0; li < N_LAUNCHES; ++li) {
        a.ph_lo = (N_LAUNCHES == 1) ? 0 : li; a.ph_hi = (N_LAUNCHES == 1) ? N_PHASES : li + 1;
        hipLaunchKernelGGL(mk_fwd, dim3(grid), dim3(NTHREADS), LDS_BYTES, stream, a);
        const hipError_t le = hipPeekAtLastError();
        if (le != hipSuccess) { fprintf(stderr, "kernel_launch: launch %d failed: %s\n", li, hipGetErrorName(le)); break; }
    }
}
```

```cpp
#include <hip/hip_runtime.h>
#include <cstdio>
#include <cstdint>
namespace pg8 {
#define PG8_LAS __attribute__((address_space(3)))
typedef unsigned short bf16_t;
typedef short bf16x8 __attribute__((ext_vector_type(8)));
typedef float f32x4 __attribute__((ext_vector_type(4)));
typedef unsigned u32x4 __attribute__((ext_vector_type(4)));
constexpr int BM = 256, BK = 64, HALF = 128, HTB = HALF * BK * 2  , STAGE_BYTES = 8 * HTB, NXCD = 8, WGM = 8;

__host__ __device__ __forceinline__ int lds_byte(int r, int c) { const int st = (r >> 4) * 2 + (c >> 5), rr = r & 15, cc = c & 31, ob = rr * 64 + cc * 2; return st * 1024 + (ob ^ (((ob >> 9) & 1) << 5)); }
__host__ __device__ __forceinline__ void stage_rc(int b, int& R, int& C) { const int st = b / 1024, sb = b % 1024, swz = sb ^ (((sb >> 9) & 1) << 5); R = (st >> 1) * 16 + swz / 64; C = (st & 1) * 32 + (swz % 64) / 2; }
__host__ __device__ __forceinline__ int perm32(int rho) { const int n = rho >> 4, i = rho & 15; return 8 * (i >> 2) + 4 * n + (i & 3); }

struct Unit { int pm, pn; };
struct Gemm { const bf16_t* A; const bf16_t* Bt; int M, N, K; };

struct StaticOrder {
    int nM, nN, nwg, G, c;
    __host__ __device__ void init(int M, int N, int G_, int c_) { nM = M / BM; nN = N / BM; nwg = nM * nN; G = G_; c = c_; }
    __host__ __device__ bool next(int i, Unit& u) const {
        const long L = (long)i * G + c; if (L >= nwg) return false;
        int wgid = (int)L; { const int q = nwg / NXCD, r = nwg % NXCD, xcd = wgid % NXCD, off = wgid / NXCD; wgid = (xcd < r ? xcd * (q + 1) : r * (q + 1) + (xcd - r) * q) + off; }
        const int nig = WGM * nN, gid = wgid / nig, fm = gid * WGM, gsz = (nM - fm) < WGM ? (nM - fm) : WGM;
        u.pm = fm + ((wgid % nig) % gsz); u.pn = (wgid % nig) / gsz; return true;
    }
    __device__ __forceinline__ void a_ready(const Unit&) const {}
    __device__ __forceinline__ void done(const Unit&) const {}
};
__device__ __forceinline__ unsigned cvt_pk_bf16(float lo, float hi) { unsigned r; asm volatile("v_cvt_pk_bf16_f32 %0, %1, %2" : "=v"(r) : "v"(lo), "v"(hi)); return r; }
template <class Epi, class Sched, bool ALIGN_EPI = false, bool SP2 = false>
__device__ __forceinline__ void gemm_phase(PG8_LAS unsigned char* lds, const Gemm g, const Sched& S, const Epi& E, const int tid_in) {
    const int tid = tid_in, wid = __builtin_amdgcn_readfirstlane(tid >> 6), lane = tid & 63, wr = wid >> 2, wc = wid & 3, fr = lane & 15, fq = lane >> 4;
    const int K = g.K, nt = K / BK;
    unsigned voffA[2], voffB[2];
#pragma unroll
    for (int i = 0; i < 2; ++i) { int R, C; stage_rc(tid * 16 + i * 8192, R, C); const int Rb = Epi::PERM ? ((R & ~31) + perm32(R & 31)) : R;
        voffA[i] = (unsigned)(R * K + C) * 2u; voffB[i] = (unsigned)(Rb * K + C) * 2u; }
    const size_t kstep = (size_t)(BK * 2);
    const size_t hstep = (size_t)HALF * K * 2;
    const size_t tstep = 2 * hstep;
    const unsigned ldsw = (unsigned)wid * 1024u;
    const int aoff = lds_byte(wr * 64 + fr, fq * 8), boff = lds_byte(wc * 32 + fr, fq * 8);
#define PG8_SA(b, h) (((b) * 2 + (h)) * HTB)
#define PG8_SB(b, h) ((4 + (b) * 2 + (h)) * HTB)
#define PG8_STAGE(bufoff, gbase, voff) do { _Pragma("unroll") for (int _i = 0; _i < 2; ++_i) \
        __builtin_amdgcn_global_load_lds((const unsigned*)((const char*)(gbase) + (voff)[_i]), (PG8_LAS unsigned*)(lds + (bufoff) + ldsw + _i * 8192), 16, 0, 0); } while (0)
#define PG8_LDA(dst, b, h) do { _Pragma("unroll") for (int m = 0; m < 4; ++m) _Pragma("unroll") for (int k = 0; k < 2; ++k) dst[m][k] = *(const PG8_LAS bf16x8*)(lds + PG8_SA(b, h) + aoff + m * 2048 + k * 1024); } while (0)
#define PG8_LDB(dst, b, h) do { _Pragma("unroll") for (int n = 0; n < 2; ++n) _Pragma("unroll") for (int k = 0; k < 2; ++k) dst[n][k] = *(const PG8_LAS bf16x8*)(lds + PG8_SB(b, h) + boff + n * 2048 + k * 1024); } while (0)
#define PG8_MMA(ai, bj, At, Bt) do { __builtin_amdgcn_s_setprio(1); _Pragma("unroll") for (int m = 0; m < 4; ++m) _Pragma("unroll") for (int n = 0; n < 2; ++n) _Pragma("unroll") for (int k = 0; k < 2; ++k) \
        acc[ai][bj][m][n] = __builtin_amdgcn_mfma_f32_16x16x32_bf16(Bt[n][k], At[m][k], acc[ai][bj][m][n], 0, 0, 0); __builtin_amdgcn_s_setprio(0); } while (0)
#define PG8_WAIT_V(n) asm volatile("s_waitcnt vmcnt(" #n ")" ::: "memory")
#define PG8_WAIT_L(n) asm volatile("s_waitcnt lgkmcnt(" #n ")" ::: "memory")
#define PG8_BAR __builtin_amdgcn_s_barrier()
#define PG8_SCHED __builtin_amdgcn_sched_barrier(0)
    Unit cur, nxt; int ui = 0;
    if (!S.next(0, cur)) return;
    f32x4 acc[2][2][4][2];
#pragma unroll
    for (int a = 0; a < 2; ++a)
#pragma unroll
        for (int b = 0; b < 2; ++b)
#pragma unroll
            for (int m = 0; m < 4; ++m)
#pragma unroll
                for (int n = 0; n < 2; ++n) acc[a][b][m][n] = (f32x4){0.f, 0.f, 0.f, 0.f};
    bf16x8 At[4][2], B0[2][2], B1[2][2];
    const char* cA = (const char*)g.A + (size_t)cur.pm * tstep; const char* cB = (const char*)g.Bt + (size_t)cur.pn * tstep;
    S.a_ready(cur);
    if constexpr (SP2) {
        PG8_STAGE(PG8_SB(0, 0), cB, voffB); PG8_STAGE(PG8_SB(0, 1), cB + hstep, voffB); PG8_STAGE(PG8_SA(0, 0), cA, voffA); PG8_STAGE(PG8_SA(0, 1), cA + hstep, voffA);
        if (wr == 1) PG8_BAR;
        PG8_WAIT_V(2); PG8_BAR;
        PG8_STAGE(PG8_SB(1, 0), cB + kstep, voffB); PG8_STAGE(PG8_SA(1, 0), cA + kstep, voffA); PG8_STAGE(PG8_SB(1, 1), cB + hstep + kstep, voffB);
        PG8_WAIT_V(6); PG8_BAR;
    } else {
        PG8_STAGE(PG8_SB(0, 0), cB, voffB); PG8_STAGE(PG8_SA(0, 0), cA, voffA); PG8_STAGE(PG8_SB(0, 1), cB + hstep, voffB); PG8_STAGE(PG8_SA(0, 1), cA + hstep, voffA);
        if (wr == 1) PG8_BAR;
        PG8_WAIT_V(4); PG8_BAR;
        PG8_STAGE(PG8_SB(1, 0), cB + kstep, voffB); PG8_STAGE(PG8_SA(1, 0), cA + kstep, voffA); PG8_STAGE(PG8_SB(1, 1), cB + hstep + kstep, voffB);
        PG8_WAIT_V(6); PG8_BAR;
    }
    for (;;) {
        const bool has_next = S.next(ui + 1, nxt);
        const char* nA = has_next ? (const char*)g.A + (size_t)nxt.pm * tstep : cA; const char* nB = has_next ? (const char*)g.Bt + (size_t)nxt.pn * tstep : cB;
        for (int t = 0; t < nt; t += 2) {
            const bool last = (t == nt - 2);
            const char* a1 = cA + (size_t)(t + 1) * kstep;
            const char* a2 = last ? nA : cA + (size_t)(t + 2) * kstep; const char* b2 = last ? nB : cB + (size_t)(t + 2) * kstep;
            const char* a3 = a2 + kstep; const char* b3 = b2 + kstep;
            if (last && has_next) S.a_ready(nxt);
            if constexpr (SP2) {
            PG8_LDB(B0, 0, 0); PG8_LDB(B1, 0, 1); PG8_SCHED; PG8_LDA(At, 0, 0); PG8_STAGE(PG8_SA(1, 1), a1 + hstep, voffA);
            PG8_WAIT_V(8); PG8_WAIT_L(0); PG8_BAR; PG8_MMA(0, 0, At, B0); PG8_MMA(0, 1, At, B1); PG8_BAR; PG8_SCHED;
            PG8_LDA(At, 0, 1); PG8_STAGE(PG8_SB(0, 0), b2, voffB); PG8_STAGE(PG8_SB(0, 1), b2 + hstep, voffB); PG8_STAGE(PG8_SA(0, 0), a2, voffA);
            PG8_WAIT_V(8); PG8_WAIT_L(0); PG8_BAR; PG8_MMA(1, 0, At, B0); PG8_MMA(1, 1, At, B1); PG8_BAR; PG8_SCHED;
            PG8_LDB(B0, 1, 0); PG8_LDB(B1, 1, 1); PG8_SCHED; PG8_LDA(At, 1, 0); PG8_STAGE(PG8_SA(0, 1), a2 + hstep, voffA);
            PG8_WAIT_V(8); PG8_WAIT_L(0); PG8_BAR; PG8_MMA(0, 0, At, B0); PG8_MMA(0, 1, At, B1); PG8_BAR; PG8_SCHED;
            PG8_LDA(At, 1, 1); PG8_STAGE(PG8_SB(1, 0), b3, voffB); PG8_STAGE(PG8_SB(1, 1), b3 + hstep, voffB); PG8_STAGE(PG8_SA(1, 0), a3, voffA);
            PG8_WAIT_V(8); PG8_WAIT_L(0); PG8_BAR; PG8_MMA(1, 0, At, B0); PG8_MMA(1, 1, At, B1); PG8_BAR; PG8_SCHED;
            } else {
            PG8_LDB(B0, 0, 0); PG8_SCHED; PG8_LDA(At, 0, 0); PG8_STAGE(PG8_SA(1, 1), a1 + hstep, voffA);
            PG8_WAIT_L(8); PG8_BAR; PG8_WAIT_L(0); PG8_MMA(0, 0, At, B0); PG8_BAR; PG8_SCHED;
            PG8_LDB(B1, 0, 1); PG8_STAGE(PG8_SB(0, 0), b2, voffB);
            PG8_BAR; PG8_WAIT_L(0); PG8_MMA(0, 1, At, B1); PG8_BAR;
            PG8_LDA(At, 0, 1); PG8_STAGE(PG8_SA(0, 0), a2, voffA);
            PG8_BAR; PG8_WAIT_L(0); PG8_MMA(1, 0, At, B0); PG8_BAR; PG8_SCHED;
            PG8_STAGE(PG8_SB(0, 1), b2 + hstep, voffB);
            PG8_WAIT_V(6); PG8_BAR; PG8_MMA(1, 1, At, B1); PG8_BAR;
            PG8_LDB(B0, 1, 0); PG8_SCHED; PG8_LDA(At, 1, 0); PG8_STAGE(PG8_SA(0, 1), a2 + hstep, voffA);
            PG8_WAIT_L(8); PG8_BAR; PG8_WAIT_L(0); PG8_MMA(0, 0, At, B0); PG8_BAR; PG8_SCHED;
            PG8_LDB(B1, 1, 1); PG8_STAGE(PG8_SB(1, 0), b3, voffB);
            PG8_BAR; PG8_WAIT_L(0); PG8_MMA(0, 1, At, B1); PG8_BAR;
            PG8_LDA(At, 1, 1); PG8_STAGE(PG8_SA(1, 0), a3, voffA);
            PG8_BAR; PG8_WAIT_L(0); PG8_MMA(1, 0, At, B0); PG8_BAR; PG8_SCHED;
            PG8_STAGE(PG8_SB(1, 1), b3 + hstep, voffB);
            PG8_WAIT_V(6); PG8_BAR; PG8_MMA(1, 1, At, B1); PG8_BAR;
            }
        }
        if constexpr (ALIGN_EPI) { if (wr == 0) PG8_BAR; }
        if constexpr (!Epi::AFTER_DRAIN) { E(acc, cur, wr, wc, fr, fq); S.done(cur); }
        if (!has_next) break;
#pragma unroll
        for (int a = 0; a < 2; ++a)
#pragma unroll
            for (int b = 0; b < 2; ++b)
#pragma unroll
                for (int m = 0; m < 4; ++m)
#pragma unroll
                    for (int n = 0; n < 2; ++n) acc[a][b][m][n] = (f32x4){0.f, 0.f, 0.f, 0.f};
        cur = nxt; cA = nA; cB = nB; ++ui;
        if constexpr (ALIGN_EPI) { if (wr == 1) PG8_BAR; }
    }
    PG8_WAIT_V(0);
    if constexpr (!ALIGN_EPI) { if (wr == 0) PG8_BAR; }
    PG8_BAR;
    if constexpr (Epi::AFTER_DRAIN) { E.fused(acc, cur, wr, wc, fr, fq, lds, wid, lane); S.done(cur); }
#undef PG8_SA
#undef PG8_SB
#undef PG8_STAGE
#undef PG8_LDA
#undef PG8_LDB
#undef PG8_MMA
#undef PG8_WAIT_V
#undef PG8_WAIT_L
#undef PG8_BAR
#undef PG8_SCHED
}
}

#ifndef PG8_SP2
#define PG8_SP2 true
#endif
#ifndef PG8_ALIGN
#define PG8_ALIGN true
#endif
namespace pg8 {
constexpr float RMS_EPS = 1e-6f;
__device__ __forceinline__ float silu_f(float x) { return x * __builtin_amdgcn_rcpf(1.0f + __expf(-x)); }
typedef float f32x2n __attribute__((ext_vector_type(2)));
typedef __bf16 bf16x2n __attribute__((ext_vector_type(2)));
__device__ __forceinline__ unsigned cvt2_bf16(float lo, float hi) { const f32x2n v = {lo, hi}; return __builtin_bit_cast(unsigned, __builtin_convertvector(v, bf16x2n)); }

struct EpiSwiGLU {
    static constexpr bool PERM = true, AFTER_DRAIN = false;
    bf16_t* H; int ldh; const float* rowss; bool dry;
    __device__ __forceinline__ void operator()(const f32x4 (&acc)[2][2][4][2], const Unit& u, int wr, int wc, int fr, int fq) const {
        if (dry) { asm volatile("" :: "v"(acc[0][0][0][0]), "v"(acc[1][1][3][1])); return; }
        const int row0 = u.pm * BM + wr * 64 + fr, col0 = u.pn * HALF + wc * 32 + 8 * fq;
        float rs[2][4];
#pragma unroll
        for (int ai = 0; ai < 2; ++ai)
#pragma unroll
            for (int m = 0; m < 4; ++m) rs[ai][m] = rowss[row0 + ai * HALF + m * 16];
#pragma unroll
        for (int ai = 0; ai < 2; ++ai)
#pragma unroll
            for (int m = 0; m < 4; ++m) {
                const int row = row0 + ai * HALF + m * 16;
                const float ms = rs[ai][m] * (1.0f / 1024.0f) + RMS_EPS, c1 = -1.4426950408889634f * rsqrtf(ms);
                const f32x4 g0 = acc[ai][0][m][0], g1 = acc[ai][0][m][1], u0 = acc[ai][1][m][0], u1 = acc[ai][1][m][1];
                const f32x4 t0 = g0 * c1, t1 = g1 * c1; f32x4 e0, e1, i0, i1;
#pragma unroll
                for (int e = 0; e < 4; ++e) { e0[e] = __builtin_amdgcn_exp2f(t0[e]); e1[e] = __builtin_amdgcn_exp2f(t1[e]); }
                const f32x4 d0 = e0 * ms + ms, d1 = e1 * ms + ms;
#pragma unroll
                for (int e = 0; e < 4; ++e) { i0[e] = __builtin_amdgcn_rcpf(d0[e]); i1[e] = __builtin_amdgcn_rcpf(d1[e]); }
                const f32x4 h0 = (g0 * u0) * i0, h1 = (g1 * u1) * i1;
                u32x4 w; w.x = cvt2_bf16(h0[0], h0[1]); w.y = cvt2_bf16(h0[2], h0[3]); w.z = cvt2_bf16(h1[0], h1[1]); w.w = cvt2_bf16(h1[2], h1[3]);
                *(u32x4*)(H + (size_t)row * ldh + col0) = w;
            }
    }
};
struct EpiResid {
    static constexpr bool PERM = true, AFTER_DRAIN = false;
    bf16_t* xb; float* rowss; float scale; bool fin;
    __device__ __forceinline__ void operator()(const f32x4 (&acc)[2][2][4][2], const Unit& u, int wr, int wc, int fr, int fq) const {
        const int row0 = u.pm * BM + wr * 64 + fr, col0 = u.pn * BM + wc * 32 + 8 * fq;
        u32x4 xv[2][4][2];
#pragma unroll
        for (int ai = 0; ai < 2; ++ai)
#pragma unroll
            for (int m = 0; m < 4; ++m)
#pragma unroll
                for (int bj = 0; bj < 2; ++bj) xv[ai][m][bj] = *(const u32x4*)(xb + (size_t)(row0 + ai * HALF + m * 16) * 1024 + col0 + bj * HALF);
        float ssv[2][4];
#pragma unroll
        for (int ai = 0; ai < 2; ++ai)
#pragma unroll
            for (int m = 0; m < 4; ++m) {
                const int row = row0 + ai * HALF + m * 16;
                float ss = 0.f;
#pragma unroll
                for (int bj = 0; bj < 2; ++bj) {
                    const u32x4 xo = xv[ai][m][bj]; u32x4 w;
#pragma unroll
                    for (int k = 0; k < 4; ++k) {
                        const float a0 = __uint_as_float(xo[k] << 16) + acc[ai][bj][m][k >> 1][(k & 1) * 2] * scale, a1 = __uint_as_float(xo[k] & 0xffff0000u) + acc[ai][bj][m][k >> 1][(k & 1) * 2 + 1] * scale;
                        const unsigned p = cvt_pk_bf16(a0, a1); w[k] = p;
                        const float r0 = __uint_as_float(p << 16), r1 = __uint_as_float(p & 0xffff0000u); ss += r0 * r0 + r1 * r1;
                    }
                    *(u32x4*)(xb + (size_t)row * 1024 + col0 + bj * HALF) = w;
                }
                ssv[ai][m] = ss;
            }
#pragma unroll
        for (int ai = 0; ai < 2; ++ai)
#pragma unroll
            for (int m = 0; m < 4; ++m) ssv[ai][m] += __shfl_xor(ssv[ai][m], 16);
#pragma unroll
        for (int ai = 0; ai < 2; ++ai)
#pragma unroll
            for (int m = 0; m < 4; ++m) ssv[ai][m] += __shfl_xor(ssv[ai][m], 32);
        if (fq == 0 && fin) {
#pragma unroll
            for (int ai = 0; ai < 2; ++ai)
#pragma unroll
                for (int m = 0; m < 4; ++m) unsafeAtomicAdd(rowss + row0 + ai * HALF + m * 16, ssv[ai][m]);
        }
    }
};
struct EpiProj {
    static constexpr bool PERM = true, AFTER_DRAIN = false;
    bf16_t* P; int ldp; const float* rowss;
    __device__ __forceinline__ void operator()(const f32x4 (&acc)[2][2][4][2], const Unit& u, int wr, int wc, int fr, int fq) const {
        const int row0 = u.pm * BM + wr * 64 + fr, col0 = u.pn * BM + wc * 32 + 8 * fq;
        const bool act = (u.pn == 3) || (u.pn == 4) || (u.pn == 7) || (u.pn == 8);
        float rs[2][4];
#pragma unroll
        for (int ai = 0; ai < 2; ++ai)
#pragma unroll
            for (int m = 0; m < 4; ++m) rs[ai][m] = rowss[row0 + ai * HALF + m * 16];
#pragma unroll
        for (int ai = 0; ai < 2; ++ai)
#pragma unroll
            for (int m = 0; m < 4; ++m) {
                const int row = row0 + ai * HALF + m * 16;
                const float r = rsqrtf(rs[ai][m] * (1.0f / 1024.0f) + RMS_EPS);
#pragma unroll
                for (int bj = 0; bj < 2; ++bj) {
                    f32x4 a = acc[ai][bj][m][0] * r, b = acc[ai][bj][m][1] * r;
                    if (act) {
#pragma unroll
                        for (int e = 0; e < 4; ++e) { a[e] = silu_f(a[e]); b[e] = silu_f(b[e]); }
                    }
                    u32x4 w; w.x = cvt_pk_bf16(a[0], a[1]); w.y = cvt_pk_bf16(a[2], a[3]); w.z = cvt_pk_bf16(b[0], b[1]); w.w = cvt_pk_bf16(b[2], b[3]);
                    *(u32x4*)(P + (size_t)row * ldp + col0 + bj * HALF) = w;
                }
            }
    }
};
}

constexpr int NWAVES = 8, NTHREADS = 512;
#ifndef MK_N_LAUNCHES
#define MK_N_LAUNCHES 1
#endif
constexpr int N_PHASES = 18;
constexpr int N_LAUNCHES = MK_N_LAUNCHES;

constexpr int D = 1024, FF = 2816, NGU = 2 * FF, NIN = 3092, NINP = 3328, DEPTH = 2;
constexpr int BP = 8, TP = 2048, BS = 128, TS = 8, PAST_LEN = 16384;
constexpr int MP = BP * TP, MS = BS * TS, M = MP + MS;
static_assert(M % 256 == 0 && NGU % 256 == 0 && NINP % 256 == 0 && FF % 128 == 0, "GEMM tiling");
static_assert(DEPTH == 2, "the HGRN2 lower bounds (cumulative softmax over layers minus its first term) are written out for two layers: 0 and softmax(logits)[1] = sigmoid(l1 - l0)");
constexpr int PC_PX = 0, PC_GQ = 256, PC_GK = 384, PC_GV = 512, PC_GR = 768, PC_RQ = 1024, PC_RF = 1280, PC_RI = 1536, PC_RG = 1792, PC_SZ = 2048, PC_XBC = 2304, PC_LR = 3072, PC_DT = 3088;
constexpr int MC_POOL = 0, MC_GLA = 256, MC_HGRN = 512, MC_SSM = 768;
enum { I_XP = 0, I_XS, I_SPOOL, I_SGLA, I_SHGRN, I_SSSM, I_SCONV, I_F1N, I_F1G, I_F1U, I_F1D, I_MIXN, I_WIN, I_POOLW, I_POOLS, I_GLAWG, I_GLAB, I_GLAN,
       I_LBL, I_HGN, I_CONVW, I_CONVB, I_DTB, I_ALOG, I_SSMD, I_SSMN, I_WOUT, I_F2N, I_F2G, I_F2U, I_F2D, I_FINALN, N_INPUTS };
constexpr size_t O_YP = 0, O_YS = O_YP + (size_t)MP * D, O_POOLP = O_YS + (size_t)MS * D, O_POOLS = O_POOLP + (size_t)DEPTH * BP * 15 * 256,
    O_GLAP = O_POOLS + (size_t)DEPTH * BS * 15 * 256, O_GLAS = O_GLAP + (size_t)DEPTH * BP * 4 * 32 * 64, O_HGP = O_GLAS + (size_t)DEPTH * BS * 4 * 32 * 64,
    O_HGS = O_HGP + (size_t)DEPTH * BP * 4 * 64 * 64, O_SSMP = O_HGS + (size_t)DEPTH * BS * 4 * 64 * 64, O_SSMS = O_SSMP + (size_t)DEPTH * BP * 4 * 64 * 128,
    O_CONVP = O_SSMS + (size_t)DEPTH * BS * 4 * 64 * 128, O_CONVS = O_CONVP + (size_t)DEPTH * BP * 3 * 768, O_END = O_CONVS + (size_t)DEPTH * BS * 3 * 768;
static_assert(O_END == 35094528, "output size");

constexpr size_t KiB = 1024, MiB = 1u << 20;
constexpr size_t WS_CTL = 0, CTL_ZERO_BYTES = 1 * MiB;
constexpr size_t WS_RSS = 512 * KiB;
static_assert(WS_RSS + 7 * (size_t)M * 4 <= CTL_ZERO_BYTES, "rowss inside the memset region");
constexpr size_t WS_W = 1 * MiB, W_LAYER = 41 * MiB + 512 * KiB;
constexpr size_t WO_GU1 = 0, WO_D1 = 11 * MiB, WO_IN = 16 * MiB + 512 * KiB, WO_OUT = 23 * MiB, WO_GU2 = 25 * MiB, WO_D2 = 36 * MiB;
static_assert((size_t)NGU * D * 2 == 11 * MiB && (size_t)D * FF * 2 == 5 * MiB + 512 * KiB && (size_t)NINP * D * 2 == 6 * MiB + 512 * KiB && WO_D2 + 5 * MiB + 512 * KiB == W_LAYER, "weight map");
constexpr size_t WS_XB = WS_W + 2 * W_LAYER;
constexpr size_t WS_MIX = WS_XB + 34 * MiB;
constexpr size_t WS_HP = WS_MIX + 34 * MiB;
constexpr size_t WS_END = WS_HP + (size_t)M * NINP * 2;
static_assert((size_t)M * D * 2 == 34 * MiB && WS_END == 262 * MiB + 512 * KiB, "d_ws map");
constexpr int CW_BAR = 4096;
constexpr int CW_SUB = 8192;
constexpr int RING_OFF = 0, RING_BYTES = 131072;
constexpr int LDSCTL_OFF = RING_BYTES, MISC_OFF = LDSCTL_OFF + 320;
constexpr int LDS_BYTES = 147456;

#define GAS __attribute__((address_space(1)))
#define LAS __attribute__((address_space(3)))
typedef unsigned short bf16;
typedef unsigned v4u __attribute__((ext_vector_type(4)));
typedef unsigned v2u __attribute__((ext_vector_type(2)));
typedef float f32x4 __attribute__((ext_vector_type(4)));
typedef GAS unsigned gu32;
#define RLX_AGENT __ATOMIC_RELAXED, __HIP_MEMORY_SCOPE_AGENT
#define LDS_WAIT() asm volatile("s_waitcnt lgkmcnt(0)" ::: "memory")
#define VM_WAIT() asm volatile("s_waitcnt vmcnt(0)" ::: "memory")
__device__ __forceinline__ unsigned f2bf(float f) { unsigned u = __builtin_bit_cast(unsigned, f); return (u + 0x7fffu + ((u >> 16) & 1u)) >> 16; }
__device__ __forceinline__ unsigned pk2(float lo, float hi) { return f2bf(lo) | (f2bf(hi) << 16); }
__device__ __forceinline__ float bf2f(bf16 b) { return __builtin_bit_cast(float, (unsigned)b << 16); }
__device__ __forceinline__ float sigmoid_f(float x) { return __builtin_amdgcn_rcpf(1.0f + __expf(-x)); }
__device__ __forceinline__ float silu_f(float x) { return x * __builtin_amdgcn_rcpf(1.0f + __expf(-x)); }
__device__ __forceinline__ float softplus_f(float x) { return x > 20.f ? x : log1pf(__expf(x)); }
__device__ __forceinline__ float logsigmoid_f(float x) { return fminf(x, 0.f) - log1pf(__expf(-fabsf(x))); }
typedef float f32x2v __attribute__((ext_vector_type(2)));
typedef __bf16 bf16x2v __attribute__((ext_vector_type(2)));
__device__ __forceinline__ unsigned cvtpk(float lo, float hi) { const f32x2v v = {lo, hi}; return __builtin_bit_cast(unsigned, __builtin_convertvector(v, bf16x2v)); }
#define XB_TMO      128
#define XB_XCNT(j)  (256  + 64 * (j))
#define XB_XSUB(j)  (1280 + 64 * (j))
#define XB_XGEN(j)  (2304 + 64 * (j))
#define XB_TOP      3328
#define XB_TOPGEN   3392
#define XCD_BAR_WORDS 3456
#define XB_SPIN_CAP (1u << 18)

__device__ __forceinline__ unsigned xb_ld(unsigned* p)              { return __hip_atomic_load(p, __ATOMIC_RELAXED, __HIP_MEMORY_SCOPE_AGENT); }
__device__ __forceinline__ unsigned xb_add(unsigned* p, unsigned v) { return __hip_atomic_fetch_add(p, v, __ATOMIC_RELAXED, __HIP_MEMORY_SCOPE_AGENT); }
__device__ __forceinline__ unsigned xb_xcc_id() { return (unsigned)__builtin_amdgcn_s_getreg((3 << 11) | 20) & 0xFu; }
#define XB_SPIN(cond, bar) do { unsigned _sp = 0; while (cond) { __builtin_amdgcn_s_sleep(1); \
    if ((++_sp & 255u) == 0u) { if (xb_ld(&(bar)[XB_TMO])) break; if (_sp > XB_SPIN_CAP) { atomicAdd(&(bar)[XB_TMO], 1u); break; } } } } while (0)

struct XcdBarrier {
    unsigned* bar; unsigned x;
    volatile LAS unsigned* st;
};

__device__ __forceinline__ XcdBarrier xcd_barrier_post(unsigned* bar, volatile LAS unsigned* st) {
    XcdBarrier b; b.bar = bar; b.x = xb_xcc_id(); b.st = st;
    if (threadIdx.x == 0) (void)xb_add(&bar[XB_XCNT(b.x)], 1u);
    return b;
}
__device__ __forceinline__ void xcd_barrier_complete(unsigned* bar, unsigned x, unsigned& nloc, unsigned& nx) {
    const unsigned G = gridDim.x * gridDim.y * gridDim.z;
    unsigned sum, cnt, mine, sp = 0u;
    for (;;) {
        sum = 0u; cnt = 0u; mine = 0u;
#pragma unroll
        for (unsigned j = 0; j < 16; ++j) { const unsigned c = xb_ld(&bar[XB_XCNT(j)]); sum += c; cnt += (c > 0u) ? 1u : 0u; mine = (j == x) ? c : mine; }
        if (sum == G) break;
        __builtin_amdgcn_s_sleep(1);
        if ((++sp & 255u) == 0u) { if (xb_ld(&bar[XB_TMO])) break; if (sp > XB_SPIN_CAP) { atomicAdd(&bar[XB_TMO], 1u); break; } }
    }
    nloc = mine > 0u ? mine : 1u; nx = cnt > 0u ? cnt : 1u;
}

__device__ __forceinline__ void xcd_barrier(const XcdBarrier& b) {
    asm volatile("s_waitcnt vmcnt(0)" ::: "memory");
    __syncthreads();
    if (threadIdx.x == 0) {
        unsigned* bar = b.bar;
        __builtin_amdgcn_s_waitcnt(0);
        unsigned nloc = b.st[0], nx = b.st[1];
        if (nloc == 0u) { xcd_barrier_complete(bar, b.x, nloc, nx); b.st[0] = nloc; b.st[1] = nx; }
        const unsigned old = xb_add(&bar[XB_XSUB(b.x)], 1u);
        const unsigned gen = old / nloc;
        if (old + 1u == (gen + 1u) * nloc) {
            __builtin_amdgcn_fence(__ATOMIC_RELEASE, "agent");
            asm volatile("s_waitcnt vmcnt(0)" ::: "memory");
            const unsigned og = xb_add(&bar[XB_TOP], 1u);
            const unsigned tg = og / nx;
            if (og + 1u == (tg + 1u) * nx) xb_add(&bar[XB_TOPGEN], 1u);
            else XB_SPIN(xb_ld(&bar[XB_TOPGEN]) == tg, bar);
            __builtin_amdgcn_fence(__ATOMIC_ACQUIRE, "agent");
            xb_add(&bar[XB_XGEN(b.x)], 1u);
            asm volatile("s_waitcnt vmcnt(0)" ::: "memory");
        } else {
            XB_SPIN(xb_ld(&bar[XB_XGEN(b.x)]) == gen, bar);
            __builtin_amdgcn_fence(__ATOMIC_ACQUIRE, "agent");
            asm volatile("s_waitcnt vmcnt(0)" ::: "memory");
        }
    }
    __syncthreads();
}

struct Args { const float* in[N_INPUTS]; float* out; unsigned char* ws; int ph_lo, ph_hi; };
static_assert(sizeof(Args) == 34 * 8 + 8, "Args has no holes");

__device__ __forceinline__ float wave_sum(float v) {
#pragma unroll
    for (int o = 1; o < 64; o <<= 1) v += __shfl_xor(v, o);
    return v;
}

template <int KIND>
__device__ __forceinline__ void p0_item(const float* W0, const float* W1, int K, int Nsrc, const float* gain, bf16* WT, LAS float* scr, int item, int nblk, int lane) {
    const int kb = item / nblk, nb = item % nblk, k0 = 64 * kb, n0 = 32 * nb;
    if (KIND == 2 && n0 >= 3072) {
        const int np = n0 + (lane & 31);
        int col = 0; bool valid = true;
        if (np < 3088) col = 1024 + (np - 3072); else if (np < NIN) col = np; else valid = false;
        float vv[32];
#pragma unroll
        for (int i = 0; i < 32; ++i) vv[i] = W0[(size_t)(k0 + 2 * i + (lane >> 5)) * Nsrc + col];
#pragma unroll
        for (int i = 0; i < 32; ++i) { const int kk = 2 * i + (lane >> 5); float v = valid ? vv[i] : 0.f; if (gain) v *= gain[k0 + kk]; scr[kk * 33 + (lane & 31)] = v; }
    } else {
        const float* W = W0; int col0 = n0;
        if (KIND == 0) { const int pn = n0 >> 8, bj = (n0 >> 7) & 1, jj = n0 & 127; W = bj ? W1 : W0; col0 = pn * 128 + jj; }
        if (KIND == 2) col0 = (n0 < 1024) ? n0 : n0 + 16;
        const int kr = lane >> 3, nq = lane & 7;
        f32x4 vv[8]; float gv[8];
#pragma unroll
        for (int i = 0; i < 8; ++i) vv[i] = *(const f32x4*)(W + (size_t)(k0 + 8 * i + kr) * Nsrc + col0 + 4 * nq);
#pragma unroll
        for (int i = 0; i < 8; ++i) gv[i] = gain ? gain[k0 + 8 * i + kr] : 1.0f;
#pragma unroll
        for (int i = 0; i < 8; ++i) { LAS float* sp = scr + (8 * i + kr) * 33 + 4 * nq; const f32x4 v = vv[i] * gv[i]; sp[0] = v[0]; sp[1] = v[1]; sp[2] = v[2]; sp[3] = v[3]; }
    }
    LDS_WAIT(); asm volatile("" ::: "memory");
    const int c = lane & 7;
#pragma unroll
    for (int j = 0; j < 4; ++j) { const int n = (lane >> 3) + 8 * j; const LAS float* s = scr + (8 * c) * 33 + n;
        v4u o; o.x = cvtpk(s[0 * 33], s[1 * 33]); o.y = cvtpk(s[2 * 33], s[3 * 33]); o.z = cvtpk(s[4 * 33], s[5 * 33]); o.w = cvtpk(s[6 * 33], s[7 * 33]);
        *(v4u*)(WT + (size_t)(n0 + n) * K + k0 + 8 * c) = o; }
    LDS_WAIT(); asm volatile("" ::: "memory");
}
constexpr int IT_GU = (D / 64) * (NGU / 32), IT_D = (FF / 64) * (D / 32), IT_IN = (D / 64) * (NINP / 32), IT_OUT = (D / 64) * (D / 32);
constexpr int IT_LAYER = 2 * IT_GU + 2 * IT_D + IT_IN + IT_OUT;

__device__ __forceinline__ void convert_weights(const Args& A, LAS unsigned char* ldsl, int wave, int lane, int it_lo, int it_hi, int gw, int NGW) {
    LAS float* scr = (LAS float*)(ldsl + RING_OFF + wave * 16384);
    unsigned char* ws = A.ws;
    for (int it = it_lo + gw; it < it_hi; it += NGW) {
        const int l = it / IT_LAYER; int r = it % IT_LAYER;
        unsigned char* wl = ws + WS_W + (size_t)l * W_LAYER;
        if (r < IT_GU) { p0_item<0>(A.in[I_F1G] + (size_t)l * D * FF, A.in[I_F1U] + (size_t)l * D * FF, D, FF, A.in[I_F1N] + l * D, (bf16*)(wl + WO_GU1), scr, r, NGU / 32, lane); continue; } r -= IT_GU;
        if (r < IT_D) { p0_item<1>(A.in[I_F1D] + (size_t)l * D * FF, nullptr, FF, D, nullptr, (bf16*)(wl + WO_D1), scr, r, D / 32, lane); continue; } r -= IT_D;
        if (r < IT_IN) { p0_item<2>(A.in[I_WIN] + (size_t)l * D * NIN, nullptr, D, NIN, A.in[I_MIXN] + l * D, (bf16*)(wl + WO_IN), scr, r, NINP / 32, lane); continue; } r -= IT_IN;
        if (r < IT_OUT) { p0_item<1>(A.in[I_WOUT] + (size_t)l * D * D, nullptr, D, D, nullptr, (bf16*)(wl + WO_OUT), scr, r, D / 32, lane); continue; } r -= IT_OUT;
        if (r < IT_GU) { p0_item<0>(A.in[I_F2G] + (size_t)l * D * FF, A.in[I_F2U] + (size_t)l * D * FF, D, FF, A.in[I_F2N] + l * D, (bf16*)(wl + WO_GU2), scr, r, NGU / 32, lane); continue; } r -= IT_GU;
        p0_item<1>(A.in[I_F2D] + (size_t)l * D * FF, nullptr, FF, D, nullptr, (bf16*)(wl + WO_D2), scr, r, D / 32, lane);
    }
}
constexpr int IT_EARLY = DEPTH * IT_LAYER;
__device__ __forceinline__ void p0_prologue(const Args& A, LAS unsigned char* ldsl, int wave, int lane, int G) {
    const int gw = blockIdx.x * NWAVES + wave, NGW = G * NWAVES;
    unsigned char* ws = A.ws;
    convert_weights(A, ldsl, wave, lane, 0, IT_EARLY, gw, NGW);
    bf16* xb = (bf16*)(ws + WS_XB); float* rss = (float*)(ws + WS_RSS);
    for (int m = gw; m < M; m += NGW) {
        const float* src = (m < MP) ? A.in[I_XP] + (size_t)m * D : A.in[I_XS] + (size_t)(m - MP) * D;
        const f32x4* xr = (const f32x4*)src + lane; f32x4 v[4]; float s = 0.f;
#pragma unroll
        for (int j = 0; j < 4; ++j) v[j] = xr[64 * j];
        v2u* bo = (v2u*)(xb + (size_t)m * D) + lane;
#pragma unroll
        for (int j = 0; j < 4; ++j) { v2u w; w.x = pk2(v[j].x, v[j].y); w.y = pk2(v[j].z, v[j].w); bo[64 * j] = w;
            const float r0 = __builtin_bit_cast(float, w.x << 16), r1 = __builtin_bit_cast(float, w.x & 0xffff0000u), r2 = __builtin_bit_cast(float, w.y << 16), r3 = __builtin_bit_cast(float, w.y & 0xffff0000u);
            s += (r0 * r0 + r1 * r1) + (r2 * r2 + r3 * r3); }
        s = wave_sum(s);
        if (lane == 0) rss[m] = s;
    }
}

#ifndef MK_REP_S1
#define MK_REP_S1 1
#endif
#ifndef MK_REP_S3
#define MK_REP_S3 1
#endif
#ifndef MK_REP_S2SMP
#define MK_REP_S2SMP 1
#endif
struct MixP {
    const bf16* P; bf16* mixb; float* out; int l; float* DS; float* ESC; unsigned* subc;
    bf16* XC;
    const float *s_pool, *s_gla, *s_hgrn, *s_ssm, *s_conv;
    const float *pool_w, *pool_scale, *gla_wg, *gla_b, *gla_n, *lbl, *hg_n, *conv_w, *conv_b, *dt_b, *a_log, *ssm_d, *ssm_n;
};
typedef short bf16x8 __attribute__((ext_vector_type(8)));
constexpr int MIX_CONST_OFF = 113664;
#define MFMA16(a, b, c) __builtin_amdgcn_mfma_f32_16x16x32_bf16((a), (b), (c), 0, 0, 0)
template <int CTRL> __device__ __forceinline__ float dpp_shr1(float x) { return __builtin_bit_cast(float, __builtin_amdgcn_update_dpp(0x3f800000, __builtin_bit_cast(int, x), CTRL, 0xf, 0xf, false)); }
template <int CTRL, int ROWMASK> __device__ __forceinline__ float dpp_sel(float oldv, float x) { return __builtin_bit_cast(float, __builtin_amdgcn_update_dpp(__builtin_bit_cast(int, oldv), __builtin_bit_cast(int, x), CTRL, ROWMASK, 0xf, false)); }
__device__ __forceinline__ float dpp_bcast15(float oldv, float x) { return dpp_sel<0x142, 0xa>(oldv, x); }
__device__ __forceinline__ float quad_sum(float v) { v += dpp_sel<0xB1, 0xf>(0.f, v); v += dpp_sel<0x4E, 0xf>(0.f, v); return v; }
__device__ __forceinline__ float oct_sum(float v) { v = quad_sum(v); v += dpp_sel<0x141, 0xf>(0.f, v); return v; }
__device__ __forceinline__ bf16x8 frag16(const LAS unsigned char* p) { return *(const LAS bf16x8*)p; }
__device__ __forceinline__ bf16x8 frag8x2(const LAS unsigned char* p0, const LAS unsigned char* p1) { const v2u a = *(const LAS v2u*)p0, b = *(const LAS v2u*)p1; v4u w; w.x = a.x; w.y = a.y; w.z = b.x; w.w = b.y; return __builtin_bit_cast(bf16x8, w); }
__device__ __forceinline__ bf16x8 pack_frag(const f32x4 a, const f32x4 b) { v4u w; w.x = cvtpk(a[0], a[1]); w.y = cvtpk(a[2], a[3]); w.z = cvtpk(b[0], b[1]); w.w = cvtpk(b[2], b[3]); return __builtin_bit_cast(bf16x8, w); }
__device__ __forceinline__ float bfe(const v4u w, const int e) { const unsigned x = w[e >> 1]; return __builtin_bit_cast(float, (e & 1) ? (x & 0xffff0000u) : (x << 16)); }
__device__ __forceinline__ float bfe2(const v2u w, const int e) { const unsigned x = w[e >> 1]; return __builtin_bit_cast(float, (e & 1) ? (x & 0xffff0000u) : (x << 16)); }
__device__ __forceinline__ unsigned short bfbits(const v4u w, const int e) { const unsigned x = w[e >> 1]; return (unsigned short)((e & 1) ? (x >> 16) : (x & 0xffffu)); }

template <int K> struct GHL { static constexpr int RS = K * 2 + 16, OFF_Q = 0, OFF_K = 32 * RS, OFF_KT = 64 * RS, OFF_VT = OFF_KT + K * 80, OFF_E = OFF_VT + 64 * 80, OFF_O = OFF_E + K * 4, UNIT = OFF_O + 32 * 272; };
static_assert(GHL<64>::UNIT == 28416 && 4 * GHL<64>::UNIT <= MIX_CONST_OFF, "GLA/HGRN LDS map");

template <int K>
__device__ __forceinline__ void s2_gh_unit(LAS unsigned char* U, f32x4 (&S)[K / 16], const int cs, const int lane) {
    typedef GHL<K> G; constexpr int NS = K / 32, KT = K / 16;
    const int q = lane >> 4, r16 = lane & 15, c = 16 * cs + r16;
    const f32x4 z4 = {0.f, 0.f, 0.f, 0.f};
    const LAS unsigned char* vrow = U + G::OFF_VT + c * 80;
    bf16x8 kf0[NS], kf1[NS], qf0[NS], qf1[NS], qp0[NS], qp1[NS], ktf[KT]; f32x4 e4[KT];
#pragma unroll
    for (int kt = 0; kt < KT; ++kt) { ktf[kt] = frag16(U + G::OFF_KT + (16 * kt + r16) * 80 + (8 * q) * 2); e4[kt] = *(const LAS f32x4*)(U + G::OFF_E + (16 * kt + 4 * q) * 4); }
    const bf16x8 vn = frag16(vrow + (8 * q) * 2);
#pragma unroll
    for (int s = 0; s < NS; ++s) {
        const LAS unsigned char* qr0 = U + G::OFF_Q + r16 * G::RS + (32 * s + 4 * q) * 2; const LAS unsigned char* qr1 = qr0 + 16 * G::RS;
        qp0[s] = frag8x2(qr0, qr0 + 32); qp1[s] = frag8x2(qr1, qr1 + 32);
    }
#pragma unroll
    for (int s = 0; s < NS; ++s) {
        const int kb = (32 * s + 8 * q) * 2;
        kf0[s] = frag16(U + G::OFF_K + r16 * G::RS + kb); kf1[s] = frag16(U + G::OFF_K + (16 + r16) * G::RS + kb);
        qf0[s] = frag16(U + G::OFF_Q + r16 * G::RS + kb); qf1[s] = frag16(U + G::OFF_Q + (16 + r16) * G::RS + kb);
    }
    const bf16x8 vb = frag8x2(vrow + (4 * q) * 2, vrow + (16 + 4 * q) * 2);
    bf16x8 sb[NS];
#pragma unroll
    for (int s = 0; s < NS; ++s) sb[s] = pack_frag(S[2 * s], S[2 * s + 1]);
#pragma unroll
    for (int kt = 0; kt < KT; ++kt) { S[kt] = MFMA16(ktf[kt], vn, S[kt]); S[kt] = S[kt] * e4[kt]; }
    f32x4 X00 = z4, X01 = z4, X11 = z4;
#pragma unroll
    for (int s = 0; s < NS; ++s) { X00 = MFMA16(kf0[s], qf0[s], X00); X01 = MFMA16(kf0[s], qf1[s], X01); X11 = MFMA16(kf1[s], qf1[s], X11); }
    f32x4 o0 = z4, o1 = z4;
#pragma unroll
    for (int s = 0; s < NS; ++s) { o0 = MFMA16(qp0[s], sb[s], o0); o1 = MFMA16(qp1[s], sb[s], o1); }
#pragma unroll
    for (int r = 0; r < 4; ++r) if (4 * q + r > r16) { X00[r] = 0.f; X11[r] = 0.f; }
    const bf16x8 a0 = pack_frag(X00, z4), a1 = pack_frag(X01, X11);
    o0 = MFMA16(a0, vb, o0); o1 = MFMA16(a1, vb, o1);
    LAS float* ob = (LAS float*)(U + G::OFF_O);
#pragma unroll
    for (int r = 0; r < 4; ++r) { ob[(4 * q + r) * 68 + c] = o0[r]; ob[(16 + 4 * q + r) * 68 + c] = o1[r]; }
}

template <int MT>
__device__ __forceinline__ void chain_gh(LAS unsigned char* L, const MixP& C, const int h, const int b0, const bool smp, const int tid) {
    constexpr int K = (MT == 0) ? 32 : 64, KT = K / 16, NK = K / 4;
    typedef GHL<K> G;
    const int w = __builtin_amdgcn_readfirstlane(tid >> 6), lane = tid & 63;
    const int u1 = tid >> 7, t1 = tid & 31, kg = (tid >> 5) & 3;
    LAS float* cst = (LAS float*)(L + MIX_CONST_OFF);
    if (MT == 0) { cst[tid] = C.gla_wg[(tid >> 5) * 128 + h * 32 + (tid & 31)]; if (tid < 32) cst[512 + tid] = C.gla_b[h * 32 + tid]; }
    if (tid >= 64 && tid < 128) cst[600 + tid - 64] = ((MT == 0) ? C.gla_n : C.hg_n)[tid - 64];
    if (MT == 1) { if (tid < 64) cst[tid] = (C.l == 0) ? 0.f : sigmoid_f(C.lbl[256 + h * 64 + tid] - C.lbl[h * 64 + tid]); }
    __syncthreads();
    const float* sin = (MT == 0) ? C.s_gla : C.s_hgrn;
    const size_t o_p = (MT == 0) ? O_GLAP : O_HGP, o_s = (MT == 0) ? O_GLAS : O_HGS;
    f32x4 S[KT];
#pragma unroll
    for (int kt = 0; kt < KT; ++kt) S[kt] = (f32x4){0.f, 0.f, 0.f, 0.f};
    const int nsc = smp ? 1 : TP / 128;
    v4u rw0, rw1, rw2, rw3, rw4, rw5;
#define GH_LOAD_RAW(SC) do { const bool valid_ = smp ? (t1 < TS) : true; \
        const int row_ = smp ? (MP + (b0 + u1) * TS + (valid_ ? t1 : 0)) : (b0 * TP + (SC) * 128 + u1 * 32 + t1); \
        const bf16* prow_ = C.P + (size_t)row_ * NINP; \
        if (MT == 0) { rw0 = *(const v4u*)(prow_ + PC_GQ + h * 32 + 8 * kg); rw1 = *(const v4u*)(prow_ + PC_GK + h * 32 + 8 * kg); rw2 = *(const v4u*)(prow_ + PC_LR); rw3 = *(const v4u*)(prow_ + PC_LR + 8); \
                       rw4 = *(const v4u*)(prow_ + PC_GV + h * 64 + 16 * kg); rw5 = *(const v4u*)(prow_ + PC_GV + h * 64 + 16 * kg + 8); } \
        else { rw0 = *(const v4u*)(prow_ + PC_RQ + h * 64 + 16 * kg); rw1 = *(const v4u*)(prow_ + PC_RQ + h * 64 + 16 * kg + 8); rw2 = *(const v4u*)(prow_ + PC_RF + h * 64 + 16 * kg); rw3 = *(const v4u*)(prow_ + PC_RF + h * 64 + 16 * kg + 8); \
               rw4 = *(const v4u*)(prow_ + PC_RI + h * 64 + 16 * kg); rw5 = *(const v4u*)(prow_ + PC_RI + h * 64 + 16 * kg + 8); } } while (0)
    GH_LOAD_RAW(0);
    for (int sc = 0; sc < nsc; ++sc) {
#pragma unroll 1
        for (int rep1 = 0; rep1 < MK_REP_S1; ++rep1) {
            const bool valid = smp ? (t1 < TS) : true;
            LAS unsigned char* U = L + u1 * G::UNIT;
            float f[NK], kk[NK], qq[NK]; v4u vraw0 = rw4, vraw1 = rw5;
            if (MT == 0) {
                const v4u gq = rw0, gk = rw1, lr0 = rw2, lr1 = rw3;
                float lg[NK];
#pragma unroll
                for (int e = 0; e < NK; ++e) lg[e] = cst[512 + 8 * kg + e];
#pragma unroll
                for (int j = 0; j < 16; ++j) { const float lv = (j < 8) ? bfe(lr0, j) : bfe(lr1, j - 8);
                    const f32x4 w0 = *(const LAS f32x4*)(cst + j * 32 + 8 * kg), w1 = *(const LAS f32x4*)(cst + j * 32 + 8 * kg + 4);
                    lg[0] += lv * w0[0]; lg[1] += lv * w0[1]; lg[2] += lv * w0[2]; lg[3] += lv * w0[3]; lg[4] += lv * w1[0]; lg[5] += lv * w1[1]; lg[6] += lv * w1[2]; lg[7] += lv * w1[3]; }
#pragma unroll
                for (int e = 0; e < NK; ++e) { f[e] = __expf(logsigmoid_f(lg[e]) * (1.0f / 16.0f)); kk[e] = bfe(gk, e); qq[e] = bfe(gq, e) * 0.17677669529663687f; }
            } else {
                const v4u rq0 = rw0, rq1 = rw1, rf0 = rw2, rf1 = rw3;
#pragma unroll
                for (int e = 0; e < NK; ++e) { const float z = (e < 8) ? bfe(rf0, e) : bfe(rf1, e - 8), qv = (e < 8) ? bfe(rq0, e) : bfe(rq1, e - 8);
                    const float lb = cst[16 * kg + e], sg = sigmoid_f(z);
                    f[e] = lb + (1.f - lb) * sg; kk[e] = (1.f - lb) * (1.f - sg); qq[e] = qv; }
            }
            if (!valid) {
#pragma unroll
                for (int e = 0; e < NK; ++e) { f[e] = 1.f; kk[e] = 0.f; qq[e] = 0.f; }
                vraw0 = (v4u){0u, 0u, 0u, 0u}; vraw1 = vraw0;
            }
#pragma unroll
            for (int e = 0; e < NK; ++e) {
                float p = f[e];
                p *= dpp_shr1<0x111>(p); p *= dpp_shr1<0x112>(p); p *= dpp_shr1<0x114>(p); p *= dpp_shr1<0x118>(p);
                p *= dpp_bcast15(1.0f, p);
                f[e] = p;
            }
            float qt[NK], kt_[NK];
#pragma unroll
            for (int e = 0; e < NK; ++e) { qt[e] = qq[e] * f[e]; kt_[e] = kk[e] * __builtin_amdgcn_rcpf(fmaxf(f[e], 1e-30f)); }
#pragma unroll
            for (int e8 = 0; e8 < NK; e8 += 8) {
                v4u wq, wk;
                wq.x = cvtpk(qt[e8 + 0], qt[e8 + 1]); wq.y = cvtpk(qt[e8 + 2], qt[e8 + 3]); wq.z = cvtpk(qt[e8 + 4], qt[e8 + 5]); wq.w = cvtpk(qt[e8 + 6], qt[e8 + 7]);
                wk.x = cvtpk(kt_[e8 + 0], kt_[e8 + 1]); wk.y = cvtpk(kt_[e8 + 2], kt_[e8 + 3]); wk.z = cvtpk(kt_[e8 + 4], kt_[e8 + 5]); wk.w = cvtpk(kt_[e8 + 6], kt_[e8 + 7]);
                *(LAS v4u*)(U + G::OFF_Q + t1 * G::RS + (NK * kg + e8) * 2) = wq;
                *(LAS v4u*)(U + G::OFF_K + t1 * G::RS + (NK * kg + e8) * 2) = wk;
#pragma unroll
                for (int e = 0; e < 8; ++e) *(LAS unsigned short*)(U + G::OFF_KT + (NK * kg + e8 + e) * 80 + t1 * 2) = bfbits(wk, e);
            }
#pragma unroll
            for (int e = 0; e < 16; ++e) *(LAS unsigned short*)(U + G::OFF_VT + (16 * kg + e) * 80 + t1 * 2) = (e < 8) ? bfbits(vraw0, e) : bfbits(vraw1, e - 8);
            if (t1 == 31) {
#pragma unroll
                for (int e = 0; e < NK; ++e) *(LAS float*)(U + G::OFF_E + (NK * kg + e) * 4) = f[e];
            }
        }
        __syncthreads();
        const int tok3 = tid >> 2, cq3 = tid & 3, u3 = tok3 >> 5, i3 = tok3 & 31;
        const bool valid3 = smp ? (i3 < TS) : true;
        const int row3 = smp ? (MP + (b0 + u3) * TS + (valid3 ? i3 : 0)) : (b0 * TP + sc * 128 + tok3);
        v4u gg0, gg1;
        { const bf16* grow = C.P + (size_t)row3 * NINP + ((MT == 0) ? PC_GR : PC_RG) + h * 64 + 16 * cq3; gg0 = *(const v4u*)grow; gg1 = *(const v4u*)(grow + 8); }
        GH_LOAD_RAW((sc + 1 < nsc) ? sc + 1 : sc);
        if (!smp) {
            if (w < 4) {
#pragma unroll 1
                for (int u = 0; u < 4; ++u) s2_gh_unit<K>(L + u * G::UNIT, S, w, lane);
            }
        } else {
#pragma unroll 1
            for (int job = w; job < 16; job += 8) {
                const int u = job >> 2, cs = job & 3, q = lane >> 4, c = 16 * cs + (lane & 15);
                const size_t sb = ((size_t)(b0 + u) * 4 + h) * K * 64;
#pragma unroll
                for (int kt = 0; kt < KT; ++kt)
#pragma unroll
                    for (int r = 0; r < 4; ++r) S[kt][r] = sin[sb + (size_t)(16 * kt + 4 * q + r) * 64 + c];
                s2_gh_unit<K>(L + u * G::UNIT, S, cs, lane);
                float* so = C.out + o_s + (((size_t)C.l * BS + b0 + u) * 4 + h) * K * 64;
#pragma unroll
                for (int kt = 0; kt < KT; ++kt)
#pragma unroll
                    for (int r = 0; r < 4; ++r) so[(size_t)(16 * kt + 4 * q + r) * 64 + c] = S[kt][r];
            }
        }
        __syncthreads();
#pragma unroll 1
        for (int rep3 = 0; rep3 < MK_REP_S3; ++rep3) {
            const LAS float* ob = (const LAS float*)(L + u3 * G::UNIT + G::OFF_O) + i3 * 68 + 16 * cq3;
            f32x4 o[4]; float ss = 0.f;
#pragma unroll
            for (int j = 0; j < 4; ++j) { o[j] = *(const LAS f32x4*)(ob + 4 * j); ss += (o[j][0] * o[j][0] + o[j][1] * o[j][1]) + (o[j][2] * o[j][2] + o[j][3] * o[j][3]); }
            ss = quad_sum(ss);
            const float r = rsqrtf(ss * (1.0f / 64.0f) + 1e-6f);
            float res[16], nwv[16];
#pragma unroll
            for (int j = 0; j < 4; ++j) { const f32x4 t = *(const LAS f32x4*)(cst + 600 + 16 * cq3 + 4 * j); nwv[4 * j] = t[0]; nwv[4 * j + 1] = t[1]; nwv[4 * j + 2] = t[2]; nwv[4 * j + 3] = t[3]; }
#pragma unroll
            for (int e = 0; e < 16; ++e) { const float gv = (e < 8) ? bfe(gg0, e) : bfe(gg1, e - 8); res[e] = o[e >> 2][e & 3] * r * nwv[e] * gv; }
            if (valid3) {
                v4u w0, w1;
                w0.x = cvtpk(res[0], res[1]); w0.y = cvtpk(res[2], res[3]); w0.z = cvtpk(res[4], res[5]); w0.w = cvtpk(res[6], res[7]);
                w1.x = cvtpk(res[8], res[9]); w1.y = cvtpk(res[10], res[11]); w1.z = cvtpk(res[12], res[13]); w1.w = cvtpk(res[14], res[15]);
                bf16* mo = C.mixb + (size_t)row3 * D + ((MT == 0) ? MC_GLA : MC_HGRN) + h * 64 + 16 * cq3;
                *(v4u*)mo = w0; *(v4u*)(mo + 8) = w1;
            }
        }
    }
#undef GH_LOAD_RAW
    if (!smp && w < 4) {
        const int q = lane >> 4, c = 16 * w + (lane & 15);
        float* so = C.out + o_p + (((size_t)C.l * BP + b0) * 4 + h) * K * 64;
#pragma unroll
        for (int kt = 0; kt < KT; ++kt)
#pragma unroll
            for (int r = 0; r < 4; ++r) so[(size_t)(16 * kt + 4 * q + r) * 64 + c] = S[kt][r];
    }
    __syncthreads();
}

namespace SL { constexpr int OFF_C = 0, OFF_B = 8704, OFF_BT = 17408, OFF_XT = 27648, OFF_TAB = 37888, OFF_Y = 39168, UNIT = 56064; }
static_assert(2 * SL::UNIT <= MIX_CONST_OFF, "SSD LDS map");

__device__ __forceinline__ void s2_ssd_unit(LAS unsigned char* U, f32x4 (&S)[8], const int hh, const int ps, const int lane, const float Dh) {
    const int q = lane >> 4, r16 = lane & 15, p = 16 * ps + r16;
    const f32x4 z4 = {0.f, 0.f, 0.f, 0.f};
    const LAS float* tab = (const LAS float*)(U + SL::OFF_TAB) + hh * 160;
    const LAS unsigned char* xrow = U + SL::OFF_XT + hh * 5120 + p * 80;
    bf16x8 btf[8];
#pragma unroll
    for (int nt = 0; nt < 8; ++nt) btf[nt] = frag16(U + SL::OFF_BT + (16 * nt + r16) * 80 + (8 * q) * 2);
    const v4u xn = *(const LAS v4u*)(xrow + (8 * q) * 2);
    const f32x4 w0 = *(const LAS f32x4*)(tab + 96 + 8 * q), w1 = *(const LAS f32x4*)(tab + 96 + 8 * q + 4);
    const float eL = tab[128];
    bf16x8 cp0[4], cp1[4];
#pragma unroll
    for (int s = 0; s < 4; ++s) { const LAS unsigned char* cr0 = U + SL::OFF_C + r16 * 272 + (32 * s + 4 * q) * 2; const LAS unsigned char* cr1 = cr0 + 16 * 272; cp0[s] = frag8x2(cr0, cr0 + 32); cp1[s] = frag8x2(cr1, cr1 + 32); }
    bf16x8 sb[4];
#pragma unroll
    for (int s = 0; s < 4; ++s) sb[s] = pack_frag(S[2 * s], S[2 * s + 1]);
    const f32x4 xa = {bfe(xn, 0) * w0[0], bfe(xn, 1) * w0[1], bfe(xn, 2) * w0[2], bfe(xn, 3) * w0[3]}, xc = {bfe(xn, 4) * w1[0], bfe(xn, 5) * w1[1], bfe(xn, 6) * w1[2], bfe(xn, 7) * w1[3]};
    const bf16x8 xh = pack_frag(xa, xc);
#pragma unroll
    for (int nt = 0; nt < 8; ++nt) S[nt] = MFMA16(btf[nt], xh, S[nt] * eL);
    f32x4 X00 = z4, X01 = z4, X11 = z4;
#pragma unroll
    for (int s = 0; s < 4; ++s) {
        const int nb = (32 * s + 8 * q) * 2;
        const bf16x8 b0 = frag16(U + SL::OFF_B + r16 * 272 + nb), b1 = frag16(U + SL::OFF_B + (16 + r16) * 272 + nb);
        const bf16x8 c0 = frag16(U + SL::OFF_C + r16 * 272 + nb), c1 = frag16(U + SL::OFF_C + (16 + r16) * 272 + nb);
        X00 = MFMA16(b0, c0, X00); X01 = MFMA16(b0, c1, X01); X11 = MFMA16(b1, c1, X11);
    }
    f32x4 y20 = z4, y21 = z4;
#pragma unroll
    for (int s = 0; s < 4; ++s) { y20 = MFMA16(cp0[s], sb[s], y20); y21 = MFMA16(cp1[s], sb[s], y21); }
    const float ci0 = tab[r16], ci1 = tab[16 + r16];
    const f32x4 cj0 = *(const LAS f32x4*)(tab + 4 * q), cj1 = *(const LAS f32x4*)(tab + 16 + 4 * q);
#pragma unroll
    for (int r = 0; r < 4; ++r) {
        X00[r] = (4 * q + r > r16) ? 0.f : X00[r] * __expf(fminf(ci0 - cj0[r], 0.f));
        X01[r] = X01[r] * __expf(fminf(ci1 - cj0[r], 0.f));
        X11[r] = (4 * q + r > r16) ? 0.f : X11[r] * __expf(fminf(ci1 - cj1[r], 0.f));
    }
    const bf16x8 a0 = pack_frag(X00, z4), a1 = pack_frag(X01, X11);
    bf16x8 xb; f32x4 ux0, ux1;
    { const v2u xl = *(const LAS v2u*)(xrow + (4 * q) * 2), xh_ = *(const LAS v2u*)(xrow + (16 + 4 * q) * 2);
      const f32x4 d0 = *(const LAS f32x4*)(tab + 64 + 4 * q), d1 = *(const LAS f32x4*)(tab + 64 + 16 + 4 * q);
      const f32x4 fa = {__builtin_bit_cast(float, xl.x << 16) * d0[0], __builtin_bit_cast(float, xl.x & 0xffff0000u) * d0[1], __builtin_bit_cast(float, xl.y << 16) * d0[2], __builtin_bit_cast(float, xl.y & 0xffff0000u) * d0[3]};
      const f32x4 fb = {__builtin_bit_cast(float, xh_.x << 16) * d1[0], __builtin_bit_cast(float, xh_.x & 0xffff0000u) * d1[1], __builtin_bit_cast(float, xh_.y << 16) * d1[2], __builtin_bit_cast(float, xh_.y & 0xffff0000u) * d1[3]};
      xb = pack_frag(fa, fb);
      ux0 = (f32x4){__builtin_bit_cast(float, xl.x << 16), __builtin_bit_cast(float, xl.x & 0xffff0000u), __builtin_bit_cast(float, xl.y << 16), __builtin_bit_cast(float, xl.y & 0xffff0000u)} * Dh;
      ux1 = (f32x4){__builtin_bit_cast(float, xh_.x << 16), __builtin_bit_cast(float, xh_.x & 0xffff0000u), __builtin_bit_cast(float, xh_.y << 16), __builtin_bit_cast(float, xh_.y & 0xffff0000u)} * Dh; }
    const f32x4 y10 = MFMA16(a0, xb, z4), y11 = MFMA16(a1, xb, z4);
    const f32x4 e0 = *(const LAS f32x4*)(tab + 32 + 4 * q), e1 = *(const LAS f32x4*)(tab + 32 + 16 + 4 * q);
    LAS float* yb = (LAS float*)(U + SL::OFF_Y);
#pragma unroll
    for (int r = 0; r < 4; ++r) { yb[(4 * q + r) * 132 + hh * 64 + p] = y10[r] + e0[r] * y20[r] + ux0[r]; yb[(16 + 4 * q + r) * 132 + hh * 64 + p] = y11[r] + e1[r] * y21[r] + ux1[r]; }
}

__device__ __forceinline__ void s2_ssd_state(LAS unsigned char* U, f32x4 (&S)[8], const int hh, const int ps, const int lane) {
    const int q = lane >> 4, r16 = lane & 15, p = 16 * ps + r16;
    const LAS float* tab = (const LAS float*)(U + SL::OFF_TAB) + hh * 160;
    const LAS unsigned char* xrow = U + SL::OFF_XT + hh * 5120 + p * 80;
    bf16x8 btf[8];
#pragma unroll
    for (int nt = 0; nt < 8; ++nt) btf[nt] = frag16(U + SL::OFF_BT + (16 * nt + r16) * 80 + (8 * q) * 2);
    const v4u xn = *(const LAS v4u*)(xrow + (8 * q) * 2);
    const f32x4 w0 = *(const LAS f32x4*)(tab + 96 + 8 * q), w1 = *(const LAS f32x4*)(tab + 96 + 8 * q + 4);
    const float eL = tab[128];
    const f32x4 xa = {bfe(xn, 0) * w0[0], bfe(xn, 1) * w0[1], bfe(xn, 2) * w0[2], bfe(xn, 3) * w0[3]}, xc = {bfe(xn, 4) * w1[0], bfe(xn, 5) * w1[1], bfe(xn, 6) * w1[2], bfe(xn, 7) * w1[3]};
    const bf16x8 xh = pack_frag(xa, xc);
#pragma unroll
    for (int nt = 0; nt < 8; ++nt) S[nt] = MFMA16(btf[nt], xh, S[nt] * eL);
}

__device__ __forceinline__ void conv_phase(const MixP& C, const int G, const int tid) {
    constexpr int NTASK = (M / 8) * 96;
    for (int task = blockIdx.x * NTHREADS + tid; task < NTASK; task += G * NTHREADS) {
        const int g8 = task / 96, bl = task - g8 * 96, ch0 = 8 * bl, row0 = 8 * g8;
        const bool smp = g8 >= MP / 8;
        const int bsm = smp ? g8 - MP / 8 : 0;
        const bool head = smp ? true : ((row0 & (TP - 1)) == 0);
#pragma unroll 1
        for (int hf = 0; hf < 2; ++hf) {
            const int chh = ch0 + 4 * hf;
            v2u xr[11];
#pragma unroll
            for (int i = 0; i < 11; ++i) { int r = row0 - 3 + i; if (head && i < 3) r = row0; xr[i] = *(const v2u*)(C.P + (size_t)r * NINP + PC_XBC + chh); }
            f32x4 st[3];
#pragma unroll
            for (int r = 0; r < 3; ++r) st[r] = (f32x4){0.f, 0.f, 0.f, 0.f};
            if (smp) {
#pragma unroll
                for (int r = 0; r < 3; ++r) st[r] = *(const f32x4*)(C.s_conv + ((size_t)bsm * 3 + r) * 768 + chh);
            }
            float wt[4][4], bs[4];
#pragma unroll
            for (int j = 0; j < 4; ++j) { const f32x4 wa = *(const f32x4*)(C.conv_w + j * 768 + chh);
#pragma unroll
                for (int c = 0; c < 4; ++c) wt[j][c] = wa[c]; }
            { const f32x4 wa = *(const f32x4*)(C.conv_b + chh);
#pragma unroll
              for (int c = 0; c < 4; ++c) bs[c] = wa[c]; }
            float p3[4], p2[4], p1[4];
#pragma unroll
            for (int c = 0; c < 4; ++c) { p3[c] = head ? st[0][c] : bfe2(xr[0], c); p2[c] = head ? st[1][c] : bfe2(xr[1], c); p1[c] = head ? st[2][c] : bfe2(xr[2], c); }
#pragma unroll
            for (int et = 0; et < 8; ++et) {
                float val[4];
#pragma unroll
                for (int c = 0; c < 4; ++c) { const float cur = bfe2(xr[et + 3], c);
                    val[c] = silu_f(bs[c] + wt[0][c] * p3[c] + wt[1][c] * p2[c] + wt[2][c] * p1[c] + wt[3][c] * cur); p3[c] = p2[c]; p2[c] = p1[c]; p1[c] = cur; }
                v2u wv; wv.x = cvtpk(val[0], val[1]); wv.y = cvtpk(val[2], val[3]);
                *(v2u*)(C.XC + (size_t)(row0 + et) * 768 + chh) = wv;
            }
        }
    }
}

__device__ __forceinline__ void chain_ssd(LAS unsigned char* L, const MixP& C, const int g, const int b0, const int mode, const int sc0, const int tid) {
    const bool smp = (mode == 1);
    const int w = __builtin_amdgcn_readfirstlane(tid >> 6), lane = tid & 63;
    const int hh2 = w >> 2, ps = w & 3, h2 = 2 * g + hh2;
    const float A0 = -__expf(C.a_log[2 * g]), A1 = -__expf(C.a_log[2 * g + 1]), dtb0 = C.dt_b[2 * g], dtb1 = C.dt_b[2 * g + 1], D0 = C.ssm_d[2 * g], D1 = C.ssm_d[2 * g + 1];
    f32x4 S[8];
#pragma unroll
    for (int nt = 0; nt < 8; ++nt) S[nt] = (f32x4){0.f, 0.f, 0.f, 0.f};
    const int cu1 = tid >> 8, ct = tid & 255;
    const int tg1 = ct / 48, bl1 = ct - tg1 * 48, lc01 = 8 * bl1;
    const int ch01 = (bl1 < 16) ? 128 * g + lc01 : (bl1 < 32) ? 256 + 128 * g + (lc01 - 128) : 512 + 128 * g + (lc01 - 256);
    const int tbase = smp ? 0 : sc0 * 64 + cu1 * 32;
    const int rowbase = smp ? MP + (b0 + cu1) * TS : b0 * TP;
    v4u xr[8]; bf16 sdraw = 0;
    if (ct < 192) { const bf16* xsrc = C.XC + (size_t)(rowbase + (smp ? 0 : tbase + 8 * tg1)) * 768 + ch01;
#pragma unroll
        for (int et = 0; et < 8; ++et) xr[et] = *(const v4u*)(xsrc + (size_t)et * 768); }
    else { const int t1 = ct & 31, hh = (ct - 192) >> 5; const bool valid = smp ? (t1 < TS) : true;
        sdraw = C.P[(size_t)(rowbase + tbase + (valid ? t1 : 0)) * NINP + PC_DT + 2 * g + hh]; }
    const int tok3 = tid >> 3, c83 = tid & 7, u3 = tok3 >> 5, i3 = tok3 & 31;
    const bool valid3 = smp ? (i3 < TS) : true;
    const int row3 = smp ? (MP + (b0 + u3) * TS + (valid3 ? i3 : 0)) : (b0 * TP + sc0 * 64 + tok3);
    v4u zz0, zz1;
    { const bf16* zrow = C.P + (size_t)row3 * NINP + PC_SZ + 128 * g + 16 * c83; zz0 = *(const v4u*)zrow; zz1 = *(const v4u*)(zrow + 8); }
    LAS float* cst = (LAS float*)(L + MIX_CONST_OFF);
    if (tid < 128) cst[tid] = C.ssm_n[128 * g + tid];
    {
        LAS unsigned char* U = L + cu1 * SL::UNIT;
        if (ct < 192) {
            const int tg = tg1, bl = bl1, lc0 = lc01;
            const bool tok_ok = smp ? (tg == 0) : true;
            if (!tok_ok) {
#pragma unroll
                for (int et = 0; et < 8; ++et) xr[et] = (v4u){0u, 0u, 0u, 0u};
            }
            if (bl >= 16) {
                LAS unsigned char* rb = U + ((bl < 32) ? SL::OFF_B + (lc0 - 128) * 2 : SL::OFF_C + (lc0 - 256) * 2) + (8 * tg) * 272;
#pragma unroll
                for (int et = 0; et < 8; ++et) *(LAS v4u*)(rb + et * 272) = xr[et];
            }
            if (bl < 32) {
                LAS unsigned char* tb = U + ((bl < 16) ? SL::OFF_XT + lc0 * 80 : SL::OFF_BT + (lc0 - 128) * 80) + 16 * tg;
#pragma unroll
                for (int c = 0; c < 8; ++c) { v4u o;
#pragma unroll
                    for (int k = 0; k < 4; ++k) { const unsigned a = xr[2 * k][c >> 1], b = xr[2 * k + 1][c >> 1]; o[k] = (c & 1) ? ((a >> 16) | (b & 0xffff0000u)) : ((a & 0xffffu) | (b << 16)); }
                    *(LAS v4u*)(tb + c * 80) = o; }
            }
        } else {
            const int t1 = ct & 31, hh = (ct - 192) >> 5;
            const bool valid = smp ? (t1 < TS) : true;
            const float dt = valid ? softplus_f(bf2f(sdraw) + ((hh == 0) ? dtb0 : dtb1)) : 0.f;
            float c0 = dt * ((hh == 0) ? A0 : A1);
            c0 += dpp_sel<0x111, 0xf>(0.f, c0); c0 += dpp_sel<0x112, 0xf>(0.f, c0); c0 += dpp_sel<0x114, 0xf>(0.f, c0); c0 += dpp_sel<0x118, 0xf>(0.f, c0); c0 += dpp_bcast15(0.f, c0);
            const float cl = (lane & 32) ? __builtin_bit_cast(float, __builtin_amdgcn_readlane(__builtin_bit_cast(int, c0), 63)) : __builtin_bit_cast(float, __builtin_amdgcn_readlane(__builtin_bit_cast(int, c0), 31));
            LAS float* tab = (LAS float*)(U + SL::OFF_TAB) + hh * 160;
            tab[t1] = c0; tab[32 + t1] = __expf(c0); tab[64 + t1] = dt; tab[96 + t1] = dt * __expf(cl - c0);
            if (t1 == 31) tab[128] = __expf(cl);
        }
    }
    __syncthreads();
    const int q2 = lane >> 4, p2 = 16 * ps + (lane & 15);
    float* dsp = C.DS + ((((size_t)(b0 * 2 + g) * (TP / 64) + sc0) * 2 + hh2) * 64 + p2) * 128;
    if (mode == 2) {
#pragma unroll 1
        for (int u = 0; u < 2; ++u) s2_ssd_state(L + u * SL::UNIT, S, hh2, ps, lane);
#pragma unroll
        for (int nt = 0; nt < 8; ++nt) *(f32x4*)(dsp + 16 * nt + 4 * q2) = S[nt];
        if (ps == 0 && lane == 0) C.ESC[((size_t)(b0 * 2 + g) * (TP / 64) + sc0) * 2 + hh2] = ((const LAS float*)(L + SL::OFF_TAB))[hh2 * 160 + 128] * ((const LAS float*)(L + SL::UNIT + SL::OFF_TAB))[hh2 * 160 + 128];
    } else if (mode == 3) {
#pragma unroll
        for (int nt = 0; nt < 8; ++nt) S[nt] = *(const f32x4*)(dsp + 16 * nt + 4 * q2);
#pragma unroll 1
        for (int u = 0; u < 2; ++u) s2_ssd_unit(L + u * SL::UNIT, S, hh2, ps, lane, (hh2 == 0) ? D0 : D1);
    } else {
#pragma unroll 1
        for (int u = 0; u < 2; ++u) {
            const float* sp = C.s_ssm + (((size_t)(b0 + u) * 4 + h2) * 64 + p2) * 128;
#pragma unroll
            for (int nt = 0; nt < 8; ++nt) S[nt] = *(const f32x4*)(sp + 16 * nt + 4 * q2);
            s2_ssd_unit(L + u * SL::UNIT, S, hh2, ps, lane, (hh2 == 0) ? D0 : D1);
            float* so = C.out + O_SSMS + ((((size_t)C.l * BS + b0 + u) * 4 + h2) * 64 + p2) * 128;
#pragma unroll
            for (int nt = 0; nt < 8; ++nt) *(f32x4*)(so + 16 * nt + 4 * q2) = S[nt];
        }
    }
    __syncthreads();
    if (mode != 2) {
        const LAS float* yb = (const LAS float*)(L + u3 * SL::UNIT + SL::OFF_Y) + i3 * 132 + 16 * c83;
        float y[16]; float ss = 0.f;
#pragma unroll
        for (int j = 0; j < 4; ++j) { const f32x4 v = *(const LAS f32x4*)(yb + 4 * j);
#pragma unroll
            for (int e = 0; e < 4; ++e) { const int ee = 4 * j + e; const float zv = (ee < 8) ? bfe(zz0, ee) : bfe(zz1, ee - 8); y[ee] = v[e] * zv; ss += y[ee] * y[ee]; } }
        ss = oct_sum(ss);
        const float r = rsqrtf(ss * (1.0f / 128.0f) + 1e-6f);
        if (valid3) {
            float nwv[16];
#pragma unroll
            for (int j = 0; j < 4; ++j) { const f32x4 t = *(const LAS f32x4*)(cst + 16 * c83 + 4 * j); nwv[4 * j] = t[0]; nwv[4 * j + 1] = t[1]; nwv[4 * j + 2] = t[2]; nwv[4 * j + 3] = t[3]; }
            v4u w0, w1;
            w0.x = cvtpk(y[0] * r * nwv[0], y[1] * r * nwv[1]); w0.y = cvtpk(y[2] * r * nwv[2], y[3] * r * nwv[3]); w0.z = cvtpk(y[4] * r * nwv[4], y[5] * r * nwv[5]); w0.w = cvtpk(y[6] * r * nwv[6], y[7] * r * nwv[7]);
            w1.x = cvtpk(y[8] * r * nwv[8], y[9] * r * nwv[9]); w1.y = cvtpk(y[10] * r * nwv[10], y[11] * r * nwv[11]); w1.z = cvtpk(y[12] * r * nwv[12], y[13] * r * nwv[13]); w1.w = cvtpk(y[14] * r * nwv[14], y[15] * r * nwv[15]);
            bf16* mo = C.mixb + (size_t)row3 * D + MC_SSM + 128 * g + 16 * c83;
            *(v4u*)mo = w0; *(v4u*)(mo + 8) = w1;
        }
    }
    __syncthreads();
}

__device__ __forceinline__ void ssd_scan(const MixP& C, const int wg, const int nwgs, const int tid) {
    constexpr int NSC = TP / 64, NEL = BP * 2 * 2 * 8192;
    for (int idx = wg * NTHREADS + tid; idx < NEL; idx += nwgs * NTHREADS) {
        const int e = idx & 8191, bgh = idx >> 13, hh = bgh & 1, bg = bgh >> 1;
        float* dp = C.DS + ((size_t)bg * NSC * 2 + hh) * 8192 + e;
        const float* ep = C.ESC + (size_t)bg * NSC * 2 + hh;
        float d[NSC], E[NSC];
#pragma unroll
        for (int sc = 0; sc < NSC; ++sc) { d[sc] = dp[(size_t)sc * 2 * 8192]; E[sc] = ep[sc * 2]; }
        float s = 0.f;
#pragma unroll
        for (int sc = 0; sc < NSC; ++sc) { dp[(size_t)sc * 2 * 8192] = s; s = E[sc] * s + d[sc]; }
        const int b = bg >> 1, g = bg & 1;
        C.out[O_SSMP + (((size_t)C.l * BP + b) * 4 + 2 * g + hh) * 8192 + e] = s;
    }
}

__device__ __forceinline__ void sub_barrier(unsigned* cnt, const unsigned nwg) {
    asm volatile("s_waitcnt vmcnt(0)" ::: "memory");
    __syncthreads();
    if (threadIdx.x == 0) {
        __builtin_amdgcn_fence(__ATOMIC_RELEASE, "agent");
        asm volatile("s_waitcnt vmcnt(0)" ::: "memory");
        (void)__hip_atomic_fetch_add(cnt, 1u, __ATOMIC_RELAXED, __HIP_MEMORY_SCOPE_AGENT);
        unsigned sp = 0;
        while (__hip_atomic_load(cnt, __ATOMIC_RELAXED, __HIP_MEMORY_SCOPE_AGENT) < nwg) { __builtin_amdgcn_s_sleep(2); if (++sp > (1u << 22)) break; }
        __builtin_amdgcn_fence(__ATOMIC_ACQUIRE, "agent");
        asm volatile("s_waitcnt vmcnt(0)" ::: "memory");
    }
    __syncthreads();
}
__device__ __forceinline__ void pool_item(LAS unsigned char* L, const MixP& C, const int tile, const int tid) {
    constexpr int DF_OFF = 40960, WT_OFF = 74752;
    const int m0 = tile * 64;
    {
        f32x4 wv[8];
#pragma unroll
        for (int i = 0; i < 8; ++i) { const int e4 = tid + NTHREADS * i; wv[i] = *(const f32x4*)(C.pool_w + (size_t)e4 * 4); }
#pragma unroll
        for (int i = 0; i < 8; ++i) { const int e4 = tid + NTHREADS * i, d0 = (e4 & 15) * 4, c = (e4 >> 4) & 63, g = e4 >> 10;
            LAS unsigned char* wp = L + WT_OFF + g * 9216 + d0 * 144 + c * 2;
            const unsigned p01 = cvtpk(wv[i][0], wv[i][1]), p23 = cvtpk(wv[i][2], wv[i][3]);
            *(LAS unsigned short*)(wp) = (unsigned short)(p01 & 0xffffu); *(LAS unsigned short*)(wp + 144) = (unsigned short)(p01 >> 16);
            *(LAS unsigned short*)(wp + 288) = (unsigned short)(p23 & 0xffffu); *(LAS unsigned short*)(wp + 432) = (unsigned short)(p23 >> 16); }
    }
    if (m0 < MP) {
        const int tt0 = m0 & (TP - 1);
#pragma unroll
        for (int idx = tid; idx < 79 * 32; idx += NTHREADS) {
            const int r = idx >> 5, c8 = idx & 31, tr = tt0 - 15 + r, trc = tr < 0 ? 0 : tr;
            const v4u ld = *(const v4u*)(C.P + (size_t)(m0 - tt0 + trc) * NINP + PC_PX + 8 * c8);
            *(LAS v4u*)(L + r * 512 + c8 * 16) = (tr >= 0) ? ld : (v4u){0u, 0u, 0u, 0u};
        }
        __syncthreads();
        {
            const int c = tid & 255, th = tid >> 8, g = c >> 6, w = 2 << g, tA = 32 * th;
            const LAS unsigned short* col = (const LAS unsigned short*)L + c;
            float s = 0.f;
            for (int j = 1; j < w; ++j) s += bf2f(col[(tA + 15 - j) * 256]);
            for (int t = tA; t < tA + 32; ++t) {
                const float x = bf2f(col[(t + 15) * 256]); s += x;
                const int tt = tt0 + t, cnt = (tt + 1 < w) ? tt + 1 : w;
                *(LAS unsigned short*)(L + DF_OFF + t * 528 + c * 2) = (unsigned short)(cvtpk(s * __builtin_amdgcn_rcpf((float)cnt) - x, 0.f) & 0xffffu);
                s -= bf2f(col[(t + 16 - w) * 256]);
            }
        }
    } else {
#pragma unroll 1
        for (int task = tid; task < 8 * 256; task += NTHREADS) {
            const int bb = task >> 8, c = task & 255, g = c >> 6, w = 2 << g, bg = (m0 - MP) / TS + bb;
            float xs[23];
#pragma unroll
            for (int r = 0; r < 15; ++r) xs[r] = C.s_pool[((size_t)bg * 15 + r) * 256 + c];
            bf16 xraw[8];
#pragma unroll
            for (int t = 0; t < 8; ++t) xraw[t] = C.P[(size_t)(m0 + bb * TS + t) * NINP + PC_PX + c];
#pragma unroll
            for (int t = 0; t < 8; ++t) xs[15 + t] = bf2f(xraw[t]);
            const float rw = __builtin_amdgcn_rcpf((float)w);
#pragma unroll
            for (int t = 0; t < 8; ++t) { float s = 0.f;
#pragma unroll
                for (int j = 0; j < 16; ++j) s += (j < w) ? xs[15 + t - j] : 0.f;
                *(LAS unsigned short*)(L + DF_OFF + (bb * TS + t) * 528 + c * 2) = (unsigned short)(cvtpk(s * rw - xs[15 + t], 0.f) & 0xffffu); }
        }
    }
    __syncthreads();
    {
        const int w8 = __builtin_amdgcn_readfirstlane(tid >> 6), lane = tid & 63, q = lane >> 4, r16 = lane & 15, g = w8 >> 1, dh = w8 & 1;
        f32x4 acc[2][4];
#pragma unroll
        for (int a = 0; a < 2; ++a)
#pragma unroll
            for (int b = 0; b < 4; ++b) acc[a][b] = (f32x4){0.f, 0.f, 0.f, 0.f};
#pragma unroll
        for (int ks = 0; ks < 2; ++ks) {
            bf16x8 wa[2], db[4];
#pragma unroll
            for (int a = 0; a < 2; ++a) wa[a] = frag16(L + WT_OFF + g * 9216 + (16 * (2 * dh + a) + r16) * 144 + (32 * ks + 8 * q) * 2);
#pragma unroll
            for (int b = 0; b < 4; ++b) db[b] = frag16(L + DF_OFF + (16 * b + r16) * 528 + (g * 64 + 32 * ks + 8 * q) * 2);
#pragma unroll
            for (int a = 0; a < 2; ++a)
#pragma unroll
                for (int b = 0; b < 4; ++b) acc[a][b] = MFMA16(wa[a], db[b], acc[a][b]);
        }
#pragma unroll
        for (int a = 0; a < 2; ++a) {
            const int d0 = g * 64 + 16 * (2 * dh + a) + 4 * q;
            const f32x4 sc = *(const f32x4*)(C.pool_scale + d0);
#pragma unroll
            for (int b = 0; b < 4; ++b) { const f32x4 v = acc[a][b] * sc; v2u o; o.x = cvtpk(v[0], v[1]); o.y = cvtpk(v[2], v[3]);
                *(v2u*)(C.mixb + (size_t)(m0 + 16 * b + r16) * D + MC_POOL + d0) = o; }
        }
    }
    __syncthreads();
}

constexpr int N_CP_PP = BP * 15 * 32, N_CP_PS = BS * 15 * 32, N_CP_CP = BP * 3 * 96, N_CP_CS = BS * 3 * 96, N_CP = N_CP_PP + N_CP_PS + N_CP_CP + N_CP_CS;
__device__ __forceinline__ void copy_states(const MixP& C, const int wg, const int nwgs, const int tid) {
    const int l = C.l;
    for (int i = wg * NTHREADS + tid; i < N_CP; i += nwgs * NTHREADS) {
        const bf16* src = nullptr; const float* fsrc = nullptr; float* dst;
        if (i < N_CP_PP) { const int b = i / 480, rem = i % 480, r = rem >> 5, c = (rem & 31) * 8;
            src = C.P + (size_t)(b * TP + TP - 15 + r) * NINP + PC_PX + c; dst = C.out + O_POOLP + ((size_t)(l * BP + b) * 15 + r) * 256 + c; }
        else if (i < N_CP_PP + N_CP_PS) { const int j = i - N_CP_PP, b = j / 480, rem = j % 480, r = rem >> 5, c = (rem & 31) * 8;
            if (r < 7) fsrc = C.s_pool + ((size_t)b * 15 + 8 + r) * 256 + c; else src = C.P + (size_t)(MP + b * TS + (r - 7)) * NINP + PC_PX + c;
            dst = C.out + O_POOLS + ((size_t)(l * BS + b) * 15 + r) * 256 + c; }
        else if (i < N_CP_PP + N_CP_PS + N_CP_CP) { const int j = i - N_CP_PP - N_CP_PS, b = j / 288, rem = j % 288, r = rem / 96, c = (rem % 96) * 8;
            src = C.P + (size_t)(b * TP + TP - 3 + r) * NINP + PC_XBC + c; dst = C.out + O_CONVP + ((size_t)(l * BP + b) * 3 + r) * 768 + c; }
        else { const int j = i - N_CP_PP - N_CP_PS - N_CP_CP, b = j / 288, rem = j % 288, r = rem / 96, c = (rem % 96) * 8;
            src = C.P + (size_t)(MP + b * TS + 5 + r) * NINP + PC_XBC + c; dst = C.out + O_CONVS + ((size_t)(l * BS + b) * 3 + r) * 768 + c; }
        f32x4 v0, v1;
        if (src) { const v4u w = *(const v4u*)src; v0 = (f32x4){bfe(w, 0), bfe(w, 1), bfe(w, 2), bfe(w, 3)}; v1 = (f32x4){bfe(w, 4), bfe(w, 5), bfe(w, 6), bfe(w, 7)}; }
        else { v0 = *(const f32x4*)fsrc; v1 = *(const f32x4*)(fsrc + 4); }
        *(f32x4*)dst = v0; *(f32x4*)(dst + 4) = v1;
    }
}

constexpr int NGH = BP * 8, N_SSD_IT = BP * 2 * (TP / 64), N_IT_SMP_GH = (BS / 4) * 4, N_IT_SMP_SSD = (BS / 2) * 2, N_IT_POOL = M / 64;
constexpr int IT_M3 = N_SSD_IT, IT_SGLA = 2 * N_SSD_IT, IT_SHG = IT_SGLA + N_IT_SMP_GH, IT_SSSD = IT_SHG + N_IT_SMP_GH, IT_POOL = IT_SSSD + N_IT_SMP_SSD, IT_GHP = IT_POOL + N_IT_POOL, IT_END = IT_GHP + NGH;
constexpr int N_IT_PROMPT = NGH;
__device__ __forceinline__ void mixer_phase(unsigned char* ldsg, LAS unsigned char* ldsl, const MixP& C, int G, const int tid) {
    const int bx = blockIdx.x;
    const int ngh = (G >= 2 * NGH) ? NGH : 0;
    const int nw = G - ngh;
    int it, step, lim; bool synced;
    if (bx < ngh) { it = IT_GHP + bx; step = 1 << 30; lim = IT_END; synced = true; }
    else { it = bx - ngh; step = nw; lim = (ngh > 0) ? IT_GHP : IT_END; synced = false; copy_states(C, bx - ngh, nw, tid); }
    int rep_it = 0;
    for (; it < lim; it += step) {
        if (!synced && it >= IT_M3) { sub_barrier(C.subc, (unsigned)nw); ssd_scan(C, bx - ngh, nw, tid); sub_barrier(C.subc + 64, (unsigned)nw); synced = true; }
        int tidl = tid; asm volatile("" : "+v"(tidl));
        int kind, a, b0, mode = 0, sc0 = 0; bool smp = true;
        if (it < IT_SGLA) { const int j = (it < IT_M3) ? it : it - IT_M3; kind = 2; mode = (it < IT_M3) ? 2 : 3; sc0 = j & (TP / 64 - 1); a = (j >> 5) & 1; b0 = j >> 6; }
        else if (it < IT_SHG) { const int j = it - IT_SGLA; kind = 0; a = j & 3; b0 = (j >> 2) * 4; }
        else if (it < IT_SSSD) { const int j = it - IT_SHG; kind = 1; a = j & 3; b0 = (j >> 2) * 4; }
        else if (it < IT_POOL) { const int j = it - IT_SSSD; kind = 2; mode = 1; a = j & 1; b0 = (j >> 1) * 2; }
        else if (it < IT_GHP) { kind = 3; a = it - IT_POOL; b0 = 0; }
        else { const int j = it - IT_GHP; smp = false; b0 = j >> 3; kind = ((j & 7) < 4) ? 0 : 1; a = j & 3; }
        if (kind == 0) {
#ifndef MK_NO_GLA
            chain_gh<0>(ldsl, C, a, b0, smp, tidl);
#endif
        } else if (kind == 1) {
#ifndef MK_NO_HGRN
            chain_gh<1>(ldsl, C, a, b0, smp, tidl);
#endif
        } else if (kind == 2) {
#ifndef MK_NO_SSD
            chain_ssd(ldsl, C, a, b0, mode, sc0, tidl);
#endif
        } else {
#ifndef MK_NO_POOL
            pool_item(ldsl, C, a, tidl);
#endif
        }
        int want = 1;
#ifdef MK_DUP_POOL
        if (kind == 3) want = 2;
#endif
#ifdef MK_DUP_SMPGH
        if (kind < 2 && smp) want = 2;
#endif
#ifdef MK_DUP_SMPSSD
        if (kind == 2 && mode == 1) want = 2;
#endif
#ifdef MK_DUP_GHP
        if (!smp) want = 2;
#endif
#ifdef MK_DUP_M3
        if (kind == 2 && mode == 3) want = 2;
#endif
        if (++rep_it < want) it -= step; else rep_it = 0;
    }
    if (!synced) { sub_barrier(C.subc, (unsigned)nw); ssd_scan(C, bx - ngh, nw, tid); sub_barrier(C.subc + 64, (unsigned)nw); }
}

__device__ __forceinline__ void srg_phase(LAS unsigned char* L, const bf16* Aop, const bf16* Bt, const int K, bf16* xb, float* rowss, const float scale, const bool fin, const int G, const int tid) {
    const int w = __builtin_amdgcn_readfirstlane(tid >> 6), lane = tid & 63, q = lane >> 4, r16 = lane & 15, wm = w >> 1, wn = w & 1;
    const int lr = tid >> 3, lc = (tid & 7) * 8;
    const int nt = K / 128;
    for (int tile = blockIdx.x; tile < 256; tile += G) {
        const int tm = tile >> 4, tn = tile & 15;
        const bf16* ag = Aop + (size_t)(MP + 64 * tm + lr) * K + lc;
        const bf16* bg = Bt + (size_t)(64 * tn + lr) * K + lc;
        f32x4 acc0 = {0.f, 0.f, 0.f, 0.f}, acc1 = acc0;
        v4u ra[2][2], rb[2][2];
#pragma unroll
        for (int i = 0; i < 2; ++i) { ra[i][0] = *(const v4u*)(ag + i * 128); ra[i][1] = *(const v4u*)(ag + i * 128 + 64); rb[i][0] = *(const v4u*)(bg + i * 128); rb[i][1] = *(const v4u*)(bg + i * 128 + 64); }
        LAS unsigned char* wr0 = L + lr * 272 + lc * 2;
        const LAS unsigned char* fa = L + (16 * wm + r16) * 272 + (8 * q) * 2;
        const LAS unsigned char* fb = L + 17408 + (32 * wn + r16) * 272 + (8 * q) * 2;
#pragma unroll 1
        for (int t = 0; t < nt; t += 2) {
#pragma unroll
            for (int i = 0; i < 2; ++i) {
                LAS unsigned char* wb_ = wr0 + i * 34816;
                *(LAS v4u*)(wb_) = ra[i][0]; *(LAS v4u*)(wb_ + 128) = ra[i][1]; *(LAS v4u*)(wb_ + 17408) = rb[i][0]; *(LAS v4u*)(wb_ + 17408 + 128) = rb[i][1];
                { const int tn2 = (t + 2 + i < nt) ? t + 2 + i : i; const bf16* a2 = ag + (size_t)tn2 * 128; const bf16* b2 = bg + (size_t)tn2 * 128;
                  ra[i][0] = *(const v4u*)a2; ra[i][1] = *(const v4u*)(a2 + 64); rb[i][0] = *(const v4u*)b2; rb[i][1] = *(const v4u*)(b2 + 64); }
                __syncthreads();
#pragma unroll
                for (int ks = 0; ks < 4; ++ks) {
                    const bf16x8 af = frag16(fa + i * 34816 + ks * 64), b0 = frag16(fb + i * 34816 + ks * 64), b1 = frag16(fb + i * 34816 + 16 * 272 + ks * 64);
                    acc0 = MFMA16(b0, af, acc0); acc1 = MFMA16(b1, af, acc1);
                }
            }
        }
        {
            const int row = MP + 64 * tm + 16 * wm + r16, col0 = 64 * tn + 32 * wn + 4 * q;
            bf16* px = xb + (size_t)row * D + col0;
            const v2u xa = *(const v2u*)px, xc = *(const v2u*)(px + 16);
            const float a0 = __builtin_bit_cast(float, xa.x << 16) + acc0[0] * scale, a1 = __builtin_bit_cast(float, xa.x & 0xffff0000u) + acc0[1] * scale, a2 = __builtin_bit_cast(float, xa.y << 16) + acc0[2] * scale, a3 = __builtin_bit_cast(float, xa.y & 0xffff0000u) + acc0[3] * scale;
            const float b0 = __builtin_bit_cast(float, xc.x << 16) + acc1[0] * scale, b1 = __builtin_bit_cast(float, xc.x & 0xffff0000u) + acc1[1] * scale, b2 = __builtin_bit_cast(float, xc.y << 16) + acc1[2] * scale, b3 = __builtin_bit_cast(float, xc.y & 0xffff0000u) + acc1[3] * scale;
            v2u wa, wb; wa.x = cvtpk(a0, a1); wa.y = cvtpk(a2, a3); wb.x = cvtpk(b0, b1); wb.y = cvtpk(b2, b3);
            *(v2u*)px = wa; *(v2u*)(px + 16) = wb;
            float ss = 0.f;
#pragma unroll
            for (int k = 0; k < 2; ++k) { const unsigned pa = wa[k], pb = wb[k]; const float r0 = __builtin_bit_cast(float, pa << 16), r1 = __builtin_bit_cast(float, pa & 0xffff0000u), r2 = __builtin_bit_cast(float, pb << 16), r3 = __builtin_bit_cast(float, pb & 0xffff0000u); ss += (r0 * r0 + r1 * r1) + (r2 * r2 + r3 * r3); }
            ss += __shfl_xor(ss, 16); ss += __shfl_xor(ss, 32);
            if (q == 0 && fin) unsafeAtomicAdd(rowss + row, ss);
        }
        __syncthreads();
    }
}

__device__ __forceinline__ void final_phase(const Args& A, int wave, int lane, int G) {
    const int gw = blockIdx.x * NWAVES + wave, NGW = G * NWAVES;
    const float* rss = (const float*)(A.ws + WS_RSS) + (size_t)6 * M; const f32x4* gn = (const f32x4*)A.in[I_FINALN] + lane; const bf16* xb = (const bf16*)(A.ws + WS_XB);
    for (int m = gw; m < M; m += NGW) {
        const float r = rsqrtf(rss[m] * (1.0f / 1024.0f) + 1e-6f);
        const v2u* xr = (const v2u*)(xb + (size_t)m * D) + lane; f32x4* yo = (f32x4*)(A.out + (size_t)m * D) + lane;
#pragma unroll
        for (int j = 0; j < 4; ++j) { const v2u w = xr[64 * j]; const f32x4 v = {__builtin_bit_cast(float, w.x << 16), __builtin_bit_cast(float, w.x & 0xffff0000u), __builtin_bit_cast(float, w.y << 16), __builtin_bit_cast(float, w.y & 0xffff0000u)};
            yo[64 * j] = v * r * gn[64 * j]; }
    }
}

__device__ __forceinline__ void side_convert(const Args& A, LAS unsigned char* ldsl, const int tidv, const int first, const int G, const int it_lo, const int it_hi) {
    const int wv = __builtin_amdgcn_readfirstlane(tidv >> 6);
    if (first > 0 && first < G) { if ((int)blockIdx.x >= first) convert_weights(A, ldsl, wv, tidv & 63, it_lo, it_hi, ((int)blockIdx.x - first) * NWAVES + wv, (G - first) * NWAVES); }
    else convert_weights(A, ldsl, wv, tidv & 63, it_lo, it_hi, (int)blockIdx.x * NWAVES + wv, G * NWAVES);
}
__device__ __forceinline__ int sub_of(int ph) { const int j = (ph - 1) & 7; return (j < 3) ? j : (j == 3 ? 7 : j - 1); }
__global__ void __launch_bounds__(NTHREADS, 2) mk_fwd(Args args) {
    extern __shared__ __attribute__((aligned(16))) unsigned char lds[];
    LAS unsigned char* ldsl = (LAS unsigned char*)lds;
    volatile LAS unsigned* MISC = (volatile LAS unsigned*)(ldsl + MISC_OFF);
    const int tid = threadIdx.x, lane = tid & 63, wave = __builtin_amdgcn_readfirstlane(tid >> 6), G = gridDim.x;
    unsigned char* ws = args.ws;
    gu32* ctl = (gu32*)(ws + WS_CTL);
    for (int u = tid; u < (LDS_BYTES - LDSCTL_OFF) / 4; u += NTHREADS) ((LAS unsigned*)(ldsl + LDSCTL_OFF))[u] = 0u;
    __syncthreads();
    const int lo = args.ph_lo, hi = args.ph_hi;
    XcdBarrier bar; bar.bar = (unsigned*)(ctl + CW_BAR); bar.x = 0; bar.st = nullptr;
    if (hi - lo > 1) bar = xcd_barrier_post((unsigned*)(ctl + CW_BAR), MISC + 8);

    bf16* xb = (bf16*)(ws + WS_XB); bf16* mixb = (bf16*)(ws + WS_MIX); bf16* hp = (bf16*)(ws + WS_HP);
    float* rss = (float*)(ws + WS_RSS);

    bool first = true;
    for (int si = 2 * lo; si < 2 * hi; ++si) {
        const int ph = si >> 1;
        if (si & 1) {
            bool dup = false;
#ifdef MK_DUP_P0
            dup = dup || (ph == 0);
#endif
#ifdef MK_DUP_MIX
            dup = dup || (ph >= 1 && ph < N_PHASES - 1 && sub_of(ph) == 3);
#endif
#ifdef MK_DUP_GU
            dup = dup || (ph >= 1 && ph < N_PHASES - 1 && (sub_of(ph) == 0 || sub_of(ph) == 5));
#endif
#ifdef MK_DUP_RESID
            dup = dup || (ph >= 1 && ph < N_PHASES - 1 && (sub_of(ph) == 1 || sub_of(ph) == 4 || sub_of(ph) == 6));
#endif
#ifdef MK_DUP_IN
            dup = dup || (ph >= 1 && ph < N_PHASES - 1 && sub_of(ph) == 2);
#endif
            if (!dup) continue;
        }
        if (!first) xcd_barrier(bar);
        first = false;
        int tidv = threadIdx.x; asm volatile("" : "+v"(tidv));
        if (ph == 0) {
#ifndef MK_NO_P0
            p0_prologue(args, ldsl, __builtin_amdgcn_readfirstlane(tidv >> 6), tidv & 63, G);
#endif
        }
        else if (ph == N_PHASES - 1) { final_phase(args, __builtin_amdgcn_readfirstlane(tidv >> 6), tidv & 63, G); }
        else {
            const int l = (ph - 1) / 8, s = sub_of(ph);
            const unsigned char* wl = ws + WS_W + (size_t)l * W_LAYER;
            if (s == 0 || s == 5) {
                pg8::Gemm g{xb, (const bf16*)(wl + (s == 0 ? WO_GU1 : WO_GU2)), M, NGU, D}; pg8::StaticOrder S; S.init(M, NGU, G, (int)blockIdx.x);
                bool gdry = false;
#ifdef MK_DRY_GU
                gdry = (si & 1) == 0;
#endif
                pg8::EpiSwiGLU E{hp, FF, rss + (size_t)(3 * l + (s == 0 ? 0 : 2)) * M, gdry};
#ifndef MK_NO_G1
                pg8::gemm_phase<pg8::EpiSwiGLU, pg8::StaticOrder, PG8_ALIGN, PG8_SP2>(ldsl + RING_OFF, g, S, E, tidv);
#endif
            } else if (s == 1 || s == 4 || s == 6) {
                const bf16* Aop = (s == 4) ? mixb : hp; const int K = (s == 4) ? D : FF;
                const size_t wo = (s == 1) ? WO_D1 : (s == 4) ? WO_OUT : WO_D2;
                pg8::Gemm g{Aop, (const bf16*)(wl + wo), MP, D, K}; pg8::StaticOrder S; S.init(MP, D, G, (int)blockIdx.x);
                float* rso = rss + (size_t)(3 * l + (s == 1 ? 1 : (s == 4 ? 2 : 3))) * M;
                const float rscale = (s == 4) ? 1.0f : 0.5f;
                float esc = rscale; bool efin = true;
#ifdef MK_DUP_RESID
                esc = 0.5f * rscale; efin = (si & 1) != 0;
#endif
                pg8::EpiResid E{xb, rso, esc, efin};
#ifndef MK_NO_G2
                const bool srg_first = (blockIdx.x & 1) != 0;
                if (srg_first) srg_phase(ldsl + RING_OFF, Aop, (const bf16*)(wl + wo), K, xb, rso, esc, efin, G, tidv);
                pg8::gemm_phase<pg8::EpiResid, pg8::StaticOrder, PG8_ALIGN, PG8_SP2>(ldsl + RING_OFF, g, S, E, tidv);
                if (!srg_first)
#ifdef MK_DUP_SRG
                srg_phase(ldsl + RING_OFF, Aop, (const bf16*)(wl + wo), K, xb, rso, 0.5f * esc, false, G, tidv);
                srg_phase(ldsl + RING_OFF, Aop, (const bf16*)(wl + wo), K, xb, rso, 0.5f * esc, efin, G, tidv);
#else
                srg_phase(ldsl + RING_OFF, Aop, (const bf16*)(wl + wo), K, xb, rso, esc, efin, G, tidv);
#endif
#endif
            } else if (s == 2) {
                pg8::Gemm g{xb, (const bf16*)(wl + WO_IN), M, NINP, D}; pg8::StaticOrder S; S.init(M, NINP, G, (int)blockIdx.x);
                pg8::EpiProj E{hp, NINP, rss + (size_t)(3 * l + 1) * M};
#ifndef MK_NO_G3
                pg8::gemm_phase<pg8::EpiProj, pg8::StaticOrder, PG8_ALIGN, PG8_SP2>(ldsl + RING_OFF, g, S, E, tidv);
#endif
            } else {
                MixP C;
                C.P = hp; C.mixb = mixb; C.out = args.out; C.l = l; C.XC = (bf16*)args.out;
                C.DS = args.out + 8388608; C.ESC = args.out + 16900000; C.subc = (unsigned*)(ctl + CW_SUB + 128 * l);
                C.s_pool = args.in[I_SPOOL] + (size_t)l * BS * 15 * 256; C.s_gla = args.in[I_SGLA] + (size_t)l * BS * 4 * 32 * 64; C.s_hgrn = args.in[I_SHGRN] + (size_t)l * BS * 4 * 64 * 64;
                C.s_ssm = args.in[I_SSSM] + (size_t)l * BS * 4 * 64 * 128; C.s_conv = args.in[I_SCONV] + (size_t)l * BS * 3 * 768;
                C.pool_w = args.in[I_POOLW] + (size_t)l * 4 * 64 * 64; C.pool_scale = args.in[I_POOLS] + l * 256; C.gla_wg = args.in[I_GLAWG] + l * 16 * 128; C.gla_b = args.in[I_GLAB] + l * 128;
                C.gla_n = args.in[I_GLAN] + l * 64; C.lbl = args.in[I_LBL]; C.hg_n = args.in[I_HGN] + l * 64; C.conv_w = args.in[I_CONVW] + l * 4 * 768; C.conv_b = args.in[I_CONVB] + l * 768;
                C.dt_b = args.in[I_DTB] + l * 4; C.a_log = args.in[I_ALOG] + l * 4; C.ssm_d = args.in[I_SSMD] + l * 4; C.ssm_n = args.in[I_SSMN] + l * 256;
#ifndef MK_NO_MIXER
                if (s == 7) conv_phase(C, G, tidv); else mixer_phase(lds + RING_OFF, ldsl + RING_OFF, C, G, tidv);
#endif
            }
        }
    }
}

extern "C" void kernel_launch(void* const* d_in, const int* in_sizes, int n_in, void* d_out, int out_size, void* d_ws, size_t ws_size, hipStream_t stream) {
    static int grid = 0;
    if (grid == 0) {
        if (n_in != N_INPUTS || in_sizes[0] != MP * D || (size_t)out_size != O_END || ws_size < WS_END) {
            fprintf(stderr, "kernel_launch: shape mismatch: n_in %d, in0 %d, out %d, ws %zu (need %zu); nothing launched\n", n_in, n_in > 0 ? in_sizes[0] : -1, out_size, ws_size, (size_t)WS_END); grid = -1; return; }
        int dev = 0, cus = 0, per_cu = 0;
        if (hipGetDevice(&dev) != hipSuccess || hipDeviceGetAttribute(&cus, hipDeviceAttributeMultiprocessorCount, dev) != hipSuccess) { fprintf(stderr, "kernel_launch: device query failed\n"); grid = -1; return; }
        if (hipFuncSetAttribute((const void*)mk_fwd, hipFuncAttributeMaxDynamicSharedMemorySize, LDS_BYTES) != hipSuccess) { fprintf(stderr, "kernel_launch: hipFuncSetAttribute failed\n"); grid = -1; return; }
        if (hipOccupancyMaxActiveBlocksPerMultiprocessor(&per_cu, (const void*)mk_fwd, NTHREADS, LDS_BYTES) != hipSuccess || per_cu < 1) {
            fprintf(stderr, "kernel_launch: occupancy query reports %d workgroups per CU; nothing launched\n", per_cu); (void)hipGetLastError(); grid = -1; return; }
        grid = cus;
    }
    if (grid < 0) return;
    if (hipMemsetAsync((char*)d_ws + WS_CTL, 0, CTL_ZERO_BYTES, stream) != hipSuccess) { fprintf(stderr, "kernel_launch: hipMemsetAsync failed\n"); return; }
    Args a{};
    for (int i = 0; i < N_INPUTS; ++i) a.in[i] = (const float*)d_in[i];
    a.out = (float*)d_out; a.ws = (unsigned char*)d_ws;
    for (int li = 0; li < N_LAUNCHES; ++li) {
        a.ph_lo = (N_LAUNCHES == 1) ? 0 : li; a.ph_hi = (N_LAUNCHES == 1) ? N_PHASES : li + 1;
        hipLaunchKernelGGL(mk_fwd, dim3(grid), dim3(NTHREADS), LDS_BYTES, stream, a);
        const hipError_t le = hipPeekAtLastError();
        if (le != hipSuccess) { fprintf(stderr, "kernel_launch: launch %d failed: %s\n", li, hipGetErrorName(le)); break; }
    }
}
```

```cpp
#include <hip/hip_runtime.h>
#include <cstdio>
#include <cstdint>
namespace pg8 {
#define PG8_LAS __attribute__((address_space(3)))
typedef unsigned short bf16_t;
typedef short bf16x8 __attribute__((ext_vector_type(8)));
typedef float f32x4 __attribute__((ext_vector_type(4)));
typedef unsigned u32x4 __attribute__((ext_vector_type(4)));
constexpr int BM = 256, BK = 64, HALF = 128, HTB = HALF * BK * 2  , STAGE_BYTES = 8 * HTB, NXCD = 8, WGM = 8;

__host__ __device__ __forceinline__ int lds_byte(int r, int c) { const int st = (r >> 4) * 2 + (c >> 5), rr = r & 15, cc = c & 31, ob = rr * 64 + cc * 2; return st * 1024 + (ob ^ (((ob >> 9) & 1) << 5)); }
__host__ __device__ __forceinline__ void stage_rc(int b, int& R, int& C) { const int st = b / 1024, sb = b % 1024, swz = sb ^ (((sb >> 9) & 1) << 5); R = (st >> 1) * 16 + swz / 64; C = (st & 1) * 32 + (swz % 64) / 2; }
__host__ __device__ __forceinline__ int perm32(int rho) { const int n = rho >> 4, i = rho & 15; return 8 * (i >> 2) + 4 * n + (i & 3); }

struct Unit { int pm, pn; };
struct Gemm { const bf16_t* A; const bf16_t* Bt; int M, N, K; };

struct StaticOrder {
    int nM, nN, nwg, G, c;
    __host__ __device__ void init(int M, int N, int G_, int c_) { nM = M / BM; nN = N / BM; nwg = nM * nN; G = G_; c = c_; }
    __host__ __device__ bool next(int i, Unit& u) const {
        const long L = (long)i * G + c; if (L >= nwg) return false;
        int wgid = (int)L; { const int q = nwg / NXCD, r = nwg % NXCD, xcd = wgid % NXCD, off = wgid / NXCD; wgid = (xcd < r ? xcd * (q + 1) : r * (q + 1) + (xcd - r) * q) + off; }
        const int nig = WGM * nN, gid = wgid / nig, fm = gid * WGM, gsz = (nM - fm) < WGM ? (nM - fm) : WGM;
        u.pm = fm + ((wgid % nig) % gsz); u.pn = (wgid % nig) / gsz; return true;
    }
    __device__ __forceinline__ void a_ready(const Unit&) const {}
    __device__ __forceinline__ void done(const Unit&) const {}
};
__device__ __forceinline__ unsigned cvt_pk_bf16(float lo, float hi) { unsigned r; asm volatile("v_cvt_pk_bf16_f32 %0, %1, %2" : "=v"(r) : "v"(lo), "v"(hi)); return r; }
template <class Epi, class Sched, bool ALIGN_EPI = false, bool SP2 = false>
__device__ __forceinline__ void gemm_phase(PG8_LAS unsigned char* lds, const Gemm g, const Sched& S, const Epi& E, const int tid_in) {
    const int tid = tid_in, wid = __builtin_amdgcn_readfirstlane(tid >> 6), lane = tid & 63, wr = wid >> 2, wc = wid & 3, fr = lane & 15, fq = lane >> 4;
    const int K = g.K, nt = K / BK;
    unsigned voffA[2], voffB[2];
#pragma unroll
    for (int i = 0; i < 2; ++i) { int R, C; stage_rc(tid * 16 + i * 8192, R, C); const int Rb = Epi::PERM ? ((R & ~31) + perm32(R & 31)) : R;
        voffA[i] = (unsigned)(R * K + C) * 2u; voffB[i] = (unsigned)(Rb * K + C) * 2u; }
    const size_t kstep = (size_t)(BK * 2);
    const size_t hstep = (size_t)HALF * K * 2;
    const size_t tstep = 2 * hstep;
    const unsigned ldsw = (unsigned)wid * 1024u;
    const int aoff = lds_byte(wr * 64 + fr, fq * 8), boff = lds_byte(wc * 32 + fr, fq * 8);
#define PG8_SA(b, h) (((b) * 2 + (h)) * HTB)
#define PG8_SB(b, h) ((4 + (b) * 2 + (h)) * HTB)
#define PG8_STAGE(bufoff, gbase, voff) do { _Pragma("unroll") for (int _i = 0; _i < 2; ++_i) \
        __builtin_amdgcn_global_load_lds((const unsigned*)((const char*)(gbase) + (voff)[_i]), (PG8_LAS unsigned*)(lds + (bufoff) + ldsw + _i * 8192), 16, 0, 0); } while (0)
#define PG8_LDA(dst, b, h) do { _Pragma("unroll") for (int m = 0; m < 4; ++m) _Pragma("unroll") for (int k = 0; k < 2; ++k) dst[m][k] = *(const PG8_LAS bf16x8*)(lds + PG8_SA(b, h) + aoff + m * 2048 + k * 1024); } while (0)
#define PG8_LDB(dst, b, h) do { _Pragma("unroll") for (int n = 0; n < 2; ++n) _Pragma("unroll") for (int k = 0; k < 2; ++k) dst[n][k] = *(const PG8_LAS bf16x8*)(lds + PG8_SB(b, h) + boff + n * 2048 + k * 1024); } while (0)
#define PG8_MMA(ai, bj, At, Bt) do { __builtin_amdgcn_s_setprio(1); _Pragma("unroll") for (int m = 0; m < 4; ++m) _Pragma("unroll") for (int n = 0; n < 2; ++n) _Pragma("unroll") for (int k = 0; k < 2; ++k) \
        acc[ai][bj][m][n] = __builtin_amdgcn_mfma_f32_16x16x32_bf16(Bt[n][k], At[m][k], acc[ai][bj][m][n], 0, 0, 0); __builtin_amdgcn_s_setprio(0); } while (0)
#define PG8_WAIT_V(n) asm volatile("s_waitcnt vmcnt(" #n ")" ::: "memory")
#define PG8_WAIT_L(n) asm volatile("s_waitcnt lgkmcnt(" #n ")" ::: "memory")
#define PG8_BAR __builtin_amdgcn_s_barrier()
#define PG8_SCHED __builtin_amdgcn_sched_barrier(0)
    Unit cur, nxt; int ui = 0;
    if (!S.next(0, cur)) return;
    f32x4 acc[2][2][4][2];
#pragma unroll
    for (int a = 0; a < 2; ++a)
#pragma unroll
        for (int b = 0; b < 2; ++b)
#pragma unroll
            for (int m = 0; m < 4; ++m)
#pragma unroll
                for (int n = 0; n < 2; ++n) acc[a][b][m][n] = (f32x4){0.f, 0.f, 0.f, 0.f};
    bf16x8 At[4][2], B0[2][2], B1[2][2];
    const char* cA = (const char*)g.A + (size_t)cur.pm * tstep; const char* cB = (const char*)g.Bt + (size_t)cur.pn * tstep;
    S.a_ready(cur);
    if constexpr (SP2) {
        PG8_STAGE(PG8_SB(0, 0), cB, voffB); PG8_STAGE(PG8_SB(0, 1), cB + hstep, voffB); PG8_STAGE(PG8_SA(0, 0), cA, voffA); PG8_STAGE(PG8_SA(0, 1), cA + hstep, voffA);
        if (wr == 1) PG8_BAR;
        PG8_WAIT_V(2); PG8_BAR;
        PG8_STAGE(PG8_SB(1, 0), cB + kstep, voffB); PG8_STAGE(PG8_SA(1, 0), cA + kstep, voffA); PG8_STAGE(PG8_SB(1, 1), cB + hstep + kstep, voffB);
        PG8_WAIT_V(6); PG8_BAR;
    } else {
        PG8_STAGE(PG8_SB(0, 0), cB, voffB); PG8_STAGE(PG8_SA(0, 0), cA, voffA); PG8_STAGE(PG8_SB(0, 1), cB + hstep, voffB); PG8_STAGE(PG8_SA(0, 1), cA + hstep, voffA);
        if (wr == 1) PG8_BAR;
        PG8_WAIT_V(4); PG8_BAR;
        PG8_STAGE(PG8_SB(1, 0), cB + kstep, voffB); PG8_STAGE(PG8_SA(1, 0), cA + kstep, voffA); PG8_STAGE(PG8_SB(1, 1), cB + hstep + kstep, voffB);
        PG8_WAIT_V(6); PG8_BAR;
    }
    for (;;) {
        const bool has_next = S.next(ui + 1, nxt);
        const char* nA = has_next ? (const char*)g.A + (size_t)nxt.pm * tstep : cA; const char* nB = has_next ? (const char*)g.Bt + (size_t)nxt.pn * tstep : cB;
        for (int t = 0; t < nt; t += 2) {
            const bool last = (t == nt - 2);
            const char* a1 = cA + (size_t)(t + 1) * kstep;
            const char* a2 = last ? nA : cA + (size_t)(t + 2) * kstep; const char* b2 = last ? nB : cB + (size_t)(t + 2) * kstep;
            const char* a3 = a2 + kstep; const char* b3 = b2 + kstep;
            if (last && has_next) S.a_ready(nxt);
            if constexpr (SP2) {
            PG8_LDB(B0, 0, 0); PG8_LDB(B1, 0, 1); PG8_SCHED; PG8_LDA(At, 0, 0); PG8_STAGE(PG8_SA(1, 1), a1 + hstep, voffA);
            PG8_WAIT_V(8); PG8_WAIT_L(0); PG8_BAR; PG8_MMA(0, 0, At, B0); PG8_MMA(0, 1, At, B1); PG8_BAR; PG8_SCHED;
            PG8_LDA(At, 0, 1); PG8_STAGE(PG8_SB(0, 0), b2, voffB); PG8_STAGE(PG8_SB(0, 1), b2 + hstep, voffB); PG8_STAGE(PG8_SA(0, 0), a2, voffA);
            PG8_WAIT_V(8); PG8_WAIT_L(0); PG8_BAR; PG8_MMA(1, 0, At, B0); PG8_MMA(1, 1, At, B1); PG8_BAR; PG8_SCHED;
            PG8_LDB(B0, 1, 0); PG8_LDB(B1, 1, 1); PG8_SCHED; PG8_LDA(At, 1, 0); PG8_STAGE(PG8_SA(0, 1), a2 + hstep, voffA);
            PG8_WAIT_V(8); PG8_WAIT_L(0); PG8_BAR; PG8_MMA(0, 0, At, B0); PG8_MMA(0, 1, At, B1); PG8_BAR; PG8_SCHED;
            PG8_LDA(At, 1, 1); PG8_STAGE(PG8_SB(1, 0), b3, voffB); PG8_STAGE(PG8_SB(1, 1), b3 + hstep, voffB); PG8_STAGE(PG8_SA(1, 0), a3, voffA);
            PG8_WAIT_V(8); PG8_WAIT_L(0); PG8_BAR; PG8_MMA(1, 0, At, B0); PG8_MMA(1, 1, At, B1); PG8_BAR; PG8_SCHED;
            } else {
            PG8_LDB(B0, 0, 0); PG8_SCHED; PG8_LDA(At, 0, 0); PG8_STAGE(PG8_SA(1, 1), a1 + hstep, voffA);
            PG8_WAIT_L(8); PG8_BAR; PG8_WAIT_L(0); PG8_MMA(0, 0, At, B0); PG8_BAR; PG8_SCHED;
            PG8_LDB(B1, 0, 1); PG8_STAGE(PG8_SB(0, 0), b2, voffB);
            PG8_BAR; PG8_WAIT_L(0); PG8_MMA(0, 1, At, B1); PG8_BAR;
            PG8_LDA(At, 0, 1); PG8_STAGE(PG8_SA(0, 0), a2, voffA);
            PG8_BAR; PG8_WAIT_L(0); PG8_MMA(1, 0, At, B0); PG8_BAR; PG8_SCHED;
            PG8_STAGE(PG8_SB(0, 1), b2 + hstep, voffB);
            PG8_WAIT_V(6); PG8_BAR; PG8_MMA(1, 1, At, B1); PG8_BAR;
            PG8_LDB(B0, 1, 0); PG8_SCHED; PG8_LDA(At, 1, 0); PG8_STAGE(PG8_SA(0, 1), a2 + hstep, voffA);
            PG8_WAIT_L(8); PG8_BAR; PG8_WAIT_L(0); PG8_MMA(0, 0, At, B0); PG8_BAR; PG8_SCHED;
            PG8_LDB(B1, 1, 1); PG8_STAGE(PG8_SB(1, 0), b3, voffB);
            PG8_BAR; PG8_WAIT_L(0); PG8_MMA(0, 1, At, B1); PG8_BAR;
            PG8_LDA(At, 1, 1); PG8_STAGE(PG8_SA(1, 0), a3, voffA);
            PG8_BAR; PG8_WAIT_L(0); PG8_MMA(1, 0, At, B0); PG8_BAR; PG8_SCHED;
            PG8_STAGE(PG8_SB(1, 1), b3 + hstep, voffB);
            PG8_WAIT_V(6); PG8_BAR; PG8_MMA(1, 1, At, B1); PG8_BAR;
            }
        }
        if constexpr (ALIGN_EPI) { if (wr == 0) PG8_BAR; }
        if constexpr (!Epi::AFTER_DRAIN) { E(acc, cur, wr, wc, fr, fq); S.done(cur); }
        if (!has_next) break;
#pragma unroll
        for (int a = 0; a < 2; ++a)
#pragma unroll
            for (int b = 0; b < 2; ++b)
#pragma unroll
                for (int m = 0; m < 4; ++m)
#pragma unroll
                    for (int n = 0; n < 2; ++n) acc[a][b][m][n] = (f32x4){0.f, 0.f, 0.f, 0.f};
        cur = nxt; cA = nA; cB = nB; ++ui;
        if constexpr (ALIGN_EPI) { if (wr == 1) PG8_BAR; }
    }
    PG8_WAIT_V(0);
    if constexpr (!ALIGN_EPI) { if (wr == 0) PG8_BAR; }
    PG8_BAR;
    if constexpr (Epi::AFTER_DRAIN) { E.fused(acc, cur, wr, wc, fr, fq, lds, wid, lane); S.done(cur); }
#undef PG8_SA
#undef PG8_SB
#undef PG8_STAGE
#undef PG8_LDA
#undef PG8_LDB
#undef PG8_MMA
#undef PG8_WAIT_V
#undef PG8_WAIT_L
#undef PG8_BAR
#undef PG8_SCHED
}
}

#ifndef PG8_SP2
#define PG8_SP2 true
#endif
#ifndef PG8_ALIGN
#define PG8_ALIGN true
#endif
namespace pg8 {
constexpr float RMS_EPS = 1e-6f;
__device__ __forceinline__ float silu_f(float x) { return x * __builtin_amdgcn_rcpf(1.0f + __expf(-x)); }
typedef float f32x2n __attribute__((ext_vector_type(2)));
typedef __bf16 bf16x2n __attribute__((ext_vector_type(2)));
__device__ __forceinline__ unsigned cvt2_bf16(float lo, float hi) { const f32x2n v = {lo, hi}; return __builtin_bit_cast(unsigned, __builtin_convertvector(v, bf16x2n)); }

struct EpiSwiGLU {
    static constexpr bool PERM = true, AFTER_DRAIN = false;
    bf16_t* H; int ldh; const float* rowss; bool dry;
    __device__ __forceinline__ void operator()(const f32x4 (&acc)[2][2][4][2], const Unit& u, int wr, int wc, int fr, int fq) const {
        if (dry) { asm volatile("" :: "v"(acc[0][0][0][0]), "v"(acc[1][1][3][1])); return; }
        const int row0 = u.pm * BM + wr * 64 + fr, col0 = u.pn * HALF + wc * 32 + 8 * fq;
        float rs[2][4];
#pragma unroll
        for (int ai = 0; ai < 2; ++ai)
#pragma unroll
            for (int m = 0; m < 4; ++m) rs[ai][m] = rowss[row0 + ai * HALF + m * 16];
#pragma unroll
        for (int ai = 0; ai < 2; ++ai)
#pragma unroll
            for (int m = 0; m < 4; ++m) {
                const int row = row0 + ai * HALF + m * 16;
                const float ms = rs[ai][m] * (1.0f / 1024.0f) + RMS_EPS, c1 = -1.4426950408889634f * rsqrtf(ms);
                const f32x4 g0 = acc[ai][0][m][0], g1 = acc[ai][0][m][1], u0 = acc[ai][1][m][0], u1 = acc[ai][1][m][1];
                const f32x4 t0 = g0 * c1, t1 = g1 * c1; f32x4 e0, e1, i0, i1;
#pragma unroll
                for (int e = 0; e < 4; ++e) { e0[e] = __builtin_amdgcn_exp2f(t0[e]); e1[e] = __builtin_amdgcn_exp2f(t1[e]); }
                const f32x4 d0 = e0 * ms + ms, d1 = e1 * ms + ms;
#pragma unroll
                for (int e = 0; e < 4; ++e) { i0[e] = __builtin_amdgcn_rcpf(d0[e]); i1[e] = __builtin_amdgcn_rcpf(d1[e]); }
                const f32x4 h0 = (g0 * u0) * i0, h1 = (g1 * u1) * i1;
                u32x4 w; w.x = cvt2_bf16(h0[0], h0[1]); w.y = cvt2_bf16(h0[2], h0[3]); w.z = cvt2_bf16(h1[0], h1[1]); w.w = cvt2_bf16(h1[2], h1[3]);
                *(u32x4*)(H + (size_t)row * ldh + col0) = w;
            }
    }
};
struct EpiResid {
    static constexpr bool PERM = true, AFTER_DRAIN = false;
    bf16_t* xb; float* rowss; float scale; bool fin;
    __device__ __forceinline__ void operator()(const f32x4 (&acc)[2][2][4][2], const Unit& u, int wr, int wc, int fr, int fq) const {
        const int row0 = u.pm * BM + wr * 64 + fr, col0 = u.pn * BM + wc * 32 + 8 * fq;
        u32x4 xv[2][4][2];
#pragma unroll
        for (int ai = 0; ai < 2; ++ai)
#pragma unroll
            for (int m = 0; m < 4; ++m)
#pragma unroll
                for (int bj = 0; bj < 2; ++bj) xv[ai][m][bj] = *(const u32x4*)(xb + (size_t)(row0 + ai * HALF + m * 16) * 1024 + col0 + bj * HALF);
        float ssv[2][4];
#pragma unroll
        for (int ai = 0; ai < 2; ++ai)
#pragma unroll
            for (int m = 0; m < 4; ++m) {
                const int row = row0 + ai * HALF + m * 16;
                float ss = 0.f;
#pragma unroll
                for (int bj = 0; bj < 2; ++bj) {
                    const u32x4 xo = xv[ai][m][bj]; u32x4 w;
#pragma unroll
                    for (int k = 0; k < 4; ++k) {
                        const float a0 = __uint_as_float(xo[k] << 16) + acc[ai][bj][m][k >> 1][(k & 1) * 2] * scale, a1 = __uint_as_float(xo[k] & 0xffff0000u) + acc[ai][bj][m][k >> 1][(k & 1) * 2 + 1] * scale;
                        const unsigned p = cvt_pk_bf16(a0, a1); w[k] = p;
                        const float r0 = __uint_as_float(p << 16), r1 = __uint_as_float(p & 0xffff0000u); ss += r0 * r0 + r1 * r1;
                    }
                    *(u32x4*)(xb + (size_t)row * 1024 + col0 + bj * HALF) = w;
                }
                ssv[ai][m] = ss;
            }
#pragma unroll
        for (int ai = 0; ai < 2; ++ai)
#pragma unroll
            for (int m = 0; m < 4; ++m) ssv[ai][m] += __shfl_xor(ssv[ai][m], 16);
#pragma unroll
        for (int ai = 0; ai < 2; ++ai)
#pragma unroll
            for (int m = 0; m < 4; ++m) ssv[ai][m] += __shfl_xor(ssv[ai][m], 32);
        if (fq == 0 && fin) {
#pragma unroll
            for (int ai = 0; ai < 2; ++ai)
#pragma unroll
                for (int m = 0; m < 4; ++m) unsafeAtomicAdd(rowss + row0 + ai * HALF + m * 16, ssv[ai][m]);
        }
    }
};
struct EpiProj {
    static constexpr bool PERM = true, AFTER_DRAIN = false;
    bf16_t* P; int ldp; const float* rowss;
    __device__ __forceinline__ void operator()(const f32x4 (&acc)[2][2][4][2], const Unit& u, int wr, int wc, int fr, int fq) const {
        const int row0 = u.pm * BM + wr * 64 + fr, col0 = u.pn * BM + wc * 32 + 8 * fq;
        const bool act = (u.pn == 3) || (u.pn == 4) || (u.pn == 7) || (u.pn == 8);
        float rs[2][4];
#pragma unroll
        for (int ai = 0; ai < 2; ++ai)
#pragma unroll
            for (int m = 0; m < 4; ++m) rs[ai][m] = rowss[row0 + ai * HALF + m * 16];
#pragma unroll
        for (int ai = 0; ai < 2; ++ai)
#pragma unroll
            for (int m = 0; m < 4; ++m) {
                const int row = row0 + ai * HALF + m * 16;
                const float r = rsqrtf(rs[ai][m] * (1.0f / 1024.0f) + RMS_EPS);
#pragma unroll
                for (int bj = 0; bj < 2; ++bj) {
                    f32x4 a = acc[ai][bj][m][0] * r, b = acc[ai][bj][m][1] * r;
                    if (act) {
#pragma unroll
                        for (int e = 0; e < 4; ++e) { a[e] = silu_f(a[e]); b[e] = silu_f(b[e]); }
                    }
                    u32x4 w; w.x = cvt_pk_bf16(a[0], a[1]); w.y = cvt_pk_bf16(a[2], a[3]); w.z = cvt_pk_bf16(b[0], b[1]); w.w = cvt_pk_bf16(b[2], b[3]);
                    *(u32x4*)(P + (size_t)row * ldp + col0 + bj * HALF) = w;
                }
            }
    }
};
}

constexpr int NWAVES = 8, NTHREADS = 512;
#ifndef MK_N_LAUNCHES
#define MK_N_LAUNCHES 1
#endif
constexpr int N_PHASES = 18;
constexpr int N_LAUNCHES = MK_N_LAUNCHES;

constexpr int D = 1024, FF = 2816, NGU = 2 * FF, NIN = 3092, NINP = 3328, DEPTH = 2;
constexpr int BP = 8, TP = 2048, BS = 128, TS = 8, PAST_LEN = 16384;
constexpr int MP = BP * TP, MS = BS * TS, M = MP + MS;
static_assert(M % 256 == 0 && NGU % 256 == 0 && NINP % 256 == 0 && FF % 128 == 0, "GEMM tiling");
static_assert(DEPTH == 2, "the HGRN2 lower bounds (cumulative softmax over layers minus its first term) are written out for two layers: 0 and softmax(logits)[1] = sigmoid(l1 - l0)");
constexpr int PC_PX = 0, PC_GQ = 256, PC_GK = 384, PC_GV = 512, PC_GR = 768, PC_RQ = 1024, PC_RF = 1280, PC_RI = 1536, PC_RG = 1792, PC_SZ = 2048, PC_XBC = 2304, PC_LR = 3072, PC_DT = 3088;
constexpr int MC_POOL = 0, MC_GLA = 256, MC_HGRN = 512, MC_SSM = 768;
enum { I_XP = 0, I_XS, I_SPOOL, I_SGLA, I_SHGRN, I_SSSM, I_SCONV, I_F1N, I_F1G, I_F1U, I_F1D, I_MIXN, I_WIN, I_POOLW, I_POOLS, I_GLAWG, I_GLAB, I_GLAN,
       I_LBL, I_HGN, I_CONVW, I_CONVB, I_DTB, I_ALOG, I_SSMD, I_SSMN, I_WOUT, I_F2N, I_F2G, I_F2U, I_F2D, I_FINALN, N_INPUTS };
constexpr size_t O_YP = 0, O_YS = O_YP + (size_t)MP * D, O_POOLP = O_YS + (size_t)MS * D, O_POOLS = O_POOLP + (size_t)DEPTH * BP * 15 * 256,
    O_GLAP = O_POOLS + (size_t)DEPTH * BS * 15 * 256, O_GLAS = O_GLAP + (size_t)DEPTH * BP * 4 * 32 * 64, O_HGP = O_GLAS + (size_t)DEPTH * BS * 4 * 32 * 64,
    O_HGS = O_HGP + (size_t)DEPTH * BP * 4 * 64 * 64, O_SSMP = O_HGS + (size_t)DEPTH * BS * 4 * 64 * 64, O_SSMS = O_SSMP + (size_t)DEPTH * BP * 4 * 64 * 128,
    O_CONVP = O_SSMS + (size_t)DEPTH * BS * 4 * 64 * 128, O_CONVS = O_CONVP + (size_t)DEPTH * BP * 3 * 768, O_END = O_CONVS + (size_t)DEPTH * BS * 3 * 768;
static_assert(O_END == 35094528, "output size");

constexpr size_t KiB = 1024, MiB = 1u << 20;
constexpr size_t WS_CTL = 0, CTL_ZERO_BYTES = 1 * MiB;
constexpr size_t WS_RSS = 512 * KiB;
static_assert(WS_RSS + 7 * (size_t)M * 4 <= CTL_ZERO_BYTES, "rowss inside the memset region");
constexpr size_t WS_W = 1 * MiB, W_LAYER = 41 * MiB + 512 * KiB;
constexpr size_t WO_GU1 = 0, WO_D1 = 11 * MiB, WO_IN = 16 * MiB + 512 * KiB, WO_OUT = 23 * MiB, WO_GU2 = 25 * MiB, WO_D2 = 36 * MiB;
static_assert((size_t)NGU * D * 2 == 11 * MiB && (size_t)D * FF * 2 == 5 * MiB + 512 * KiB && (size_t)NINP * D * 2 == 6 * MiB + 512 * KiB && WO_D2 + 5 * MiB + 512 * KiB == W_LAYER, "weight map");
constexpr size_t WS_XB = WS_W + 2 * W_LAYER;
constexpr size_t WS_MIX = WS_XB + 34 * MiB;
constexpr size_t WS_HP = WS_MIX + 34 * MiB;
constexpr size_t WS_END = WS_HP + (size_t)M * NINP * 2;
static_assert((size_t)M * D * 2 == 34 * MiB && WS_END == 262 * MiB + 512 * KiB, "d_ws map");
constexpr int CW_BAR = 4096;
constexpr int CW_SUB = 8192;
constexpr int RING_OFF = 0, RING_BYTES = 131072;
constexpr int LDSCTL_OFF = RING_BYTES, MISC_OFF = LDSCTL_OFF + 320;
constexpr int LDS_BYTES = 147456;

#define GAS __attribute__((address_space(1)))
#define LAS __attribute__((address_space(3)))
typedef unsigned short bf16;
typedef unsigned v4u __attribute__((ext_vector_type(4)));
typedef unsigned v2u __attribute__((ext_vector_type(2)));
typedef float f32x4 __attribute__((ext_vector_type(4)));
typedef GAS unsigned gu32;
#define RLX_AGENT __ATOMIC_RELAXED, __HIP_MEMORY_SCOPE_AGENT
#define LDS_WAIT() asm volatile("s_waitcnt lgkmcnt(0)" ::: "memory")
#define VM_WAIT() asm volatile("s_waitcnt vmcnt(0)" ::: "memory")
__device__ __forceinline__ unsigned f2bf(float f) { unsigned u = __builtin_bit_cast(unsigned, f); return (u + 0x7fffu + ((u >> 16) & 1u)) >> 16; }
__device__ __forceinline__ unsigned pk2(float lo, float hi) { return f2bf(lo) | (f2bf(hi) << 16); }
__device__ __forceinline__ float bf2f(bf16 b) { return __builtin_bit_cast(float, (unsigned)b << 16); }
__device__ __forceinline__ float sigmoid_f(float x) { return __builtin_amdgcn_rcpf(1.0f + __expf(-x)); }
__device__ __forceinline__ float silu_f(float x) { return x * __builtin_amdgcn_rcpf(1.0f + __expf(-x)); }
__device__ __forceinline__ float lse0_f(float x) { return 0.6931471805599453f * __builtin_amdgcn_logf(1.0f + __builtin_amdgcn_exp2f(-1.4426950408889634f * fabsf(x))); }
__device__ __forceinline__ float softplus_f(float x) { return fmaxf(x, 0.f) + lse0_f(x); }
__device__ __forceinline__ float logsigmoid_f(float x) { return fminf(x, 0.f) - lse0_f(x); }
typedef float f32x2v __attribute__((ext_vector_type(2)));
typedef __bf16 bf16x2v __attribute__((ext_vector_type(2)));
__device__ __forceinline__ unsigned cvtpk(float lo, float hi) { const f32x2v v = {lo, hi}; return __builtin_bit_cast(unsigned, __builtin_convertvector(v, bf16x2v)); }
#define XB_TMO      128
#define XB_XCNT(j)  (256  + 64 * (j))
#define XB_XSUB(j)  (1280 + 64 * (j))
#define XB_XGEN(j)  (2304 + 64 * (j))
#define XB_TOP      3328
#define XB_TOPGEN   3392
#define XCD_BAR_WORDS 3456
#define XB_SPIN_CAP (1u << 18)

__device__ __forceinline__ unsigned xb_ld(unsigned* p)              { return __hip_atomic_load(p, __ATOMIC_RELAXED, __HIP_MEMORY_SCOPE_AGENT); }
__device__ __forceinline__ unsigned xb_add(unsigned* p, unsigned v) { return __hip_atomic_fetch_add(p, v, __ATOMIC_RELAXED, __HIP_MEMORY_SCOPE_AGENT); }
__device__ __forceinline__ unsigned xb_xcc_id() { return (unsigned)__builtin_amdgcn_s_getreg((3 << 11) | 20) & 0xFu; }
#define XB_SPIN(cond, bar) do { unsigned _sp = 0; while (cond) { __builtin_amdgcn_s_sleep(1); \
    if ((++_sp & 255u) == 0u) { if (xb_ld(&(bar)[XB_TMO])) break; if (_sp > XB_SPIN_CAP) { atomicAdd(&(bar)[XB_TMO], 1u); break; } } } } while (0)

struct XcdBarrier {
    unsigned* bar; unsigned x;
    volatile LAS unsigned* st;
};

__device__ __forceinline__ XcdBarrier xcd_barrier_post(unsigned* bar, volatile LAS unsigned* st) {
    XcdBarrier b; b.bar = bar; b.x = xb_xcc_id(); b.st = st;
    if (threadIdx.x == 0) (void)xb_add(&bar[XB_XCNT(b.x)], 1u);
    return b;
}
__device__ __forceinline__ void xcd_barrier_complete(unsigned* bar, unsigned x, unsigned& nloc, unsigned& nx) {
    const unsigned G = gridDim.x * gridDim.y * gridDim.z;
    unsigned sum, cnt, mine, sp = 0u;
    for (;;) {
        sum = 0u; cnt = 0u; mine = 0u;
#pragma unroll
        for (unsigned j = 0; j < 16; ++j) { const unsigned c = xb_ld(&bar[XB_XCNT(j)]); sum += c; cnt += (c > 0u) ? 1u : 0u; mine = (j == x) ? c : mine; }
        if (sum == G) break;
        __builtin_amdgcn_s_sleep(1);
        if ((++sp & 255u) == 0u) { if (xb_ld(&bar[XB_TMO])) break; if (sp > XB_SPIN_CAP) { atomicAdd(&bar[XB_TMO], 1u); break; } }
    }
    nloc = mine > 0u ? mine : 1u; nx = cnt > 0u ? cnt : 1u;
}

__device__ __forceinline__ void xcd_barrier(const XcdBarrier& b) {
    asm volatile("s_waitcnt vmcnt(0)" ::: "memory");
    __syncthreads();
    if (threadIdx.x == 0) {
        unsigned* bar = b.bar;
        __builtin_amdgcn_s_waitcnt(0);
        unsigned nloc = b.st[0], nx = b.st[1];
        if (nloc == 0u) { xcd_barrier_complete(bar, b.x, nloc, nx); b.st[0] = nloc; b.st[1] = nx; }
        const unsigned old = xb_add(&bar[XB_XSUB(b.x)], 1u);
        const unsigned gen = old / nloc;
        if (old + 1u == (gen + 1u) * nloc) {
            __builtin_amdgcn_fence(__ATOMIC_RELEASE, "agent");
            asm volatile("s_waitcnt vmcnt(0)" ::: "memory");
            const unsigned og = xb_add(&bar[XB_TOP], 1u);
            const unsigned tg = og / nx;
            if (og + 1u == (tg + 1u) * nx) xb_add(&bar[XB_TOPGEN], 1u);
            else XB_SPIN(xb_ld(&bar[XB_TOPGEN]) == tg, bar);
            __builtin_amdgcn_fence(__ATOMIC_ACQUIRE, "agent");
            xb_add(&bar[XB_XGEN(b.x)], 1u);
            asm volatile("s_waitcnt vmcnt(0)" ::: "memory");
        } else {
            XB_SPIN(xb_ld(&bar[XB_XGEN(b.x)]) == gen, bar);
            __builtin_amdgcn_fence(__ATOMIC_ACQUIRE, "agent");
            asm volatile("s_waitcnt vmcnt(0)" ::: "memory");
        }
    }
    __syncthreads();
}

struct Args { const float* in[N_INPUTS]; float* out; unsigned char* ws; int ph_lo, ph_hi; };
static_assert(sizeof(Args) == 34 * 8 + 8, "Args has no holes");

__device__ __forceinline__ float wave_sum(float v) {
#pragma unroll
    for (int o = 1; o < 64; o <<= 1) v += __shfl_xor(v, o);
    return v;
}

template <int KIND>
__device__ __forceinline__ void p0_item(const float* W0, const float* W1, int K, int Nsrc, const float* gain, bf16* WT, LAS float* scr, int item, int nblk, int lane) {
    const int kb = item / nblk, nb = item % nblk, k0 = 64 * kb, n0 = 32 * nb;
    if (KIND == 2 && n0 >= 3072) {
        const int np = n0 + (lane & 31);
        int col = 0; bool valid = true;
        if (np < 3088) col = 1024 + (np - 3072); else if (np < NIN) col = np; else valid = false;
        float vv[32];
#pragma unroll
        for (int i = 0; i < 32; ++i) vv[i] = W0[(size_t)(k0 + 2 * i + (lane >> 5)) * Nsrc + col];
#pragma unroll
        for (int i = 0; i < 32; ++i) { const int kk = 2 * i + (lane >> 5); float v = valid ? vv[i] : 0.f; if (gain) v *= gain[k0 + kk]; scr[kk * 33 + (lane & 31)] = v; }
    } else {
        const float* W = W0; int col0 = n0;
        if (KIND == 0) { const int pn = n0 >> 8, bj = (n0 >> 7) & 1, jj = n0 & 127; W = bj ? W1 : W0; col0 = pn * 128 + jj; }
        if (KIND == 2) col0 = (n0 < 1024) ? n0 : n0 + 16;
        const int kr = lane >> 3, nq = lane & 7;
        f32x4 vv[8]; float gv[8];
#pragma unroll
        for (int i = 0; i < 8; ++i) vv[i] = *(const f32x4*)(W + (size_t)(k0 + 8 * i + kr) * Nsrc + col0 + 4 * nq);
#pragma unroll
        for (int i = 0; i < 8; ++i) gv[i] = gain ? gain[k0 + 8 * i + kr] : 1.0f;
#pragma unroll
        for (int i = 0; i < 8; ++i) { LAS float* sp = scr + (8 * i + kr) * 33 + 4 * nq; const f32x4 v = vv[i] * gv[i]; sp[0] = v[0]; sp[1] = v[1]; sp[2] = v[2]; sp[3] = v[3]; }
    }
    LDS_WAIT(); asm volatile("" ::: "memory");
    const int c = lane & 7;
#pragma unroll
    for (int j = 0; j < 4; ++j) { const int n = (lane >> 3) + 8 * j; const LAS float* s = scr + (8 * c) * 33 + n;
        v4u o; o.x = cvtpk(s[0 * 33], s[1 * 33]); o.y = cvtpk(s[2 * 33], s[3 * 33]); o.z = cvtpk(s[4 * 33], s[5 * 33]); o.w = cvtpk(s[6 * 33], s[7 * 33]);
        *(v4u*)(WT + (size_t)(n0 + n) * K + k0 + 8 * c) = o; }
    LDS_WAIT(); asm volatile("" ::: "memory");
}
constexpr int IT_GU = (D / 64) * (NGU / 32), IT_D = (FF / 64) * (D / 32), IT_IN = (D / 64) * (NINP / 32), IT_OUT = (D / 64) * (D / 32);
constexpr int IT_LAYER = 2 * IT_GU + 2 * IT_D + IT_IN + IT_OUT;

struct CvtList { int a0, n0, a1, n1, a2, n2, a3, n3; };
constexpr int R_GU1 = 0, R_D1 = IT_GU, R_IN = R_D1 + IT_D, R_OUT = R_IN + IT_IN, R_GU2 = R_OUT + IT_OUT, R_D2 = R_GU2 + IT_GU, N_LATE = IT_LAYER - R_OUT;
static_assert(R_D2 + IT_D == IT_LAYER && IT_GU == 2816 && IT_D == 1408 && IT_IN == 1664 && N_LATE == 4736, "conversion item map");
constexpr int G1A = 352, G1B = 864, G1C = IT_GU - G1A - G1B;
#ifndef MK_CVT_ALL_EARLY
constexpr CvtList CV_P0 = {R_GU1, IT_GU, R_IN, IT_IN, IT_LAYER + R_IN, IT_IN, IT_LAYER + R_GU1, G1A};
constexpr CvtList CV_GU1_L0 = {R_D1, IT_D, 0, 0, 0, 0, 0, 0};
constexpr CvtList CV_IN_L0 = {R_OUT, N_LATE, IT_LAYER + R_GU1 + G1A, G1B, 0, 0, 0, 0};
constexpr CvtList CV_GU2_L0 = {IT_LAYER + R_GU1 + G1A + G1B, G1C, 0, 0, 0, 0, 0, 0};
constexpr CvtList CV_GU1_L1 = {IT_LAYER + R_D1, IT_D, 0, 0, 0, 0, 0, 0};
constexpr CvtList CV_IN_L1 = {IT_LAYER + R_OUT, N_LATE, 0, 0, 0, 0, 0, 0};
#else
constexpr CvtList CV_P0 = {0, DEPTH * IT_LAYER, 0, 0, 0, 0, 0, 0};
constexpr CvtList CV_GU1_L0 = {0, 0, 0, 0, 0, 0, 0, 0}, CV_IN_L0 = CV_GU1_L0, CV_GU2_L0 = CV_GU1_L0, CV_GU1_L1 = CV_GU1_L0, CV_IN_L1 = CV_GU1_L0;
#endif
static_assert(G1C == 1600 && CV_P0.n0 + CV_P0.n1 + CV_P0.n2 + CV_P0.n3 + CV_GU1_L0.n0 + CV_IN_L0.n0 + CV_IN_L0.n1 + CV_GU2_L0.n0 + CV_GU1_L1.n0 + CV_IN_L1.n0 == DEPTH * IT_LAYER, "every weight item is converted exactly once");
struct CvtItem { const float* W; const float* gain; bf16* WT; int K, Nsrc, col0, k0, n0; bool spec; };
__device__ __forceinline__ CvtItem cvt_decode(const Args& A, const int it) {
    CvtItem c; const int l = it / IT_LAYER; int r = it % IT_LAYER;
    unsigned char* wl = A.ws + WS_W + (size_t)l * W_LAYER;
    int kind, nblk; const float* W0; const float* W1 = nullptr; c.gain = nullptr;
    if (r < IT_GU) { kind = 0; W0 = A.in[I_F1G] + (size_t)l * D * FF; W1 = A.in[I_F1U] + (size_t)l * D * FF; c.K = D; c.Nsrc = FF; c.gain = A.in[I_F1N] + l * D; c.WT = (bf16*)(wl + WO_GU1); nblk = NGU / 32; }
    else if ((r -= IT_GU) < IT_D) { kind = 1; W0 = A.in[I_F1D] + (size_t)l * D * FF; c.K = FF; c.Nsrc = D; c.WT = (bf16*)(wl + WO_D1); nblk = D / 32; }
    else if ((r -= IT_D) < IT_IN) { kind = 2; W0 = A.in[I_WIN] + (size_t)l * D * NIN; c.K = D; c.Nsrc = NIN; c.gain = A.in[I_MIXN] + l * D; c.WT = (bf16*)(wl + WO_IN); nblk = NINP / 32; }
    else if ((r -= IT_IN) < IT_OUT) { kind = 1; W0 = A.in[I_WOUT] + (size_t)l * D * D; c.K = D; c.Nsrc = D; c.WT = (bf16*)(wl + WO_OUT); nblk = D / 32; }
    else if ((r -= IT_OUT) < IT_GU) { kind = 0; W0 = A.in[I_F2G] + (size_t)l * D * FF; W1 = A.in[I_F2U] + (size_t)l * D * FF; c.K = D; c.Nsrc = FF; c.gain = A.in[I_F2N] + l * D; c.WT = (bf16*)(wl + WO_GU2); nblk = NGU / 32; }
    else { r -= IT_GU; kind = 1; W0 = A.in[I_F2D] + (size_t)l * D * FF; c.K = FF; c.Nsrc = D; c.WT = (bf16*)(wl + WO_D2); nblk = D / 32; }
    const int kb = r / nblk, nb = r % nblk; c.k0 = 64 * kb; c.n0 = 32 * nb; c.spec = (kind == 2) && (c.n0 >= 3072);
    c.W = W0; c.col0 = c.n0;
    if (kind == 0) { const int pn = c.n0 >> 8, bj = (c.n0 >> 7) & 1, jj = c.n0 & 127; c.W = bj ? W1 : W0; c.col0 = pn * 128 + jj; }
    if (kind == 2) c.col0 = (c.n0 < 1024) ? c.n0 : c.n0 + 16;
    return c;
}
__device__ __forceinline__ void cvt_load(const CvtItem& c, const int lane, f32x4 (&vv)[8], float (&gv)[8]) {
    const int kr = lane >> 3, nq = lane & 7;
    if (!c.spec) {
#pragma unroll
        for (int i = 0; i < 8; ++i) vv[i] = *(const f32x4*)(c.W + (size_t)(c.k0 + 8 * i + kr) * c.Nsrc + c.col0 + 4 * nq);
#pragma unroll
        for (int i = 0; i < 8; ++i) gv[i] = c.gain ? c.gain[c.k0 + 8 * i + kr] : 1.0f;
    }
}
__device__ __forceinline__ void cvt_finish(const CvtItem& c, const int lane, LAS float* scr, const f32x4 (&vv)[8], const float (&gv)[8]) {
    if (c.spec) {
        const int np = c.n0 + (lane & 31);
        int col = 0; bool valid = true;
        if (np < 3088) col = 1024 + (np - 3072); else if (np < NIN) col = np; else valid = false;
        float ev[32];
#pragma unroll
        for (int i = 0; i < 32; ++i) ev[i] = c.W[(size_t)(c.k0 + 2 * i + (lane >> 5)) * c.Nsrc + col];
#pragma unroll
        for (int i = 0; i < 32; ++i) { const int kk = 2 * i + (lane >> 5); float v = valid ? ev[i] : 0.f; if (c.gain) v *= c.gain[c.k0 + kk]; scr[kk * 33 + (lane & 31)] = v; }
    } else {
        const int kr = lane >> 3, nq = lane & 7;
#pragma unroll
        for (int i = 0; i < 8; ++i) { LAS float* sp = scr + (8 * i + kr) * 33 + 4 * nq; const f32x4 v = vv[i] * gv[i]; sp[0] = v[0]; sp[1] = v[1]; sp[2] = v[2]; sp[3] = v[3]; }
    }
    LDS_WAIT(); asm volatile("" ::: "memory");
    const int cc = lane & 7;
#pragma unroll
    for (int j = 0; j < 4; ++j) { const int n = (lane >> 3) + 8 * j; const LAS float* sr = scr + (8 * cc) * 33 + n;
        v4u o; o.x = cvtpk(sr[0 * 33], sr[1 * 33]); o.y = cvtpk(sr[2 * 33], sr[3 * 33]); o.z = cvtpk(sr[4 * 33], sr[5 * 33]); o.w = cvtpk(sr[6 * 33], sr[7 * 33]);
        *(v4u*)(c.WT + (size_t)(c.n0 + n) * c.K + c.k0 + 8 * cc) = o; }
    LDS_WAIT(); asm volatile("" ::: "memory");
}
__device__ __forceinline__ void convert_weights(const Args& A, LAS unsigned char* ldsl, int wave, int lane, const CvtList Lst, int gw, int NGW) {
    LAS float* scr = (LAS float*)(ldsl + RING_OFF + wave * 16384);
    const int e0 = Lst.n0, e1 = e0 + Lst.n1, e2 = e1 + Lst.n2, e3 = e2 + Lst.n3;
#define CVT_MAP(vi) (((vi) < e0) ? Lst.a0 + (vi) : ((vi) < e1) ? Lst.a1 + ((vi) - e0) : ((vi) < e2) ? Lst.a2 + ((vi) - e1) : Lst.a3 + ((vi) - e2))
    int vi = gw;
    if (vi >= e3) return;
    CvtItem cur = cvt_decode(A, CVT_MAP(vi));
    f32x4 va[8]; float ga[8];
    cvt_load(cur, lane, va, ga);
    for (;;) {
        const int vn = vi + NGW; const bool more = vn < e3;
        CvtItem nxt = cur; f32x4 vb[8]; float gb[8];
#pragma unroll
        for (int i = 0; i < 8; ++i) { vb[i] = va[i]; gb[i] = ga[i]; }
        if (more) { nxt = cvt_decode(A, CVT_MAP(vn)); cvt_load(nxt, lane, vb, gb); }
        cvt_finish(cur, lane, scr, va, ga);
        if (!more) break;
        cur = nxt; vi = vn;
#pragma unroll
        for (int i = 0; i < 8; ++i) { va[i] = vb[i]; ga[i] = gb[i]; }
    }
#undef CVT_MAP
}
__device__ __forceinline__ void p0_prologue(const Args& A, LAS unsigned char* ldsl, int wave, int lane, int G) {
    const int gw = blockIdx.x * NWAVES + wave, NGW = G * NWAVES;
    unsigned char* ws = A.ws;
    convert_weights(A, ldsl, wave, lane, CV_P0, gw, NGW);
    bf16* xb = (bf16*)(ws + WS_XB); float* rss = (float*)(ws + WS_RSS);
    constexpr int NR = 4;
    for (int m0 = gw; m0 < M; m0 += NR * NGW) {
        f32x4 v[NR][4];
#pragma unroll
        for (int h = 0; h < NR; ++h) { const int mh = m0 + h * NGW, m = (mh < M) ? mh : m0;
            const float* sp = (m < MP) ? A.in[I_XP] + (size_t)m * D : A.in[I_XS] + (size_t)(m - MP) * D;
#pragma unroll
            for (int j = 0; j < 4; ++j) v[h][j] = ((const f32x4*)sp + lane)[64 * j]; }
#pragma unroll
        for (int h = 0; h < NR; ++h) {
            const int mh = m0 + h * NGW; const bool ok = mh < M; const int m = ok ? mh : m0;
            v2u* bo = (v2u*)(xb + (size_t)m * D) + lane; float s = 0.f;
#pragma unroll
            for (int j = 0; j < 4; ++j) { v2u w; w.x = cvtpk(v[h][j].x, v[h][j].y); w.y = cvtpk(v[h][j].z, v[h][j].w); if (ok) bo[64 * j] = w;
                const float r0 = __builtin_bit_cast(float, w.x << 16), r1 = __builtin_bit_cast(float, w.x & 0xffff0000u), r2 = __builtin_bit_cast(float, w.y << 16), r3 = __builtin_bit_cast(float, w.y & 0xffff0000u);
                s += (r0 * r0 + r1 * r1) + (r2 * r2 + r3 * r3); }
            s = wave_sum(s);
            if (lane == 0 && ok) rss[m] = s;
        }
    }
}

#ifndef MK_REP_S1
#define MK_REP_S1 1
#endif
#ifndef MK_REP_S3
#define MK_REP_S3 1
#endif
#ifndef MK_REP_S2SMP
#define MK_REP_S2SMP 1
#endif
struct MixP {
    const bf16* P; bf16* mixb; float* out; int l; float* DS; float* ESC; unsigned* subc;
    bf16* XC;
    const float *s_pool, *s_gla, *s_hgrn, *s_ssm, *s_conv;
    const float *pool_w, *pool_scale, *gla_wg, *gla_b, *gla_n, *lbl, *hg_n, *conv_w, *conv_b, *dt_b, *a_log, *ssm_d, *ssm_n;
};
typedef short bf16x8 __attribute__((ext_vector_type(8)));
constexpr int MIX_CONST_OFF = 113664;
#define MFMA16(a, b, c) __builtin_amdgcn_mfma_f32_16x16x32_bf16((a), (b), (c), 0, 0, 0)
template <int CTRL> __device__ __forceinline__ float dpp_shr1(float x) { return __builtin_bit_cast(float, __builtin_amdgcn_update_dpp(0x3f800000, __builtin_bit_cast(int, x), CTRL, 0xf, 0xf, false)); }
template <int CTRL, int ROWMASK> __device__ __forceinline__ float dpp_sel(float oldv, float x) { return __builtin_bit_cast(float, __builtin_amdgcn_update_dpp(__builtin_bit_cast(int, oldv), __builtin_bit_cast(int, x), CTRL, ROWMASK, 0xf, false)); }
__device__ __forceinline__ float dpp_bcast15(float oldv, float x) { return dpp_sel<0x142, 0xa>(oldv, x); }
__device__ __forceinline__ float quad_sum(float v) { v += dpp_sel<0xB1, 0xf>(0.f, v); v += dpp_sel<0x4E, 0xf>(0.f, v); return v; }
__device__ __forceinline__ float oct_sum(float v) { v = quad_sum(v); v += dpp_sel<0x141, 0xf>(0.f, v); return v; }
__device__ __forceinline__ bf16x8 frag16(const LAS unsigned char* p) { return *(const LAS bf16x8*)p; }
__device__ __forceinline__ bf16x8 frag8x2(const LAS unsigned char* p0, const LAS unsigned char* p1) { const v2u a = *(const LAS v2u*)p0, b = *(const LAS v2u*)p1; v4u w; w.x = a.x; w.y = a.y; w.z = b.x; w.w = b.y; return __builtin_bit_cast(bf16x8, w); }
__device__ __forceinline__ bf16x8 pack_frag(const f32x4 a, const f32x4 b) { v4u w; w.x = cvtpk(a[0], a[1]); w.y = cvtpk(a[2], a[3]); w.z = cvtpk(b[0], b[1]); w.w = cvtpk(b[2], b[3]); return __builtin_bit_cast(bf16x8, w); }
__device__ __forceinline__ float bfe(const v4u w, const int e) { const unsigned x = w[e >> 1]; return __builtin_bit_cast(float, (e & 1) ? (x & 0xffff0000u) : (x << 16)); }
__device__ __forceinline__ float bfe2(const v2u w, const int e) { const unsigned x = w[e >> 1]; return __builtin_bit_cast(float, (e & 1) ? (x & 0xffff0000u) : (x << 16)); }
__device__ __forceinline__ unsigned short bfbits(const v4u w, const int e) { const unsigned x = w[e >> 1]; return (unsigned short)((e & 1) ? (x >> 16) : (x & 0xffffu)); }

#define GH_SCAN_STEP(CTRL) "v_mul_f32_dpp %0, %0, %0 " CTRL "\n\tv_mul_f32_dpp %1, %1, %1 " CTRL "\n\tv_mul_f32_dpp %2, %2, %2 " CTRL "\n\tv_mul_f32_dpp %3, %3, %3 " CTRL "\n\t" \
                           "v_mul_f32_dpp %4, %4, %4 " CTRL "\n\tv_mul_f32_dpp %5, %5, %5 " CTRL "\n\tv_mul_f32_dpp %6, %6, %6 " CTRL "\n\tv_mul_f32_dpp %7, %7, %7 " CTRL "\n\t"
__device__ __forceinline__ void gh_scan8(float& a, float& b, float& c, float& d, float& e, float& f, float& g, float& h) {
    asm volatile("s_nop 1\n\t"
                 GH_SCAN_STEP("row_shr:1 row_mask:0xf bank_mask:0xf") GH_SCAN_STEP("row_shr:2 row_mask:0xf bank_mask:0xf") GH_SCAN_STEP("row_shr:4 row_mask:0xf bank_mask:0xf")
                 GH_SCAN_STEP("row_shr:8 row_mask:0xf bank_mask:0xf") GH_SCAN_STEP("row_bcast:15 row_mask:0xa bank_mask:0xf") "s_nop 1"
                 : "+v"(a), "+v"(b), "+v"(c), "+v"(d), "+v"(e), "+v"(f), "+v"(g), "+v"(h));
}
#undef GH_SCAN_STEP
template <int K> struct GHL { static constexpr int RS = K * 2 + 16, OFF_Q = 0, OFF_K = 32 * RS, OFF_KT = 64 * RS, OFF_VT = OFF_KT + K * 80, OFF_E = OFF_VT + 64 * 80, OFF_O = OFF_E + K * 4, UNIT = OFF_O + 32 * 272; };
static_assert(GHL<64>::UNIT == 28416 && 4 * GHL<64>::UNIT <= MIX_CONST_OFF, "GLA/HGRN LDS map");

template <int K>
__device__ __forceinline__ void s2_gh_unit(LAS unsigned char* U, f32x4 (&S)[K / 16], const int cs, const int lane) {
    typedef GHL<K> G; constexpr int NS = K / 32, KT = K / 16;
    const int q = lane >> 4, r16 = lane & 15, c = 16 * cs + r16;
    const f32x4 z4 = {0.f, 0.f, 0.f, 0.f};
    const LAS unsigned char* vrow = U + G::OFF_VT + c * 80;
    bf16x8 kf0[NS], kf1[NS], qf0[NS], qf1[NS], qp0[NS], qp1[NS], ktf[KT]; f32x4 e4[KT];
#pragma unroll
    for (int kt = 0; kt < KT; ++kt) { ktf[kt] = frag16(U + G::OFF_KT + (16 * kt + r16) * 80 + (8 * q) * 2); e4[kt] = *(const LAS f32x4*)(U + G::OFF_E + (16 * kt + 4 * q) * 4); }
    const bf16x8 vn = frag16(vrow + (8 * q) * 2);
#pragma unroll
    for (int s = 0; s < NS; ++s) {
        const LAS unsigned char* qr0 = U + G::OFF_Q + r16 * G::RS + (32 * s + 4 * q) * 2; const LAS unsigned char* qr1 = qr0 + 16 * G::RS;
        qp0[s] = frag8x2(qr0, qr0 + 32); qp1[s] = frag8x2(qr1, qr1 + 32);
    }
#pragma unroll
    for (int s = 0; s < NS; ++s) {
        const int kb = (32 * s + 8 * q) * 2;
        kf0[s] = frag16(U + G::OFF_K + r16 * G::RS + kb); kf1[s] = frag16(U + G::OFF_K + (16 + r16) * G::RS + kb);
        qf0[s] = frag16(U + G::OFF_Q + r16 * G::RS + kb); qf1[s] = frag16(U + G::OFF_Q + (16 + r16) * G::RS + kb);
    }
    const bf16x8 vb = frag8x2(vrow + (4 * q) * 2, vrow + (16 + 4 * q) * 2);
    bf16x8 sb[NS];
#pragma unroll
    for (int s = 0; s < NS; ++s) sb[s] = pack_frag(S[2 * s], S[2 * s + 1]);
#pragma unroll
    for (int kt = 0; kt < KT; ++kt) { S[kt] = MFMA16(ktf[kt], vn, S[kt]); S[kt] = S[kt] * e4[kt]; }
    f32x4 X00 = z4, X01 = z4, X11 = z4;
#pragma unroll
    for (int s = 0; s < NS; ++s) { X00 = MFMA16(kf0[s], qf0[s], X00); X01 = MFMA16(kf0[s], qf1[s], X01); X11 = MFMA16(kf1[s], qf1[s], X11); }
    f32x4 o0 = z4, o1 = z4;
#pragma unroll
    for (int s = 0; s < NS; ++s) { o0 = MFMA16(qp0[s], sb[s], o0); o1 = MFMA16(qp1[s], sb[s], o1); }
#pragma unroll
    for (int r = 0; r < 4; ++r) if (4 * q + r > r16) { X00[r] = 0.f; X11[r] = 0.f; }
    const bf16x8 a0 = pack_frag(X00, z4), a1 = pack_frag(X01, X11);
    o0 = MFMA16(a0, vb, o0); o1 = MFMA16(a1, vb, o1);
    LAS float* ob = (LAS float*)(U + G::OFF_O);
#pragma unroll
    for (int r = 0; r < 4; ++r) { ob[(4 * q + r) * 68 + c] = o0[r]; ob[(16 + 4 * q + r) * 68 + c] = o1[r]; }
}

template <int MT>
__device__ __forceinline__ void chain_gh(LAS unsigned char* L, const MixP& C, const int h, const int b0, const bool smp, const int tid) {
    constexpr int K = (MT == 0) ? 32 : 64, KT = K / 16, NK = K / 4;
    typedef GHL<K> G;
    const int w = __builtin_amdgcn_readfirstlane(tid >> 6), lane = tid & 63;
    const int u1 = tid >> 7, t1 = tid & 31, kg = (tid >> 5) & 3;
    LAS float* cst = (LAS float*)(L + MIX_CONST_OFF);
    if (MT == 0) { cst[tid] = C.gla_wg[(tid >> 5) * 128 + h * 32 + (tid & 31)]; if (tid < 32) cst[512 + tid] = C.gla_b[h * 32 + tid]; }
    if (tid >= 64 && tid < 128) cst[600 + tid - 64] = ((MT == 0) ? C.gla_n : C.hg_n)[tid - 64];
    if (MT == 1) { if (tid < 64) cst[tid] = (C.l == 0) ? 0.f : sigmoid_f(C.lbl[256 + h * 64 + tid] - C.lbl[h * 64 + tid]); }
    __syncthreads();
    const float* sin = (MT == 0) ? C.s_gla : C.s_hgrn;
    const size_t o_p = (MT == 0) ? O_GLAP : O_HGP, o_s = (MT == 0) ? O_GLAS : O_HGS;
    f32x4 S[KT];
#pragma unroll
    for (int kt = 0; kt < KT; ++kt) S[kt] = (f32x4){0.f, 0.f, 0.f, 0.f};
    const int nsc = smp ? 1 : TP / 128;
    v4u rw0, rw1, rw2, rw3, rw4, rw5;
#define GH_LOAD_RAW(SC) do { const bool valid_ = smp ? (t1 < TS) : true; \
        const int row_ = smp ? (MP + (b0 + u1) * TS + (valid_ ? t1 : 0)) : (b0 * TP + (SC) * 128 + u1 * 32 + t1); \
        const bf16* prow_ = C.P + (size_t)row_ * NINP; \
        if (MT == 0) { rw0 = *(const v4u*)(prow_ + PC_GQ + h * 32 + 8 * kg); rw1 = *(const v4u*)(prow_ + PC_GK + h * 32 + 8 * kg); rw2 = *(const v4u*)(prow_ + PC_LR); rw3 = *(const v4u*)(prow_ + PC_LR + 8); \
                       rw4 = *(const v4u*)(prow_ + PC_GV + h * 64 + 16 * kg); rw5 = *(const v4u*)(prow_ + PC_GV + h * 64 + 16 * kg + 8); } \
        else { rw0 = *(const v4u*)(prow_ + PC_RQ + h * 64 + 16 * kg); rw1 = *(const v4u*)(prow_ + PC_RQ + h * 64 + 16 * kg + 8); rw2 = *(const v4u*)(prow_ + PC_RF + h * 64 + 16 * kg); rw3 = *(const v4u*)(prow_ + PC_RF + h * 64 + 16 * kg + 8); \
               rw4 = *(const v4u*)(prow_ + PC_RI + h * 64 + 16 * kg); rw5 = *(const v4u*)(prow_ + PC_RI + h * 64 + 16 * kg + 8); } } while (0)
    GH_LOAD_RAW(0);
    for (int sc = 0; sc < nsc; ++sc) {
#pragma unroll 1
        for (int rep1 = 0; rep1 < MK_REP_S1; ++rep1) {
#if MK_REP_S1 > 1
            asm volatile("" : "+v"(rw0), "+v"(rw1), "+v"(rw2), "+v"(rw3), "+v"(rw4), "+v"(rw5));
#endif
            const bool valid = smp ? (t1 < TS) : true;
            LAS unsigned char* U = L + u1 * G::UNIT;
            float f[NK], kk[NK], qq[NK]; v4u vraw0 = rw4, vraw1 = rw5;
            if (MT == 0) {
                const v4u gq = rw0, gk = rw1, lr0 = rw2, lr1 = rw3;
                float lg[NK];
#pragma unroll
                for (int e = 0; e < NK; ++e) lg[e] = cst[512 + 8 * kg + e];
#pragma unroll
                for (int j = 0; j < 16; ++j) { const float lv = (j < 8) ? bfe(lr0, j) : bfe(lr1, j - 8);
                    const f32x4 w0 = *(const LAS f32x4*)(cst + j * 32 + 8 * kg), w1 = *(const LAS f32x4*)(cst + j * 32 + 8 * kg + 4);
                    lg[0] += lv * w0[0]; lg[1] += lv * w0[1]; lg[2] += lv * w0[2]; lg[3] += lv * w0[3]; lg[4] += lv * w1[0]; lg[5] += lv * w1[1]; lg[6] += lv * w1[2]; lg[7] += lv * w1[3]; }
#pragma unroll
                for (int e = 0; e < NK; ++e) { f[e] = __expf(logsigmoid_f(lg[e]) * (1.0f / 16.0f)); kk[e] = bfe(gk, e); qq[e] = bfe(gq, e) * 0.17677669529663687f; }
            } else {
                const v4u rq0 = rw0, rq1 = rw1, rf0 = rw2, rf1 = rw3;
#pragma unroll
                for (int e = 0; e < NK; ++e) { const float z = (e < 8) ? bfe(rf0, e) : bfe(rf1, e - 8), qv = (e < 8) ? bfe(rq0, e) : bfe(rq1, e - 8);
                    const float lb = cst[16 * kg + e], sg = sigmoid_f(z);
                    f[e] = lb + (1.f - lb) * sg; kk[e] = (1.f - lb) * (1.f - sg); qq[e] = qv; }
            }
            if (!valid) {
#pragma unroll
                for (int e = 0; e < NK; ++e) { f[e] = 1.f; kk[e] = 0.f; qq[e] = 0.f; }
                vraw0 = (v4u){0u, 0u, 0u, 0u}; vraw1 = vraw0;
            }
#pragma unroll
            for (int e8 = 0; e8 < NK; e8 += 8) gh_scan8(f[e8 + 0], f[e8 + 1], f[e8 + 2], f[e8 + 3], f[e8 + 4], f[e8 + 5], f[e8 + 6], f[e8 + 7]);
            float qt[NK], kt_[NK];
#pragma unroll
            for (int e = 0; e < NK; ++e) { qt[e] = qq[e] * f[e]; kt_[e] = kk[e] * __builtin_amdgcn_rcpf(fmaxf(f[e], 1e-30f)); }
#pragma unroll
            for (int e8 = 0; e8 < NK; e8 += 8) {
                v4u wq, wk;
                wq.x = cvtpk(qt[e8 + 0], qt[e8 + 1]); wq.y = cvtpk(qt[e8 + 2], qt[e8 + 3]); wq.z = cvtpk(qt[e8 + 4], qt[e8 + 5]); wq.w = cvtpk(qt[e8 + 6], qt[e8 + 7]);
                wk.x = cvtpk(kt_[e8 + 0], kt_[e8 + 1]); wk.y = cvtpk(kt_[e8 + 2], kt_[e8 + 3]); wk.z = cvtpk(kt_[e8 + 4], kt_[e8 + 5]); wk.w = cvtpk(kt_[e8 + 6], kt_[e8 + 7]);
                *(LAS v4u*)(U + G::OFF_Q + t1 * G::RS + (NK * kg + e8) * 2) = wq;
                *(LAS v4u*)(U + G::OFF_K + t1 * G::RS + (NK * kg + e8) * 2) = wk;
#pragma unroll
                for (int e = 0; e < 8; ++e) *(LAS unsigned short*)(U + G::OFF_KT + (NK * kg + e8 + e) * 80 + t1 * 2) = bfbits(wk, e);
            }
#pragma unroll
            for (int e = 0; e < 16; ++e) *(LAS unsigned short*)(U + G::OFF_VT + (16 * kg + e) * 80 + t1 * 2) = (e < 8) ? bfbits(vraw0, e) : bfbits(vraw1, e - 8);
            if (t1 == 31) {
#pragma unroll
                for (int e = 0; e < NK; ++e) *(LAS float*)(U + G::OFF_E + (NK * kg + e) * 4) = f[e];
            }
        }
        __syncthreads();
        const int tok3 = tid >> 2, cq3 = tid & 3, u3 = tok3 >> 5, i3 = tok3 & 31;
        const bool valid3 = smp ? (i3 < TS) : true;
        const int row3 = smp ? (MP + (b0 + u3) * TS + (valid3 ? i3 : 0)) : (b0 * TP + sc * 128 + tok3);
        v4u gg0, gg1;
        { const bf16* grow = C.P + (size_t)row3 * NINP + ((MT == 0) ? PC_GR : PC_RG) + h * 64 + 16 * cq3; gg0 = *(const v4u*)grow; gg1 = *(const v4u*)(grow + 8); }
        GH_LOAD_RAW((sc + 1 < nsc) ? sc + 1 : sc);
        if (!smp) {
            if (w < 4) {
#pragma unroll 1
                for (int u = 0; u < 4; ++u) {
#ifdef MK_REP_S2GH
                    { f32x4 Sd[KT];
#pragma unroll
                      for (int kt = 0; kt < KT; ++kt) Sd[kt] = S[kt];
                      s2_gh_unit<K>(L + u * G::UNIT, Sd, w, lane);
#pragma unroll
                      for (int kt = 0; kt < KT; ++kt) asm volatile("" :: "v"(Sd[kt])); }
#endif
                    s2_gh_unit<K>(L + u * G::UNIT, S, w, lane);
                }
            }
        } else {
#pragma unroll 1
            for (int job = w; job < 16; job += 8) {
                const int u = job >> 2, cs = job & 3, q = lane >> 4, c = 16 * cs + (lane & 15);
                const size_t sb = ((size_t)(b0 + u) * 4 + h) * K * 64;
#pragma unroll
                for (int kt = 0; kt < KT; ++kt)
#pragma unroll
                    for (int r = 0; r < 4; ++r) S[kt][r] = sin[sb + (size_t)(16 * kt + 4 * q + r) * 64 + c];
                s2_gh_unit<K>(L + u * G::UNIT, S, cs, lane);
                float* so = C.out + o_s + (((size_t)C.l * BS + b0 + u) * 4 + h) * K * 64;
#pragma unroll
                for (int kt = 0; kt < KT; ++kt)
#pragma unroll
                    for (int r = 0; r < 4; ++r) so[(size_t)(16 * kt + 4 * q + r) * 64 + c] = S[kt][r];
            }
        }
        __syncthreads();
#pragma unroll 1
        for (int rep3 = 0; rep3 < MK_REP_S3; ++rep3) {
#if MK_REP_S3 > 1
            asm volatile("" : "+v"(gg0), "+v"(gg1));
#endif
            const LAS float* ob = (const LAS float*)(L + u3 * G::UNIT + G::OFF_O) + i3 * 68 + 16 * cq3;
            f32x4 o[4]; float ss = 0.f;
#pragma unroll
            for (int j = 0; j < 4; ++j) { o[j] = *(const LAS f32x4*)(ob + 4 * j); ss += (o[j][0] * o[j][0] + o[j][1] * o[j][1]) + (o[j][2] * o[j][2] + o[j][3] * o[j][3]); }
            ss = quad_sum(ss);
            const float r = rsqrtf(ss * (1.0f / 64.0f) + 1e-6f);
            float res[16], nwv[16];
#pragma unroll
            for (int j = 0; j < 4; ++j) { const f32x4 t = *(const LAS f32x4*)(cst + 600 + 16 * cq3 + 4 * j); nwv[4 * j] = t[0]; nwv[4 * j + 1] = t[1]; nwv[4 * j + 2] = t[2]; nwv[4 * j + 3] = t[3]; }
#pragma unroll
            for (int e = 0; e < 16; ++e) { const float gv = (e < 8) ? bfe(gg0, e) : bfe(gg1, e - 8); res[e] = o[e >> 2][e & 3] * r * nwv[e] * gv; }
            if (valid3) {
                v4u w0, w1;
                w0.x = cvtpk(res[0], res[1]); w0.y = cvtpk(res[2], res[3]); w0.z = cvtpk(res[4], res[5]); w0.w = cvtpk(res[6], res[7]);
                w1.x = cvtpk(res[8], res[9]); w1.y = cvtpk(res[10], res[11]); w1.z = cvtpk(res[12], res[13]); w1.w = cvtpk(res[14], res[15]);
                bf16* mo = C.mixb + (size_t)row3 * D + ((MT == 0) ? MC_GLA : MC_HGRN) + h * 64 + 16 * cq3;
                *(v4u*)mo = w0; *(v4u*)(mo + 8) = w1;
            }
        }
    }
#undef GH_LOAD_RAW
    if (!smp && w < 4) {
        const int q = lane >> 4, c = 16 * w + (lane & 15);
        float* so = C.out + o_p + (((size_t)C.l * BP + b0) * 4 + h) * K * 64;
#pragma unroll
        for (int kt = 0; kt < KT; ++kt)
#pragma unroll
            for (int r = 0; r < 4; ++r) so[(size_t)(16 * kt + 4 * q + r) * 64 + c] = S[kt][r];
    }
    __syncthreads();
}

namespace SL { constexpr int OFF_C = 0, OFF_B = 8704, OFF_BT = 17408, OFF_XT = 27648, OFF_TAB = 37888, OFF_Y = 39168, UNIT = 56064; }
static_assert(2 * SL::UNIT <= MIX_CONST_OFF, "SSD LDS map");

__device__ __forceinline__ void s2_ssd_unit(LAS unsigned char* U, f32x4 (&S)[8], const int hh, const int ps, const int lane, const float Dh) {
    const int q = lane >> 4, r16 = lane & 15, p = 16 * ps + r16;
    const f32x4 z4 = {0.f, 0.f, 0.f, 0.f};
    const LAS float* tab = (const LAS float*)(U + SL::OFF_TAB) + hh * 160;
    const LAS unsigned char* xrow = U + SL::OFF_XT + hh * 5120 + p * 80;
    bf16x8 btf[8];
#pragma unroll
    for (int nt = 0; nt < 8; ++nt) btf[nt] = frag16(U + SL::OFF_BT + (16 * nt + r16) * 80 + (8 * q) * 2);
    const v4u xn = *(const LAS v4u*)(xrow + (8 * q) * 2);
    const f32x4 w0 = *(const LAS f32x4*)(tab + 96 + 8 * q), w1 = *(const LAS f32x4*)(tab + 96 + 8 * q + 4);
    const float eL = tab[128];
    bf16x8 cp0[4], cp1[4];
#pragma unroll
    for (int s = 0; s < 4; ++s) { const LAS unsigned char* cr0 = U + SL::OFF_C + r16 * 272 + (32 * s + 4 * q) * 2; const LAS unsigned char* cr1 = cr0 + 16 * 272; cp0[s] = frag8x2(cr0, cr0 + 32); cp1[s] = frag8x2(cr1, cr1 + 32); }
    bf16x8 sb[4];
#pragma unroll
    for (int s = 0; s < 4; ++s) sb[s] = pack_frag(S[2 * s], S[2 * s + 1]);
    const f32x4 xa = {bfe(xn, 0) * w0[0], bfe(xn, 1) * w0[1], bfe(xn, 2) * w0[2], bfe(xn, 3) * w0[3]}, xc = {bfe(xn, 4) * w1[0], bfe(xn, 5) * w1[1], bfe(xn, 6) * w1[2], bfe(xn, 7) * w1[3]};
    const bf16x8 xh = pack_frag(xa, xc);
#pragma unroll
    for (int nt = 0; nt < 8; ++nt) S[nt] = MFMA16(btf[nt], xh, S[nt] * eL);
    f32x4 X00 = z4, X01 = z4, X11 = z4;
#pragma unroll
    for (int s = 0; s < 4; ++s) {
        const int nb = (32 * s + 8 * q) * 2;
        const bf16x8 b0 = frag16(U + SL::OFF_B + r16 * 272 + nb), b1 = frag16(U + SL::OFF_B + (16 + r16) * 272 + nb);
        const bf16x8 c0 = frag16(U + SL::OFF_C + r16 * 272 + nb), c1 = frag16(U + SL::OFF_C + (16 + r16) * 272 + nb);
        X00 = MFMA16(b0, c0, X00); X01 = MFMA16(b0, c1, X01); X11 = MFMA16(b1, c1, X11);
    }
    f32x4 y20 = z4, y21 = z4;
#pragma unroll
    for (int s = 0; s < 4; ++s) { y20 = MFMA16(cp0[s], sb[s], y20); y21 = MFMA16(cp1[s], sb[s], y21); }
    const float ci0 = tab[r16], ci1 = tab[16 + r16];
    const f32x4 cj0 = *(const LAS f32x4*)(tab + 4 * q), cj1 = *(const LAS f32x4*)(tab + 16 + 4 * q);
#pragma unroll
    for (int r = 0; r < 4; ++r) {
        X00[r] = (4 * q + r > r16) ? 0.f : X00[r] * __expf(fminf(ci0 - cj0[r], 0.f));
        X01[r] = X01[r] * __expf(fminf(ci1 - cj0[r], 0.f));
        X11[r] = (4 * q + r > r16) ? 0.f : X11[r] * __expf(fminf(ci1 - cj1[r], 0.f));
    }
    const bf16x8 a0 = pack_frag(X00, z4), a1 = pack_frag(X01, X11);
    bf16x8 xb; f32x4 ux0, ux1;
    { const v2u xl = *(const LAS v2u*)(xrow + (4 * q) * 2), xh_ = *(const LAS v2u*)(xrow + (16 + 4 * q) * 2);
      const f32x4 d0 = *(const LAS f32x4*)(tab + 64 + 4 * q), d1 = *(const LAS f32x4*)(tab + 64 + 16 + 4 * q);
      const f32x4 fa = {__builtin_bit_cast(float, xl.x << 16) * d0[0], __builtin_bit_cast(float, xl.x & 0xffff0000u) * d0[1], __builtin_bit_cast(float, xl.y << 16) * d0[2], __builtin_bit_cast(float, xl.y & 0xffff0000u) * d0[3]};
      const f32x4 fb = {__builtin_bit_cast(float, xh_.x << 16) * d1[0], __builtin_bit_cast(float, xh_.x & 0xffff0000u) * d1[1], __builtin_bit_cast(float, xh_.y << 16) * d1[2], __builtin_bit_cast(float, xh_.y & 0xffff0000u) * d1[3]};
      xb = pack_frag(fa, fb);
      ux0 = (f32x4){__builtin_bit_cast(float, xl.x << 16), __builtin_bit_cast(float, xl.x & 0xffff0000u), __builtin_bit_cast(float, xl.y << 16), __builtin_bit_cast(float, xl.y & 0xffff0000u)} * Dh;
      ux1 = (f32x4){__builtin_bit_cast(float, xh_.x << 16), __builtin_bit_cast(float, xh_.x & 0xffff0000u), __builtin_bit_cast(float, xh_.y << 16), __builtin_bit_cast(float, xh_.y & 0xffff0000u)} * Dh; }
    const f32x4 y10 = MFMA16(a0, xb, z4), y11 = MFMA16(a1, xb, z4);
    const f32x4 e0 = *(const LAS f32x4*)(tab + 32 + 4 * q), e1 = *(const LAS f32x4*)(tab + 32 + 16 + 4 * q);
    LAS float* yb = (LAS float*)(U + SL::OFF_Y);
#pragma unroll
    for (int r = 0; r < 4; ++r) { yb[(4 * q + r) * 132 + hh * 64 + p] = y10[r] + e0[r] * y20[r] + ux0[r]; yb[(16 + 4 * q + r) * 132 + hh * 64 + p] = y11[r] + e1[r] * y21[r] + ux1[r]; }
}

__device__ __forceinline__ void s2_ssd_state(LAS unsigned char* U, f32x4 (&S)[8], const int hh, const int ps, const int lane) {
    const int q = lane >> 4, r16 = lane & 15, p = 16 * ps + r16;
    const LAS float* tab = (const LAS float*)(U + SL::OFF_TAB) + hh * 160;
    const LAS unsigned char* xrow = U + SL::OFF_XT + hh * 5120 + p * 80;
    bf16x8 btf[8];
#pragma unroll
    for (int nt = 0; nt < 8; ++nt) btf[nt] = frag16(U + SL::OFF_BT + (16 * nt + r16) * 80 + (8 * q) * 2);
    const v4u xn = *(const LAS v4u*)(xrow + (8 * q) * 2);
    const f32x4 w0 = *(const LAS f32x4*)(tab + 96 + 8 * q), w1 = *(const LAS f32x4*)(tab + 96 + 8 * q + 4);
    const float eL = tab[128];
    const f32x4 xa = {bfe(xn, 0) * w0[0], bfe(xn, 1) * w0[1], bfe(xn, 2) * w0[2], bfe(xn, 3) * w0[3]}, xc = {bfe(xn, 4) * w1[0], bfe(xn, 5) * w1[1], bfe(xn, 6) * w1[2], bfe(xn, 7) * w1[3]};
    const bf16x8 xh = pack_frag(xa, xc);
#pragma unroll
    for (int nt = 0; nt < 8; ++nt) S[nt] = MFMA16(btf[nt], xh, S[nt] * eL);
}

__device__ __forceinline__ void conv_phase(const MixP& C, const int G, const int tid) {
    constexpr int NTASK = (M / 8) * 96;
    for (int task = blockIdx.x * NTHREADS + tid; task < NTASK; task += G * NTHREADS) {
        const int g8 = task / 96, bl = task - g8 * 96, ch0 = 8 * bl, row0 = 8 * g8;
        const bool smp = g8 >= MP / 8;
        const int bsm = smp ? g8 - MP / 8 : 0;
        const bool head = smp ? true : ((row0 & (TP - 1)) == 0);
        {
            v4u xr[11];
#pragma unroll
            for (int i = 0; i < 11; ++i) { int r = row0 - 3 + i; if (head && i < 3) r = row0; xr[i] = *(const v4u*)(C.P + (size_t)r * NINP + PC_XBC + ch0); }
            f32x4 st[3][2];
#pragma unroll
            for (int r = 0; r < 3; ++r) { st[r][0] = (f32x4){0.f, 0.f, 0.f, 0.f}; st[r][1] = st[r][0]; }
            if (smp) {
#pragma unroll
                for (int r = 0; r < 3; ++r) { st[r][0] = *(const f32x4*)(C.s_conv + ((size_t)bsm * 3 + r) * 768 + ch0); st[r][1] = *(const f32x4*)(C.s_conv + ((size_t)bsm * 3 + r) * 768 + ch0 + 4); }
            }
            float wt[4][8], bs[8];
#pragma unroll
            for (int j = 0; j < 4; ++j) { const f32x4 wa = *(const f32x4*)(C.conv_w + j * 768 + ch0), wb = *(const f32x4*)(C.conv_w + j * 768 + ch0 + 4);
#pragma unroll
                for (int c = 0; c < 4; ++c) { wt[j][c] = wa[c]; wt[j][4 + c] = wb[c]; } }
            { const f32x4 wa = *(const f32x4*)(C.conv_b + ch0), wb = *(const f32x4*)(C.conv_b + ch0 + 4);
#pragma unroll
              for (int c = 0; c < 4; ++c) { bs[c] = wa[c]; bs[4 + c] = wb[c]; } }
            float p3[8], p2[8], p1[8];
#pragma unroll
            for (int c = 0; c < 8; ++c) { p3[c] = head ? st[0][c >> 2][c & 3] : bfe(xr[0], c); p2[c] = head ? st[1][c >> 2][c & 3] : bfe(xr[1], c); p1[c] = head ? st[2][c >> 2][c & 3] : bfe(xr[2], c); }
#pragma unroll
            for (int et = 0; et < 8; ++et) {
                float val[8];
#pragma unroll
                for (int c = 0; c < 8; ++c) { const float cur = bfe(xr[et + 3], c);
                    val[c] = silu_f(bs[c] + wt[0][c] * p3[c] + wt[1][c] * p2[c] + wt[2][c] * p1[c] + wt[3][c] * cur); p3[c] = p2[c]; p2[c] = p1[c]; p1[c] = cur; }
                v4u wv; wv.x = cvtpk(val[0], val[1]); wv.y = cvtpk(val[2], val[3]); wv.z = cvtpk(val[4], val[5]); wv.w = cvtpk(val[6], val[7]);
                *(v4u*)(C.XC + (size_t)(row0 + et) * 768 + ch0) = wv;
            }
        }
    }
}

__device__ __forceinline__ void chain_ssd(LAS unsigned char* L, const MixP& C, const int g, const int b0, const int mode, const int sc0, const int tid) {
    const bool smp = (mode == 1);
    const int w = __builtin_amdgcn_readfirstlane(tid >> 6), lane = tid & 63;
    const int hh2 = w >> 2, ps = w & 3, h2 = 2 * g + hh2;
    const float A0 = -__expf(C.a_log[2 * g]), A1 = -__expf(C.a_log[2 * g + 1]), dtb0 = C.dt_b[2 * g], dtb1 = C.dt_b[2 * g + 1], D0 = C.ssm_d[2 * g], D1 = C.ssm_d[2 * g + 1];
    f32x4 S[8];
#pragma unroll
    for (int nt = 0; nt < 8; ++nt) S[nt] = (f32x4){0.f, 0.f, 0.f, 0.f};
    const int cu1 = tid >> 8, ct = tid & 255;
    const int tg1 = ct / 48, bl1 = ct - tg1 * 48, lc01 = 8 * bl1;
    const int ch01 = (bl1 < 16) ? 128 * g + lc01 : (bl1 < 32) ? 256 + 128 * g + (lc01 - 128) : 512 + 128 * g + (lc01 - 256);
    const int tbase = smp ? 0 : sc0 * 64 + cu1 * 32;
    const int rowbase = smp ? MP + (b0 + cu1) * TS : b0 * TP;
    v4u xr[8]; bf16 sdraw = 0;
    if (ct < 192) { const bf16* xsrc = C.XC + (size_t)(rowbase + (smp ? 0 : tbase + 8 * tg1)) * 768 + ch01;
#pragma unroll
        for (int et = 0; et < 8; ++et) xr[et] = *(const v4u*)(xsrc + (size_t)et * 768); }
    else { const int t1 = ct & 31, hh = (ct - 192) >> 5; const bool valid = smp ? (t1 < TS) : true;
        sdraw = C.P[(size_t)(rowbase + tbase + (valid ? t1 : 0)) * NINP + PC_DT + 2 * g + hh]; }
    const int tok3 = tid >> 3, c83 = tid & 7, u3 = tok3 >> 5, i3 = tok3 & 31;
    const bool valid3 = smp ? (i3 < TS) : true;
    const int row3 = smp ? (MP + (b0 + u3) * TS + (valid3 ? i3 : 0)) : (b0 * TP + sc0 * 64 + tok3);
    v4u zz0, zz1;
    { const bf16* zrow = C.P + (size_t)row3 * NINP + PC_SZ + 128 * g + 16 * c83; zz0 = *(const v4u*)zrow; zz1 = *(const v4u*)(zrow + 8); }
    LAS float* cst = (LAS float*)(L + MIX_CONST_OFF);
    if (tid < 128) cst[tid] = C.ssm_n[128 * g + tid];
    {
        LAS unsigned char* U = L + cu1 * SL::UNIT;
        if (ct < 192) {
            const int tg = tg1, bl = bl1, lc0 = lc01;
            const bool tok_ok = smp ? (tg == 0) : true;
            if (!tok_ok) {
#pragma unroll
                for (int et = 0; et < 8; ++et) xr[et] = (v4u){0u, 0u, 0u, 0u};
            }
            if (bl >= 16) {
                LAS unsigned char* rb = U + ((bl < 32) ? SL::OFF_B + (lc0 - 128) * 2 : SL::OFF_C + (lc0 - 256) * 2) + (8 * tg) * 272;
#pragma unroll
                for (int et = 0; et < 8; ++et) *(LAS v4u*)(rb + et * 272) = xr[et];
            }
            if (bl < 32) {
                LAS unsigned char* tb = U + ((bl < 16) ? SL::OFF_XT + lc0 * 80 : SL::OFF_BT + (lc0 - 128) * 80) + 16 * tg;
#pragma unroll
                for (int c = 0; c < 8; ++c) { v4u o;
#pragma unroll
                    for (int k = 0; k < 4; ++k) { const unsigned a = xr[2 * k][c >> 1], b = xr[2 * k + 1][c >> 1]; o[k] = (c & 1) ? ((a >> 16) | (b & 0xffff0000u)) : ((a & 0xffffu) | (b << 16)); }
                    *(LAS v4u*)(tb + c * 80) = o; }
            }
        } else {
            const int t1 = ct & 31, hh = (ct - 192) >> 5;
            const bool valid = smp ? (t1 < TS) : true;
            const float dt = valid ? softplus_f(bf2f(sdraw) + ((hh == 0) ? dtb0 : dtb1)) : 0.f;
            float c0 = dt * ((hh == 0) ? A0 : A1);
            c0 += dpp_sel<0x111, 0xf>(0.f, c0); c0 += dpp_sel<0x112, 0xf>(0.f, c0); c0 += dpp_sel<0x114, 0xf>(0.f, c0); c0 += dpp_sel<0x118, 0xf>(0.f, c0); c0 += dpp_bcast15(0.f, c0);
            const float cl = (lane & 32) ? __builtin_bit_cast(float, __builtin_amdgcn_readlane(__builtin_bit_cast(int, c0), 63)) : __builtin_bit_cast(float, __builtin_amdgcn_readlane(__builtin_bit_cast(int, c0), 31));
            LAS float* tab = (LAS float*)(U + SL::OFF_TAB) + hh * 160;
            tab[t1] = c0; tab[32 + t1] = __expf(c0); tab[64 + t1] = dt; tab[96 + t1] = dt * __expf(cl - c0);
            if (t1 == 31) tab[128] = __expf(cl);
        }
    }
    __syncthreads();
    const int q2 = lane >> 4, p2 = 16 * ps + (lane & 15);
    float* dsp = C.DS + ((((size_t)(b0 * 2 + g) * (TP / 64) + sc0) * 2 + hh2) * 64 + p2) * 128;
    if (mode == 2) {
#pragma unroll 1
        for (int u = 0; u < 2; ++u) s2_ssd_state(L + u * SL::UNIT, S, hh2, ps, lane);
#pragma unroll
        for (int nt = 0; nt < 8; ++nt) *(f32x4*)(dsp + 16 * nt + 4 * q2) = S[nt];
        if (ps == 0 && lane == 0) C.ESC[((size_t)(b0 * 2 + g) * (TP / 64) + sc0) * 2 + hh2] = ((const LAS float*)(L + SL::OFF_TAB))[hh2 * 160 + 128] * ((const LAS float*)(L + SL::UNIT + SL::OFF_TAB))[hh2 * 160 + 128];
    } else if (mode == 3) {
#pragma unroll
        for (int nt = 0; nt < 8; ++nt) S[nt] = *(const f32x4*)(dsp + 16 * nt + 4 * q2);
#pragma unroll 1
        for (int u = 0; u < 2; ++u) s2_ssd_unit(L + u * SL::UNIT, S, hh2, ps, lane, (hh2 == 0) ? D0 : D1);
    } else {
#pragma unroll 1
        for (int u = 0; u < 2; ++u) {
            const float* sp = C.s_ssm + (((size_t)(b0 + u) * 4 + h2) * 64 + p2) * 128;
#pragma unroll
            for (int nt = 0; nt < 8; ++nt) S[nt] = *(const f32x4*)(sp + 16 * nt + 4 * q2);
            s2_ssd_unit(L + u * SL::UNIT, S, hh2, ps, lane, (hh2 == 0) ? D0 : D1);
            float* so = C.out + O_SSMS + ((((size_t)C.l * BS + b0 + u) * 4 + h2) * 64 + p2) * 128;
#pragma unroll
            for (int nt = 0; nt < 8; ++nt) *(f32x4*)(so + 16 * nt + 4 * q2) = S[nt];
        }
    }
    __syncthreads();
    if (mode != 2) {
        const LAS float* yb = (const LAS float*)(L + u3 * SL::UNIT + SL::OFF_Y) + i3 * 132 + 16 * c83;
        float y[16]; float ss = 0.f;
#pragma unroll
        for (int j = 0; j < 4; ++j) { const f32x4 v = *(const LAS f32x4*)(yb + 4 * j);
#pragma unroll
            for (int e = 0; e < 4; ++e) { const int ee = 4 * j + e; const float zv = (ee < 8) ? bfe(zz0, ee) : bfe(zz1, ee - 8); y[ee] = v[e] * zv; ss += y[ee] * y[ee]; } }
        ss = oct_sum(ss);
        const float r = rsqrtf(ss * (1.0f / 128.0f) + 1e-6f);
        if (valid3) {
            float nwv[16];
#pragma unroll
            for (int j = 0; j < 4; ++j) { const f32x4 t = *(const LAS f32x4*)(cst + 16 * c83 + 4 * j); nwv[4 * j] = t[0]; nwv[4 * j + 1] = t[1]; nwv[4 * j + 2] = t[2]; nwv[4 * j + 3] = t[3]; }
            v4u w0, w1;
            w0.x = cvtpk(y[0] * r * nwv[0], y[1] * r * nwv[1]); w0.y = cvtpk(y[2] * r * nwv[2], y[3] * r * nwv[3]); w0.z = cvtpk(y[4] * r * nwv[4], y[5] * r * nwv[5]); w0.w = cvtpk(y[6] * r * nwv[6], y[7] * r * nwv[7]);
            w1.x = cvtpk(y[8] * r * nwv[8], y[9] * r * nwv[9]); w1.y = cvtpk(y[10] * r * nwv[10], y[11] * r * nwv[11]); w1.z = cvtpk(y[12] * r * nwv[12], y[13] * r * nwv[13]); w1.w = cvtpk(y[14] * r * nwv[14], y[15] * r * nwv[15]);
            bf16* mo = C.mixb + (size_t)row3 * D + MC_SSM + 128 * g + 16 * c83;
            *(v4u*)mo = w0; *(v4u*)(mo + 8) = w1;
        }
    }
    __syncthreads();
}

__device__ __forceinline__ void ssd_scan(const MixP& C, const int wg, const int nwgs, const int tid) {
    constexpr int NSC = TP / 64, NEL = BP * 2 * 2 * 8192;
    for (int idx = wg * NTHREADS + tid; idx < NEL; idx += nwgs * NTHREADS) {
        const int e = idx & 8191, bgh = idx >> 13, hh = bgh & 1, bg = bgh >> 1;
        float* dp = C.DS + ((size_t)bg * NSC * 2 + hh) * 8192 + e;
        const float* ep = C.ESC + (size_t)bg * NSC * 2 + hh;
        float d[NSC], E[NSC];
#pragma unroll
        for (int sc = 0; sc < NSC; ++sc) { d[sc] = dp[(size_t)sc * 2 * 8192]; E[sc] = ep[sc * 2]; }
        float s = 0.f;
#pragma unroll
        for (int sc = 0; sc < NSC; ++sc) { dp[(size_t)sc * 2 * 8192] = s; s = E[sc] * s + d[sc]; }
        const int b = bg >> 1, g = bg & 1;
        C.out[O_SSMP + (((size_t)C.l * BP + b) * 4 + 2 * g + hh) * 8192 + e] = s;
    }
}

__device__ __forceinline__ void sub_barrier(unsigned* cnt, const unsigned nwg) {
    asm volatile("s_waitcnt vmcnt(0)" ::: "memory");
    __syncthreads();
    if (threadIdx.x == 0) {
        __builtin_amdgcn_fence(__ATOMIC_RELEASE, "agent");
        asm volatile("s_waitcnt vmcnt(0)" ::: "memory");
        (void)__hip_atomic_fetch_add(cnt, 1u, __ATOMIC_RELAXED, __HIP_MEMORY_SCOPE_AGENT);
        unsigned sp = 0;
        while (__hip_atomic_load(cnt, __ATOMIC_RELAXED, __HIP_MEMORY_SCOPE_AGENT) < nwg) { __builtin_amdgcn_s_sleep(2); if (++sp > (1u << 22)) break; }
        __builtin_amdgcn_fence(__ATOMIC_ACQUIRE, "agent");
        asm volatile("s_waitcnt vmcnt(0)" ::: "memory");
    }
    __syncthreads();
}
__device__ __forceinline__ void pool_item(LAS unsigned char* L, const MixP& C, const int tile, const int tid) {
    constexpr int DF_OFF = 40960, WT_OFF = 74752;
    const int m0 = tile * 64;
    {
        f32x4 wv[8];
#pragma unroll
        for (int i = 0; i < 8; ++i) { const int e4 = tid + NTHREADS * i; wv[i] = *(const f32x4*)(C.pool_w + (size_t)e4 * 4); }
#pragma unroll
        for (int i = 0; i < 8; ++i) { const int e4 = tid + NTHREADS * i, d0 = (e4 & 15) * 4, c = (e4 >> 4) & 63, g = e4 >> 10;
            LAS unsigned char* wp = L + WT_OFF + g * 9216 + d0 * 144 + c * 2;
            const unsigned p01 = cvtpk(wv[i][0], wv[i][1]), p23 = cvtpk(wv[i][2], wv[i][3]);
            *(LAS unsigned short*)(wp) = (unsigned short)(p01 & 0xffffu); *(LAS unsigned short*)(wp + 144) = (unsigned short)(p01 >> 16);
            *(LAS unsigned short*)(wp + 288) = (unsigned short)(p23 & 0xffffu); *(LAS unsigned short*)(wp + 432) = (unsigned short)(p23 >> 16); }
    }
    if (m0 < MP) {
        const int tt0 = m0 & (TP - 1);
#pragma unroll
        for (int idx = tid; idx < 79 * 32; idx += NTHREADS) {
            const int r = idx >> 5, c8 = idx & 31, tr = tt0 - 15 + r, trc = tr < 0 ? 0 : tr;
            const v4u ld = *(const v4u*)(C.P + (size_t)(m0 - tt0 + trc) * NINP + PC_PX + 8 * c8);
            *(LAS v4u*)(L + r * 512 + c8 * 16) = (tr >= 0) ? ld : (v4u){0u, 0u, 0u, 0u};
        }
        __syncthreads();
        {
            const int c = tid & 255, th = tid >> 8, g = c >> 6, w = 2 << g, tA = 32 * th;
            const LAS unsigned short* col = (const LAS unsigned short*)L + c;
            float s = 0.f;
            for (int j = 1; j < w; ++j) s += bf2f(col[(tA + 15 - j) * 256]);
            for (int t = tA; t < tA + 32; ++t) {
                const float x = bf2f(col[(t + 15) * 256]); s += x;
                const int tt = tt0 + t, cnt = (tt + 1 < w) ? tt + 1 : w;
                *(LAS unsigned short*)(L + DF_OFF + t * 528 + c * 2) = (unsigned short)(cvtpk(s * __builtin_amdgcn_rcpf((float)cnt) - x, 0.f) & 0xffffu);
                s -= bf2f(col[(t + 16 - w) * 256]);
            }
        }
    } else {
#pragma unroll 1
        for (int task = tid; task < 8 * 256; task += NTHREADS) {
            const int bb = task >> 8, c = task & 255, g = c >> 6, w = 2 << g, bg = (m0 - MP) / TS + bb;
            float xs[23];
#pragma unroll
            for (int r = 0; r < 15; ++r) xs[r] = C.s_pool[((size_t)bg * 15 + r) * 256 + c];
            bf16 xraw[8];
#pragma unroll
            for (int t = 0; t < 8; ++t) xraw[t] = C.P[(size_t)(m0 + bb * TS + t) * NINP + PC_PX + c];
#pragma unroll
            for (int t = 0; t < 8; ++t) xs[15 + t] = bf2f(xraw[t]);
            const float rw = __builtin_amdgcn_rcpf((float)w);
#pragma unroll
            for (int t = 0; t < 8; ++t) { float s = 0.f;
#pragma unroll
                for (int j = 0; j < 16; ++j) s += (j < w) ? xs[15 + t - j] : 0.f;
                *(LAS unsigned short*)(L + DF_OFF + (bb * TS + t) * 528 + c * 2) = (unsigned short)(cvtpk(s * rw - xs[15 + t], 0.f) & 0xffffu); }
        }
    }
    __syncthreads();
    {
        const int w8 = __builtin_amdgcn_readfirstlane(tid >> 6), lane = tid & 63, q = lane >> 4, r16 = lane & 15, g = w8 >> 1, dh = w8 & 1;
        f32x4 acc[2][4];
#pragma unroll
        for (int a = 0; a < 2; ++a)
#pragma unroll
            for (int b = 0; b < 4; ++b) acc[a][b] = (f32x4){0.f, 0.f, 0.f, 0.f};
#pragma unroll
        for (int ks = 0; ks < 2; ++ks) {
            bf16x8 wa[2], db[4];
#pragma unroll
            for (int a = 0; a < 2; ++a) wa[a] = frag16(L + WT_OFF + g * 9216 + (16 * (2 * dh + a) + r16) * 144 + (32 * ks + 8 * q) * 2);
#pragma unroll
            for (int b = 0; b < 4; ++b) db[b] = frag16(L + DF_OFF + (16 * b + r16) * 528 + (g * 64 + 32 * ks + 8 * q) * 2);
#pragma unroll
            for (int a = 0; a < 2; ++a)
#pragma unroll
                for (int b = 0; b < 4; ++b) acc[a][b] = MFMA16(wa[a], db[b], acc[a][b]);
        }
#pragma unroll
        for (int a = 0; a < 2; ++a) {
            const int d0 = g * 64 + 16 * (2 * dh + a) + 4 * q;
            const f32x4 sc = *(const f32x4*)(C.pool_scale + d0);
#pragma unroll
            for (int b = 0; b < 4; ++b) { const f32x4 v = acc[a][b] * sc; v2u o; o.x = cvtpk(v[0], v[1]); o.y = cvtpk(v[2], v[3]);
                *(v2u*)(C.mixb + (size_t)(m0 + 16 * b + r16) * D + MC_POOL + d0) = o; }
        }
    }
    __syncthreads();
}

constexpr int N_CP_PP = BP * 15 * 32, N_CP_PS = BS * 15 * 32, N_CP_CP = BP * 3 * 96, N_CP_CS = BS * 3 * 96, N_CP = N_CP_PP + N_CP_PS + N_CP_CP + N_CP_CS;
__device__ __forceinline__ void copy_states(const MixP& C, const int wg, const int nwgs, const int tid) {
    const int l = C.l;
    for (int i = wg * NTHREADS + tid; i < N_CP; i += nwgs * NTHREADS) {
        const bf16* src = nullptr; const float* fsrc = nullptr; float* dst;
        if (i < N_CP_PP) { const int b = i / 480, rem = i % 480, r = rem >> 5, c = (rem & 31) * 8;
            src = C.P + (size_t)(b * TP + TP - 15 + r) * NINP + PC_PX + c; dst = C.out + O_POOLP + ((size_t)(l * BP + b) * 15 + r) * 256 + c; }
        else if (i < N_CP_PP + N_CP_PS) { const int j = i - N_CP_PP, b = j / 480, rem = j % 480, r = rem >> 5, c = (rem & 31) * 8;
            if (r < 7) fsrc = C.s_pool + ((size_t)b * 15 + 8 + r) * 256 + c; else src = C.P + (size_t)(MP + b * TS + (r - 7)) * NINP + PC_PX + c;
            dst = C.out + O_POOLS + ((size_t)(l * BS + b) * 15 + r) * 256 + c; }
        else if (i < N_CP_PP + N_CP_PS + N_CP_CP) { const int j = i - N_CP_PP - N_CP_PS, b = j / 288, rem = j % 288, r = rem / 96, c = (rem % 96) * 8;
            src = C.P + (size_t)(b * TP + TP - 3 + r) * NINP + PC_XBC + c; dst = C.out + O_CONVP + ((size_t)(l * BP + b) * 3 + r) * 768 + c; }
        else { const int j = i - N_CP_PP - N_CP_PS - N_CP_CP, b = j / 288, rem = j % 288, r = rem / 96, c = (rem % 96) * 8;
            src = C.P + (size_t)(MP + b * TS + 5 + r) * NINP + PC_XBC + c; dst = C.out + O_CONVS + ((size_t)(l * BS + b) * 3 + r) * 768 + c; }
        f32x4 v0, v1;
        if (src) { const v4u w = *(const v4u*)src; v0 = (f32x4){bfe(w, 0), bfe(w, 1), bfe(w, 2), bfe(w, 3)}; v1 = (f32x4){bfe(w, 4), bfe(w, 5), bfe(w, 6), bfe(w, 7)}; }
        else { v0 = *(const f32x4*)fsrc; v1 = *(const f32x4*)(fsrc + 4); }
        *(f32x4*)dst = v0; *(f32x4*)(dst + 4) = v1;
    }
}

constexpr int NGH = BP * 8, N_SSD_IT = BP * 2 * (TP / 64), N_IT_SMP_GH = (BS / 4) * 4, N_IT_SMP_SSD = (BS / 2) * 2, N_IT_POOL = M / 64;
constexpr int IT_M3 = N_SSD_IT, IT_SGLA = 2 * N_SSD_IT, IT_SHG = IT_SGLA + N_IT_SMP_GH, IT_SSSD = IT_SHG + N_IT_SMP_GH, IT_POOL = IT_SSSD + N_IT_SMP_SSD, IT_GHP = IT_POOL + N_IT_POOL, IT_END = IT_GHP + NGH;
constexpr int N_IT_PROMPT = NGH;
__device__ __forceinline__ void mixer_phase(unsigned char* ldsg, LAS unsigned char* ldsl, const MixP& C, int G, const int tid) {
    const int bx = blockIdx.x;
    const int ngh = (G >= 2 * NGH) ? NGH : 0;
    const int nw = G - ngh;
    int it, step, lim; bool synced;
    if (bx < ngh) { it = IT_GHP + bx; step = 1 << 30; lim = IT_END; synced = true; }
    else { it = bx - ngh; step = nw; lim = (ngh > 0) ? IT_GHP : IT_END; synced = false; copy_states(C, bx - ngh, nw, tid); }
    int rep_it = 0;
    constexpr int NFILL = 64, V_SYNC = N_SSD_IT + NFILL;
    for (int vi = it; vi < lim; vi += step) {
        it = vi;
        if (ngh > 0 && bx >= ngh) {
            if (vi < N_SSD_IT) it = vi;
            else if (vi < V_SYNC) it = IT_POOL + (vi - N_SSD_IT);
            else if (vi < V_SYNC + N_SSD_IT) it = IT_M3 + (vi - V_SYNC);
            else if (vi < V_SYNC + N_SSD_IT + (IT_POOL - IT_SGLA)) it = IT_SGLA + (vi - V_SYNC - N_SSD_IT);
            else it = IT_POOL + NFILL + (vi - (V_SYNC + N_SSD_IT + (IT_POOL - IT_SGLA)));
        }
        if (!synced && ((ngh > 0) ? (vi >= V_SYNC) : (it >= IT_M3))) { sub_barrier(C.subc, (unsigned)nw); ssd_scan(C, bx - ngh, nw, tid); sub_barrier(C.subc + 64, (unsigned)nw); synced = true; }
        int tidl = tid; asm volatile("" : "+v"(tidl));
        int kind, a, b0, mode = 0, sc0 = 0; bool smp = true;
        if (it < IT_SGLA) { const int j = (it < IT_M3) ? it : it - IT_M3; kind = 2; mode = (it < IT_M3) ? 2 : 3; sc0 = j & (TP / 64 - 1); a = (j >> 5) & 1; b0 = j >> 6; }
        else if (it < IT_SHG) { const int j = it - IT_SGLA; kind = 0; a = j & 3; b0 = (j >> 2) * 4; }
        else if (it < IT_SSSD) { const int j = it - IT_SHG; kind = 1; a = j & 3; b0 = (j >> 2) * 4; }
        else if (it < IT_POOL) { const int j = it - IT_SSSD; kind = 2; mode = 1; a = j & 1; b0 = (j >> 1) * 2; }
        else if (it < IT_GHP) { kind = 3; a = it - IT_POOL; b0 = 0; }
        else { const int j = it - IT_GHP; smp = false; b0 = j >> 3; kind = ((j & 7) < 4) ? 0 : 1; a = j & 3; }
        if (kind == 0) {
#ifndef MK_NO_GLA
            chain_gh<0>(ldsl, C, a, b0, smp, tidl);
#endif
        } else if (kind == 1) {
#ifndef MK_NO_HGRN
            chain_gh<1>(ldsl, C, a, b0, smp, tidl);
#endif
        } else if (kind == 2) {
#ifndef MK_NO_SSD
            chain_ssd(ldsl, C, a, b0, mode, sc0, tidl);
#endif
        } else {
#ifndef MK_NO_POOL
            pool_item(ldsl, C, a, tidl);
#endif
        }
        int want = 1;
#ifdef MK_DUP_POOL
        if (kind == 3) want = 2;
#endif
#ifdef MK_DUP_SMPGH
        if (kind < 2 && smp) want = 2;
#endif
#ifdef MK_DUP_SMPSSD
        if (kind == 2 && mode == 1) want = 2;
#endif
#ifdef MK_DUP_GHP
        if (!smp) want = 2;
#endif
#ifdef MK_DUP_M3
        if (kind == 2 && mode == 3) want = 2;
#endif
        if (++rep_it < want) vi -= step; else rep_it = 0;
    }
    if (!synced) { sub_barrier(C.subc, (unsigned)nw); ssd_scan(C, bx - ngh, nw, tid); sub_barrier(C.subc + 64, (unsigned)nw); }
}

__device__ __forceinline__ void srg_phase(LAS unsigned char* L, const bf16* Aop, const bf16* Bt, const int K, bf16* xb, float* rowss, const float scale, const bool fin, const int G, const int tid) {
    const int w = __builtin_amdgcn_readfirstlane(tid >> 6), lane = tid & 63, q = lane >> 4, r16 = lane & 15, wm = w >> 1, wn = w & 1;
    const int lr = tid >> 3, lc = (tid & 7) * 8;
    const int nt = K / 128;
    for (int tile = blockIdx.x; tile < 256; tile += G) {
        const int tm = tile >> 4, tn = tile & 15;
        const bf16* ag = Aop + (size_t)(MP + 64 * tm + lr) * K + lc;
        const bf16* bg = Bt + (size_t)(64 * tn + lr) * K + lc;
        f32x4 acc0 = {0.f, 0.f, 0.f, 0.f}, acc1 = acc0;
        v4u ra[2][2], rb[2][2];
#pragma unroll
        for (int i = 0; i < 2; ++i) { ra[i][0] = *(const v4u*)(ag + i * 128); ra[i][1] = *(const v4u*)(ag + i * 128 + 64); rb[i][0] = *(const v4u*)(bg + i * 128); rb[i][1] = *(const v4u*)(bg + i * 128 + 64); }
        LAS unsigned char* wr0 = L + lr * 272 + lc * 2;
        const LAS unsigned char* fa = L + (16 * wm + r16) * 272 + (8 * q) * 2;
        const LAS unsigned char* fb = L + 17408 + (32 * wn + r16) * 272 + (8 * q) * 2;
#pragma unroll 1
        for (int t = 0; t < nt; t += 2) {
#pragma unroll
            for (int i = 0; i < 2; ++i) {
                LAS unsigned char* wb_ = wr0 + i * 34816;
                *(LAS v4u*)(wb_) = ra[i][0]; *(LAS v4u*)(wb_ + 128) = ra[i][1]; *(LAS v4u*)(wb_ + 17408) = rb[i][0]; *(LAS v4u*)(wb_ + 17408 + 128) = rb[i][1];
                { const int tn2 = (t + 2 + i < nt) ? t + 2 + i : i; const bf16* a2 = ag + (size_t)tn2 * 128; const bf16* b2 = bg + (size_t)tn2 * 128;
                  ra[i][0] = *(const v4u*)a2; ra[i][1] = *(const v4u*)(a2 + 64); rb[i][0] = *(const v4u*)b2; rb[i][1] = *(const v4u*)(b2 + 64); }
                __syncthreads();
#pragma unroll
                for (int ks = 0; ks < 4; ++ks) {
                    const bf16x8 af = frag16(fa + i * 34816 + ks * 64), b0 = frag16(fb + i * 34816 + ks * 64), b1 = frag16(fb + i * 34816 + 16 * 272 + ks * 64);
                    acc0 = MFMA16(b0, af, acc0); acc1 = MFMA16(b1, af, acc1);
                }
            }
        }
        {
            const int row = MP + 64 * tm + 16 * wm + r16, col0 = 64 * tn + 32 * wn + 4 * q;
            bf16* px = xb + (size_t)row * D + col0;
            const v2u xa = *(const v2u*)px, xc = *(const v2u*)(px + 16);
            const float a0 = __builtin_bit_cast(float, xa.x << 16) + acc0[0] * scale, a1 = __builtin_bit_cast(float, xa.x & 0xffff0000u) + acc0[1] * scale, a2 = __builtin_bit_cast(float, xa.y << 16) + acc0[2] * scale, a3 = __builtin_bit_cast(float, xa.y & 0xffff0000u) + acc0[3] * scale;
            const float b0 = __builtin_bit_cast(float, xc.x << 16) + acc1[0] * scale, b1 = __builtin_bit_cast(float, xc.x & 0xffff0000u) + acc1[1] * scale, b2 = __builtin_bit_cast(float, xc.y << 16) + acc1[2] * scale, b3 = __builtin_bit_cast(float, xc.y & 0xffff0000u) + acc1[3] * scale;
            v2u wa, wb; wa.x = cvtpk(a0, a1); wa.y = cvtpk(a2, a3); wb.x = cvtpk(b0, b1); wb.y = cvtpk(b2, b3);
            *(v2u*)px = wa; *(v2u*)(px + 16) = wb;
            float ss = 0.f;
#pragma unroll
            for (int k = 0; k < 2; ++k) { const unsigned pa = wa[k], pb = wb[k]; const float r0 = __builtin_bit_cast(float, pa << 16), r1 = __builtin_bit_cast(float, pa & 0xffff0000u), r2 = __builtin_bit_cast(float, pb << 16), r3 = __builtin_bit_cast(float, pb & 0xffff0000u); ss += (r0 * r0 + r1 * r1) + (r2 * r2 + r3 * r3); }
            ss += __shfl_xor(ss, 16); ss += __shfl_xor(ss, 32);
            if (q == 0 && fin) unsafeAtomicAdd(rowss + row, ss);
        }
        __syncthreads();
    }
}

__device__ __forceinline__ void final_phase(const Args& A, int wave, int lane, int G) {
    const int gw = blockIdx.x * NWAVES + wave, NGW = G * NWAVES;
    const float* rss = (const float*)(A.ws + WS_RSS) + (size_t)6 * M; const f32x4* gn = (const f32x4*)A.in[I_FINALN] + lane; const bf16* xb = (const bf16*)(A.ws + WS_XB);
    f32x4 g4[4];
#pragma unroll
    for (int j = 0; j < 4; ++j) g4[j] = gn[64 * j];
    constexpr int NR = 4;
    for (int m0 = gw; m0 < M; m0 += NR * NGW) {
        float q[NR]; v2u w[NR][4];
#pragma unroll
        for (int h = 0; h < NR; ++h) { const int mh = m0 + h * NGW, m = (mh < M) ? mh : m0; q[h] = rss[m];
            const v2u* xr = (const v2u*)(xb + (size_t)m * D) + lane;
#pragma unroll
            for (int j = 0; j < 4; ++j) w[h][j] = xr[64 * j]; }
#pragma unroll
        for (int h = 0; h < NR; ++h) {
            const int mh = m0 + h * NGW;
            if (mh < M) {
                const float r = rsqrtf(q[h] * (1.0f / 1024.0f) + 1e-6f);
                f32x4* yo = (f32x4*)(A.out + (size_t)mh * D) + lane;
#pragma unroll
                for (int j = 0; j < 4; ++j) { const v2u ww = w[h][j]; const f32x4 v = {__builtin_bit_cast(float, ww.x << 16), __builtin_bit_cast(float, ww.x & 0xffff0000u), __builtin_bit_cast(float, ww.y << 16), __builtin_bit_cast(float, ww.y & 0xffff0000u)};
                    yo[64 * j] = v * r * g4[j]; }
            }
        }
    }
}

__device__ __forceinline__ void side_convert(const Args& A, LAS unsigned char* ldsl, const int tidv, const int first, const int G, const CvtList Lst) {
    const int wv = __builtin_amdgcn_readfirstlane(tidv >> 6);
    if (first > 0 && first < G) { if ((int)blockIdx.x >= first) convert_weights(A, ldsl, wv, tidv & 63, Lst, ((int)blockIdx.x - first) * NWAVES + wv, (G - first) * NWAVES); }
    else convert_weights(A, ldsl, wv, tidv & 63, Lst, (int)blockIdx.x * NWAVES + wv, G * NWAVES);
}
__device__ __forceinline__ int sub_of(int ph) { const int j = (ph - 1) & 7; return (j < 3) ? j : (j == 3 ? 7 : j - 1); }
__global__ void __launch_bounds__(NTHREADS, 2) mk_fwd(Args args) {
    extern __shared__ __attribute__((aligned(16))) unsigned char lds[];
    LAS unsigned char* ldsl = (LAS unsigned char*)lds;
    volatile LAS unsigned* MISC = (volatile LAS unsigned*)(ldsl + MISC_OFF);
    const int tid = threadIdx.x, lane = tid & 63, wave = __builtin_amdgcn_readfirstlane(tid >> 6), G = gridDim.x;
    unsigned char* ws = args.ws;
    gu32* ctl = (gu32*)(ws + WS_CTL);
    for (int u = tid; u < (LDS_BYTES - LDSCTL_OFF) / 4; u += NTHREADS) ((LAS unsigned*)(ldsl + LDSCTL_OFF))[u] = 0u;
    __syncthreads();
    const int lo = args.ph_lo, hi = args.ph_hi;
    XcdBarrier bar; bar.bar = (unsigned*)(ctl + CW_BAR); bar.x = 0; bar.st = nullptr;
    if (hi - lo > 1) bar = xcd_barrier_post((unsigned*)(ctl + CW_BAR), MISC + 8);

    bf16* xb = (bf16*)(ws + WS_XB); bf16* mixb = (bf16*)(ws + WS_MIX); bf16* hp = (bf16*)(ws + WS_HP);
    float* rss = (float*)(ws + WS_RSS);

    bool first = true;
    for (int si = 2 * lo; si < 2 * hi; ++si) {
        const int ph = si >> 1;
        if (si & 1) {
            bool dup = false;
#ifdef MK_DUP_P0
            dup = dup || (ph == 0);
#endif
#ifdef MK_DUP_MIX
            dup = dup || (ph >= 1 && ph < N_PHASES - 1 && sub_of(ph) == 3);
#endif
#ifdef MK_DUP_GU
            dup = dup || (ph >= 1 && ph < N_PHASES - 1 && (sub_of(ph) == 0 || sub_of(ph) == 5));
#endif
#ifdef MK_DUP_RESID
            dup = dup || (ph >= 1 && ph < N_PHASES - 1 && (sub_of(ph) == 1 || sub_of(ph) == 4 || sub_of(ph) == 6));
#endif
#ifdef MK_DUP_IN
            dup = dup || (ph >= 1 && ph < N_PHASES - 1 && sub_of(ph) == 2);
#endif
            if (!dup) continue;
        }
        if (!first) xcd_barrier(bar);
        first = false;
        int tidv = threadIdx.x; asm volatile("" : "+v"(tidv));
        if (ph == 0) {
#ifndef MK_NO_P0
            p0_prologue(args, ldsl, __builtin_amdgcn_readfirstlane(tidv >> 6), tidv & 63, G);
#endif
        }
        else if (ph == N_PHASES - 1) { final_phase(args, __builtin_amdgcn_readfirstlane(tidv >> 6), tidv & 63, G); }
        else {
            const int l = (ph - 1) / 8, s = sub_of(ph);
            CvtList side = {0, 0, 0, 0, 0, 0, 0, 0}; int side_first = 0;
            const unsigned char* wl = ws + WS_W + (size_t)l * W_LAYER;
            if (s == 0 || s == 5) {
                pg8::Gemm g{xb, (const bf16*)(wl + (s == 0 ? WO_GU1 : WO_GU2)), M, NGU, D}; pg8::StaticOrder S; S.init(M, NGU, G, (int)blockIdx.x);
                bool gdry = false;
#ifdef MK_DRY_GU
                gdry = (si & 1) == 0;
#endif
                pg8::EpiSwiGLU E{hp, FF, rss + (size_t)(3 * l + (s == 0 ? 0 : 2)) * M, gdry};
#ifndef MK_NO_G1
                pg8::gemm_phase<pg8::EpiSwiGLU, pg8::StaticOrder, PG8_ALIGN, PG8_SP2>(ldsl + RING_OFF, g, S, E, tidv);
#endif
                side = (l == 0) ? ((s == 0) ? CV_GU1_L0 : CV_GU2_L0) : ((s == 0) ? CV_GU1_L1 : CvtList{0, 0, 0, 0, 0, 0, 0, 0}); side_first = ((M / 256) * (NGU / 256)) % G;
            } else if (s == 1 || s == 4 || s == 6) {
                const bf16* Aop = (s == 4) ? mixb : hp; const int K = (s == 4) ? D : FF;
                const size_t wo = (s == 1) ? WO_D1 : (s == 4) ? WO_OUT : WO_D2;
                pg8::Gemm g{Aop, (const bf16*)(wl + wo), MP, D, K}; pg8::StaticOrder S; S.init(MP, D, G, (int)blockIdx.x);
                float* rso = rss + (size_t)(3 * l + (s == 1 ? 1 : (s == 4 ? 2 : 3))) * M;
                const float rscale = (s == 4) ? 1.0f : 0.5f;
                float esc = rscale; bool efin = true;
#ifdef MK_DUP_RESID
                esc = 0.5f * rscale; efin = (si & 1) != 0;
#endif
                pg8::EpiResid E{xb, rso, esc, efin};
#ifndef MK_NO_G2
                const bool srg_first = (blockIdx.x & 1) != 0;
                if (srg_first) srg_phase(ldsl + RING_OFF, Aop, (const bf16*)(wl + wo), K, xb, rso, esc, efin, G, tidv);
                pg8::gemm_phase<pg8::EpiResid, pg8::StaticOrder, PG8_ALIGN, PG8_SP2>(ldsl + RING_OFF, g, S, E, tidv);
                if (!srg_first)
#ifdef MK_DUP_SRG
                srg_phase(ldsl + RING_OFF, Aop, (const bf16*)(wl + wo), K, xb, rso, 0.5f * esc, false, G, tidv);
                srg_phase(ldsl + RING_OFF, Aop, (const bf16*)(wl + wo), K, xb, rso, 0.5f * esc, efin, G, tidv);
#else
                srg_phase(ldsl + RING_OFF, Aop, (const bf16*)(wl + wo), K, xb, rso, esc, efin, G, tidv);
#endif
#endif
            } else if (s == 2) {
                pg8::Gemm g{xb, (const bf16*)(wl + WO_IN), M, NINP, D}; pg8::StaticOrder S; S.init(M, NINP, G, (int)blockIdx.x);
                pg8::EpiProj E{hp, NINP, rss + (size_t)(3 * l + 1) * M};
#ifndef MK_NO_G3
                pg8::gemm_phase<pg8::EpiProj, pg8::StaticOrder, PG8_ALIGN, PG8_SP2>(ldsl + RING_OFF, g, S, E, tidv);
#endif
                side = (l == 0) ? CV_IN_L0 : CV_IN_L1; side_first = ((M / 256) * (NINP / 256)) % G;
            } else {
                MixP C;
                C.P = hp; C.mixb = mixb; C.out = args.out; C.l = l; C.XC = (bf16*)args.out;
                C.DS = args.out + 8388608; C.ESC = args.out + 16900000; C.subc = (unsigned*)(ctl + CW_SUB + 128 * l);
                C.s_pool = args.in[I_SPOOL] + (size_t)l * BS * 15 * 256; C.s_gla = args.in[I_SGLA] + (size_t)l * BS * 4 * 32 * 64; C.s_hgrn = args.in[I_SHGRN] + (size_t)l * BS * 4 * 64 * 64;
                C.s_ssm = args.in[I_SSSM] + (size_t)l * BS * 4 * 64 * 128; C.s_conv = args.in[I_SCONV] + (size_t)l * BS * 3 * 768;
                C.pool_w = args.in[I_POOLW] + (size_t)l * 4 * 64 * 64; C.pool_scale = args.in[I_POOLS] + l * 256; C.gla_wg = args.in[I_GLAWG] + l * 16 * 128; C.gla_b = args.in[I_GLAB] + l * 128;
                C.gla_n = args.in[I_GLAN] + l * 64; C.lbl = args.in[I_LBL]; C.hg_n = args.in[I_HGN] + l * 64; C.conv_w = args.in[I_CONVW] + l * 4 * 768; C.conv_b = args.in[I_CONVB] + l * 768;
                C.dt_b = args.in[I_DTB] + l * 4; C.a_log = args.in[I_ALOG] + l * 4; C.ssm_d = args.in[I_SSMD] + l * 4; C.ssm_n = args.in[I_SSMN] + l * 256;
#ifndef MK_NO_MIXER
                if (s == 7) conv_phase(C, G, tidv); else mixer_phase(lds + RING_OFF, ldsl + RING_OFF, C, G, tidv);
#endif
            }
            if (side.n0 + side.n1 > 0) side_convert(args, ldsl, tidv, side_first, G, side);
        }
    }
}

extern "C" void kernel_launch(void* const* d_in, const int* in_sizes, int n_in, void* d_out, int out_size, void* d_ws, size_t ws_size, hipStream_t stream) {
    static int grid = 0;
    if (grid == 0) {
        if (n_in != N_INPUTS || in_sizes[0] != MP * D || (size_t)out_size != O_END || ws_size < WS_END) {
            fprintf(stderr, "kernel_launch: shape mismatch: n_in %d, in0 %d, out %d, ws %zu (need %zu); nothing launched\n", n_in, n_in > 0 ? in_sizes[0] : -1, out_size, ws_size, (size_t)WS_END); grid = -1; return; }
        int dev = 0, cus = 0, per_cu = 0;
        if (hipGetDevice(&dev) != hipSuccess || hipDeviceGetAttribute(&cus, hipDeviceAttributeMultiprocessorCount, dev) != hipSuccess) { fprintf(stderr, "kernel_launch: device query failed\n"); grid = -1; return; }
        if (hipFuncSetAttribute((const void*)mk_fwd, hipFuncAttributeMaxDynamicSharedMemorySize, LDS_BYTES) != hipSuccess) { fprintf(stderr, "kernel_launch: hipFuncSetAttribute failed\n"); grid = -1; return; }
        if (hipOccupancyMaxActiveBlocksPerMultiprocessor(&per_cu, (const void*)mk_fwd, NTHREADS, LDS_BYTES) != hipSuccess || per_cu < 1) {
            fprintf(stderr, "kernel_launch: occupancy query reports %d workgroups per CU; nothing launched\n", per_cu); (void)hipGetLastError(); grid = -1; return; }
        grid = cus;
    }
    if (grid < 0) return;
    if (hipMemsetAsync((char*)d_ws + WS_CTL, 0, CTL_ZERO_BYTES, stream) != hipSuccess) { fprintf(stderr, "kernel_launch: hipMemsetAsync failed\n"); return; }
    Args a{};
    for (int i = 0; i < N_INPUTS; ++i) a.in[i] = (const float*)d_in[i];
    a.out = (float*)d_out; a.ws = (unsigned char*)d_ws;
    for (int li = 0; li < N_LAUNCHES; ++li) {
        a.ph_lo = (N_LAUNCHES == 1) ? 0 : li; a.ph_hi = (N_LAUNCHES == 1) ? N_PHASES : li + 1;
        hipLaunchKernelGGL(mk_fwd, dim3(grid), dim3(NTHREADS), LDS_BYTES, stream, a);
        const hipError_t le = hipPeekAtLastError();
        if (le != hipSuccess) { fprintf(stderr, "kernel_launch: launch %d failed: %s\n", li, hipGetErrorName(le)); break; }
    }
}
```

```cpp
#include <hip/hip_runtime.h>
#include <cstdio>
#include <cstdint>
namespace pg8 {
#define PG8_LAS __attribute__((address_space(3)))
typedef unsigned short bf16_t;
typedef short bf16x8 __attribute__((ext_vector_type(8)));
typedef float f32x4 __attribute__((ext_vector_type(4)));
typedef unsigned u32x4 __attribute__((ext_vector_type(4)));
constexpr int BM = 256, BK = 64, HALF = 128, HTB = HALF * BK * 2  , STAGE_BYTES = 8 * HTB, NXCD = 8, WGM = 8;

__host__ __device__ __forceinline__ int lds_byte(int r, int c) { const int st = (r >> 4) * 2 + (c >> 5), rr = r & 15, cc = c & 31, ob = rr * 64 + cc * 2; return st * 1024 + (ob ^ (((ob >> 9) & 1) << 5)); }
__host__ __device__ __forceinline__ void stage_rc(int b, int& R, int& C) { const int st = b / 1024, sb = b % 1024, swz = sb ^ (((sb >> 9) & 1) << 5); R = (st >> 1) * 16 + swz / 64; C = (st & 1) * 32 + (swz % 64) / 2; }
__host__ __device__ __forceinline__ int perm32(int rho) { const int n = rho >> 4, i = rho & 15; return 8 * (i >> 2) + 4 * n + (i & 3); }

struct Unit { int pm, pn; };
struct Gemm { const bf16_t* A; const bf16_t* Bt; int M, N, K; };

struct StaticOrder {
    int nM, nN, nwg, G, c;
    __host__ __device__ void init(int M, int N, int G_, int c_) { nM = M / BM; nN = N / BM; nwg = nM * nN; G = G_; c = c_; }
    __host__ __device__ bool next(int i, Unit& u) const {
        const long L = (long)i * G + c; if (L >= nwg) return false;
        int wgid = (int)L; { const int q = nwg / NXCD, r = nwg % NXCD, xcd = wgid % NXCD, off = wgid / NXCD; wgid = (xcd < r ? xcd * (q + 1) : r * (q + 1) + (xcd - r) * q) + off; }
        const int nig = WGM * nN, gid = wgid / nig, fm = gid * WGM, gsz = (nM - fm) < WGM ? (nM - fm) : WGM;
        u.pm = fm + ((wgid % nig) % gsz); u.pn = (wgid % nig) / gsz; return true;
    }
    __device__ __forceinline__ void a_ready(const Unit&) const {}
    __device__ __forceinline__ void done(const Unit&) const {}
};
__device__ __forceinline__ unsigned cvt_pk_bf16(float lo, float hi) { unsigned r; asm volatile("v_cvt_pk_bf16_f32 %0, %1, %2" : "=v"(r) : "v"(lo), "v"(hi)); return r; }
template <class Epi, class Sched, bool ALIGN_EPI = false, bool SP2 = false>
__device__ __forceinline__ void gemm_phase(PG8_LAS unsigned char* lds, const Gemm g, const Sched& S, const Epi& E, const int tid_in) {
    const int tid = tid_in, wid = __builtin_amdgcn_readfirstlane(tid >> 6), lane = tid & 63, wr = wid >> 2, wc = wid & 3, fr = lane & 15, fq = lane >> 4;
    const int K = g.K, nt = K / BK;
    unsigned voffA[2], voffB[2];
#pragma unroll
    for (int i = 0; i < 2; ++i) { int R, C; stage_rc(tid * 16 + i * 8192, R, C); const int Rb = Epi::PERM ? ((R & ~31) + perm32(R & 31)) : R;
        voffA[i] = (unsigned)(R * K + C) * 2u; voffB[i] = (unsigned)(Rb * K + C) * 2u; }
    const size_t kstep = (size_t)(BK * 2);
    const size_t hstep = (size_t)HALF * K * 2;
    const size_t tstep = 2 * hstep;
    const unsigned ldsw = (unsigned)wid * 1024u;
    const int aoff = lds_byte(wr * 64 + fr, fq * 8), boff = lds_byte(wc * 32 + fr, fq * 8);
#define PG8_SA(b, h) (((b) * 2 + (h)) * HTB)
#define PG8_SB(b, h) ((4 + (b) * 2 + (h)) * HTB)
#define PG8_STAGE(bufoff, gbase, voff) do { _Pragma("unroll") for (int _i = 0; _i < 2; ++_i) \
        __builtin_amdgcn_global_load_lds((const unsigned*)((const char*)(gbase) + (voff)[_i]), (PG8_LAS unsigned*)(lds + (bufoff) + ldsw + _i * 8192), 16, 0, 0); } while (0)
#define PG8_LDA(dst, b, h) do { _Pragma("unroll") for (int m = 0; m < 4; ++m) _Pragma("unroll") for (int k = 0; k < 2; ++k) dst[m][k] = *(const PG8_LAS bf16x8*)(lds + PG8_SA(b, h) + aoff + m * 2048 + k * 1024); } while (0)
#define PG8_LDB(dst, b, h) do { _Pragma("unroll") for (int n = 0; n < 2; ++n) _Pragma("unroll") for (int k = 0; k < 2; ++k) dst[n][k] = *(const PG8_LAS bf16x8*)(lds + PG8_SB(b, h) + boff + n * 2048 + k * 1024); } while (0)
#define PG8_MMA(ai, bj, At, Bt) do { __builtin_amdgcn_s_setprio(1); _Pragma("unroll") for (int m = 0; m < 4; ++m) _Pragma("unroll") for (int n = 0; n < 2; ++n) _Pragma("unroll") for (int k = 0; k < 2; ++k) \
        acc[ai][bj][m][n] = __builtin_amdgcn_mfma_f32_16x16x32_bf16(Bt[n][k], At[m][k], acc[ai][bj][m][n], 0, 0, 0); __builtin_amdgcn_s_setprio(0); } while (0)
#define PG8_WAIT_V(n) asm volatile("s_waitcnt vmcnt(" #n ")" ::: "memory")
#define PG8_WAIT_L(n) asm volatile("s_waitcnt lgkmcnt(" #n ")" ::: "memory")
#define PG8_BAR __builtin_amdgcn_s_barrier()
#define PG8_SCHED __builtin_amdgcn_sched_barrier(0)
    Unit cur, nxt; int ui = 0;
    if (!S.next(0, cur)) return;
    f32x4 acc[2][2][4][2];
#pragma unroll
    for (int a = 0; a < 2; ++a)
#pragma unroll
        for (int b = 0; b < 2; ++b)
#pragma unroll
            for (int m = 0; m < 4; ++m)
#pragma unroll
                for (int n = 0; n < 2; ++n) acc[a][b][m][n] = (f32x4){0.f, 0.f, 0.f, 0.f};
    bf16x8 At[4][2], B0[2][2], B1[2][2];
    const char* cA = (const char*)g.A + (size_t)cur.pm * tstep; const char* cB = (const char*)g.Bt + (size_t)cur.pn * tstep;
    S.a_ready(cur);
    if constexpr (SP2) {
        PG8_STAGE(PG8_SB(0, 0), cB, voffB); PG8_STAGE(PG8_SB(0, 1), cB + hstep, voffB); PG8_STAGE(PG8_SA(0, 0), cA, voffA); PG8_STAGE(PG8_SA(0, 1), cA + hstep, voffA);
        if (wr == 1) PG8_BAR;
        PG8_WAIT_V(2); PG8_BAR;
        PG8_STAGE(PG8_SB(1, 0), cB + kstep, voffB); PG8_STAGE(PG8_SA(1, 0), cA + kstep, voffA); PG8_STAGE(PG8_SB(1, 1), cB + hstep + kstep, voffB);
        PG8_WAIT_V(6); PG8_BAR;
    } else {
        PG8_STAGE(PG8_SB(0, 0), cB, voffB); PG8_STAGE(PG8_SA(0, 0), cA, voffA); PG8_STAGE(PG8_SB(0, 1), cB + hstep, voffB); PG8_STAGE(PG8_SA(0, 1), cA + hstep, voffA);
        if (wr == 1) PG8_BAR;
        PG8_WAIT_V(4); PG8_BAR;
        PG8_STAGE(PG8_SB(1, 0), cB + kstep, voffB); PG8_STAGE(PG8_SA(1, 0), cA + kstep, voffA); PG8_STAGE(PG8_SB(1, 1), cB + hstep + kstep, voffB);
        PG8_WAIT_V(6); PG8_BAR;
    }
    for (;;) {
        const bool has_next = S.next(ui + 1, nxt);
        const char* nA = has_next ? (const char*)g.A + (size_t)nxt.pm * tstep : cA; const char* nB = has_next ? (const char*)g.Bt + (size_t)nxt.pn * tstep : cB;
        for (int t = 0; t < nt; t += 2) {
            const bool last = (t == nt - 2);
            const char* a1 = cA + (size_t)(t + 1) * kstep;
            const char* a2 = last ? nA : cA + (size_t)(t + 2) * kstep; const char* b2 = last ? nB : cB + (size_t)(t + 2) * kstep;
            const char* a3 = a2 + kstep; const char* b3 = b2 + kstep;
            if (last && has_next) S.a_ready(nxt);
            if constexpr (SP2) {
            PG8_LDB(B0, 0, 0); PG8_LDB(B1, 0, 1); PG8_SCHED; PG8_LDA(At, 0, 0); PG8_STAGE(PG8_SA(1, 1), a1 + hstep, voffA);
            PG8_WAIT_V(8); PG8_WAIT_L(0); PG8_BAR; PG8_MMA(0, 0, At, B0); PG8_MMA(0, 1, At, B1); PG8_BAR; PG8_SCHED;
            PG8_LDA(At, 0, 1); PG8_STAGE(PG8_SB(0, 0), b2, voffB); PG8_STAGE(PG8_SB(0, 1), b2 + hstep, voffB); PG8_STAGE(PG8_SA(0, 0), a2, voffA);
            PG8_WAIT_V(8); PG8_WAIT_L(0); PG8_BAR; PG8_MMA(1, 0, At, B0); PG8_MMA(1, 1, At, B1); PG8_BAR; PG8_SCHED;
            PG8_LDB(B0, 1, 0); PG8_LDB(B1, 1, 1); PG8_SCHED; PG8_LDA(At, 1, 0); PG8_STAGE(PG8_SA(0, 1), a2 + hstep, voffA);
            PG8_WAIT_V(8); PG8_WAIT_L(0); PG8_BAR; PG8_MMA(0, 0, At, B0); PG8_MMA(0, 1, At, B1); PG8_BAR; PG8_SCHED;
            PG8_LDA(At, 1, 1); PG8_STAGE(PG8_SB(1, 0), b3, voffB); PG8_STAGE(PG8_SB(1, 1), b3 + hstep, voffB); PG8_STAGE(PG8_SA(1, 0), a3, voffA);
            PG8_WAIT_V(8); PG8_WAIT_L(0); PG8_BAR; PG8_MMA(1, 0, At, B0); PG8_MMA(1, 1, At, B1); PG8_BAR; PG8_SCHED;
            } else {
            PG8_LDB(B0, 0, 0); PG8_SCHED; PG8_LDA(At, 0, 0); PG8_STAGE(PG8_SA(1, 1), a1 + hstep, voffA);
            PG8_WAIT_L(8); PG8_BAR; PG8_WAIT_L(0); PG8_MMA(0, 0, At, B0); PG8_BAR; PG8_SCHED;
            PG8_LDB(B1, 0, 1); PG8_STAGE(PG8_SB(0, 0), b2, voffB);
            PG8_BAR; PG8_WAIT_L(0); PG8_MMA(0, 1, At, B1); PG8_BAR;
            PG8_LDA(At, 0, 1); PG8_STAGE(PG8_SA(0, 0), a2, voffA);
            PG8_BAR; PG8_WAIT_L(0); PG8_MMA(1, 0, At, B0); PG8_BAR; PG8_SCHED;
            PG8_STAGE(PG8_SB(0, 1), b2 + hstep, voffB);
            PG8_WAIT_V(6); PG8_BAR; PG8_MMA(1, 1, At, B1); PG8_BAR;
            PG8_LDB(B0, 1, 0); PG8_SCHED; PG8_LDA(At, 1, 0); PG8_STAGE(PG8_SA(0, 1), a2 + hstep, voffA);
            PG8_WAIT_L(8); PG8_BAR; PG8_WAIT_L(0); PG8_MMA(0, 0, At, B0); PG8_BAR; PG8_SCHED;
            PG8_LDB(B1, 1, 1); PG8_STAGE(PG8_SB(1, 0), b3, voffB);
            PG8_BAR; PG8_WAIT_L(0); PG8_MMA(0, 1, At, B1); PG8_BAR;
            PG8_LDA(At, 1, 1); PG8_STAGE(PG8_SA(1, 0), a3, voffA);
            PG8_BAR; PG8_WAIT_L(0); PG8_MMA(1, 0, At, B0); PG8_BAR; PG8_SCHED;
            PG8_STAGE(PG8_SB(1, 1), b3 + hstep, voffB);
            PG8_WAIT_V(6); PG8_BAR; PG8_MMA(1, 1, At, B1); PG8_BAR;
            }
        }
        if constexpr (ALIGN_EPI) { if (wr == 0) PG8_BAR; }
        if constexpr (!Epi::AFTER_DRAIN) { E(acc, cur, wr, wc, fr, fq); S.done(cur); }
        if (!has_next) break;
#pragma unroll
        for (int a = 0; a < 2; ++a)
#pragma unroll
            for (int b = 0; b < 2; ++b)
#pragma unroll
                for (int m = 0; m < 4; ++m)
#pragma unroll
                    for (int n = 0; n < 2; ++n) acc[a][b][m][n] = (f32x4){0.f, 0.f, 0.f, 0.f};
        cur = nxt; cA = nA; cB = nB; ++ui;
        if constexpr (ALIGN_EPI) { if (wr == 1) PG8_BAR; }
    }
    PG8_WAIT_V(0);
    if constexpr (!ALIGN_EPI) { if (wr == 0) PG8_BAR; }
    PG8_BAR;
    if constexpr (Epi::AFTER_DRAIN) { E.fused(acc, cur, wr, wc, fr, fq, lds, wid, lane); S.done(cur); }
#undef PG8_SA
#undef PG8_SB
#undef PG8_STAGE
#undef PG8_LDA
#undef PG8_LDB
#undef PG8_MMA
#undef PG8_WAIT_V
#undef PG8_WAIT_L
#undef PG8_BAR
#undef PG8_SCHED
}
}

#ifndef PG8_SP2
#define PG8_SP2 true
#endif
#ifndef PG8_ALIGN
#define PG8_ALIGN true
#endif
namespace pg8 {
constexpr float RMS_EPS = 1e-6f;
__device__ __forceinline__ float silu_f(float x) { return x * __builtin_amdgcn_rcpf(1.0f + __expf(-x)); }
typedef float f32x2n __attribute__((ext_vector_type(2)));
typedef __bf16 bf16x2n __attribute__((ext_vector_type(2)));
__device__ __forceinline__ unsigned cvt2_bf16(float lo, float hi) { const f32x2n v = {lo, hi}; return __builtin_bit_cast(unsigned, __builtin_convertvector(v, bf16x2n)); }

struct EpiSwiGLU {
    static constexpr bool PERM = true, AFTER_DRAIN = false;
    bf16_t* H; int ldh; const float* rowss; bool dry;
    __device__ __forceinline__ void operator()(const f32x4 (&acc)[2][2][4][2], const Unit& u, int wr, int wc, int fr, int fq) const {
        if (dry) { asm volatile("" :: "v"(acc[0][0][0][0]), "v"(acc[1][1][3][1])); return; }
        const int row0 = u.pm * BM + wr * 64 + fr, col0 = u.pn * HALF + wc * 32 + 8 * fq;
        float rs[2][4];
#pragma unroll
        for (int ai = 0; ai < 2; ++ai)
#pragma unroll
            for (int m = 0; m < 4; ++m) rs[ai][m] = rowss[row0 + ai * HALF + m * 16];
#pragma unroll
        for (int ai = 0; ai < 2; ++ai)
#pragma unroll
            for (int m = 0; m < 4; ++m) {
                const int row = row0 + ai * HALF + m * 16;
                const float ms = rs[ai][m] * (1.0f / 1024.0f) + RMS_EPS, c1 = -1.4426950408889634f * rsqrtf(ms);
                const f32x4 g0 = acc[ai][0][m][0], g1 = acc[ai][0][m][1], u0 = acc[ai][1][m][0], u1 = acc[ai][1][m][1];
                const f32x4 t0 = g0 * c1, t1 = g1 * c1; f32x4 e0, e1, i0, i1;
#pragma unroll
                for (int e = 0; e < 4; ++e) { e0[e] = __builtin_amdgcn_exp2f(t0[e]); e1[e] = __builtin_amdgcn_exp2f(t1[e]); }
                const f32x4 d0 = e0 * ms + ms, d1 = e1 * ms + ms;
#pragma unroll
                for (int e = 0; e < 4; ++e) { i0[e] = __builtin_amdgcn_rcpf(d0[e]); i1[e] = __builtin_amdgcn_rcpf(d1[e]); }
                const f32x4 h0 = (g0 * u0) * i0, h1 = (g1 * u1) * i1;
                u32x4 w; w.x = cvt2_bf16(h0[0], h0[1]); w.y = cvt2_bf16(h0[2], h0[3]); w.z = cvt2_bf16(h1[0], h1[1]); w.w = cvt2_bf16(h1[2], h1[3]);
                *(u32x4*)(H + (size_t)row * ldh + col0) = w;
            }
    }
};
struct EpiResid {
    static constexpr bool PERM = true, AFTER_DRAIN = false;
    bf16_t* xb; float* rowss; float scale; bool fin;
    __device__ __forceinline__ void operator()(const f32x4 (&acc)[2][2][4][2], const Unit& u, int wr, int wc, int fr, int fq) const {
        const int row0 = u.pm * BM + wr * 64 + fr, col0 = u.pn * BM + wc * 32 + 8 * fq;
        u32x4 xv[2][4][2];
#pragma unroll
        for (int ai = 0; ai < 2; ++ai)
#pragma unroll
            for (int m = 0; m < 4; ++m)
#pragma unroll
                for (int bj = 0; bj < 2; ++bj) xv[ai][m][bj] = *(const u32x4*)(xb + (size_t)(row0 + ai * HALF + m * 16) * 1024 + col0 + bj * HALF);
        float ssv[2][4];
#pragma unroll
        for (int ai = 0; ai < 2; ++ai)
#pragma unroll
            for (int m = 0; m < 4; ++m) {
                const int row = row0 + ai * HALF + m * 16;
                float ss = 0.f;
#pragma unroll
                for (int bj = 0; bj < 2; ++bj) {
                    const u32x4 xo = xv[ai][m][bj]; u32x4 w;
#pragma unroll
                    for (int k = 0; k < 4; ++k) {
                        const float a0 = __uint_as_float(xo[k] << 16) + acc[ai][bj][m][k >> 1][(k & 1) * 2] * scale, a1 = __uint_as_float(xo[k] & 0xffff0000u) + acc[ai][bj][m][k >> 1][(k & 1) * 2 + 1] * scale;
                        const unsigned p = cvt_pk_bf16(a0, a1); w[k] = p;
                        const float r0 = __uint_as_float(p << 16), r1 = __uint_as_float(p & 0xffff0000u); ss += r0 * r0 + r1 * r1;
                    }
                    *(u32x4*)(xb + (size_t)row * 1024 + col0 + bj * HALF) = w;
                }
                ssv[ai][m] = ss;
            }
#pragma unroll
        for (int ai = 0; ai < 2; ++ai)
#pragma unroll
            for (int m = 0; m < 4; ++m) ssv[ai][m] += __shfl_xor(ssv[ai][m], 16);
#pragma unroll
        for (int ai = 0; ai < 2; ++ai)
#pragma unroll
            for (int m = 0; m < 4; ++m) ssv[ai][m] += __shfl_xor(ssv[ai][m], 32);
        if (fq == 0 && fin) {
#pragma unroll
            for (int ai = 0; ai < 2; ++ai)
#pragma unroll
                for (int m = 0; m < 4; ++m) unsafeAtomicAdd(rowss + row0 + ai * HALF + m * 16, ssv[ai][m]);
        }
    }
};
struct EpiProj {
    static constexpr bool PERM = true, AFTER_DRAIN = false;
    bf16_t* P; int ldp; const float* rowss;
    __device__ __forceinline__ void operator()(const f32x4 (&acc)[2][2][4][2], const Unit& u, int wr, int wc, int fr, int fq) const {
        const int row0 = u.pm * BM + wr * 64 + fr, col0 = u.pn * BM + wc * 32 + 8 * fq;
        const bool act = (u.pn == 3) || (u.pn == 4) || (u.pn == 7) || (u.pn == 8);
        float rs[2][4];
#pragma unroll
        for (int ai = 0; ai < 2; ++ai)
#pragma unroll
            for (int m = 0; m < 4; ++m) rs[ai][m] = rowss[row0 + ai * HALF + m * 16];
#pragma unroll
        for (int ai = 0; ai < 2; ++ai)
#pragma unroll
            for (int m = 0; m < 4; ++m) {
                const int row = row0 + ai * HALF + m * 16;
                const float r = rsqrtf(rs[ai][m] * (1.0f / 1024.0f) + RMS_EPS);
#pragma unroll
                for (int bj = 0; bj < 2; ++bj) {
                    f32x4 a = acc[ai][bj][m][0] * r, b = acc[ai][bj][m][1] * r;
                    if (act) {
#pragma unroll
                        for (int e = 0; e < 4; ++e) { a[e] = silu_f(a[e]); b[e] = silu_f(b[e]); }
                    }
                    u32x4 w; w.x = cvt_pk_bf16(a[0], a[1]); w.y = cvt_pk_bf16(a[2], a[3]); w.z = cvt_pk_bf16(b[0], b[1]); w.w = cvt_pk_bf16(b[2], b[3]);
                    *(u32x4*)(P + (size_t)row * ldp + col0 + bj * HALF) = w;
                }
            }
    }
};
}

constexpr int NWAVES = 8, NTHREADS = 512;
#ifndef MK_N_LAUNCHES
#define MK_N_LAUNCHES 1
#endif
constexpr int N_PHASES = 18;
constexpr int N_LAUNCHES = MK_N_LAUNCHES;

constexpr int D = 1024, FF = 2816, NGU = 2 * FF, NIN = 3092, NINP = 3328, DEPTH = 2;
constexpr int BP = 8, TP = 2048, BS = 128, TS = 8, PAST_LEN = 16384;
constexpr int MP = BP * TP, MS = BS * TS, M = MP + MS;
static_assert(M % 256 == 0 && NGU % 256 == 0 && NINP % 256 == 0 && FF % 128 == 0, "GEMM tiling");
static_assert(DEPTH == 2, "the HGRN2 lower bounds (cumulative softmax over layers minus its first term) are written out for two layers: 0 and softmax(logits)[1] = sigmoid(l1 - l0)");
constexpr int PC_PX = 0, PC_GQ = 256, PC_GK = 384, PC_GV = 512, PC_GR = 768, PC_RQ = 1024, PC_RF = 1280, PC_RI = 1536, PC_RG = 1792, PC_SZ = 2048, PC_XBC = 2304, PC_LR = 3072, PC_DT = 3088;
constexpr int MC_POOL = 0, MC_GLA = 256, MC_HGRN = 512, MC_SSM = 768;
enum { I_XP = 0, I_XS, I_SPOOL, I_SGLA, I_SHGRN, I_SSSM, I_SCONV, I_F1N, I_F1G, I_F1U, I_F1D, I_MIXN, I_WIN, I_POOLW, I_POOLS, I_GLAWG, I_GLAB, I_GLAN,
       I_LBL, I_HGN, I_CONVW, I_CONVB, I_DTB, I_ALOG, I_SSMD, I_SSMN, I_WOUT, I_F2N, I_F2G, I_F2U, I_F2D, I_FINALN, N_INPUTS };
constexpr size_t O_YP = 0, O_YS = O_YP + (size_t)MP * D, O_POOLP = O_YS + (size_t)MS * D, O_POOLS = O_POOLP + (size_t)DEPTH * BP * 15 * 256,
    O_GLAP = O_POOLS + (size_t)DEPTH * BS * 15 * 256, O_GLAS = O_GLAP + (size_t)DEPTH * BP * 4 * 32 * 64, O_HGP = O_GLAS + (size_t)DEPTH * BS * 4 * 32 * 64,
    O_HGS = O_HGP + (size_t)DEPTH * BP * 4 * 64 * 64, O_SSMP = O_HGS + (size_t)DEPTH * BS * 4 * 64 * 64, O_SSMS = O_SSMP + (size_t)DEPTH * BP * 4 * 64 * 128,
    O_CONVP = O_SSMS + (size_t)DEPTH * BS * 4 * 64 * 128, O_CONVS = O_CONVP + (size_t)DEPTH * BP * 3 * 768, O_END = O_CONVS + (size_t)DEPTH * BS * 3 * 768;
static_assert(O_END == 35094528, "output size");

constexpr size_t KiB = 1024, MiB = 1u << 20;
constexpr size_t WS_CTL = 0, CTL_ZERO_BYTES = 1 * MiB;
constexpr size_t WS_RSS = 512 * KiB;
static_assert(WS_RSS + 7 * (size_t)M * 4 <= CTL_ZERO_BYTES, "rowss inside the memset region");
constexpr size_t WS_W = 1 * MiB, W_LAYER = 41 * MiB + 512 * KiB;
constexpr size_t WO_GU1 = 0, WO_D1 = 11 * MiB, WO_IN = 16 * MiB + 512 * KiB, WO_OUT = 23 * MiB, WO_GU2 = 25 * MiB, WO_D2 = 36 * MiB;
static_assert((size_t)NGU * D * 2 == 11 * MiB && (size_t)D * FF * 2 == 5 * MiB + 512 * KiB && (size_t)NINP * D * 2 == 6 * MiB + 512 * KiB && WO_D2 + 5 * MiB + 512 * KiB == W_LAYER, "weight map");
constexpr size_t WS_XB = WS_W + 2 * W_LAYER;
constexpr size_t WS_MIX = WS_XB + 34 * MiB;
constexpr size_t WS_HP = WS_MIX + 34 * MiB;
constexpr size_t WS_END = WS_HP + (size_t)M * NINP * 2;
static_assert((size_t)M * D * 2 == 34 * MiB && WS_END == 262 * MiB + 512 * KiB, "d_ws map");
constexpr int CW_BAR = 4096;
constexpr int CW_SUB = 8192;
constexpr int RING_OFF = 0, RING_BYTES = 131072;
constexpr int LDSCTL_OFF = RING_BYTES, MISC_OFF = LDSCTL_OFF + 320;
constexpr int LDS_BYTES = 147456;

#define GAS __attribute__((address_space(1)))
#define LAS __attribute__((address_space(3)))
typedef unsigned short bf16;
typedef unsigned v4u __attribute__((ext_vector_type(4)));
typedef unsigned v2u __attribute__((ext_vector_type(2)));
typedef float f32x4 __attribute__((ext_vector_type(4)));
typedef GAS unsigned gu32;
#define RLX_AGENT __ATOMIC_RELAXED, __HIP_MEMORY_SCOPE_AGENT
#define LDS_WAIT() asm volatile("s_waitcnt lgkmcnt(0)" ::: "memory")
#define VM_WAIT() asm volatile("s_waitcnt vmcnt(0)" ::: "memory")
__device__ __forceinline__ unsigned f2bf(float f) { unsigned u = __builtin_bit_cast(unsigned, f); return (u + 0x7fffu + ((u >> 16) & 1u)) >> 16; }
__device__ __forceinline__ unsigned pk2(float lo, float hi) { return f2bf(lo) | (f2bf(hi) << 16); }
__device__ __forceinline__ float bf2f(bf16 b) { return __builtin_bit_cast(float, (unsigned)b << 16); }
__device__ __forceinline__ float sigmoid_f(float x) { return __builtin_amdgcn_rcpf(1.0f + __expf(-x)); }
__device__ __forceinline__ float silu_f(float x) { return x * __builtin_amdgcn_rcpf(1.0f + __expf(-x)); }
__device__ __forceinline__ float lse0_f(float x) { return 0.6931471805599453f * __builtin_amdgcn_logf(1.0f + __builtin_amdgcn_exp2f(-1.4426950408889634f * fabsf(x))); }
__device__ __forceinline__ float softplus_f(float x) { return fmaxf(x, 0.f) + lse0_f(x); }
__device__ __forceinline__ float logsigmoid_f(float x) { return fminf(x, 0.f) - lse0_f(x); }
typedef float f32x2v __attribute__((ext_vector_type(2)));
typedef __bf16 bf16x2v __attribute__((ext_vector_type(2)));
__device__ __forceinline__ unsigned cvtpk(float lo, float hi) { const f32x2v v = {lo, hi}; return __builtin_bit_cast(unsigned, __builtin_convertvector(v, bf16x2v)); }
#define XB_TMO      128
#define XB_XCNT(j)  (256  + 64 * (j))
#define XB_XSUB(j)  (1280 + 64 * (j))
#define XB_XGEN(j)  (2304 + 64 * (j))
#define XB_TOP      3328
#define XB_TOPGEN   3392
#define XCD_BAR_WORDS 3456
#define XB_SPIN_CAP (1u << 18)

__device__ __forceinline__ unsigned xb_ld(unsigned* p)              { return __hip_atomic_load(p, __ATOMIC_RELAXED, __HIP_MEMORY_SCOPE_AGENT); }
__device__ __forceinline__ unsigned xb_add(unsigned* p, unsigned v) { return __hip_atomic_fetch_add(p, v, __ATOMIC_RELAXED, __HIP_MEMORY_SCOPE_AGENT); }
__device__ __forceinline__ unsigned xb_xcc_id() { return (unsigned)__builtin_amdgcn_s_getreg((3 << 11) | 20) & 0xFu; }
#define XB_SPIN(cond, bar) do { unsigned _sp = 0; while (cond) { __builtin_amdgcn_s_sleep(1); \
    if ((++_sp & 255u) == 0u) { if (xb_ld(&(bar)[XB_TMO])) break; if (_sp > XB_SPIN_CAP) { atomicAdd(&(bar)[XB_TMO], 1u); break; } } } } while (0)

struct XcdBarrier {
    unsigned* bar; unsigned x;
    volatile LAS unsigned* st;
};

__device__ __forceinline__ XcdBarrier xcd_barrier_post(unsigned* bar, volatile LAS unsigned* st) {
    XcdBarrier b; b.bar = bar; b.x = xb_xcc_id(); b.st = st;
    if (threadIdx.x == 0) (void)xb_add(&bar[XB_XCNT(b.x)], 1u);
    return b;
}
__device__ __forceinline__ void xcd_barrier_complete(unsigned* bar, unsigned x, unsigned& nloc, unsigned& nx) {
    const unsigned G = gridDim.x * gridDim.y * gridDim.z;
    unsigned sum, cnt, mine, sp = 0u;
    for (;;) {
        sum = 0u; cnt = 0u; mine = 0u;
#pragma unroll
        for (unsigned j = 0; j < 16; ++j) { const unsigned c = xb_ld(&bar[XB_XCNT(j)]); sum += c; cnt += (c > 0u) ? 1u : 0u; mine = (j == x) ? c : mine; }
        if (sum == G) break;
        __builtin_amdgcn_s_sleep(1);
        if ((++sp & 255u) == 0u) { if (xb_ld(&bar[XB_TMO])) break; if (sp > XB_SPIN_CAP) { atomicAdd(&bar[XB_TMO], 1u); break; } }
    }
    nloc = mine > 0u ? mine : 1u; nx = cnt > 0u ? cnt : 1u;
}

__device__ __forceinline__ void xcd_barrier(const XcdBarrier& b) {
    asm volatile("s_waitcnt vmcnt(0)" ::: "memory");
    __syncthreads();
    if (threadIdx.x == 0) {
        unsigned* bar = b.bar;
        __builtin_amdgcn_s_waitcnt(0);
        unsigned nloc = b.st[0], nx = b.st[1];
        if (nloc == 0u) { xcd_barrier_complete(bar, b.x, nloc, nx); b.st[0] = nloc; b.st[1] = nx; }
        const unsigned old = xb_add(&bar[XB_XSUB(b.x)], 1u);
        const unsigned gen = old / nloc;
        if (old + 1u == (gen + 1u) * nloc) {
            __builtin_amdgcn_fence(__ATOMIC_RELEASE, "agent");
            asm volatile("s_waitcnt vmcnt(0)" ::: "memory");
            const unsigned og = xb_add(&bar[XB_TOP], 1u);
            const unsigned tg = og / nx;
            if (og + 1u == (tg + 1u) * nx) xb_add(&bar[XB_TOPGEN], 1u);
            else XB_SPIN(xb_ld(&bar[XB_TOPGEN]) == tg, bar);
            __builtin_amdgcn_fence(__ATOMIC_ACQUIRE, "agent");
            xb_add(&bar[XB_XGEN(b.x)], 1u);
            asm volatile("s_waitcnt vmcnt(0)" ::: "memory");
        } else {
            XB_SPIN(xb_ld(&bar[XB_XGEN(b.x)]) == gen, bar);
            __builtin_amdgcn_fence(__ATOMIC_ACQUIRE, "agent");
            asm volatile("s_waitcnt vmcnt(0)" ::: "memory");
        }
    }
    __syncthreads();
}

struct Args { const float* in[N_INPUTS]; float* out; unsigned char* ws; int ph_lo, ph_hi; };
static_assert(sizeof(Args) == 34 * 8 + 8, "Args has no holes");

__device__ __forceinline__ float wave_sum(float v) {
#pragma unroll
    for (int o = 1; o < 64; o <<= 1) v += __shfl_xor(v, o);
    return v;
}

template <int KIND>
__device__ __forceinline__ void p0_item(const float* W0, const float* W1, int K, int Nsrc, const float* gain, bf16* WT, LAS float* scr, int item, int nblk, int lane) {
    const int kb = item / nblk, nb = item % nblk, k0 = 64 * kb, n0 = 32 * nb;
    if (KIND == 2 && n0 >= 3072) {
        const int np = n0 + (lane & 31);
        int col = 0; bool valid = true;
        if (np < 3088) col = 1024 + (np - 3072); else if (np < NIN) col = np; else valid = false;
        float vv[32];
#pragma unroll
        for (int i = 0; i < 32; ++i) vv[i] = W0[(size_t)(k0 + 2 * i + (lane >> 5)) * Nsrc + col];
#pragma unroll
        for (int i = 0; i < 32; ++i) { const int kk = 2 * i + (lane >> 5); float v = valid ? vv[i] : 0.f; if (gain) v *= gain[k0 + kk]; scr[kk * 33 + (lane & 31)] = v; }
    } else {
        const float* W = W0; int col0 = n0;
        if (KIND == 0) { const int pn = n0 >> 8, bj = (n0 >> 7) & 1, jj = n0 & 127; W = bj ? W1 : W0; col0 = pn * 128 + jj; }
        if (KIND == 2) col0 = (n0 < 1024) ? n0 : n0 + 16;
        const int kr = lane >> 3, nq = lane & 7;
        f32x4 vv[8]; float gv[8];
#pragma unroll
        for (int i = 0; i < 8; ++i) vv[i] = *(const f32x4*)(W + (size_t)(k0 + 8 * i + kr) * Nsrc + col0 + 4 * nq);
#pragma unroll
        for (int i = 0; i < 8; ++i) gv[i] = gain ? gain[k0 + 8 * i + kr] : 1.0f;
#pragma unroll
        for (int i = 0; i < 8; ++i) { LAS float* sp = scr + (8 * i + kr) * 33 + 4 * nq; const f32x4 v = vv[i] * gv[i]; sp[0] = v[0]; sp[1] = v[1]; sp[2] = v[2]; sp[3] = v[3]; }
    }
    LDS_WAIT(); asm volatile("" ::: "memory");
    const int c = lane & 7;
#pragma unroll
    for (int j = 0; j < 4; ++j) { const int n = (lane >> 3) + 8 * j; const LAS float* s = scr + (8 * c) * 33 + n;
        v4u o; o.x = cvtpk(s[0 * 33], s[1 * 33]); o.y = cvtpk(s[2 * 33], s[3 * 33]); o.z = cvtpk(s[4 * 33], s[5 * 33]); o.w = cvtpk(s[6 * 33], s[7 * 33]);
        *(v4u*)(WT + (size_t)(n0 + n) * K + k0 + 8 * c) = o; }
    LDS_WAIT(); asm volatile("" ::: "memory");
}
constexpr int IT_GU = (D / 64) * (NGU / 32), IT_D = (FF / 64) * (D / 32), IT_IN = (D / 64) * (NINP / 32), IT_OUT = (D / 64) * (D / 32);
constexpr int IT_LAYER = 2 * IT_GU + 2 * IT_D + IT_IN + IT_OUT;

struct CvtList { int a0, n0, a1, n1, a2, n2, a3, n3; };
constexpr int R_GU1 = 0, R_D1 = IT_GU, R_IN = R_D1 + IT_D, R_OUT = R_IN + IT_IN, R_GU2 = R_OUT + IT_OUT, R_D2 = R_GU2 + IT_GU, N_LATE = IT_LAYER - R_OUT;
static_assert(R_D2 + IT_D == IT_LAYER && IT_GU == 2816 && IT_D == 1408 && IT_IN == 1664 && N_LATE == 4736, "conversion item map");
constexpr int G1A = 352, G1B = 864, G1C = IT_GU - G1A - G1B;
#ifndef MK_CVT_ALL_EARLY
constexpr CvtList CV_P0 = {R_GU1, IT_GU, R_IN, IT_IN, IT_LAYER + R_IN, IT_IN, IT_LAYER + R_GU1, G1A};
constexpr CvtList CV_GU1_L0 = {R_D1, IT_D, 0, 0, 0, 0, 0, 0};
constexpr CvtList CV_IN_L0 = {R_OUT, N_LATE, IT_LAYER + R_GU1 + G1A, G1B, 0, 0, 0, 0};
constexpr CvtList CV_GU2_L0 = {IT_LAYER + R_GU1 + G1A + G1B, G1C, 0, 0, 0, 0, 0, 0};
constexpr CvtList CV_GU1_L1 = {IT_LAYER + R_D1, IT_D, 0, 0, 0, 0, 0, 0};
constexpr CvtList CV_IN_L1 = {IT_LAYER + R_OUT, N_LATE, 0, 0, 0, 0, 0, 0};
#else
constexpr CvtList CV_P0 = {0, DEPTH * IT_LAYER, 0, 0, 0, 0, 0, 0};
constexpr CvtList CV_GU1_L0 = {0, 0, 0, 0, 0, 0, 0, 0}, CV_IN_L0 = CV_GU1_L0, CV_GU2_L0 = CV_GU1_L0, CV_GU1_L1 = CV_GU1_L0, CV_IN_L1 = CV_GU1_L0;
#endif
static_assert(G1C == 1600 && CV_P0.n0 + CV_P0.n1 + CV_P0.n2 + CV_P0.n3 + CV_GU1_L0.n0 + CV_IN_L0.n0 + CV_IN_L0.n1 + CV_GU2_L0.n0 + CV_GU1_L1.n0 + CV_IN_L1.n0 == DEPTH * IT_LAYER, "every weight item is converted exactly once");
struct CvtItem { const float* W; const float* gain; bf16* WT; int K, Nsrc, col0, k0, n0; bool spec; };
__device__ __forceinline__ CvtItem cvt_decode(const Args& A, const int it) {
    CvtItem c; const int l = it / IT_LAYER; int r = it % IT_LAYER;
    unsigned char* wl = A.ws + WS_W + (size_t)l * W_LAYER;
    int kind, nblk; const float* W0; const float* W1 = nullptr; c.gain = nullptr;
    if (r < IT_GU) { kind = 0; W0 = A.in[I_F1G] + (size_t)l * D * FF; W1 = A.in[I_F1U] + (size_t)l * D * FF; c.K = D; c.Nsrc = FF; c.gain = A.in[I_F1N] + l * D; c.WT = (bf16*)(wl + WO_GU1); nblk = NGU / 32; }
    else if ((r -= IT_GU) < IT_D) { kind = 1; W0 = A.in[I_F1D] + (size_t)l * D * FF; c.K = FF; c.Nsrc = D; c.WT = (bf16*)(wl + WO_D1); nblk = D / 32; }
    else if ((r -= IT_D) < IT_IN) { kind = 2; W0 = A.in[I_WIN] + (size_t)l * D * NIN; c.K = D; c.Nsrc = NIN; c.gain = A.in[I_MIXN] + l * D; c.WT = (bf16*)(wl + WO_IN); nblk = NINP / 32; }
    else if ((r -= IT_IN) < IT_OUT) { kind = 1; W0 = A.in[I_WOUT] + (size_t)l * D * D; c.K = D; c.Nsrc = D; c.WT = (bf16*)(wl + WO_OUT); nblk = D / 32; }
    else if ((r -= IT_OUT) < IT_GU) { kind = 0; W0 = A.in[I_F2G] + (size_t)l * D * FF; W1 = A.in[I_F2U] + (size_t)l * D * FF; c.K = D; c.Nsrc = FF; c.gain = A.in[I_F2N] + l * D; c.WT = (bf16*)(wl + WO_GU2); nblk = NGU / 32; }
    else { r -= IT_GU; kind = 1; W0 = A.in[I_F2D] + (size_t)l * D * FF; c.K = FF; c.Nsrc = D; c.WT = (bf16*)(wl + WO_D2); nblk = D / 32; }
    const int kb = r / nblk, nb = r % nblk; c.k0 = 64 * kb; c.n0 = 32 * nb; c.spec = (kind == 2) && (c.n0 >= 3072);
    c.W = W0; c.col0 = c.n0;
    if (kind == 0) { const int pn = c.n0 >> 8, bj = (c.n0 >> 7) & 1, jj = c.n0 & 127; c.W = bj ? W1 : W0; c.col0 = pn * 128 + jj; }
    if (kind == 2) c.col0 = (c.n0 < 1024) ? c.n0 : c.n0 + 16;
    return c;
}
__device__ __forceinline__ void cvt_load(const CvtItem& c, const int lane, f32x4 (&vv)[8], float (&gv)[8]) {
    const int kr = lane >> 3, nq = lane & 7;
    if (!c.spec) {
#pragma unroll
        for (int i = 0; i < 8; ++i) vv[i] = *(const f32x4*)(c.W + (size_t)(c.k0 + 8 * i + kr) * c.Nsrc + c.col0 + 4 * nq);
#pragma unroll
        for (int i = 0; i < 8; ++i) gv[i] = c.gain ? c.gain[c.k0 + 8 * i + kr] : 1.0f;
    }
}
__device__ __forceinline__ void cvt_finish(const CvtItem& c, const int lane, LAS float* scr, const f32x4 (&vv)[8], const float (&gv)[8]) {
    if (c.spec) {
        const int np = c.n0 + (lane & 31);
        int col = 0; bool valid = true;
        if (np < 3088) col = 1024 + (np - 3072); else if (np < NIN) col = np; else valid = false;
        float ev[32];
#pragma unroll
        for (int i = 0; i < 32; ++i) ev[i] = c.W[(size_t)(c.k0 + 2 * i + (lane >> 5)) * c.Nsrc + col];
#pragma unroll
        for (int i = 0; i < 32; ++i) { const int kk = 2 * i + (lane >> 5); float v = valid ? ev[i] : 0.f; if (c.gain) v *= c.gain[c.k0 + kk]; scr[kk * 33 + (lane & 31)] = v; }
    } else {
        const int kr = lane >> 3, nq = lane & 7;
#pragma unroll
        for (int i = 0; i < 8; ++i) { LAS float* sp = scr + (8 * i + kr) * 33 + 4 * nq; const f32x4 v = vv[i] * gv[i]; sp[0] = v[0]; sp[1] = v[1]; sp[2] = v[2]; sp[3] = v[3]; }
    }
    LDS_WAIT(); asm volatile("" ::: "memory");
    const int cc = lane & 7;
#pragma unroll
    for (int j = 0; j < 4; ++j) { const int n = (lane >> 3) + 8 * j; const LAS float* sr = scr + (8 * cc) * 33 + n;
        v4u o; o.x = cvtpk(sr[0 * 33], sr[1 * 33]); o.y = cvtpk(sr[2 * 33], sr[3 * 33]); o.z = cvtpk(sr[4 * 33], sr[5 * 33]); o.w = cvtpk(sr[6 * 33], sr[7 * 33]);
        *(v4u*)(c.WT + (size_t)(c.n0 + n) * c.K + c.k0 + 8 * cc) = o; }
    LDS_WAIT(); asm volatile("" ::: "memory");
}
__device__ __forceinline__ void convert_weights(const Args& A, LAS unsigned char* ldsl, int wave, int lane, const CvtList Lst, int gw, int NGW) {
    LAS float* scr = (LAS float*)(ldsl + RING_OFF + wave * 16384);
    const int e0 = Lst.n0, e1 = e0 + Lst.n1, e2 = e1 + Lst.n2, e3 = e2 + Lst.n3;
#define CVT_MAP(vi) (((vi) < e0) ? Lst.a0 + (vi) : ((vi) < e1) ? Lst.a1 + ((vi) - e0) : ((vi) < e2) ? Lst.a2 + ((vi) - e1) : Lst.a3 + ((vi) - e2))
    int vi = gw;
    if (vi >= e3) return;
    CvtItem cur = cvt_decode(A, CVT_MAP(vi));
    f32x4 va[8]; float ga[8];
    cvt_load(cur, lane, va, ga);
    for (;;) {
        const int vn = vi + NGW; const bool more = vn < e3;
        CvtItem nxt = cur; f32x4 vb[8]; float gb[8];
#pragma unroll
        for (int i = 0; i < 8; ++i) { vb[i] = va[i]; gb[i] = ga[i]; }
        if (more) { nxt = cvt_decode(A, CVT_MAP(vn)); cvt_load(nxt, lane, vb, gb); }
        cvt_finish(cur, lane, scr, va, ga);
        if (!more) break;
        cur = nxt; vi = vn;
#pragma unroll
        for (int i = 0; i < 8; ++i) { va[i] = vb[i]; ga[i] = gb[i]; }
    }
#undef CVT_MAP
}
__device__ __forceinline__ void p0_prologue(const Args& A, LAS unsigned char* ldsl, int wave, int lane, int G) {
    const int gw = blockIdx.x * NWAVES + wave, NGW = G * NWAVES;
    unsigned char* ws = A.ws;
    convert_weights(A, ldsl, wave, lane, CV_P0, gw, NGW);
    bf16* xb = (bf16*)(ws + WS_XB); float* rss = (float*)(ws + WS_RSS);
    for (int m0 = gw; m0 < M; m0 += 2 * NGW) {
        const int m1 = m0 + NGW; const bool two = m1 < M; const int m1c = two ? m1 : m0;
        const float* s0 = (m0 < MP) ? A.in[I_XP] + (size_t)m0 * D : A.in[I_XS] + (size_t)(m0 - MP) * D;
        const float* s1 = (m1c < MP) ? A.in[I_XP] + (size_t)m1c * D : A.in[I_XS] + (size_t)(m1c - MP) * D;
        f32x4 v[2][4];
#pragma unroll
        for (int j = 0; j < 4; ++j) { v[0][j] = ((const f32x4*)s0 + lane)[64 * j]; v[1][j] = ((const f32x4*)s1 + lane)[64 * j]; }
#pragma unroll
        for (int h = 0; h < 2; ++h) {
            const int m = h ? m1c : m0;
            v2u* bo = (v2u*)(xb + (size_t)m * D) + lane; float s = 0.f;
#pragma unroll
            for (int j = 0; j < 4; ++j) { v2u w; w.x = cvtpk(v[h][j].x, v[h][j].y); w.y = cvtpk(v[h][j].z, v[h][j].w); if (h == 0 || two) bo[64 * j] = w;
                const float r0 = __builtin_bit_cast(float, w.x << 16), r1 = __builtin_bit_cast(float, w.x & 0xffff0000u), r2 = __builtin_bit_cast(float, w.y << 16), r3 = __builtin_bit_cast(float, w.y & 0xffff0000u);
                s += (r0 * r0 + r1 * r1) + (r2 * r2 + r3 * r3); }
            s = wave_sum(s);
            if (lane == 0 && (h == 0 || two)) rss[m] = s;
        }
    }
}

#ifndef MK_REP_S1
#define MK_REP_S1 1
#endif
#ifndef MK_REP_S3
#define MK_REP_S3 1
#endif
#ifndef MK_REP_S2SMP
#define MK_REP_S2SMP 1
#endif
struct MixP {
    const bf16* P; bf16* mixb; float* out; int l; float* DS; float* ESC; unsigned* subc;
    bf16* XC;
    const float *s_pool, *s_gla, *s_hgrn, *s_ssm, *s_conv;
    const float *pool_w, *pool_scale, *gla_wg, *gla_b, *gla_n, *lbl, *hg_n, *conv_w, *conv_b, *dt_b, *a_log, *ssm_d, *ssm_n;
};
typedef short bf16x8 __attribute__((ext_vector_type(8)));
constexpr int MIX_CONST_OFF = 113664;
#define MFMA16(a, b, c) __builtin_amdgcn_mfma_f32_16x16x32_bf16((a), (b), (c), 0, 0, 0)
template <int CTRL> __device__ __forceinline__ float dpp_shr1(float x) { return __builtin_bit_cast(float, __builtin_amdgcn_update_dpp(0x3f800000, __builtin_bit_cast(int, x), CTRL, 0xf, 0xf, false)); }
template <int CTRL, int ROWMASK> __device__ __forceinline__ float dpp_sel(float oldv, float x) { return __builtin_bit_cast(float, __builtin_amdgcn_update_dpp(__builtin_bit_cast(int, oldv), __builtin_bit_cast(int, x), CTRL, ROWMASK, 0xf, false)); }
__device__ __forceinline__ float dpp_bcast15(float oldv, float x) { return dpp_sel<0x142, 0xa>(oldv, x); }
__device__ __forceinline__ float quad_sum(float v) { v += dpp_sel<0xB1, 0xf>(0.f, v); v += dpp_sel<0x4E, 0xf>(0.f, v); return v; }
__device__ __forceinline__ float oct_sum(float v) { v = quad_sum(v); v += dpp_sel<0x141, 0xf>(0.f, v); return v; }
__device__ __forceinline__ bf16x8 frag16(const LAS unsigned char* p) { return *(const LAS bf16x8*)p; }
__device__ __forceinline__ bf16x8 frag8x2(const LAS unsigned char* p0, const LAS unsigned char* p1) { const v2u a = *(const LAS v2u*)p0, b = *(const LAS v2u*)p1; v4u w; w.x = a.x; w.y = a.y; w.z = b.x; w.w = b.y; return __builtin_bit_cast(bf16x8, w); }
__device__ __forceinline__ bf16x8 pack_frag(const f32x4 a, const f32x4 b) { v4u w; w.x = cvtpk(a[0], a[1]); w.y = cvtpk(a[2], a[3]); w.z = cvtpk(b[0], b[1]); w.w = cvtpk(b[2], b[3]); return __builtin_bit_cast(bf16x8, w); }
__device__ __forceinline__ float bfe(const v4u w, const int e) { const unsigned x = w[e >> 1]; return __builtin_bit_cast(float, (e & 1) ? (x & 0xffff0000u) : (x << 16)); }
__device__ __forceinline__ float bfe2(const v2u w, const int e) { const unsigned x = w[e >> 1]; return __builtin_bit_cast(float, (e & 1) ? (x & 0xffff0000u) : (x << 16)); }
__device__ __forceinline__ unsigned short bfbits(const v4u w, const int e) { const unsigned x = w[e >> 1]; return (unsigned short)((e & 1) ? (x >> 16) : (x & 0xffffu)); }

#define GH_SCAN_STEP(CTRL) "v_mul_f32_dpp %0, %0, %0 " CTRL "\n\tv_mul_f32_dpp %1, %1, %1 " CTRL "\n\tv_mul_f32_dpp %2, %2, %2 " CTRL "\n\tv_mul_f32_dpp %3, %3, %3 " CTRL "\n\t" \
                           "v_mul_f32_dpp %4, %4, %4 " CTRL "\n\tv_mul_f32_dpp %5, %5, %5 " CTRL "\n\tv_mul_f32_dpp %6, %6, %6 " CTRL "\n\tv_mul_f32_dpp %7, %7, %7 " CTRL "\n\t"
__device__ __forceinline__ void gh_scan8(float& a, float& b, float& c, float& d, float& e, float& f, float& g, float& h) {
    asm volatile("s_nop 1\n\t"
                 GH_SCAN_STEP("row_shr:1 row_mask:0xf bank_mask:0xf") GH_SCAN_STEP("row_shr:2 row_mask:0xf bank_mask:0xf") GH_SCAN_STEP("row_shr:4 row_mask:0xf bank_mask:0xf")
                 GH_SCAN_STEP("row_shr:8 row_mask:0xf bank_mask:0xf") GH_SCAN_STEP("row_bcast:15 row_mask:0xa bank_mask:0xf") "s_nop 1"
                 : "+v"(a), "+v"(b), "+v"(c), "+v"(d), "+v"(e), "+v"(f), "+v"(g), "+v"(h));
}
#undef GH_SCAN_STEP
template <int K> struct GHL { static constexpr int RS = K * 2 + 16, OFF_Q = 0, OFF_K = 32 * RS, OFF_KT = 64 * RS, OFF_VT = OFF_KT + K * 80, OFF_E = OFF_VT + 64 * 80, OFF_O = OFF_E + K * 4, UNIT = OFF_O + 32 * 272; };
static_assert(GHL<64>::UNIT == 28416 && 4 * GHL<64>::UNIT <= MIX_CONST_OFF, "GLA/HGRN LDS map");

template <int K>
__device__ __forceinline__ void s2_gh_unit(LAS unsigned char* U, f32x4 (&S)[K / 16], const int cs, const int lane) {
    typedef GHL<K> G; constexpr int NS = K / 32, KT = K / 16;
    const int q = lane >> 4, r16 = lane & 15, c = 16 * cs + r16;
    const f32x4 z4 = {0.f, 0.f, 0.f, 0.f};
    const LAS unsigned char* vrow = U + G::OFF_VT + c * 80;
    bf16x8 kf0[NS], kf1[NS], qf0[NS], qf1[NS], qp0[NS], qp1[NS], ktf[KT]; f32x4 e4[KT];
#pragma unroll
    for (int kt = 0; kt < KT; ++kt) { ktf[kt] = frag16(U + G::OFF_KT + (16 * kt + r16) * 80 + (8 * q) * 2); e4[kt] = *(const LAS f32x4*)(U + G::OFF_E + (16 * kt + 4 * q) * 4); }
    const bf16x8 vn = frag16(vrow + (8 * q) * 2);
#pragma unroll
    for (int s = 0; s < NS; ++s) {
        const LAS unsigned char* qr0 = U + G::OFF_Q + r16 * G::RS + (32 * s + 4 * q) * 2; const LAS unsigned char* qr1 = qr0 + 16 * G::RS;
        qp0[s] = frag8x2(qr0, qr0 + 32); qp1[s] = frag8x2(qr1, qr1 + 32);
    }
#pragma unroll
    for (int s = 0; s < NS; ++s) {
        const int kb = (32 * s + 8 * q) * 2;
        kf0[s] = frag16(U + G::OFF_K + r16 * G::RS + kb); kf1[s] = frag16(U + G::OFF_K + (16 + r16) * G::RS + kb);
        qf0[s] = frag16(U + G::OFF_Q + r16 * G::RS + kb); qf1[s] = frag16(U + G::OFF_Q + (16 + r16) * G::RS + kb);
    }
    const bf16x8 vb = frag8x2(vrow + (4 * q) * 2, vrow + (16 + 4 * q) * 2);
    bf16x8 sb[NS];
#pragma unroll
    for (int s = 0; s < NS; ++s) sb[s] = pack_frag(S[2 * s], S[2 * s + 1]);
#pragma unroll
    for (int kt = 0; kt < KT; ++kt) { S[kt] = MFMA16(ktf[kt], vn, S[kt]); S[kt] = S[kt] * e4[kt]; }
    f32x4 X00 = z4, X01 = z4, X11 = z4;
#pragma unroll
    for (int s = 0; s < NS; ++s) { X00 = MFMA16(kf0[s], qf0[s], X00); X01 = MFMA16(kf0[s], qf1[s], X01); X11 = MFMA16(kf1[s], qf1[s], X11); }
    f32x4 o0 = z4, o1 = z4;
#pragma unroll
    for (int s = 0; s < NS; ++s) { o0 = MFMA16(qp0[s], sb[s], o0); o1 = MFMA16(qp1[s], sb[s], o1); }
#pragma unroll
    for (int r = 0; r < 4; ++r) if (4 * q + r > r16) { X00[r] = 0.f; X11[r] = 0.f; }
    const bf16x8 a0 = pack_frag(X00, z4), a1 = pack_frag(X01, X11);
    o0 = MFMA16(a0, vb, o0); o1 = MFMA16(a1, vb, o1);
    LAS float* ob = (LAS float*)(U + G::OFF_O);
#pragma unroll
    for (int r = 0; r < 4; ++r) { ob[(4 * q + r) * 68 + c] = o0[r]; ob[(16 + 4 * q + r) * 68 + c] = o1[r]; }
}

template <int MT>
__device__ __forceinline__ void chain_gh(LAS unsigned char* L, const MixP& C, const int h, const int b0, const bool smp, const int tid) {
    constexpr int K = (MT == 0) ? 32 : 64, KT = K / 16, NK = K / 4;
    typedef GHL<K> G;
    const int w = __builtin_amdgcn_readfirstlane(tid >> 6), lane = tid & 63;
    const int u1 = tid >> 7, t1 = tid & 31, kg = (tid >> 5) & 3;
    LAS float* cst = (LAS float*)(L + MIX_CONST_OFF);
    if (MT == 0) { cst[tid] = C.gla_wg[(tid >> 5) * 128 + h * 32 + (tid & 31)]; if (tid < 32) cst[512 + tid] = C.gla_b[h * 32 + tid]; }
    if (tid >= 64 && tid < 128) cst[600 + tid - 64] = ((MT == 0) ? C.gla_n : C.hg_n)[tid - 64];
    if (MT == 1) { if (tid < 64) cst[tid] = (C.l == 0) ? 0.f : sigmoid_f(C.lbl[256 + h * 64 + tid] - C.lbl[h * 64 + tid]); }
    __syncthreads();
    const float* sin = (MT == 0) ? C.s_gla : C.s_hgrn;
    const size_t o_p = (MT == 0) ? O_GLAP : O_HGP, o_s = (MT == 0) ? O_GLAS : O_HGS;
    f32x4 S[KT];
#pragma unroll
    for (int kt = 0; kt < KT; ++kt) S[kt] = (f32x4){0.f, 0.f, 0.f, 0.f};
    const int nsc = smp ? 1 : TP / 128;
    v4u rw0, rw1, rw2, rw3, rw4, rw5;
#define GH_LOAD_RAW(SC) do { const bool valid_ = smp ? (t1 < TS) : true; \
        const int row_ = smp ? (MP + (b0 + u1) * TS + (valid_ ? t1 : 0)) : (b0 * TP + (SC) * 128 + u1 * 32 + t1); \
        const bf16* prow_ = C.P + (size_t)row_ * NINP; \
        if (MT == 0) { rw0 = *(const v4u*)(prow_ + PC_GQ + h * 32 + 8 * kg); rw1 = *(const v4u*)(prow_ + PC_GK + h * 32 + 8 * kg); rw2 = *(const v4u*)(prow_ + PC_LR); rw3 = *(const v4u*)(prow_ + PC_LR + 8); \
                       rw4 = *(const v4u*)(prow_ + PC_GV + h * 64 + 16 * kg); rw5 = *(const v4u*)(prow_ + PC_GV + h * 64 + 16 * kg + 8); } \
        else { rw0 = *(const v4u*)(prow_ + PC_RQ + h * 64 + 16 * kg); rw1 = *(const v4u*)(prow_ + PC_RQ + h * 64 + 16 * kg + 8); rw2 = *(const v4u*)(prow_ + PC_RF + h * 64 + 16 * kg); rw3 = *(const v4u*)(prow_ + PC_RF + h * 64 + 16 * kg + 8); \
               rw4 = *(const v4u*)(prow_ + PC_RI + h * 64 + 16 * kg); rw5 = *(const v4u*)(prow_ + PC_RI + h * 64 + 16 * kg + 8); } } while (0)
    GH_LOAD_RAW(0);
    for (int sc = 0; sc < nsc; ++sc) {
#pragma unroll 1
        for (int rep1 = 0; rep1 < MK_REP_S1; ++rep1) {
#if MK_REP_S1 > 1
            asm volatile("" : "+v"(rw0), "+v"(rw1), "+v"(rw2), "+v"(rw3), "+v"(rw4), "+v"(rw5));
#endif
            const bool valid = smp ? (t1 < TS) : true;
            LAS unsigned char* U = L + u1 * G::UNIT;
            float f[NK], kk[NK], qq[NK]; v4u vraw0 = rw4, vraw1 = rw5;
            if (MT == 0) {
                const v4u gq = rw0, gk = rw1, lr0 = rw2, lr1 = rw3;
                float lg[NK];
#pragma unroll
                for (int e = 0; e < NK; ++e) lg[e] = cst[512 + 8 * kg + e];
#pragma unroll
                for (int j = 0; j < 16; ++j) { const float lv = (j < 8) ? bfe(lr0, j) : bfe(lr1, j - 8);
                    const f32x4 w0 = *(const LAS f32x4*)(cst + j * 32 + 8 * kg), w1 = *(const LAS f32x4*)(cst + j * 32 + 8 * kg + 4);
                    lg[0] += lv * w0[0]; lg[1] += lv * w0[1]; lg[2] += lv * w0[2]; lg[3] += lv * w0[3]; lg[4] += lv * w1[0]; lg[5] += lv * w1[1]; lg[6] += lv * w1[2]; lg[7] += lv * w1[3]; }
#pragma unroll
                for (int e = 0; e < NK; ++e) { f[e] = __expf(logsigmoid_f(lg[e]) * (1.0f / 16.0f)); kk[e] = bfe(gk, e); qq[e] = bfe(gq, e) * 0.17677669529663687f; }
            } else {
                const v4u rq0 = rw0, rq1 = rw1, rf0 = rw2, rf1 = rw3;
#pragma unroll
                for (int e = 0; e < NK; ++e) { const float z = (e < 8) ? bfe(rf0, e) : bfe(rf1, e - 8), qv = (e < 8) ? bfe(rq0, e) : bfe(rq1, e - 8);
                    const float lb = cst[16 * kg + e], sg = sigmoid_f(z);
                    f[e] = lb + (1.f - lb) * sg; kk[e] = (1.f - lb) * (1.f - sg); qq[e] = qv; }
            }
            if (!valid) {
#pragma unroll
                for (int e = 0; e < NK; ++e) { f[e] = 1.f; kk[e] = 0.f; qq[e] = 0.f; }
                vraw0 = (v4u){0u, 0u, 0u, 0u}; vraw1 = vraw0;
            }
#pragma unroll
            for (int e8 = 0; e8 < NK; e8 += 8) gh_scan8(f[e8 + 0], f[e8 + 1], f[e8 + 2], f[e8 + 3], f[e8 + 4], f[e8 + 5], f[e8 + 6], f[e8 + 7]);
            float qt[NK], kt_[NK];
#pragma unroll
            for (int e = 0; e < NK; ++e) { qt[e] = qq[e] * f[e]; kt_[e] = kk[e] * __builtin_amdgcn_rcpf(fmaxf(f[e], 1e-30f)); }
#pragma unroll
            for (int e8 = 0; e8 < NK; e8 += 8) {
                v4u wq, wk;
                wq.x = cvtpk(qt[e8 + 0], qt[e8 + 1]); wq.y = cvtpk(qt[e8 + 2], qt[e8 + 3]); wq.z = cvtpk(qt[e8 + 4], qt[e8 + 5]); wq.w = cvtpk(qt[e8 + 6], qt[e8 + 7]);
                wk.x = cvtpk(kt_[e8 + 0], kt_[e8 + 1]); wk.y = cvtpk(kt_[e8 + 2], kt_[e8 + 3]); wk.z = cvtpk(kt_[e8 + 4], kt_[e8 + 5]); wk.w = cvtpk(kt_[e8 + 6], kt_[e8 + 7]);
                *(LAS v4u*)(U + G::OFF_Q + t1 * G::RS + (NK * kg + e8) * 2) = wq;
                *(LAS v4u*)(U + G::OFF_K + t1 * G::RS + (NK * kg + e8) * 2) = wk;
#pragma unroll
                for (int e = 0; e < 8; ++e) *(LAS unsigned short*)(U + G::OFF_KT + (NK * kg + e8 + e) * 80 + t1 * 2) = bfbits(wk, e);
            }
#pragma unroll
            for (int e = 0; e < 16; ++e) *(LAS unsigned short*)(U + G::OFF_VT + (16 * kg + e) * 80 + t1 * 2) = (e < 8) ? bfbits(vraw0, e) : bfbits(vraw1, e - 8);
            if (t1 == 31) {
#pragma unroll
                for (int e = 0; e < NK; ++e) *(LAS float*)(U + G::OFF_E + (NK * kg + e) * 4) = f[e];
            }
        }
        __syncthreads();
        const int tok3 = tid >> 2, cq3 = tid & 3, u3 = tok3 >> 5, i3 = tok3 & 31;
        const bool valid3 = smp ? (i3 < TS) : true;
        const int row3 = smp ? (MP + (b0 + u3) * TS + (valid3 ? i3 : 0)) : (b0 * TP + sc * 128 + tok3);
        v4u gg0, gg1;
        { const bf16* grow = C.P + (size_t)row3 * NINP + ((MT == 0) ? PC_GR : PC_RG) + h * 64 + 16 * cq3; gg0 = *(const v4u*)grow; gg1 = *(const v4u*)(grow + 8); }
        GH_LOAD_RAW((sc + 1 < nsc) ? sc + 1 : sc);
        if (!smp) {
            if (w < 4) {
#pragma unroll 1
                for (int u = 0; u < 4; ++u) {
#ifdef MK_REP_S2GH
                    { f32x4 Sd[KT];
#pragma unroll
                      for (int kt = 0; kt < KT; ++kt) Sd[kt] = S[kt];
                      s2_gh_unit<K>(L + u * G::UNIT, Sd, w, lane);
#pragma unroll
                      for (int kt = 0; kt < KT; ++kt) asm volatile("" :: "v"(Sd[kt])); }
#endif
                    s2_gh_unit<K>(L + u * G::UNIT, S, w, lane);
                }
            }
        } else {
#pragma unroll 1
            for (int job = w; job < 16; job += 8) {
                const int u = job >> 2, cs = job & 3, q = lane >> 4, c = 16 * cs + (lane & 15);
                const size_t sb = ((size_t)(b0 + u) * 4 + h) * K * 64;
#pragma unroll
                for (int kt = 0; kt < KT; ++kt)
#pragma unroll
                    for (int r = 0; r < 4; ++r) S[kt][r] = sin[sb + (size_t)(16 * kt + 4 * q + r) * 64 + c];
                s2_gh_unit<K>(L + u * G::UNIT, S, cs, lane);
                float* so = C.out + o_s + (((size_t)C.l * BS + b0 + u) * 4 + h) * K * 64;
#pragma unroll
                for (int kt = 0; kt < KT; ++kt)
#pragma unroll
                    for (int r = 0; r < 4; ++r) so[(size_t)(16 * kt + 4 * q + r) * 64 + c] = S[kt][r];
            }
        }
        __syncthreads();
#pragma unroll 1
        for (int rep3 = 0; rep3 < MK_REP_S3; ++rep3) {
#if MK_REP_S3 > 1
            asm volatile("" : "+v"(gg0), "+v"(gg1));
#endif
            const LAS float* ob = (const LAS float*)(L + u3 * G::UNIT + G::OFF_O) + i3 * 68 + 16 * cq3;
            f32x4 o[4]; float ss = 0.f;
#pragma unroll
            for (int j = 0; j < 4; ++j) { o[j] = *(const LAS f32x4*)(ob + 4 * j); ss += (o[j][0] * o[j][0] + o[j][1] * o[j][1]) + (o[j][2] * o[j][2] + o[j][3] * o[j][3]); }
            ss = quad_sum(ss);
            const float r = rsqrtf(ss * (1.0f / 64.0f) + 1e-6f);
            float res[16], nwv[16];
#pragma unroll
            for (int j = 0; j < 4; ++j) { const f32x4 t = *(const LAS f32x4*)(cst + 600 + 16 * cq3 + 4 * j); nwv[4 * j] = t[0]; nwv[4 * j + 1] = t[1]; nwv[4 * j + 2] = t[2]; nwv[4 * j + 3] = t[3]; }
#pragma unroll
            for (int e = 0; e < 16; ++e) { const float gv = (e < 8) ? bfe(gg0, e) : bfe(gg1, e - 8); res[e] = o[e >> 2][e & 3] * r * nwv[e] * gv; }
            if (valid3) {
                v4u w0, w1;
                w0.x = cvtpk(res[0], res[1]); w0.y = cvtpk(res[2], res[3]); w0.z = cvtpk(res[4], res[5]); w0.w = cvtpk(res[6], res[7]);
                w1.x = cvtpk(res[8], res[9]); w1.y = cvtpk(res[10], res[11]); w1.z = cvtpk(res[12], res[13]); w1.w = cvtpk(res[14], res[15]);
                bf16* mo = C.mixb + (size_t)row3 * D + ((MT == 0) ? MC_GLA : MC_HGRN) + h * 64 + 16 * cq3;
                *(v4u*)mo = w0; *(v4u*)(mo + 8) = w1;
            }
        }
    }
#undef GH_LOAD_RAW
    if (!smp && w < 4) {
        const int q = lane >> 4, c = 16 * w + (lane & 15);
        float* so = C.out + o_p + (((size_t)C.l * BP + b0) * 4 + h) * K * 64;
#pragma unroll
        for (int kt = 0; kt < KT; ++kt)
#pragma unroll
            for (int r = 0; r < 4; ++r) so[(size_t)(16 * kt + 4 * q + r) * 64 + c] = S[kt][r];
    }
    __syncthreads();
}

namespace SL { constexpr int OFF_C = 0, OFF_B = 8704, OFF_BT = 17408, OFF_XT = 27648, OFF_TAB = 37888, OFF_Y = 39168, UNIT = 56064; }
static_assert(2 * SL::UNIT <= MIX_CONST_OFF, "SSD LDS map");

__device__ __forceinline__ void s2_ssd_unit(LAS unsigned char* U, f32x4 (&S)[8], const int hh, const int ps, const int lane, const float Dh) {
    const int q = lane >> 4, r16 = lane & 15, p = 16 * ps + r16;
    const f32x4 z4 = {0.f, 0.f, 0.f, 0.f};
    const LAS float* tab = (const LAS float*)(U + SL::OFF_TAB) + hh * 160;
    const LAS unsigned char* xrow = U + SL::OFF_XT + hh * 5120 + p * 80;
    bf16x8 btf[8];
#pragma unroll
    for (int nt = 0; nt < 8; ++nt) btf[nt] = frag16(U + SL::OFF_BT + (16 * nt + r16) * 80 + (8 * q) * 2);
    const v4u xn = *(const LAS v4u*)(xrow + (8 * q) * 2);
    const f32x4 w0 = *(const LAS f32x4*)(tab + 96 + 8 * q), w1 = *(const LAS f32x4*)(tab + 96 + 8 * q + 4);
    const float eL = tab[128];
    bf16x8 cp0[4], cp1[4];
#pragma unroll
    for (int s = 0; s < 4; ++s) { const LAS unsigned char* cr0 = U + SL::OFF_C + r16 * 272 + (32 * s + 4 * q) * 2; const LAS unsigned char* cr1 = cr0 + 16 * 272; cp0[s] = frag8x2(cr0, cr0 + 32); cp1[s] = frag8x2(cr1, cr1 + 32); }
    bf16x8 sb[4];
#pragma unroll
    for (int s = 0; s < 4; ++s) sb[s] = pack_frag(S[2 * s], S[2 * s + 1]);
    const f32x4 xa = {bfe(xn, 0) * w0[0], bfe(xn, 1) * w0[1], bfe(xn, 2) * w0[2], bfe(xn, 3) * w0[3]}, xc = {bfe(xn, 4) * w1[0], bfe(xn, 5) * w1[1], bfe(xn, 6) * w1[2], bfe(xn, 7) * w1[3]};
    const bf16x8 xh = pack_frag(xa, xc);
#pragma unroll
    for (int nt = 0; nt < 8; ++nt) S[nt] = MFMA16(btf[nt], xh, S[nt] * eL);
    f32x4 X00 = z4, X01 = z4, X11 = z4;
#pragma unroll
    for (int s = 0; s < 4; ++s) {
        const int nb = (32 * s + 8 * q) * 2;
        const bf16x8 b0 = frag16(U + SL::OFF_B + r16 * 272 + nb), b1 = frag16(U + SL::OFF_B + (16 + r16) * 272 + nb);
        const bf16x8 c0 = frag16(U + SL::OFF_C + r16 * 272 + nb), c1 = frag16(U + SL::OFF_C + (16 + r16) * 272 + nb);
        X00 = MFMA16(b0, c0, X00); X01 = MFMA16(b0, c1, X01); X11 = MFMA16(b1, c1, X11);
    }
    f32x4 y20 = z4, y21 = z4;
#pragma unroll
    for (int s = 0; s < 4; ++s) { y20 = MFMA16(cp0[s], sb[s], y20); y21 = MFMA16(cp1[s], sb[s], y21); }
    const float ci0 = tab[r16], ci1 = tab[16 + r16];
    const f32x4 cj0 = *(const LAS f32x4*)(tab + 4 * q), cj1 = *(const LAS f32x4*)(tab + 16 + 4 * q);
#pragma unroll
    for (int r = 0; r < 4; ++r) {
        X00[r] = (4 * q + r > r16) ? 0.f : X00[r] * __expf(fminf(ci0 - cj0[r], 0.f));
        X01[r] = X01[r] * __expf(fminf(ci1 - cj0[r], 0.f));
        X11[r] = (4 * q + r > r16) ? 0.f : X11[r] * __expf(fminf(ci1 - cj1[r], 0.f));
    }
    const bf16x8 a0 = pack_frag(X00, z4), a1 = pack_frag(X01, X11);
    bf16x8 xb; f32x4 ux0, ux1;
    { const v2u xl = *(const LAS v2u*)(xrow + (4 * q) * 2), xh_ = *(const LAS v2u*)(xrow + (16 + 4 * q) * 2);
      const f32x4 d0 = *(const LAS f32x4*)(tab + 64 + 4 * q), d1 = *(const LAS f32x4*)(tab + 64 + 16 + 4 * q);
      const f32x4 fa = {__builtin_bit_cast(float, xl.x << 16) * d0[0], __builtin_bit_cast(float, xl.x & 0xffff0000u) * d0[1], __builtin_bit_cast(float, xl.y << 16) * d0[2], __builtin_bit_cast(float, xl.y & 0xffff0000u) * d0[3]};
      const f32x4 fb = {__builtin_bit_cast(float, xh_.x << 16) * d1[0], __builtin_bit_cast(float, xh_.x & 0xffff0000u) * d1[1], __builtin_bit_cast(float, xh_.y << 16) * d1[2], __builtin_bit_cast(float, xh_.y & 0xffff0000u) * d1[3]};
      xb = pack_frag(fa, fb);
      ux0 = (f32x4){__builtin_bit_cast(float, xl.x << 16), __builtin_bit_cast(float, xl.x & 0xffff0000u), __builtin_bit_cast(float, xl.y << 16), __builtin_bit_cast(float, xl.y & 0xffff0000u)} * Dh;
      ux1 = (f32x4){__builtin_bit_cast(float, xh_.x << 16), __builtin_bit_cast(float, xh_.x & 0xffff0000u), __builtin_bit_cast(float, xh_.y << 16), __builtin_bit_cast(float, xh_.y & 0xffff0000u)} * Dh; }
    const f32x4 y10 = MFMA16(a0, xb, z4), y11 = MFMA16(a1, xb, z4);
    const f32x4 e0 = *(const LAS f32x4*)(tab + 32 + 4 * q), e1 = *(const LAS f32x4*)(tab + 32 + 16 + 4 * q);
    LAS float* yb = (LAS float*)(U + SL::OFF_Y);
#pragma unroll
    for (int r = 0; r < 4; ++r) { yb[(4 * q + r) * 132 + hh * 64 + p] = y10[r] + e0[r] * y20[r] + ux0[r]; yb[(16 + 4 * q + r) * 132 + hh * 64 + p] = y11[r] + e1[r] * y21[r] + ux1[r]; }
}

__device__ __forceinline__ void s2_ssd_state(LAS unsigned char* U, f32x4 (&S)[8], const int hh, const int ps, const int lane) {
    const int q = lane >> 4, r16 = lane & 15, p = 16 * ps + r16;
    const LAS float* tab = (const LAS float*)(U + SL::OFF_TAB) + hh * 160;
    const LAS unsigned char* xrow = U + SL::OFF_XT + hh * 5120 + p * 80;
    bf16x8 btf[8];
#pragma unroll
    for (int nt = 0; nt < 8; ++nt) btf[nt] = frag16(U + SL::OFF_BT + (16 * nt + r16) * 80 + (8 * q) * 2);
    const v4u xn = *(const LAS v4u*)(xrow + (8 * q) * 2);
    const f32x4 w0 = *(const LAS f32x4*)(tab + 96 + 8 * q), w1 = *(const LAS f32x4*)(tab + 96 + 8 * q + 4);
    const float eL = tab[128];
    const f32x4 xa = {bfe(xn, 0) * w0[0], bfe(xn, 1) * w0[1], bfe(xn, 2) * w0[2], bfe(xn, 3) * w0[3]}, xc = {bfe(xn, 4) * w1[0], bfe(xn, 5) * w1[1], bfe(xn, 6) * w1[2], bfe(xn, 7) * w1[3]};
    const bf16x8 xh = pack_frag(xa, xc);
#pragma unroll
    for (int nt = 0; nt < 8; ++nt) S[nt] = MFMA16(btf[nt], xh, S[nt] * eL);
}

__device__ __forceinline__ void conv_phase(const MixP& C, const int G, const int tid) {
    constexpr int NTASK = (M / 8) * 96;
    for (int task = blockIdx.x * NTHREADS + tid; task < NTASK; task += G * NTHREADS) {
        const int g8 = task / 96, bl = task - g8 * 96, ch0 = 8 * bl, row0 = 8 * g8;
        const bool smp = g8 >= MP / 8;
        const int bsm = smp ? g8 - MP / 8 : 0;
        const bool head = smp ? true : ((row0 & (TP - 1)) == 0);
        {
            v4u xr[11];
#pragma unroll
            for (int i = 0; i < 11; ++i) { int r = row0 - 3 + i; if (head && i < 3) r = row0; xr[i] = *(const v4u*)(C.P + (size_t)r * NINP + PC_XBC + ch0); }
            f32x4 st[3][2];
#pragma unroll
            for (int r = 0; r < 3; ++r) { st[r][0] = (f32x4){0.f, 0.f, 0.f, 0.f}; st[r][1] = st[r][0]; }
            if (smp) {
#pragma unroll
                for (int r = 0; r < 3; ++r) { st[r][0] = *(const f32x4*)(C.s_conv + ((size_t)bsm * 3 + r) * 768 + ch0); st[r][1] = *(const f32x4*)(C.s_conv + ((size_t)bsm * 3 + r) * 768 + ch0 + 4); }
            }
            float wt[4][8], bs[8];
#pragma unroll
            for (int j = 0; j < 4; ++j) { const f32x4 wa = *(const f32x4*)(C.conv_w + j * 768 + ch0), wb = *(const f32x4*)(C.conv_w + j * 768 + ch0 + 4);
#pragma unroll
                for (int c = 0; c < 4; ++c) { wt[j][c] = wa[c]; wt[j][4 + c] = wb[c]; } }
            { const f32x4 wa = *(const f32x4*)(C.conv_b + ch0), wb = *(const f32x4*)(C.conv_b + ch0 + 4);
#pragma unroll
              for (int c = 0; c < 4; ++c) { bs[c] = wa[c]; bs[4 + c] = wb[c]; } }
            float p3[8], p2[8], p1[8];
#pragma unroll
            for (int c = 0; c < 8; ++c) { p3[c] = head ? st[0][c >> 2][c & 3] : bfe(xr[0], c); p2[c] = head ? st[1][c >> 2][c & 3] : bfe(xr[1], c); p1[c] = head ? st[2][c >> 2][c & 3] : bfe(xr[2], c); }
#pragma unroll
            for (int et = 0; et < 8; ++et) {
                float val[8];
#pragma unroll
                for (int c = 0; c < 8; ++c) { const float cur = bfe(xr[et + 3], c);
                    val[c] = silu_f(bs[c] + wt[0][c] * p3[c] + wt[1][c] * p2[c] + wt[2][c] * p1[c] + wt[3][c] * cur); p3[c] = p2[c]; p2[c] = p1[c]; p1[c] = cur; }
                v4u wv; wv.x = cvtpk(val[0], val[1]); wv.y = cvtpk(val[2], val[3]); wv.z = cvtpk(val[4], val[5]); wv.w = cvtpk(val[6], val[7]);
                *(v4u*)(C.XC + (size_t)(row0 + et) * 768 + ch0) = wv;
            }
        }
    }
}

__device__ __forceinline__ void chain_ssd(LAS unsigned char* L, const MixP& C, const int g, const int b0, const int mode, const int sc0, const int tid) {
    const bool smp = (mode == 1);
    const int w = __builtin_amdgcn_readfirstlane(tid >> 6), lane = tid & 63;
    const int hh2 = w >> 2, ps = w & 3, h2 = 2 * g + hh2;
    const float A0 = -__expf(C.a_log[2 * g]), A1 = -__expf(C.a_log[2 * g + 1]), dtb0 = C.dt_b[2 * g], dtb1 = C.dt_b[2 * g + 1], D0 = C.ssm_d[2 * g], D1 = C.ssm_d[2 * g + 1];
    f32x4 S[8];
#pragma unroll
    for (int nt = 0; nt < 8; ++nt) S[nt] = (f32x4){0.f, 0.f, 0.f, 0.f};
    const int cu1 = tid >> 8, ct = tid & 255;
    const int tg1 = ct / 48, bl1 = ct - tg1 * 48, lc01 = 8 * bl1;
    const int ch01 = (bl1 < 16) ? 128 * g + lc01 : (bl1 < 32) ? 256 + 128 * g + (lc01 - 128) : 512 + 128 * g + (lc01 - 256);
    const int tbase = smp ? 0 : sc0 * 64 + cu1 * 32;
    const int rowbase = smp ? MP + (b0 + cu1) * TS : b0 * TP;
    v4u xr[8]; bf16 sdraw = 0;
    if (ct < 192) { const bf16* xsrc = C.XC + (size_t)(rowbase + (smp ? 0 : tbase + 8 * tg1)) * 768 + ch01;
#pragma unroll
        for (int et = 0; et < 8; ++et) xr[et] = *(const v4u*)(xsrc + (size_t)et * 768); }
    else { const int t1 = ct & 31, hh = (ct - 192) >> 5; const bool valid = smp ? (t1 < TS) : true;
        sdraw = C.P[(size_t)(rowbase + tbase + (valid ? t1 : 0)) * NINP + PC_DT + 2 * g + hh]; }
    const int tok3 = tid >> 3, c83 = tid & 7, u3 = tok3 >> 5, i3 = tok3 & 31;
    const bool valid3 = smp ? (i3 < TS) : true;
    const int row3 = smp ? (MP + (b0 + u3) * TS + (valid3 ? i3 : 0)) : (b0 * TP + sc0 * 64 + tok3);
    v4u zz0, zz1;
    { const bf16* zrow = C.P + (size_t)row3 * NINP + PC_SZ + 128 * g + 16 * c83; zz0 = *(const v4u*)zrow; zz1 = *(const v4u*)(zrow + 8); }
    LAS float* cst = (LAS float*)(L + MIX_CONST_OFF);
    if (tid < 128) cst[tid] = C.ssm_n[128 * g + tid];
    {
        LAS unsigned char* U = L + cu1 * SL::UNIT;
        if (ct < 192) {
            const int tg = tg1, bl = bl1, lc0 = lc01;
            const bool tok_ok = smp ? (tg == 0) : true;
            if (!tok_ok) {
#pragma unroll
                for (int et = 0; et < 8; ++et) xr[et] = (v4u){0u, 0u, 0u, 0u};
            }
            if (bl >= 16) {
                LAS unsigned char* rb = U + ((bl < 32) ? SL::OFF_B + (lc0 - 128) * 2 : SL::OFF_C + (lc0 - 256) * 2) + (8 * tg) * 272;
#pragma unroll
                for (int et = 0; et < 8; ++et) *(LAS v4u*)(rb + et * 272) = xr[et];
            }
            if (bl < 32) {
                LAS unsigned char* tb = U + ((bl < 16) ? SL::OFF_XT + lc0 * 80 : SL::OFF_BT + (lc0 - 128) * 80) + 16 * tg;
#pragma unroll
                for (int c = 0; c < 8; ++c) { v4u o;
#pragma unroll
                    for (int k = 0; k < 4; ++k) { const unsigned a = xr[2 * k][c >> 1], b = xr[2 * k + 1][c >> 1]; o[k] = (c & 1) ? ((a >> 16) | (b & 0xffff0000u)) : ((a & 0xffffu) | (b << 16)); }
                    *(LAS v4u*)(tb + c * 80) = o; }
            }
        } else {
            const int t1 = ct & 31, hh = (ct - 192) >> 5;
            const bool valid = smp ? (t1 < TS) : true;
            const float dt = valid ? softplus_f(bf2f(sdraw) + ((hh == 0) ? dtb0 : dtb1)) : 0.f;
            float c0 = dt * ((hh == 0) ? A0 : A1);
            c0 += dpp_sel<0x111, 0xf>(0.f, c0); c0 += dpp_sel<0x112, 0xf>(0.f, c0); c0 += dpp_sel<0x114, 0xf>(0.f, c0); c0 += dpp_sel<0x118, 0xf>(0.f, c0); c0 += dpp_bcast15(0.f, c0);
            const float cl = (lane & 32) ? __builtin_bit_cast(float, __builtin_amdgcn_readlane(__builtin_bit_cast(int, c0), 63)) : __builtin_bit_cast(float, __builtin_amdgcn_readlane(__builtin_bit_cast(int, c0), 31));
            LAS float* tab = (LAS float*)(U + SL::OFF_TAB) + hh * 160;
            tab[t1] = c0; tab[32 + t1] = __expf(c0); tab[64 + t1] = dt; tab[96 + t1] = dt * __expf(cl - c0);
            if (t1 == 31) tab[128] = __expf(cl);
        }
    }
    __syncthreads();
    const int q2 = lane >> 4, p2 = 16 * ps + (lane & 15);
    float* dsp = C.DS + ((((size_t)(b0 * 2 + g) * (TP / 64) + sc0) * 2 + hh2) * 64 + p2) * 128;
    if (mode == 2) {
#pragma unroll 1
        for (int u = 0; u < 2; ++u) s2_ssd_state(L + u * SL::UNIT, S, hh2, ps, lane);
#pragma unroll
        for (int nt = 0; nt < 8; ++nt) *(f32x4*)(dsp + 16 * nt + 4 * q2) = S[nt];
        if (ps == 0 && lane == 0) C.ESC[((size_t)(b0 * 2 + g) * (TP / 64) + sc0) * 2 + hh2] = ((const LAS float*)(L + SL::OFF_TAB))[hh2 * 160 + 128] * ((const LAS float*)(L + SL::UNIT + SL::OFF_TAB))[hh2 * 160 + 128];
    } else if (mode == 3) {
#pragma unroll
        for (int nt = 0; nt < 8; ++nt) S[nt] = *(const f32x4*)(dsp + 16 * nt + 4 * q2);
#pragma unroll 1
        for (int u = 0; u < 2; ++u) s2_ssd_unit(L + u * SL::UNIT, S, hh2, ps, lane, (hh2 == 0) ? D0 : D1);
    } else {
#pragma unroll 1
        for (int u = 0; u < 2; ++u) {
            const float* sp = C.s_ssm + (((size_t)(b0 + u) * 4 + h2) * 64 + p2) * 128;
#pragma unroll
            for (int nt = 0; nt < 8; ++nt) S[nt] = *(const f32x4*)(sp + 16 * nt + 4 * q2);
            s2_ssd_unit(L + u * SL::UNIT, S, hh2, ps, lane, (hh2 == 0) ? D0 : D1);
            float* so = C.out + O_SSMS + ((((size_t)C.l * BS + b0 + u) * 4 + h2) * 64 + p2) * 128;
#pragma unroll
            for (int nt = 0; nt < 8; ++nt) *(f32x4*)(so + 16 * nt + 4 * q2) = S[nt];
        }
    }
    __syncthreads();
    if (mode != 2) {
        const LAS float* yb = (const LAS float*)(L + u3 * SL::UNIT + SL::OFF_Y) + i3 * 132 + 16 * c83;
        float y[16]; float ss = 0.f;
#pragma unroll
        for (int j = 0; j < 4; ++j) { const f32x4 v = *(const LAS f32x4*)(yb + 4 * j);
#pragma unroll
            for (int e = 0; e < 4; ++e) { const int ee = 4 * j + e; const float zv = (ee < 8) ? bfe(zz0, ee) : bfe(zz1, ee - 8); y[ee] = v[e] * zv; ss += y[ee] * y[ee]; } }
        ss = oct_sum(ss);
        const float r = rsqrtf(ss * (1.0f / 128.0f) + 1e-6f);
        if (valid3) {
            float nwv[16];
#pragma unroll
            for (int j = 0; j < 4; ++j) { const f32x4 t = *(const LAS f32x4*)(cst + 16 * c83 + 4 * j); nwv[4 * j] = t[0]; nwv[4 * j + 1] = t[1]; nwv[4 * j + 2] = t[2]; nwv[4 * j + 3] = t[3]; }
            v4u w0, w1;
            w0.x = cvtpk(y[0] * r * nwv[0], y[1] * r * nwv[1]); w0.y = cvtpk(y[2] * r * nwv[2], y[3] * r * nwv[3]); w0.z = cvtpk(y[4] * r * nwv[4], y[5] * r * nwv[5]); w0.w = cvtpk(y[6] * r * nwv[6], y[7] * r * nwv[7]);
            w1.x = cvtpk(y[8] * r * nwv[8], y[9] * r * nwv[9]); w1.y = cvtpk(y[10] * r * nwv[10], y[11] * r * nwv[11]); w1.z = cvtpk(y[12] * r * nwv[12], y[13] * r * nwv[13]); w1.w = cvtpk(y[14] * r * nwv[14], y[15] * r * nwv[15]);
            bf16* mo = C.mixb + (size_t)row3 * D + MC_SSM + 128 * g + 16 * c83;
            *(v4u*)mo = w0; *(v4u*)(mo + 8) = w1;
        }
    }
    __syncthreads();
}

__device__ __forceinline__ void ssd_scan(const MixP& C, const int wg, const int nwgs, const int tid) {
    constexpr int NSC = TP / 64, NQ = BP * 2 * 2 * 2048;
    const int per = (((NQ + nwgs - 1) / nwgs) + 63) & ~63;
    const int qi = wg * per + tid;
    if (tid < per && qi < NQ) {
        const int e = (qi & 2047) * 4, bgh = __builtin_amdgcn_readfirstlane(qi >> 11), hh = bgh & 1, bg = bgh >> 1;
        float* dp = C.DS + ((size_t)bg * NSC * 2 + hh) * 8192 + e;
        const float* ep = C.ESC + (size_t)bg * NSC * 2 + hh;
        f32x4 s = {0.f, 0.f, 0.f, 0.f};
#pragma unroll 1
        for (int h0 = 0; h0 < NSC; h0 += NSC / 2) {
            f32x4 d[NSC / 2]; float E[NSC / 2];
#pragma unroll
            for (int k = 0; k < NSC / 2; ++k) { d[k] = *(const f32x4*)(dp + (size_t)(h0 + k) * 2 * 8192); E[k] = ep[(h0 + k) * 2]; }
#pragma unroll
            for (int k = 0; k < NSC / 2; ++k) { *(f32x4*)(dp + (size_t)(h0 + k) * 2 * 8192) = s; s = s * E[k] + d[k]; }
        }
        const int b = bg >> 1, g = bg & 1;
        *(f32x4*)(C.out + O_SSMP + (((size_t)C.l * BP + b) * 4 + 2 * g + hh) * 8192 + e) = s;
    }
}

__device__ __forceinline__ void sub_barrier(unsigned* cnt, const unsigned nwg) {
    asm volatile("s_waitcnt vmcnt(0)" ::: "memory");
    __syncthreads();
    if (threadIdx.x == 0) {
        __builtin_amdgcn_fence(__ATOMIC_RELEASE, "agent");
        asm volatile("s_waitcnt vmcnt(0)" ::: "memory");
        (void)__hip_atomic_fetch_add(cnt, 1u, __ATOMIC_RELAXED, __HIP_MEMORY_SCOPE_AGENT);
        unsigned sp = 0;
        while (__hip_atomic_load(cnt, __ATOMIC_RELAXED, __HIP_MEMORY_SCOPE_AGENT) < nwg) { __builtin_amdgcn_s_sleep(2); if (++sp > (1u << 22)) break; }
        __builtin_amdgcn_fence(__ATOMIC_ACQUIRE, "agent");
        asm volatile("s_waitcnt vmcnt(0)" ::: "memory");
    }
    __syncthreads();
}
__device__ __forceinline__ void pool_item(LAS unsigned char* L, const MixP& C, const int tile, const int tid) {
    constexpr int DF_OFF = 40960, WT_OFF = 74752;
    const int m0 = tile * 64;
    {
        f32x4 wv[8];
#pragma unroll
        for (int i = 0; i < 8; ++i) { const int e4 = tid + NTHREADS * i; wv[i] = *(const f32x4*)(C.pool_w + (size_t)e4 * 4); }
#pragma unroll
        for (int i = 0; i < 8; ++i) { const int e4 = tid + NTHREADS * i, d0 = (e4 & 15) * 4, c = (e4 >> 4) & 63, g = e4 >> 10;
            LAS unsigned char* wp = L + WT_OFF + g * 9216 + d0 * 144 + c * 2;
            const unsigned p01 = cvtpk(wv[i][0], wv[i][1]), p23 = cvtpk(wv[i][2], wv[i][3]);
            *(LAS unsigned short*)(wp) = (unsigned short)(p01 & 0xffffu); *(LAS unsigned short*)(wp + 144) = (unsigned short)(p01 >> 16);
            *(LAS unsigned short*)(wp + 288) = (unsigned short)(p23 & 0xffffu); *(LAS unsigned short*)(wp + 432) = (unsigned short)(p23 >> 16); }
    }
    if (m0 < MP) {
        const int tt0 = m0 & (TP - 1);
#pragma unroll
        for (int idx = tid; idx < 79 * 32; idx += NTHREADS) {
            const int r = idx >> 5, c8 = idx & 31, tr = tt0 - 15 + r, trc = tr < 0 ? 0 : tr;
            const v4u ld = *(const v4u*)(C.P + (size_t)(m0 - tt0 + trc) * NINP + PC_PX + 8 * c8);
            *(LAS v4u*)(L + r * 512 + c8 * 16) = (tr >= 0) ? ld : (v4u){0u, 0u, 0u, 0u};
        }
        __syncthreads();
        {
            const int c = tid & 255, th = tid >> 8, g = c >> 6, w = 2 << g, tA = 32 * th;
            const LAS unsigned short* col = (const LAS unsigned short*)L + c;
            float s = 0.f;
            for (int j = 1; j < w; ++j) s += bf2f(col[(tA + 15 - j) * 256]);
            for (int t = tA; t < tA + 32; ++t) {
                const float x = bf2f(col[(t + 15) * 256]); s += x;
                const int tt = tt0 + t, cnt = (tt + 1 < w) ? tt + 1 : w;
                *(LAS unsigned short*)(L + DF_OFF + t * 528 + c * 2) = (unsigned short)(cvtpk(s * __builtin_amdgcn_rcpf((float)cnt) - x, 0.f) & 0xffffu);
                s -= bf2f(col[(t + 16 - w) * 256]);
            }
        }
    } else {
#pragma unroll 1
        for (int task = tid; task < 8 * 256; task += NTHREADS) {
            const int bb = task >> 8, c = task & 255, g = c >> 6, w = 2 << g, bg = (m0 - MP) / TS + bb;
            float xs[23];
#pragma unroll
            for (int r = 0; r < 15; ++r) xs[r] = C.s_pool[((size_t)bg * 15 + r) * 256 + c];
            bf16 xraw[8];
#pragma unroll
            for (int t = 0; t < 8; ++t) xraw[t] = C.P[(size_t)(m0 + bb * TS + t) * NINP + PC_PX + c];
#pragma unroll
            for (int t = 0; t < 8; ++t) xs[15 + t] = bf2f(xraw[t]);
            const float rw = __builtin_amdgcn_rcpf((float)w);
#pragma unroll
            for (int t = 0; t < 8; ++t) { float s = 0.f;
#pragma unroll
                for (int j = 0; j < 16; ++j) s += (j < w) ? xs[15 + t - j] : 0.f;
                *(LAS unsigned short*)(L + DF_OFF + (bb * TS + t) * 528 + c * 2) = (unsigned short)(cvtpk(s * rw - xs[15 + t], 0.f) & 0xffffu); }
        }
    }
    __syncthreads();
    {
        const int w8 = __builtin_amdgcn_readfirstlane(tid >> 6), lane = tid & 63, q = lane >> 4, r16 = lane & 15, g = w8 >> 1, dh = w8 & 1;
        f32x4 acc[2][4];
#pragma unroll
        for (int a = 0; a < 2; ++a)
#pragma unroll
            for (int b = 0; b < 4; ++b) acc[a][b] = (f32x4){0.f, 0.f, 0.f, 0.f};
#pragma unroll
        for (int ks = 0; ks < 2; ++ks) {
            bf16x8 wa[2], db[4];
#pragma unroll
            for (int a = 0; a < 2; ++a) wa[a] = frag16(L + WT_OFF + g * 9216 + (16 * (2 * dh + a) + r16) * 144 + (32 * ks + 8 * q) * 2);
#pragma unroll
            for (int b = 0; b < 4; ++b) db[b] = frag16(L + DF_OFF + (16 * b + r16) * 528 + (g * 64 + 32 * ks + 8 * q) * 2);
#pragma unroll
            for (int a = 0; a < 2; ++a)
#pragma unroll
                for (int b = 0; b < 4; ++b) acc[a][b] = MFMA16(wa[a], db[b], acc[a][b]);
        }
#pragma unroll
        for (int a = 0; a < 2; ++a) {
            const int d0 = g * 64 + 16 * (2 * dh + a) + 4 * q;
            const f32x4 sc = *(const f32x4*)(C.pool_scale + d0);
#pragma unroll
            for (int b = 0; b < 4; ++b) { const f32x4 v = acc[a][b] * sc; v2u o; o.x = cvtpk(v[0], v[1]); o.y = cvtpk(v[2], v[3]);
                *(v2u*)(C.mixb + (size_t)(m0 + 16 * b + r16) * D + MC_POOL + d0) = o; }
        }
    }
    __syncthreads();
}

constexpr int N_CP_PP = BP * 15 * 32, N_CP_PS = BS * 15 * 32, N_CP_CP = BP * 3 * 96, N_CP_CS = BS * 3 * 96, N_CP = N_CP_PP + N_CP_PS + N_CP_CP + N_CP_CS;
__device__ __forceinline__ void copy_states(const MixP& C, const int wg, const int nwgs, const int tid) {
    const int l = C.l;
    for (int i = wg * NTHREADS + tid; i < N_CP; i += nwgs * NTHREADS) {
        const bf16* src = nullptr; const float* fsrc = nullptr; float* dst;
        if (i < N_CP_PP) { const int b = i / 480, rem = i % 480, r = rem >> 5, c = (rem & 31) * 8;
            src = C.P + (size_t)(b * TP + TP - 15 + r) * NINP + PC_PX + c; dst = C.out + O_POOLP + ((size_t)(l * BP + b) * 15 + r) * 256 + c; }
        else if (i < N_CP_PP + N_CP_PS) { const int j = i - N_CP_PP, b = j / 480, rem = j % 480, r = rem >> 5, c = (rem & 31) * 8;
            if (r < 7) fsrc = C.s_pool + ((size_t)b * 15 + 8 + r) * 256 + c; else src = C.P + (size_t)(MP + b * TS + (r - 7)) * NINP + PC_PX + c;
            dst = C.out + O_POOLS + ((size_t)(l * BS + b) * 15 + r) * 256 + c; }
        else if (i < N_CP_PP + N_CP_PS + N_CP_CP) { const int j = i - N_CP_PP - N_CP_PS, b = j / 288, rem = j % 288, r = rem / 96, c = (rem % 96) * 8;
            src = C.P + (size_t)(b * TP + TP - 3 + r) * NINP + PC_XBC + c; dst = C.out + O_CONVP + ((size_t)(l * BP + b) * 3 + r) * 768 + c; }
        else { const int j = i - N_CP_PP - N_CP_PS - N_CP_CP, b = j / 288, rem = j % 288, r = rem / 96, c = (rem % 96) * 8;
            src = C.P + (size_t)(MP + b * TS + 5 + r) * NINP + PC_XBC + c; dst = C.out + O_CONVS + ((size_t)(l * BS + b) * 3 + r) * 768 + c; }
        f32x4 v0, v1;
        if (src) { const v4u w = *(const v4u*)src; v0 = (f32x4){bfe(w, 0), bfe(w, 1), bfe(w, 2), bfe(w, 3)}; v1 = (f32x4){bfe(w, 4), bfe(w, 5), bfe(w, 6), bfe(w, 7)}; }
        else { v0 = *(const f32x4*)fsrc; v1 = *(const f32x4*)(fsrc + 4); }
        *(f32x4*)dst = v0; *(f32x4*)(dst + 4) = v1;
    }
}

constexpr int NGH = BP * 8, N_SSD_IT = BP * 2 * (TP / 64), N_IT_SMP_GH = (BS / 4) * 4, N_IT_SMP_SSD = (BS / 2) * 2, N_IT_POOL = M / 64;
constexpr int IT_M3 = N_SSD_IT, IT_SGLA = 2 * N_SSD_IT, IT_SHG = IT_SGLA + N_IT_SMP_GH, IT_SSSD = IT_SHG + N_IT_SMP_GH, IT_POOL = IT_SSSD + N_IT_SMP_SSD, IT_GHP = IT_POOL + N_IT_POOL, IT_END = IT_GHP + NGH;
constexpr int N_IT_PROMPT = NGH;
__device__ __forceinline__ void mixer_phase(unsigned char* ldsg, LAS unsigned char* ldsl, const MixP& C, int G, const int tid) {
    const int bx = blockIdx.x;
    const int ngh = (G >= 2 * NGH) ? NGH : 0;
    const int nw = G - ngh;
    int it, step, lim; bool synced;
    if (bx < ngh) { it = IT_GHP + bx; step = 1 << 30; lim = IT_END; synced = true; }
    else { it = bx - ngh; step = nw; lim = (ngh > 0) ? IT_GHP : IT_END; synced = false; copy_states(C, bx - ngh, nw, tid); }
    int rep_it = 0;
    constexpr int NFILL = 64, V_SYNC = N_SSD_IT + NFILL;
    for (int vi = it; vi < lim; vi += step) {
        it = vi;
        if (ngh > 0 && bx >= ngh) {
            if (vi < N_SSD_IT) it = vi;
            else if (vi < V_SYNC) it = IT_POOL + (vi - N_SSD_IT);
            else if (vi < V_SYNC + N_SSD_IT) it = IT_M3 + (vi - V_SYNC);
            else if (vi < V_SYNC + N_SSD_IT + N_IT_SMP_SSD) it = IT_SSSD + (vi - V_SYNC - N_SSD_IT);
            else if (vi < V_SYNC + N_SSD_IT + N_IT_SMP_SSD + (N_IT_POOL - NFILL)) it = IT_POOL + NFILL + (vi - (V_SYNC + N_SSD_IT + N_IT_SMP_SSD));
            else it = IT_SGLA + (vi - (V_SYNC + N_SSD_IT + N_IT_SMP_SSD + (N_IT_POOL - NFILL)));
        }
        if (!synced && ((ngh > 0) ? (vi >= V_SYNC) : (it >= IT_M3))) { sub_barrier(C.subc, (unsigned)nw); ssd_scan(C, bx - ngh, nw, tid); sub_barrier(C.subc + 64, (unsigned)nw); synced = true; }
        int tidl = tid; asm volatile("" : "+v"(tidl));
        int kind, a, b0, mode = 0, sc0 = 0; bool smp = true;
        if (it < IT_SGLA) { const int j = (it < IT_M3) ? it : it - IT_M3; kind = 2; mode = (it < IT_M3) ? 2 : 3; sc0 = j & (TP / 64 - 1); a = (j >> 5) & 1; b0 = j >> 6; }
        else if (it < IT_SHG) { const int j = it - IT_SGLA; kind = 0; a = j & 3; b0 = (j >> 2) * 4; }
        else if (it < IT_SSSD) { const int j = it - IT_SHG; kind = 1; a = j & 3; b0 = (j >> 2) * 4; }
        else if (it < IT_POOL) { const int j = it - IT_SSSD; kind = 2; mode = 1; a = j & 1; b0 = (j >> 1) * 2; }
        else if (it < IT_GHP) { kind = 3; a = it - IT_POOL; b0 = 0; }
        else { const int j = it - IT_GHP; smp = false; b0 = j >> 3; kind = ((j & 7) < 4) ? 0 : 1; a = j & 3; }
        if (kind == 0) {
#ifndef MK_NO_GLA
            chain_gh<0>(ldsl, C, a, b0, smp, tidl);
#endif
        } else if (kind == 1) {
#ifndef MK_NO_HGRN
            chain_gh<1>(ldsl, C, a, b0, smp, tidl);
#endif
        } else if (kind == 2) {
#ifndef MK_NO_SSD
            chain_ssd(ldsl, C, a, b0, mode, sc0, tidl);
#endif
        } else {
#ifndef MK_NO_POOL
            pool_item(ldsl, C, a, tidl);
#endif
        }
        int want = 1;
#ifdef MK_DUP_POOL
        if (kind == 3) want = 2;
#endif
#ifdef MK_DUP_SMPGH
        if (kind < 2 && smp) want = 2;
#endif
#ifdef MK_DUP_SMPSSD
        if (kind == 2 && mode == 1) want = 2;
#endif
#ifdef MK_DUP_GHP
        if (!smp) want = 2;
#endif
#ifdef MK_DUP_M3
        if (kind == 2 && mode == 3) want = 2;
#endif
        if (++rep_it < want) vi -= step; else rep_it = 0;
    }
    if (!synced) { sub_barrier(C.subc, (unsigned)nw); ssd_scan(C, bx - ngh, nw, tid); sub_barrier(C.subc + 64, (unsigned)nw); }
}

__device__ __forceinline__ void srg_phase(LAS unsigned char* L, const bf16* Aop, const bf16* Bt, const int K, bf16* xb, float* rowss, const float scale, const bool fin, const int G, const int tid) {
    const int w = __builtin_amdgcn_readfirstlane(tid >> 6), lane = tid & 63, q = lane >> 4, r16 = lane & 15, wm = w >> 1, wn = w & 1;
    const int lr = tid >> 3, lc = (tid & 7) * 8;
    const int nt = K / 128;
    for (int tile = blockIdx.x; tile < 256; tile += G) {
        const int tm = tile >> 4, tn = tile & 15;
        const bf16* ag = Aop + (size_t)(MP + 64 * tm + lr) * K + lc;
        const bf16* bg = Bt + (size_t)(64 * tn + lr) * K + lc;
        f32x4 acc0 = {0.f, 0.f, 0.f, 0.f}, acc1 = acc0;
        v4u ra[2][2], rb[2][2];
#pragma unroll
        for (int i = 0; i < 2; ++i) { ra[i][0] = *(const v4u*)(ag + i * 128); ra[i][1] = *(const v4u*)(ag + i * 128 + 64); rb[i][0] = *(const v4u*)(bg + i * 128); rb[i][1] = *(const v4u*)(bg + i * 128 + 64); }
        LAS unsigned char* wr0 = L + lr * 272 + lc * 2;
        const LAS unsigned char* fa = L + (16 * wm + r16) * 272 + (8 * q) * 2;
        const LAS unsigned char* fb = L + 17408 + (32 * wn + r16) * 272 + (8 * q) * 2;
#pragma unroll 1
        for (int t = 0; t < nt; t += 2) {
#pragma unroll
            for (int i = 0; i < 2; ++i) {
                LAS unsigned char* wb_ = wr0 + i * 34816;
                *(LAS v4u*)(wb_) = ra[i][0]; *(LAS v4u*)(wb_ + 128) = ra[i][1]; *(LAS v4u*)(wb_ + 17408) = rb[i][0]; *(LAS v4u*)(wb_ + 17408 + 128) = rb[i][1];
                { const int tn2 = (t + 2 + i < nt) ? t + 2 + i : i; const bf16* a2 = ag + (size_t)tn2 * 128; const bf16* b2 = bg + (size_t)tn2 * 128;
                  ra[i][0] = *(const v4u*)a2; ra[i][1] = *(const v4u*)(a2 + 64); rb[i][0] = *(const v4u*)b2; rb[i][1] = *(const v4u*)(b2 + 64); }
                __syncthreads();
#pragma unroll
                for (int ks = 0; ks < 4; ++ks) {
                    const bf16x8 af = frag16(fa + i * 34816 + ks * 64), b0 = frag16(fb + i * 34816 + ks * 64), b1 = frag16(fb + i * 34816 + 16 * 272 + ks * 64);
                    acc0 = MFMA16(b0, af, acc0); acc1 = MFMA16(b1, af, acc1);
                }
            }
        }
        {
            const int row = MP + 64 * tm + 16 * wm + r16, col0 = 64 * tn + 32 * wn + 4 * q;
            bf16* px = xb + (size_t)row * D + col0;
            const v2u xa = *(const v2u*)px, xc = *(const v2u*)(px + 16);
            const float a0 = __builtin_bit_cast(float, xa.x << 16) + acc0[0] * scale, a1 = __builtin_bit_cast(float, xa.x & 0xffff0000u) + acc0[1] * scale, a2 = __builtin_bit_cast(float, xa.y << 16) + acc0[2] * scale, a3 = __builtin_bit_cast(float, xa.y & 0xffff0000u) + acc0[3] * scale;
            const float b0 = __builtin_bit_cast(float, xc.x << 16) + acc1[0] * scale, b1 = __builtin_bit_cast(float, xc.x & 0xffff0000u) + acc1[1] * scale, b2 = __builtin_bit_cast(float, xc.y << 16) + acc1[2] * scale, b3 = __builtin_bit_cast(float, xc.y & 0xffff0000u) + acc1[3] * scale;
            v2u wa, wb; wa.x = cvtpk(a0, a1); wa.y = cvtpk(a2, a3); wb.x = cvtpk(b0, b1); wb.y = cvtpk(b2, b3);
            *(v2u*)px = wa; *(v2u*)(px + 16) = wb;
            float ss = 0.f;
#pragma unroll
            for (int k = 0; k < 2; ++k) { const unsigned pa = wa[k], pb = wb[k]; const float r0 = __builtin_bit_cast(float, pa << 16), r1 = __builtin_bit_cast(float, pa & 0xffff0000u), r2 = __builtin_bit_cast(float, pb << 16), r3 = __builtin_bit_cast(float, pb & 0xffff0000u); ss += (r0 * r0 + r1 * r1) + (r2 * r2 + r3 * r3); }
            ss += __shfl_xor(ss, 16); ss += __shfl_xor(ss, 32);
            if (q == 0 && fin) unsafeAtomicAdd(rowss + row, ss);
        }
        __syncthreads();
    }
}

__device__ __forceinline__ void final_phase(const Args& A, int wave, int lane, int G) {
    const int gw = blockIdx.x * NWAVES + wave, NGW = G * NWAVES;
    const float* rss = (const float*)(A.ws + WS_RSS) + (size_t)6 * M; const f32x4* gn = (const f32x4*)A.in[I_FINALN] + lane; const bf16* xb = (const bf16*)(A.ws + WS_XB);
    f32x4 g4[4];
#pragma unroll
    for (int j = 0; j < 4; ++j) g4[j] = gn[64 * j];
    for (int m0 = gw; m0 < M; m0 += 2 * NGW) {
        const int m1 = m0 + NGW; const bool two = m1 < M; const int m1c = two ? m1 : m0;
        const float q0 = rss[m0], q1 = rss[m1c];
        const v2u* x0 = (const v2u*)(xb + (size_t)m0 * D) + lane; const v2u* x1 = (const v2u*)(xb + (size_t)m1c * D) + lane;
        v2u w0[4], w1[4];
#pragma unroll
        for (int j = 0; j < 4; ++j) { w0[j] = x0[64 * j]; w1[j] = x1[64 * j]; }
        const float r0 = rsqrtf(q0 * (1.0f / 1024.0f) + 1e-6f), r1 = rsqrtf(q1 * (1.0f / 1024.0f) + 1e-6f);
        f32x4* y0 = (f32x4*)(A.out + (size_t)m0 * D) + lane; f32x4* y1 = (f32x4*)(A.out + (size_t)m1c * D) + lane;
#pragma unroll
        for (int j = 0; j < 4; ++j) { const v2u w = w0[j]; const f32x4 v = {__builtin_bit_cast(float, w.x << 16), __builtin_bit_cast(float, w.x & 0xffff0000u), __builtin_bit_cast(float, w.y << 16), __builtin_bit_cast(float, w.y & 0xffff0000u)};
            y0[64 * j] = v * r0 * g4[j]; }
        if (two) {
#pragma unroll
            for (int j = 0; j < 4; ++j) { const v2u w = w1[j]; const f32x4 v = {__builtin_bit_cast(float, w.x << 16), __builtin_bit_cast(float, w.x & 0xffff0000u), __builtin_bit_cast(float, w.y << 16), __builtin_bit_cast(float, w.y & 0xffff0000u)};
                y1[64 * j] = v * r1 * g4[j]; }
        }
    }
}

__device__ __forceinline__ void side_convert(const Args& A, LAS unsigned char* ldsl, const int tidv, const int first, const int G, const CvtList Lst) {
    const int wv = __builtin_amdgcn_readfirstlane(tidv >> 6);
    if (first > 0 && first < G) { if ((int)blockIdx.x >= first) convert_weights(A, ldsl, wv, tidv & 63, Lst, ((int)blockIdx.x - first) * NWAVES + wv, (G - first) * NWAVES); }
    else convert_weights(A, ldsl, wv, tidv & 63, Lst, (int)blockIdx.x * NWAVES + wv, G * NWAVES);
}
__device__ __forceinline__ int sub_of(int ph) { const int j = (ph - 1) & 7; return (j < 3) ? j : (j == 3 ? 7 : j - 1); }
__global__ void __launch_bounds__(NTHREADS, 2) mk_fwd(Args args) {
    extern __shared__ __attribute__((aligned(16))) unsigned char lds[];
    LAS unsigned char* ldsl = (LAS unsigned char*)lds;
    volatile LAS unsigned* MISC = (volatile LAS unsigned*)(ldsl + MISC_OFF);
    const int tid = threadIdx.x, lane = tid & 63, wave = __builtin_amdgcn_readfirstlane(tid >> 6), G = gridDim.x;
    unsigned char* ws = args.ws;
    gu32* ctl = (gu32*)(ws + WS_CTL);
    for (int u = tid; u < (LDS_BYTES - LDSCTL_OFF) / 4; u += NTHREADS) ((LAS unsigned*)(ldsl + LDSCTL_OFF))[u] = 0u;
    __syncthreads();
    const int lo = args.ph_lo, hi = args.ph_hi;
    XcdBarrier bar; bar.bar = (unsigned*)(ctl + CW_BAR); bar.x = 0; bar.st = nullptr;
    if (hi - lo > 1) bar = xcd_barrier_post((unsigned*)(ctl + CW_BAR), MISC + 8);

    bf16* xb = (bf16*)(ws + WS_XB); bf16* mixb = (bf16*)(ws + WS_MIX); bf16* hp = (bf16*)(ws + WS_HP);
    float* rss = (float*)(ws + WS_RSS);

    bool first = true;
    for (int si = 2 * lo; si < 2 * hi; ++si) {
        const int ph = si >> 1;
        if (si & 1) {
            bool dup = false;
#ifdef MK_DUP_P0
            dup = dup || (ph == 0);
#endif
#ifdef MK_DUP_MIX
            dup = dup || (ph >= 1 && ph < N_PHASES - 1 && sub_of(ph) == 3);
#endif
#ifdef MK_DUP_GU
            dup = dup || (ph >= 1 && ph < N_PHASES - 1 && (sub_of(ph) == 0 || sub_of(ph) == 5));
#endif
#ifdef MK_DUP_RESID
            dup = dup || (ph >= 1 && ph < N_PHASES - 1 && (sub_of(ph) == 1 || sub_of(ph) == 4 || sub_of(ph) == 6));
#endif
#ifdef MK_DUP_IN
            dup = dup || (ph >= 1 && ph < N_PHASES - 1 && sub_of(ph) == 2);
#endif
            if (!dup) continue;
        }
        if (!first) xcd_barrier(bar);
        first = false;
        int tidv = threadIdx.x; asm volatile("" : "+v"(tidv));
        if (ph == 0) {
#ifndef MK_NO_P0
            p0_prologue(args, ldsl, __builtin_amdgcn_readfirstlane(tidv >> 6), tidv & 63, G);
#endif
        }
        else if (ph == N_PHASES - 1) { final_phase(args, __builtin_amdgcn_readfirstlane(tidv >> 6), tidv & 63, G); }
        else {
            const int l = (ph - 1) / 8, s = sub_of(ph);
            CvtList side = {0, 0, 0, 0, 0, 0, 0, 0}; int side_first = 0;
            const unsigned char* wl = ws + WS_W + (size_t)l * W_LAYER;
            if (s == 0 || s == 5) {
                pg8::Gemm g{xb, (const bf16*)(wl + (s == 0 ? WO_GU1 : WO_GU2)), M, NGU, D}; pg8::StaticOrder S; S.init(M, NGU, G, (int)blockIdx.x);
                bool gdry = false;
#ifdef MK_DRY_GU
                gdry = (si & 1) == 0;
#endif
                pg8::EpiSwiGLU E{hp, FF, rss + (size_t)(3 * l + (s == 0 ? 0 : 2)) * M, gdry};
#ifndef MK_NO_G1
                pg8::gemm_phase<pg8::EpiSwiGLU, pg8::StaticOrder, PG8_ALIGN, PG8_SP2>(ldsl + RING_OFF, g, S, E, tidv);
#endif
                side = (l == 0) ? ((s == 0) ? CV_GU1_L0 : CV_GU2_L0) : ((s == 0) ? CV_GU1_L1 : CvtList{0, 0, 0, 0, 0, 0, 0, 0}); side_first = ((M / 256) * (NGU / 256)) % G;
            } else if (s == 1 || s == 4 || s == 6) {
                const bf16* Aop = (s == 4) ? mixb : hp; const int K = (s == 4) ? D : FF;
                const size_t wo = (s == 1) ? WO_D1 : (s == 4) ? WO_OUT : WO_D2;
                pg8::Gemm g{Aop, (const bf16*)(wl + wo), MP, D, K}; pg8::StaticOrder S; S.init(MP, D, G, (int)blockIdx.x);
                float* rso = rss + (size_t)(3 * l + (s == 1 ? 1 : (s == 4 ? 2 : 3))) * M;
                const float rscale = (s == 4) ? 1.0f : 0.5f;
                float esc = rscale; bool efin = true;
#ifdef MK_DUP_RESID
                esc = 0.5f * rscale; efin = (si & 1) != 0;
#endif
                pg8::EpiResid E{xb, rso, esc, efin};
#ifndef MK_NO_G2
                const bool srg_first = (blockIdx.x & 1) != 0;
                if (srg_first) srg_phase(ldsl + RING_OFF, Aop, (const bf16*)(wl + wo), K, xb, rso, esc, efin, G, tidv);
                pg8::gemm_phase<pg8::EpiResid, pg8::StaticOrder, PG8_ALIGN, PG8_SP2>(ldsl + RING_OFF, g, S, E, tidv);
                if (!srg_first)
#ifdef MK_DUP_SRG
                srg_phase(ldsl + RING_OFF, Aop, (const bf16*)(wl + wo), K, xb, rso, 0.5f * esc, false, G, tidv);
                srg_phase(ldsl + RING_OFF, Aop, (const bf16*)(wl + wo), K, xb, rso, 0.5f * esc, efin, G, tidv);
#else
                srg_phase(ldsl + RING_OFF, Aop, (const bf16*)(wl + wo), K, xb, rso, esc, efin, G, tidv);
#endif
#endif
            } else if (s == 2) {
                pg8::Gemm g{xb, (const bf16*)(wl + WO_IN), M, NINP, D}; pg8::StaticOrder S; S.init(M, NINP, G, (int)blockIdx.x);
                pg8::EpiProj E{hp, NINP, rss + (size_t)(3 * l + 1) * M};
#ifndef MK_NO_G3
                pg8::gemm_phase<pg8::EpiProj, pg8::StaticOrder, PG8_ALIGN, PG8_SP2>(ldsl + RING_OFF, g, S, E, tidv);
#endif
                side = (l == 0) ? CV_IN_L0 : CV_IN_L1; side_first = ((M / 256) * (NINP / 256)) % G;
            } else {
                MixP C;
                C.P = hp; C.mixb = mixb; C.out = args.out; C.l = l; C.XC = (bf16*)args.out;
                C.DS = args.out + 8388608; C.ESC = args.out + 16900000; C.subc = (unsigned*)(ctl + CW_SUB + 128 * l);
                C.s_pool = args.in[I_SPOOL] + (size_t)l * BS * 15 * 256; C.s_gla = args.in[I_SGLA] + (size_t)l * BS * 4 * 32 * 64; C.s_hgrn = args.in[I_SHGRN] + (size_t)l * BS * 4 * 64 * 64;
                C.s_ssm = args.in[I_SSSM] + (size_t)l * BS * 4 * 64 * 128; C.s_conv = args.in[I_SCONV] + (size_t)l * BS * 3 * 768;
                C.pool_w = args.in[I_POOLW] + (size_t)l * 4 * 64 * 64; C.pool_scale = args.in[I_POOLS] + l * 256; C.gla_wg = args.in[I_GLAWG] + l * 16 * 128; C.gla_b = args.in[I_GLAB] + l * 128;
                C.gla_n = args.in[I_GLAN] + l * 64; C.lbl = args.in[I_LBL]; C.hg_n = args.in[I_HGN] + l * 64; C.conv_w = args.in[I_CONVW] + l * 4 * 768; C.conv_b = args.in[I_CONVB] + l * 768;
                C.dt_b = args.in[I_DTB] + l * 4; C.a_log = args.in[I_ALOG] + l * 4; C.ssm_d = args.in[I_SSMD] + l * 4; C.ssm_n = args.in[I_SSMN] + l * 256;
#ifndef MK_NO_MIXER
                if (s == 7) conv_phase(C, G, tidv); else mixer_phase(lds + RING_OFF, ldsl + RING_OFF, C, G, tidv);
#endif
            }
            if (side.n0 + side.n1 > 0) side_convert(args, ldsl, tidv, side_first, G, side);
        }
    }
}

extern "C" void kernel_launch(void* const* d_in, const int* in_sizes, int n_in, void* d_out, int out_size, void* d_ws, size_t ws_size, hipStream_t stream) {
    static int grid = 0;
    if (grid == 0) {
        if (n_in != N_INPUTS || in_sizes[0] != MP * D || (size_t)out_size != O_END || ws_size < WS_END) {
            fprintf(stderr, "kernel_launch: shape mismatch: n_in %d, in0 %d, out %d, ws %zu (need %zu); nothing launched\n", n_in, n_in > 0 ? in_sizes[0] : -1, out_size, ws_size, (size_t)WS_END); grid = -1; return; }
        int dev = 0, cus = 0, per_cu = 0;
        if (hipGetDevice(&dev) != hipSuccess || hipDeviceGetAttribute(&cus, hipDeviceAttributeMultiprocessorCount, dev) != hipSuccess) { fprintf(stderr, "kernel_launch: device query failed\n"); grid = -1; return; }
        if (hipFuncSetAttribute((const void*)mk_fwd, hipFuncAttributeMaxDynamicSharedMemorySize, LDS_BYTES) != hipSuccess) { fprintf(stderr, "kernel_launch: hipFuncSetAttribute failed\n"); grid = -1; return; }
        if (hipOccupancyMaxActiveBlocksPerMultiprocessor(&per_cu, (const void*)mk_fwd, NTHREADS, LDS_BYTES) != hipSuccess || per_cu < 1) {
            fprintf(stderr, "kernel_launch: occupancy query reports %d workgroups per CU; nothing launched\n", per_cu); (void)hipGetLastError(); grid = -1; return; }
        grid = cus;
    }
    if (grid < 0) return;
    if (hipMemsetAsync((char*)d_ws + WS_CTL, 0, CTL_ZERO_BYTES, stream) != hipSuccess) { fprintf(stderr, "kernel_launch: hipMemsetAsync failed\n"); return; }
    Args a{};
    for (int i = 0; i < N_INPUTS; ++i) a.in[i] = (const float*)d_in[i];
    a.out = (float*)d_out; a.ws = (unsigned char*)d_ws;
    for (int li = 0; li < N_LAUNCHES; ++li) {
        a.ph_lo = (N_LAUNCHES == 1) ? 0 : li; a.ph_hi = (N_LAUNCHES == 1) ? N_PHASES : li + 1;
        hipLaunchKernelGGL(mk_fwd, dim3(grid), dim3(NTHREADS), LDS_BYTES, stream, a);
        const hipError_t le = hipPeekAtLastError();
        if (le != hipSuccess) { fprintf(stderr, "kernel_launch: launch %d failed: %s\n", li, hipGetErrorName(le)); break; }
    }
}
```

```cpp
#include <hip/hip_runtime.h>
#include <cstdio>
#include <cstdint>
namespace pg8 {
#define PG8_LAS __attribute__((address_space(3)))
typedef unsigned short bf16_t;
typedef short bf16x8 __attribute__((ext_vector_type(8)));
typedef float f32x4 __attribute__((ext_vector_type(4)));
typedef unsigned u32x4 __attribute__((ext_vector_type(4)));
constexpr int BM = 256, BK = 64, HALF = 128, HTB = HALF * BK * 2  , STAGE_BYTES = 8 * HTB, NXCD = 8, WGM = 8;

__host__ __device__ __forceinline__ int lds_byte(int r, int c) { const int st = (r >> 4) * 2 + (c >> 5), rr = r & 15, cc = c & 31, ob = rr * 64 + cc * 2; return st * 1024 + (ob ^ (((ob >> 9) & 1) << 5)); }
__host__ __device__ __forceinline__ void stage_rc(int b, int& R, int& C) { const int st = b / 1024, sb = b % 1024, swz = sb ^ (((sb >> 9) & 1) << 5); R = (st >> 1) * 16 + swz / 64; C = (st & 1) * 32 + (swz % 64) / 2; }
__host__ __device__ __forceinline__ int perm32(int rho) { const int n = rho >> 4, i = rho & 15; return 8 * (i >> 2) + 4 * n + (i & 3); }

struct Unit { int pm, pn; };
struct Gemm { const bf16_t* A; const bf16_t* Bt; int M, N, K; };

struct StaticOrder {
    int nM, nN, nwg, G, c;
    __host__ __device__ void init(int M, int N, int G_, int c_) { nM = M / BM; nN = N / BM; nwg = nM * nN; G = G_; c = c_; }
    __host__ __device__ bool next(int i, Unit& u) const {
        const long L = (long)i * G + c; if (L >= nwg) return false;
        int wgid = (int)L; { const int q = nwg / NXCD, r = nwg % NXCD, xcd = wgid % NXCD, off = wgid / NXCD; wgid = (xcd < r ? xcd * (q + 1) : r * (q + 1) + (xcd - r) * q) + off; }
        const int nig = WGM * nN, gid = wgid / nig, fm = gid * WGM, gsz = (nM - fm) < WGM ? (nM - fm) : WGM;
        u.pm = fm + ((wgid % nig) % gsz); u.pn = (wgid % nig) / gsz; return true;
    }
    __device__ __forceinline__ void a_ready(const Unit&) const {}
    __device__ __forceinline__ void done(const Unit&) const {}
};
__device__ __forceinline__ unsigned cvt_pk_bf16(float lo, float hi) { unsigned r; asm volatile("v_cvt_pk_bf16_f32 %0, %1, %2" : "=v"(r) : "v"(lo), "v"(hi)); return r; }
template <class Epi, class Sched, bool ALIGN_EPI = false, bool SP2 = false>
__device__ __forceinline__ void gemm_phase(PG8_LAS unsigned char* lds, const Gemm g, const Sched& S, const Epi& E, const int tid_in) {
    const int tid = tid_in, wid = __builtin_amdgcn_readfirstlane(tid >> 6), lane = tid & 63, wr = wid >> 2, wc = wid & 3, fr = lane & 15, fq = lane >> 4;
    const int K = g.K, nt = K / BK;
    unsigned voffA[2], voffB[2];
#pragma unroll
    for (int i = 0; i < 2; ++i) { int R, C; stage_rc(tid * 16 + i * 8192, R, C); const int Rb = Epi::PERM ? ((R & ~31) + perm32(R & 31)) : R;
        voffA[i] = (unsigned)(R * K + C) * 2u; voffB[i] = (unsigned)(Rb * K + C) * 2u; }
    const size_t kstep = (size_t)(BK * 2);
    const size_t hstep = (size_t)HALF * K * 2;
    const size_t tstep = 2 * hstep;
    const unsigned ldsw = (unsigned)wid * 1024u;
    const int aoff = lds_byte(wr * 64 + fr, fq * 8), boff = lds_byte(wc * 32 + fr, fq * 8);
#define PG8_SA(b, h) (((b) * 2 + (h)) * HTB)
#define PG8_SB(b, h) ((4 + (b) * 2 + (h)) * HTB)
#define PG8_STAGE(bufoff, gbase, voff) do { _Pragma("unroll") for (int _i = 0; _i < 2; ++_i) \
        __builtin_amdgcn_global_load_lds((const unsigned*)((const char*)(gbase) + (voff)[_i]), (PG8_LAS unsigned*)(lds + (bufoff) + ldsw + _i * 8192), 16, 0, 0); } while (0)
#define PG8_LDA(dst, b, h) do { _Pragma("unroll") for (int m = 0; m < 4; ++m) _Pragma("unroll") for (int k = 0; k < 2; ++k) dst[m][k] = *(const PG8_LAS bf16x8*)(lds + PG8_SA(b, h) + aoff + m * 2048 + k * 1024); } while (0)
#define PG8_LDB(dst, b, h) do { _Pragma("unroll") for (int n = 0; n < 2; ++n) _Pragma("unroll") for (int k = 0; k < 2; ++k) dst[n][k] = *(const PG8_LAS bf16x8*)(lds + PG8_SB(b, h) + boff + n * 2048 + k * 1024); } while (0)
#define PG8_MMA(ai, bj, At, Bt) do { __builtin_amdgcn_s_setprio(1); _Pragma("unroll") for (int m = 0; m < 4; ++m) _Pragma("unroll") for (int n = 0; n < 2; ++n) _Pragma("unroll") for (int k = 0; k < 2; ++k) \
        acc[ai][bj][m][n] = __builtin_amdgcn_mfma_f32_16x16x32_bf16(Bt[n][k], At[m][k], acc[ai][bj][m][n], 0, 0, 0); __builtin_amdgcn_s_setprio(0); } while (0)
#define PG8_WAIT_V(n) asm volatile("s_waitcnt vmcnt(" #n ")" ::: "memory")
#define PG8_WAIT_L(n) asm volatile("s_waitcnt lgkmcnt(" #n ")" ::: "memory")
#define PG8_BAR __builtin_amdgcn_s_barrier()
#define PG8_SCHED __builtin_amdgcn_sched_barrier(0)
    Unit cur, nxt; int ui = 0;
    if (!S.next(0, cur)) return;
    f32x4 acc[2][2][4][2];
#pragma unroll
    for (int a = 0; a < 2; ++a)
#pragma unroll
        for (int b = 0; b < 2; ++b)
#pragma unroll
            for (int m = 0; m < 4; ++m)
#pragma unroll
                for (int n = 0; n < 2; ++n) acc[a][b][m][n] = (f32x4){0.f, 0.f, 0.f, 0.f};
    bf16x8 At[4][2], B0[2][2], B1[2][2];
    const char* cA = (const char*)g.A + (size_t)cur.pm * tstep; const char* cB = (const char*)g.Bt + (size_t)cur.pn * tstep;
    S.a_ready(cur);
    if constexpr (SP2) {
        PG8_STAGE(PG8_SB(0, 0), cB, voffB); PG8_STAGE(PG8_SB(0, 1), cB + hstep, voffB); PG8_STAGE(PG8_SA(0, 0), cA, voffA); PG8_STAGE(PG8_SA(0, 1), cA + hstep, voffA);
        if (wr == 1) PG8_BAR;
        PG8_WAIT_V(2); PG8_BAR;
        PG8_STAGE(PG8_SB(1, 0), cB + kstep, voffB); PG8_STAGE(PG8_SA(1, 0), cA + kstep, voffA); PG8_STAGE(PG8_SB(1, 1), cB + hstep + kstep, voffB);
        PG8_WAIT_V(6); PG8_BAR;
    } else {
        PG8_STAGE(PG8_SB(0, 0), cB, voffB); PG8_STAGE(PG8_SA(0, 0), cA, voffA); PG8_STAGE(PG8_SB(0, 1), cB + hstep, voffB); PG8_STAGE(PG8_SA(0, 1), cA + hstep, voffA);
        if (wr == 1) PG8_BAR;
        PG8_WAIT_V(4); PG8_BAR;
        PG8_STAGE(PG8_SB(1, 0), cB + kstep, voffB); PG8_STAGE(PG8_SA(1, 0), cA + kstep, voffA); PG8_STAGE(PG8_SB(1, 1), cB + hstep + kstep, voffB);
        PG8_WAIT_V(6); PG8_BAR;
    }
    for (;;) {
        const bool has_next = S.next(ui + 1, nxt);
        const char* nA = has_next ? (const char*)g.A + (size_t)nxt.pm * tstep : cA; const char* nB = has_next ? (const char*)g.Bt + (size_t)nxt.pn * tstep : cB;
        for (int t = 0; t < nt; t += 2) {
            const bool last = (t == nt - 2);
            const char* a1 = cA + (size_t)(t + 1) * kstep;
            const char* a2 = last ? nA : cA + (size_t)(t + 2) * kstep; const char* b2 = last ? nB : cB + (size_t)(t + 2) * kstep;
            const char* a3 = a2 + kstep; const char* b3 = b2 + kstep;
            if (last && has_next) S.a_ready(nxt);
            if constexpr (SP2) {
            PG8_LDB(B0, 0, 0); PG8_LDB(B1, 0, 1); PG8_SCHED; PG8_LDA(At, 0, 0); PG8_STAGE(PG8_SA(1, 1), a1 + hstep, voffA);
            PG8_WAIT_V(8); PG8_WAIT_L(0); PG8_BAR; PG8_MMA(0, 0, At, B0); PG8_MMA(0, 1, At, B1); PG8_BAR; PG8_SCHED;
            PG8_LDA(At, 0, 1); PG8_STAGE(PG8_SB(0, 0), b2, voffB); PG8_STAGE(PG8_SB(0, 1), b2 + hstep, voffB); PG8_STAGE(PG8_SA(0, 0), a2, voffA);
            PG8_WAIT_V(8); PG8_WAIT_L(0); PG8_BAR; PG8_MMA(1, 0, At, B0); PG8_MMA(1, 1, At, B1); PG8_BAR; PG8_SCHED;
            PG8_LDB(B0, 1, 0); PG8_LDB(B1, 1, 1); PG8_SCHED; PG8_LDA(At, 1, 0); PG8_STAGE(PG8_SA(0, 1), a2 + hstep, voffA);
            PG8_WAIT_V(8); PG8_WAIT_L(0); PG8_BAR; PG8_MMA(0, 0, At, B0); PG8_MMA(0, 1, At, B1); PG8_BAR; PG8_SCHED;
            PG8_LDA(At, 1, 1); PG8_STAGE(PG8_SB(1, 0), b3, voffB); PG8_STAGE(PG8_SB(1, 1), b3 + hstep, voffB); PG8_STAGE(PG8_SA(1, 0), a3, voffA);
            PG8_WAIT_V(8); PG8_WAIT_L(0); PG8_BAR; PG8_MMA(1, 0, At, B0); PG8_MMA(1, 1, At, B1); PG8_BAR; PG8_SCHED;
            } else {
            PG8_LDB(B0, 0, 0); PG8_SCHED; PG8_LDA(At, 0, 0); PG8_STAGE(PG8_SA(1, 1), a1 + hstep, voffA);
            PG8_WAIT_L(8); PG8_BAR; PG8_WAIT_L(0); PG8_MMA(0, 0, At, B0); PG8_BAR; PG8_SCHED;
            PG8_LDB(B1, 0, 1); PG8_STAGE(PG8_SB(0, 0), b2, voffB);
            PG8_BAR; PG8_WAIT_L(0); PG8_MMA(0, 1, At, B1); PG8_BAR;
            PG8_LDA(At, 0, 1); PG8_STAGE(PG8_SA(0, 0), a2, voffA);
            PG8_BAR; PG8_WAIT_L(0); PG8_MMA(1, 0, At, B0); PG8_BAR; PG8_SCHED;
            PG8_STAGE(PG8_SB(0, 1), b2 + hstep, voffB);
            PG8_WAIT_V(6); PG8_BAR; PG8_MMA(1, 1, At, B1); PG8_BAR;
            PG8_LDB(B0, 1, 0); PG8_SCHED; PG8_LDA(At, 1, 0); PG8_STAGE(PG8_SA(0, 1), a2 + hstep, voffA);
            PG8_WAIT_L(8); PG8_BAR; PG8_WAIT_L(0); PG8_MMA(0, 0, At, B0); PG8_BAR; PG8_SCHED;
            PG8_LDB(B1, 1, 1); PG8_STAGE(PG8_SB(1, 0), b3, voffB);
            PG8_BAR; PG8_WAIT_L(0); PG8_MMA(0, 1, At, B1); PG8_BAR;
            PG8_LDA(At, 1, 1); PG8_STAGE(PG8_SA(1, 0), a3, voffA);
            PG8_BAR; PG8_WAIT_L(0); PG8_MMA(1, 0, At, B0); PG8_BAR; PG8_SCHED;
            PG8_STAGE(PG8_SB(1, 1), b3 + hstep, voffB);
            PG8_WAIT_V(6); PG8_BAR; PG8_MMA(1, 1, At, B1); PG8_BAR;
            }
        }
        if constexpr (ALIGN_EPI) { if (wr == 0) PG8_BAR; }
        if constexpr (!Epi::AFTER_DRAIN) { E(acc, cur, wr, wc, fr, fq); S.done(cur); }
        if (!has_next) break;
#pragma unroll
        for (int a = 0; a < 2; ++a)
#pragma unroll
            for (int b = 0; b < 2; ++b)
#pragma unroll
                for (int m = 0; m < 4; ++m)
#pragma unroll
                    for (int n = 0; n < 2; ++n) acc[a][b][m][n] = (f32x4){0.f, 0.f, 0.f, 0.f};
        cur = nxt; cA = nA; cB = nB; ++ui;
        if constexpr (ALIGN_EPI) { if (wr == 1) PG8_BAR; }
    }
    PG8_WAIT_V(0);
    if constexpr (!ALIGN_EPI) { if (wr == 0) PG8_BAR; }
    PG8_BAR;
    if constexpr (Epi::AFTER_DRAIN) { E.fused(acc, cur, wr, wc, fr, fq, lds, wid, lane); S.done(cur); }
#undef PG8_SA
#undef PG8_SB
#undef PG8_STAGE
#undef PG8_LDA
#undef PG8_LDB
#undef PG8_MMA
#undef PG8_WAIT_V
#undef PG8_WAIT_L
#undef PG8_BAR
#undef PG8_SCHED
}
}

#ifndef PG8_SP2
#define PG8_SP2 true
#endif
#ifndef PG8_ALIGN
#define PG8_ALIGN true
#endif
namespace pg8 {
constexpr float RMS_EPS = 1e-6f;
__device__ __forceinline__ float silu_f(float x) { return x * __builtin_amdgcn_rcpf(1.0f + __expf(-x)); }
typedef float f32x2n __attribute__((ext_vector_type(2)));
typedef __bf16 bf16x2n __attribute__((ext_vector_type(2)));
__device__ __forceinline__ unsigned cvt2_bf16(float lo, float hi) { const f32x2n v = {lo, hi}; return __builtin_bit_cast(unsigned, __builtin_convertvector(v, bf16x2n)); }

struct EpiSwiGLU {
    static constexpr bool PERM = true, AFTER_DRAIN = false;
    bf16_t* H; int ldh; const float* rowss; bool dry;
    __device__ __forceinline__ void operator()(const f32x4 (&acc)[2][2][4][2], const Unit& u, int wr, int wc, int fr, int fq) const {
        if (dry) { asm volatile("" :: "v"(acc[0][0][0][0]), "v"(acc[1][1][3][1])); return; }
        const int row0 = u.pm * BM + wr * 64 + fr, col0 = u.pn * HALF + wc * 32 + 8 * fq;
        float rs[2][4];
#pragma unroll
        for (int ai = 0; ai < 2; ++ai)
#pragma unroll
            for (int m = 0; m < 4; ++m) rs[ai][m] = rowss[row0 + ai * HALF + m * 16];
#pragma unroll
        for (int ai = 0; ai < 2; ++ai)
#pragma unroll
            for (int m = 0; m < 4; ++m) {
                const int row = row0 + ai * HALF + m * 16;
                const float ms = rs[ai][m] * (1.0f / 1024.0f) + RMS_EPS, c1 = -1.4426950408889634f * rsqrtf(ms);
                const f32x4 g0 = acc[ai][0][m][0], g1 = acc[ai][0][m][1], u0 = acc[ai][1][m][0], u1 = acc[ai][1][m][1];
                const f32x4 t0 = g0 * c1, t1 = g1 * c1; f32x4 e0, e1, i0, i1;
#pragma unroll
                for (int e = 0; e < 4; ++e) { e0[e] = __builtin_amdgcn_exp2f(t0[e]); e1[e] = __builtin_amdgcn_exp2f(t1[e]); }
                const f32x4 d0 = e0 * ms + ms, d1 = e1 * ms + ms;
#pragma unroll
                for (int e = 0; e < 4; ++e) { i0[e] = __builtin_amdgcn_rcpf(d0[e]); i1[e] = __builtin_amdgcn_rcpf(d1[e]); }
                const f32x4 h0 = (g0 * u0) * i0, h1 = (g1 * u1) * i1;
                u32x4 w; w.x = cvt2_bf16(h0[0], h0[1]); w.y = cvt2_bf16(h0[2], h0[3]); w.z = cvt2_bf16(h1[0], h1[1]); w.w = cvt2_bf16(h1[2], h1[3]);
                *(u32x4*)(H + (size_t)row * ldh + col0) = w;
            }
    }
};
struct EpiResid {
    static constexpr bool PERM = true, AFTER_DRAIN = false;
    bf16_t* xb; float* rowss; float scale; bool fin;
    __device__ __forceinline__ void operator()(const f32x4 (&acc)[2][2][4][2], const Unit& u, int wr, int wc, int fr, int fq) const {
        const int row0 = u.pm * BM + wr * 64 + fr, col0 = u.pn * BM + wc * 32 + 8 * fq;
        u32x4 xv[2][4][2];
#pragma unroll
        for (int ai = 0; ai < 2; ++ai)
#pragma unroll
            for (int m = 0; m < 4; ++m)
#pragma unroll
                for (int bj = 0; bj < 2; ++bj) xv[ai][m][bj] = *(const u32x4*)(xb + (size_t)(row0 + ai * HALF + m * 16) * 1024 + col0 + bj * HALF);
        float ssv[2][4];
#pragma unroll
        for (int ai = 0; ai < 2; ++ai)
#pragma unroll
            for (int m = 0; m < 4; ++m) {
                const int row = row0 + ai * HALF + m * 16;
                float ss = 0.f;
#pragma unroll
                for (int bj = 0; bj < 2; ++bj) {
                    const u32x4 xo = xv[ai][m][bj]; u32x4 w;
#pragma unroll
                    for (int k = 0; k < 4; ++k) {
                        const float a0 = __uint_as_float(xo[k] << 16) + acc[ai][bj][m][k >> 1][(k & 1) * 2] * scale, a1 = __uint_as_float(xo[k] & 0xffff0000u) + acc[ai][bj][m][k >> 1][(k & 1) * 2 + 1] * scale;
                        const unsigned p = cvt_pk_bf16(a0, a1); w[k] = p;
                        const float r0 = __uint_as_float(p << 16), r1 = __uint_as_float(p & 0xffff0000u); ss += r0 * r0 + r1 * r1;
                    }
                    *(u32x4*)(xb + (size_t)row * 1024 + col0 + bj * HALF) = w;
                }
                ssv[ai][m] = ss;
            }
#pragma unroll
        for (int ai = 0; ai < 2; ++ai)
#pragma unroll
            for (int m = 0; m < 4; ++m) ssv[ai][m] += __shfl_xor(ssv[ai][m], 16);
#pragma unroll
        for (int ai = 0; ai < 2; ++ai)
#pragma unroll
            for (int m = 0; m < 4; ++m) ssv[ai][m] += __shfl_xor(ssv[ai][m], 32);
        if (fq == 0 && fin) {
#pragma unroll
            for (int ai = 0; ai < 2; ++ai)
#pragma unroll
                for (int m = 0; m < 4; ++m) unsafeAtomicAdd(rowss + row0 + ai * HALF + m * 16, ssv[ai][m]);
        }
    }
};
struct EpiProj {
    static constexpr bool PERM = true, AFTER_DRAIN = false;
    bf16_t* P; int ldp; const float* rowss;
    __device__ __forceinline__ void operator()(const f32x4 (&acc)[2][2][4][2], const Unit& u, int wr, int wc, int fr, int fq) const {
        const int row0 = u.pm * BM + wr * 64 + fr, col0 = u.pn * BM + wc * 32 + 8 * fq;
        const bool act = (u.pn == 3) || (u.pn == 4) || (u.pn == 7) || (u.pn == 8);
        float rs[2][4];
#pragma unroll
        for (int ai = 0; ai < 2; ++ai)
#pragma unroll
            for (int m = 0; m < 4; ++m) rs[ai][m] = rowss[row0 + ai * HALF + m * 16];
#pragma unroll
        for (int ai = 0; ai < 2; ++ai)
#pragma unroll
            for (int m = 0; m < 4; ++m) {
                const int row = row0 + ai * HALF + m * 16;
                const float r = rsqrtf(rs[ai][m] * (1.0f / 1024.0f) + RMS_EPS);
#pragma unroll
                for (int bj = 0; bj < 2; ++bj) {
                    f32x4 a = acc[ai][bj][m][0] * r, b = acc[ai][bj][m][1] * r;
                    if (act) {
#pragma unroll
                        for (int e = 0; e < 4; ++e) { a[e] = silu_f(a[e]); b[e] = silu_f(b[e]); }
                    }
                    u32x4 w; w.x = cvt_pk_bf16(a[0], a[1]); w.y = cvt_pk_bf16(a[2], a[3]); w.z = cvt_pk_bf16(b[0], b[1]); w.w = cvt_pk_bf16(b[2], b[3]);
                    *(u32x4*)(P + (size_t)row * ldp + col0 + bj * HALF) = w;
                }
            }
    }
};
}

constexpr int NWAVES = 8, NTHREADS = 512;
#ifndef MK_N_LAUNCHES
#define MK_N_LAUNCHES 1
#endif
constexpr int N_PHASES = 18;
constexpr int N_LAUNCHES = MK_N_LAUNCHES;

constexpr int D = 1024, FF = 2816, NGU = 2 * FF, NIN = 3092, NINP = 3328, DEPTH = 2;
constexpr int BP = 8, TP = 2048, BS = 128, TS = 8, PAST_LEN = 16384;
constexpr int MP = BP * TP, MS = BS * TS, M = MP + MS;
static_assert(M % 256 == 0 && NGU % 256 == 0 && NINP % 256 == 0 && FF % 128 == 0, "GEMM tiling");
static_assert(DEPTH == 2, "the HGRN2 lower bounds (cumulative softmax over layers minus its first term) are written out for two layers: 0 and softmax(logits)[1] = sigmoid(l1 - l0)");
constexpr int PC_PX = 0, PC_GQ = 256, PC_GK = 384, PC_GV = 512, PC_GR = 768, PC_RQ = 1024, PC_RF = 1280, PC_RI = 1536, PC_RG = 1792, PC_SZ = 2048, PC_XBC = 2304, PC_LR = 3072, PC_DT = 3088;
constexpr int MC_POOL = 0, MC_GLA = 256, MC_HGRN = 512, MC_SSM = 768;
enum { I_XP = 0, I_XS, I_SPOOL, I_SGLA, I_SHGRN, I_SSSM, I_SCONV, I_F1N, I_F1G, I_F1U, I_F1D, I_MIXN, I_WIN, I_POOLW, I_POOLS, I_GLAWG, I_GLAB, I_GLAN,
       I_LBL, I_HGN, I_CONVW, I_CONVB, I_DTB, I_ALOG, I_SSMD, I_SSMN, I_WOUT, I_F2N, I_F2G, I_F2U, I_F2D, I_FINALN, N_INPUTS };
constexpr size_t O_YP = 0, O_YS = O_YP + (size_t)MP * D, O_POOLP = O_YS + (size_t)MS * D, O_POOLS = O_POOLP + (size_t)DEPTH * BP * 15 * 256,
    O_GLAP = O_POOLS + (size_t)DEPTH * BS * 15 * 256, O_GLAS = O_GLAP + (size_t)DEPTH * BP * 4 * 32 * 64, O_HGP = O_GLAS + (size_t)DEPTH * BS * 4 * 32 * 64,
    O_HGS = O_HGP + (size_t)DEPTH * BP * 4 * 64 * 64, O_SSMP = O_HGS + (size_t)DEPTH * BS * 4 * 64 * 64, O_SSMS = O_SSMP + (size_t)DEPTH * BP * 4 * 64 * 128,
    O_CONVP = O_SSMS + (size_t)DEPTH * BS * 4 * 64 * 128, O_CONVS = O_CONVP + (size_t)DEPTH * BP * 3 * 768, O_END = O_CONVS + (size_t)DEPTH * BS * 3 * 768;
static_assert(O_END == 35094528, "output size");

constexpr size_t KiB = 1024, MiB = 1u << 20;
constexpr size_t WS_CTL = 0, CTL_ZERO_BYTES = 1 * MiB;
constexpr size_t WS_RSS = 512 * KiB;
static_assert(WS_RSS + 7 * (size_t)M * 4 <= CTL_ZERO_BYTES, "rowss inside the memset region");
constexpr size_t WS_W = 1 * MiB, W_LAYER = 41 * MiB + 512 * KiB;
constexpr size_t WO_GU1 = 0, WO_D1 = 11 * MiB, WO_IN = 16 * MiB + 512 * KiB, WO_OUT = 23 * MiB, WO_GU2 = 25 * MiB, WO_D2 = 36 * MiB;
static_assert((size_t)NGU * D * 2 == 11 * MiB && (size_t)D * FF * 2 == 5 * MiB + 512 * KiB && (size_t)NINP * D * 2 == 6 * MiB + 512 * KiB && WO_D2 + 5 * MiB + 512 * KiB == W_LAYER, "weight map");
constexpr size_t WS_XB = WS_W + 2 * W_LAYER;
constexpr size_t WS_MIX = WS_XB + 34 * MiB;
constexpr size_t WS_HP = WS_MIX + 34 * MiB;
constexpr size_t WS_END = WS_HP + (size_t)M * NINP * 2;
static_assert((size_t)M * D * 2 == 34 * MiB && WS_END == 262 * MiB + 512 * KiB, "d_ws map");
constexpr int CW_BAR = 4096;
constexpr int CW_SUB = 8192;
constexpr int RING_OFF = 0, RING_BYTES = 131072;
constexpr int LDSCTL_OFF = RING_BYTES, MISC_OFF = LDSCTL_OFF + 320;
constexpr int LDS_BYTES = 147456;

#define GAS __attribute__((address_space(1)))
#define LAS __attribute__((address_space(3)))
typedef unsigned short bf16;
typedef unsigned v4u __attribute__((ext_vector_type(4)));
typedef unsigned v2u __attribute__((ext_vector_type(2)));
typedef float f32x4 __attribute__((ext_vector_type(4)));
typedef GAS unsigned gu32;
#define RLX_AGENT __ATOMIC_RELAXED, __HIP_MEMORY_SCOPE_AGENT
#define LDS_WAIT() asm volatile("s_waitcnt lgkmcnt(0)" ::: "memory")
#define VM_WAIT() asm volatile("s_waitcnt vmcnt(0)" ::: "memory")
#define LDS_BARRIER() asm volatile("s_waitcnt lgkmcnt(0)\n\ts_barrier" ::: "memory")
__device__ __forceinline__ unsigned f2bf(float f) { unsigned u = __builtin_bit_cast(unsigned, f); return (u + 0x7fffu + ((u >> 16) & 1u)) >> 16; }
__device__ __forceinline__ unsigned pk2(float lo, float hi) { return f2bf(lo) | (f2bf(hi) << 16); }
__device__ __forceinline__ float bf2f(bf16 b) { return __builtin_bit_cast(float, (unsigned)b << 16); }
__device__ __forceinline__ float sigmoid_f(float x) { return __builtin_amdgcn_rcpf(1.0f + __expf(-x)); }
__device__ __forceinline__ float silu_f(float x) { return x * __builtin_amdgcn_rcpf(1.0f + __expf(-x)); }
__device__ __forceinline__ float lse0_f(float x) { return 0.6931471805599453f * __builtin_amdgcn_logf(1.0f + __builtin_amdgcn_exp2f(-1.4426950408889634f * fabsf(x))); }
__device__ __forceinline__ float softplus_f(float x) { return fmaxf(x, 0.f) + lse0_f(x); }
__device__ __forceinline__ float logsigmoid_f(float x) { return fminf(x, 0.f) - lse0_f(x); }
typedef float f32x2v __attribute__((ext_vector_type(2)));
typedef __bf16 bf16x2v __attribute__((ext_vector_type(2)));
__device__ __forceinline__ unsigned cvtpk(float lo, float hi) { const f32x2v v = {lo, hi}; return __builtin_bit_cast(unsigned, __builtin_convertvector(v, bf16x2v)); }
#define XB_TMO      128
#define XB_XCNT(j)  (256  + 64 * (j))
#define XB_XSUB(j)  (1280 + 64 * (j))
#define XB_XGEN(j)  (2304 + 64 * (j))
#define XB_TOP      3328
#define XB_TOPGEN   3392
#define XCD_BAR_WORDS 3456
#define XB_SPIN_CAP (1u << 18)

__device__ __forceinline__ unsigned xb_ld(unsigned* p)              { return __hip_atomic_load(p, __ATOMIC_RELAXED, __HIP_MEMORY_SCOPE_AGENT); }
__device__ __forceinline__ unsigned xb_add(unsigned* p, unsigned v) { return __hip_atomic_fetch_add(p, v, __ATOMIC_RELAXED, __HIP_MEMORY_SCOPE_AGENT); }
__device__ __forceinline__ unsigned xb_xcc_id() { return (unsigned)__builtin_amdgcn_s_getreg((3 << 11) | 20) & 0xFu; }
#define XB_SPIN(cond, bar) do { unsigned _sp = 0; while (cond) { __builtin_amdgcn_s_sleep(1); \
    if ((++_sp & 255u) == 0u) { if (xb_ld(&(bar)[XB_TMO])) break; if (_sp > XB_SPIN_CAP) { atomicAdd(&(bar)[XB_TMO], 1u); break; } } } } while (0)

struct XcdBarrier {
    unsigned* bar; unsigned x;
    volatile LAS unsigned* st;
};

__device__ __forceinline__ XcdBarrier xcd_barrier_post(unsigned* bar, volatile LAS unsigned* st) {
    XcdBarrier b; b.bar = bar; b.x = xb_xcc_id(); b.st = st;
    if (threadIdx.x == 0) (void)xb_add(&bar[XB_XCNT(b.x)], 1u);
    return b;
}
__device__ __forceinline__ void xcd_barrier_complete(unsigned* bar, unsigned x, unsigned& nloc, unsigned& nx) {
    const unsigned G = gridDim.x * gridDim.y * gridDim.z;
    unsigned sum, cnt, mine, sp = 0u;
    for (;;) {
        sum = 0u; cnt = 0u; mine = 0u;
#pragma unroll
        for (unsigned j = 0; j < 16; ++j) { const unsigned c = xb_ld(&bar[XB_XCNT(j)]); sum += c; cnt += (c > 0u) ? 1u : 0u; mine = (j == x) ? c : mine; }
        if (sum == G) break;
        __builtin_amdgcn_s_sleep(1);
        if ((++sp & 255u) == 0u) { if (xb_ld(&bar[XB_TMO])) break; if (sp > XB_SPIN_CAP) { atomicAdd(&bar[XB_TMO], 1u); break; } }
    }
    nloc = mine > 0u ? mine : 1u; nx = cnt > 0u ? cnt : 1u;
}

__device__ __forceinline__ void xcd_barrier(const XcdBarrier& b) {
    asm volatile("s_waitcnt vmcnt(0)" ::: "memory");
    __syncthreads();
    if (threadIdx.x == 0) {
        unsigned* bar = b.bar;
        __builtin_amdgcn_s_waitcnt(0);
        unsigned nloc = b.st[0], nx = b.st[1];
        if (nloc == 0u) { xcd_barrier_complete(bar, b.x, nloc, nx); b.st[0] = nloc; b.st[1] = nx; }
        const unsigned old = xb_add(&bar[XB_XSUB(b.x)], 1u);
        const unsigned gen = old / nloc;
        if (old + 1u == (gen + 1u) * nloc) {
            __builtin_amdgcn_fence(__ATOMIC_RELEASE, "agent");
            asm volatile("s_waitcnt vmcnt(0)" ::: "memory");
            const unsigned og = xb_add(&bar[XB_TOP], 1u);
            const unsigned tg = og / nx;
            if (og + 1u == (tg + 1u) * nx) xb_add(&bar[XB_TOPGEN], 1u);
            else XB_SPIN(xb_ld(&bar[XB_TOPGEN]) == tg, bar);
            __builtin_amdgcn_fence(__ATOMIC_ACQUIRE, "agent");
            xb_add(&bar[XB_XGEN(b.x)], 1u);
            asm volatile("s_waitcnt vmcnt(0)" ::: "memory");
        } else {
            XB_SPIN(xb_ld(&bar[XB_XGEN(b.x)]) == gen, bar);
            __builtin_amdgcn_fence(__ATOMIC_ACQUIRE, "agent");
            asm volatile("s_waitcnt vmcnt(0)" ::: "memory");
        }
    }
    __syncthreads();
}

struct Args { const float* in[N_INPUTS]; float* out; unsigned char* ws; int ph_lo, ph_hi; };
static_assert(sizeof(Args) == 34 * 8 + 8, "Args has no holes");

__device__ __forceinline__ float wave_sum(float v) {
#pragma unroll
    for (int o = 1; o < 64; o <<= 1) v += __shfl_xor(v, o);
    return v;
}

template <int KIND>
__device__ __forceinline__ void p0_item(const float* W0, const float* W1, int K, int Nsrc, const float* gain, bf16* WT, LAS float* scr, int item, int nblk, int lane) {
    const int kb = item / nblk, nb = item % nblk, k0 = 64 * kb, n0 = 32 * nb;
    if (KIND == 2 && n0 >= 3072) {
        const int np = n0 + (lane & 31);
        int col = 0; bool valid = true;
        if (np < 3088) col = 1024 + (np - 3072); else if (np < NIN) col = np; else valid = false;
        float vv[32];
#pragma unroll
        for (int i = 0; i < 32; ++i) vv[i] = W0[(size_t)(k0 + 2 * i + (lane >> 5)) * Nsrc + col];
#pragma unroll
        for (int i = 0; i < 32; ++i) { const int kk = 2 * i + (lane >> 5); float v = valid ? vv[i] : 0.f; if (gain) v *= gain[k0 + kk]; scr[kk * 33 + (lane & 31)] = v; }
    } else {
        const float* W = W0; int col0 = n0;
        if (KIND == 0) { const int pn = n0 >> 8, bj = (n0 >> 7) & 1, jj = n0 & 127; W = bj ? W1 : W0; col0 = pn * 128 + jj; }
        if (KIND == 2) col0 = (n0 < 1024) ? n0 : n0 + 16;
        const int kr = lane >> 3, nq = lane & 7;
        f32x4 vv[8]; float gv[8];
#pragma unroll
        for (int i = 0; i < 8; ++i) vv[i] = *(const f32x4*)(W + (size_t)(k0 + 8 * i + kr) * Nsrc + col0 + 4 * nq);
#pragma unroll
        for (int i = 0; i < 8; ++i) gv[i] = gain ? gain[k0 + 8 * i + kr] : 1.0f;
#pragma unroll
        for (int i = 0; i < 8; ++i) { LAS float* sp = scr + (8 * i + kr) * 33 + 4 * nq; const f32x4 v = vv[i] * gv[i]; sp[0] = v[0]; sp[1] = v[1]; sp[2] = v[2]; sp[3] = v[3]; }
    }
    LDS_WAIT(); asm volatile("" ::: "memory");
    const int c = lane & 7;
#pragma unroll
    for (int j = 0; j < 4; ++j) { const int n = (lane >> 3) + 8 * j; const LAS float* s = scr + (8 * c) * 33 + n;
        v4u o; o.x = cvtpk(s[0 * 33], s[1 * 33]); o.y = cvtpk(s[2 * 33], s[3 * 33]); o.z = cvtpk(s[4 * 33], s[5 * 33]); o.w = cvtpk(s[6 * 33], s[7 * 33]);
        *(v4u*)(WT + (size_t)(n0 + n) * K + k0 + 8 * c) = o; }
    LDS_WAIT(); asm volatile("" ::: "memory");
}
constexpr int IT_GU = (D / 64) * (NGU / 32), IT_D = (FF / 64) * (D / 32), IT_IN = (D / 64) * (NINP / 32), IT_OUT = (D / 64) * (D / 32);
constexpr int IT_LAYER = 2 * IT_GU + 2 * IT_D + IT_IN + IT_OUT;

struct CvtList { int a0, n0, a1, n1, a2, n2, a3, n3; };
constexpr int R_GU1 = 0, R_D1 = IT_GU, R_IN = R_D1 + IT_D, R_OUT = R_IN + IT_IN, R_GU2 = R_OUT + IT_OUT, R_D2 = R_GU2 + IT_GU, N_LATE = IT_LAYER - R_OUT;
static_assert(R_D2 + IT_D == IT_LAYER && IT_GU == 2816 && IT_D == 1408 && IT_IN == 1664 && N_LATE == 4736, "conversion item map");
constexpr int G1A = 352, G1B = 864, G1C = IT_GU - G1A - G1B;
#ifndef MK_CVT_ALL_EARLY
constexpr CvtList CV_P0 = {R_GU1, IT_GU, R_IN, IT_IN, IT_LAYER + R_IN, IT_IN, IT_LAYER + R_GU1, G1A};
constexpr CvtList CV_GU1_L0 = {R_D1, IT_D, 0, 0, 0, 0, 0, 0};
constexpr CvtList CV_IN_L0 = {R_OUT, N_LATE, IT_LAYER + R_GU1 + G1A, G1B, 0, 0, 0, 0};
constexpr CvtList CV_GU2_L0 = {IT_LAYER + R_GU1 + G1A + G1B, G1C, 0, 0, 0, 0, 0, 0};
constexpr CvtList CV_GU1_L1 = {IT_LAYER + R_D1, IT_D, 0, 0, 0, 0, 0, 0};
constexpr CvtList CV_IN_L1 = {IT_LAYER + R_OUT, N_LATE, 0, 0, 0, 0, 0, 0};
#else
constexpr CvtList CV_P0 = {0, DEPTH * IT_LAYER, 0, 0, 0, 0, 0, 0};
constexpr CvtList CV_GU1_L0 = {0, 0, 0, 0, 0, 0, 0, 0}, CV_IN_L0 = CV_GU1_L0, CV_GU2_L0 = CV_GU1_L0, CV_GU1_L1 = CV_GU1_L0, CV_IN_L1 = CV_GU1_L0;
#endif
static_assert(G1C == 1600 && CV_P0.n0 + CV_P0.n1 + CV_P0.n2 + CV_P0.n3 + CV_GU1_L0.n0 + CV_IN_L0.n0 + CV_IN_L0.n1 + CV_GU2_L0.n0 + CV_GU1_L1.n0 + CV_IN_L1.n0 == DEPTH * IT_LAYER, "every weight item is converted exactly once");
struct CvtItem { const float* W; const float* gain; bf16* WT; int K, Nsrc, col0, k0, n0; bool spec; };
__device__ __forceinline__ CvtItem cvt_decode(const Args& A, const int it) {
    CvtItem c; const int l = it / IT_LAYER; int r = it % IT_LAYER;
    unsigned char* wl = A.ws + WS_W + (size_t)l * W_LAYER;
    int kind, nblk; const float* W0; const float* W1 = nullptr; c.gain = nullptr;
    if (r < IT_GU) { kind = 0; W0 = A.in[I_F1G] + (size_t)l * D * FF; W1 = A.in[I_F1U] + (size_t)l * D * FF; c.K = D; c.Nsrc = FF; c.gain = A.in[I_F1N] + l * D; c.WT = (bf16*)(wl + WO_GU1); nblk = NGU / 32; }
    else if ((r -= IT_GU) < IT_D) { kind = 1; W0 = A.in[I_F1D] + (size_t)l * D * FF; c.K = FF; c.Nsrc = D; c.WT = (bf16*)(wl + WO_D1); nblk = D / 32; }
    else if ((r -= IT_D) < IT_IN) { kind = 2; W0 = A.in[I_WIN] + (size_t)l * D * NIN; c.K = D; c.Nsrc = NIN; c.gain = A.in[I_MIXN] + l * D; c.WT = (bf16*)(wl + WO_IN); nblk = NINP / 32; }
    else if ((r -= IT_IN) < IT_OUT) { kind = 1; W0 = A.in[I_WOUT] + (size_t)l * D * D; c.K = D; c.Nsrc = D; c.WT = (bf16*)(wl + WO_OUT); nblk = D / 32; }
    else if ((r -= IT_OUT) < IT_GU) { kind = 0; W0 = A.in[I_F2G] + (size_t)l * D * FF; W1 = A.in[I_F2U] + (size_t)l * D * FF; c.K = D; c.Nsrc = FF; c.gain = A.in[I_F2N] + l * D; c.WT = (bf16*)(wl + WO_GU2); nblk = NGU / 32; }
    else { r -= IT_GU; kind = 1; W0 = A.in[I_F2D] + (size_t)l * D * FF; c.K = FF; c.Nsrc = D; c.WT = (bf16*)(wl + WO_D2); nblk = D / 32; }
    const int kb = r / nblk, nb = r % nblk; c.k0 = 64 * kb; c.n0 = 32 * nb; c.spec = (kind == 2) && (c.n0 >= 3072);
    c.W = W0; c.col0 = c.n0;
    if (kind == 0) { const int pn = c.n0 >> 8, bj = (c.n0 >> 7) & 1, jj = c.n0 & 127; c.W = bj ? W1 : W0; c.col0 = pn * 128 + jj; }
    if (kind == 2) c.col0 = (c.n0 < 1024) ? c.n0 : c.n0 + 16;
    return c;
}
__device__ __forceinline__ void cvt_load(const CvtItem& c, const int lane, f32x4 (&vv)[8], float (&gv)[8]) {
    const int kr = lane >> 3, nq = lane & 7;
    if (!c.spec) {
#pragma unroll
        for (int i = 0; i < 8; ++i) vv[i] = *(const f32x4*)(c.W + (size_t)(c.k0 + 8 * i + kr) * c.Nsrc + c.col0 + 4 * nq);
#pragma unroll
        for (int i = 0; i < 8; ++i) gv[i] = c.gain ? c.gain[c.k0 + 8 * i + kr] : 1.0f;
    }
}
__device__ __forceinline__ void cvt_finish(const CvtItem& c, const int lane, LAS float* scr, const f32x4 (&vv)[8], const float (&gv)[8]) {
    if (c.spec) {
        const int np = c.n0 + (lane & 31);
        int col = 0; bool valid = true;
        if (np < 3088) col = 1024 + (np - 3072); else if (np < NIN) col = np; else valid = false;
        float ev[32];
#pragma unroll
        for (int i = 0; i < 32; ++i) ev[i] = c.W[(size_t)(c.k0 + 2 * i + (lane >> 5)) * c.Nsrc + col];
#pragma unroll
        for (int i = 0; i < 32; ++i) { const int kk = 2 * i + (lane >> 5); float v = valid ? ev[i] : 0.f; if (c.gain) v *= c.gain[c.k0 + kk]; scr[kk * 33 + (lane & 31)] = v; }
    } else {
        const int kr = lane >> 3, nq = lane & 7;
#pragma unroll
        for (int i = 0; i < 8; ++i) { LAS float* sp = scr + (8 * i + kr) * 33 + 4 * nq; const f32x4 v = vv[i] * gv[i]; sp[0] = v[0]; sp[1] = v[1]; sp[2] = v[2]; sp[3] = v[3]; }
    }
    LDS_WAIT(); asm volatile("" ::: "memory");
    const int cc = lane & 7;
#pragma unroll
    for (int j = 0; j < 4; ++j) { const int n = (lane >> 3) + 8 * j; const LAS float* sr = scr + (8 * cc) * 33 + n;
        v4u o; o.x = cvtpk(sr[0 * 33], sr[1 * 33]); o.y = cvtpk(sr[2 * 33], sr[3 * 33]); o.z = cvtpk(sr[4 * 33], sr[5 * 33]); o.w = cvtpk(sr[6 * 33], sr[7 * 33]);
        *(v4u*)(c.WT + (size_t)(c.n0 + n) * c.K + c.k0 + 8 * cc) = o; }
    LDS_WAIT(); asm volatile("" ::: "memory");
}
__device__ __forceinline__ void convert_weights(const Args& A, LAS unsigned char* ldsl, int wave, int lane, const CvtList Lst, int gw, int NGW) {
    LAS float* scr = (LAS float*)(ldsl + RING_OFF + wave * 16384);
    const int e0 = Lst.n0, e1 = e0 + Lst.n1, e2 = e1 + Lst.n2, e3 = e2 + Lst.n3;
#define CVT_MAP(vi) (((vi) < e0) ? Lst.a0 + (vi) : ((vi) < e1) ? Lst.a1 + ((vi) - e0) : ((vi) < e2) ? Lst.a2 + ((vi) - e1) : Lst.a3 + ((vi) - e2))
    int vi = gw;
    if (vi >= e3) return;
    CvtItem cur = cvt_decode(A, CVT_MAP(vi));
    f32x4 va[8]; float ga[8];
    cvt_load(cur, lane, va, ga);
    for (;;) {
        const int vn = vi + NGW; const bool more = vn < e3;
        CvtItem nxt = cur; f32x4 vb[8]; float gb[8];
#pragma unroll
        for (int i = 0; i < 8; ++i) { vb[i] = va[i]; gb[i] = ga[i]; }
        if (more) { nxt = cvt_decode(A, CVT_MAP(vn)); cvt_load(nxt, lane, vb, gb); }
        cvt_finish(cur, lane, scr, va, ga);
        if (!more) break;
        cur = nxt; vi = vn;
#pragma unroll
        for (int i = 0; i < 8; ++i) { va[i] = vb[i]; ga[i] = gb[i]; }
    }
#undef CVT_MAP
}
__device__ __forceinline__ void p0_prologue(const Args& A, LAS unsigned char* ldsl, int wave, int lane, int G) {
    const int gw = blockIdx.x * NWAVES + wave, NGW = G * NWAVES;
    unsigned char* ws = A.ws;
    convert_weights(A, ldsl, wave, lane, CV_P0, gw, NGW);
    bf16* xb = (bf16*)(ws + WS_XB); float* rss = (float*)(ws + WS_RSS);
    for (int m0 = gw; m0 < M; m0 += 2 * NGW) {
        const int m1 = m0 + NGW; const bool two = m1 < M; const int m1c = two ? m1 : m0;
        const float* s0 = (m0 < MP) ? A.in[I_XP] + (size_t)m0 * D : A.in[I_XS] + (size_t)(m0 - MP) * D;
        const float* s1 = (m1c < MP) ? A.in[I_XP] + (size_t)m1c * D : A.in[I_XS] + (size_t)(m1c - MP) * D;
        f32x4 v[2][4];
#pragma unroll
        for (int j = 0; j < 4; ++j) { v[0][j] = ((const f32x4*)s0 + lane)[64 * j]; v[1][j] = ((const f32x4*)s1 + lane)[64 * j]; }
#pragma unroll
        for (int h = 0; h < 2; ++h) {
            const int m = h ? m1c : m0;
            v2u* bo = (v2u*)(xb + (size_t)m * D) + lane; float s = 0.f;
#pragma unroll
            for (int j = 0; j < 4; ++j) { v2u w; w.x = cvtpk(v[h][j].x, v[h][j].y); w.y = cvtpk(v[h][j].z, v[h][j].w); if (h == 0 || two) bo[64 * j] = w;
                const float r0 = __builtin_bit_cast(float, w.x << 16), r1 = __builtin_bit_cast(float, w.x & 0xffff0000u), r2 = __builtin_bit_cast(float, w.y << 16), r3 = __builtin_bit_cast(float, w.y & 0xffff0000u);
                s += (r0 * r0 + r1 * r1) + (r2 * r2 + r3 * r3); }
            s = wave_sum(s);
            if (lane == 0 && (h == 0 || two)) rss[m] = s;
        }
    }
}

#ifndef MK_REP_S1
#define MK_REP_S1 1
#endif
#ifndef MK_REP_S3
#define MK_REP_S3 1
#endif
#ifndef MK_REP_S2SMP
#define MK_REP_S2SMP 1
#endif
struct MixP {
    const bf16* P; bf16* mixb; float* out; int l; float* DS; float* ESC; unsigned* subc;
    bf16* XC;
    const float *s_pool, *s_gla, *s_hgrn, *s_ssm, *s_conv;
    const float *pool_w, *pool_scale, *gla_wg, *gla_b, *gla_n, *lbl, *hg_n, *conv_w, *conv_b, *dt_b, *a_log, *ssm_d, *ssm_n;
};
typedef short bf16x8 __attribute__((ext_vector_type(8)));
constexpr int MIX_CONST_OFF = 113664;
#define MFMA16(a, b, c) __builtin_amdgcn_mfma_f32_16x16x32_bf16((a), (b), (c), 0, 0, 0)
template <int CTRL> __device__ __forceinline__ float dpp_shr1(float x) { return __builtin_bit_cast(float, __builtin_amdgcn_update_dpp(0x3f800000, __builtin_bit_cast(int, x), CTRL, 0xf, 0xf, false)); }
template <int CTRL, int ROWMASK> __device__ __forceinline__ float dpp_sel(float oldv, float x) { return __builtin_bit_cast(float, __builtin_amdgcn_update_dpp(__builtin_bit_cast(int, oldv), __builtin_bit_cast(int, x), CTRL, ROWMASK, 0xf, false)); }
__device__ __forceinline__ float dpp_bcast15(float oldv, float x) { return dpp_sel<0x142, 0xa>(oldv, x); }
__device__ __forceinline__ float quad_sum(float v) { v += dpp_sel<0xB1, 0xf>(0.f, v); v += dpp_sel<0x4E, 0xf>(0.f, v); return v; }
__device__ __forceinline__ float oct_sum(float v) { v = quad_sum(v); v += dpp_sel<0x141, 0xf>(0.f, v); return v; }
__device__ __forceinline__ bf16x8 frag16(const LAS unsigned char* p) { return *(const LAS bf16x8*)p; }
__device__ __forceinline__ bf16x8 frag8x2(const LAS unsigned char* p0, const LAS unsigned char* p1) { const v2u a = *(const LAS v2u*)p0, b = *(const LAS v2u*)p1; v4u w; w.x = a.x; w.y = a.y; w.z = b.x; w.w = b.y; return __builtin_bit_cast(bf16x8, w); }
__device__ __forceinline__ bf16x8 pack_frag(const f32x4 a, const f32x4 b) { v4u w; w.x = cvtpk(a[0], a[1]); w.y = cvtpk(a[2], a[3]); w.z = cvtpk(b[0], b[1]); w.w = cvtpk(b[2], b[3]); return __builtin_bit_cast(bf16x8, w); }
__device__ __forceinline__ float bfe(const v4u w, const int e) { const unsigned x = w[e >> 1]; return __builtin_bit_cast(float, (e & 1) ? (x & 0xffff0000u) : (x << 16)); }
__device__ __forceinline__ float bfe2(const v2u w, const int e) { const unsigned x = w[e >> 1]; return __builtin_bit_cast(float, (e & 1) ? (x & 0xffff0000u) : (x << 16)); }
__device__ __forceinline__ unsigned short bfbits(const v4u w, const int e) { const unsigned x = w[e >> 1]; return (unsigned short)((e & 1) ? (x >> 16) : (x & 0xffffu)); }

#define GH_SCAN_STEP(CTRL) "v_mul_f32_dpp %0, %0, %0 " CTRL "\n\tv_mul_f32_dpp %1, %1, %1 " CTRL "\n\tv_mul_f32_dpp %2, %2, %2 " CTRL "\n\tv_mul_f32_dpp %3, %3, %3 " CTRL "\n\t" \
                           "v_mul_f32_dpp %4, %4, %4 " CTRL "\n\tv_mul_f32_dpp %5, %5, %5 " CTRL "\n\tv_mul_f32_dpp %6, %6, %6 " CTRL "\n\tv_mul_f32_dpp %7, %7, %7 " CTRL "\n\t"
__device__ __forceinline__ void gh_scan8(float& a, float& b, float& c, float& d, float& e, float& f, float& g, float& h) {
    asm volatile("s_nop 1\n\t"
                 GH_SCAN_STEP("row_shr:1 row_mask:0xf bank_mask:0xf") GH_SCAN_STEP("row_shr:2 row_mask:0xf bank_mask:0xf") GH_SCAN_STEP("row_shr:4 row_mask:0xf bank_mask:0xf")
                 GH_SCAN_STEP("row_shr:8 row_mask:0xf bank_mask:0xf") GH_SCAN_STEP("row_bcast:15 row_mask:0xa bank_mask:0xf") "s_nop 1"
                 : "+v"(a), "+v"(b), "+v"(c), "+v"(d), "+v"(e), "+v"(f), "+v"(g), "+v"(h));
}
#undef GH_SCAN_STEP
template <int K> struct GHL { static constexpr int RS = K * 2 + 16, OFF_Q = 0, OFF_K = 32 * RS, OFF_KT = 64 * RS, OFF_VT = OFF_KT + K * 80, OFF_E = OFF_VT + 64 * 80, OFF_O = OFF_E + K * 4, UNIT = OFF_O + 32 * 272; };
static_assert(GHL<64>::UNIT == 28416 && 4 * GHL<64>::UNIT <= MIX_CONST_OFF, "GLA/HGRN LDS map");

template <int K>
__device__ __forceinline__ void s2_gh_unit(LAS unsigned char* U, f32x4 (&S)[K / 16], const int cs, const int lane) {
    typedef GHL<K> G; constexpr int NS = K / 32, KT = K / 16;
    const int q = lane >> 4, r16 = lane & 15, c = 16 * cs + r16;
    const f32x4 z4 = {0.f, 0.f, 0.f, 0.f};
    const LAS unsigned char* vrow = U + G::OFF_VT + c * 80;
    bf16x8 kf0[NS], kf1[NS], qf0[NS], qf1[NS], qp0[NS], qp1[NS], ktf[KT]; f32x4 e4[KT];
#pragma unroll
    for (int kt = 0; kt < KT; ++kt) { ktf[kt] = frag16(U + G::OFF_KT + (16 * kt + r16) * 80 + (8 * q) * 2); e4[kt] = *(const LAS f32x4*)(U + G::OFF_E + (16 * kt + 4 * q) * 4); }
    const bf16x8 vn = frag16(vrow + (8 * q) * 2);
#pragma unroll
    for (int s = 0; s < NS; ++s) {
        const LAS unsigned char* qr0 = U + G::OFF_Q + r16 * G::RS + (32 * s + 4 * q) * 2; const LAS unsigned char* qr1 = qr0 + 16 * G::RS;
        qp0[s] = frag8x2(qr0, qr0 + 32); qp1[s] = frag8x2(qr1, qr1 + 32);
    }
#pragma unroll
    for (int s = 0; s < NS; ++s) {
        const int kb = (32 * s + 8 * q) * 2;
        kf0[s] = frag16(U + G::OFF_K + r16 * G::RS + kb); kf1[s] = frag16(U + G::OFF_K + (16 + r16) * G::RS + kb);
        qf0[s] = frag16(U + G::OFF_Q + r16 * G::RS + kb); qf1[s] = frag16(U + G::OFF_Q + (16 + r16) * G::RS + kb);
    }
    const bf16x8 vb = frag8x2(vrow + (4 * q) * 2, vrow + (16 + 4 * q) * 2);
    bf16x8 sb[NS];
#pragma unroll
    for (int s = 0; s < NS; ++s) sb[s] = pack_frag(S[2 * s], S[2 * s + 1]);
#pragma unroll
    for (int kt = 0; kt < KT; ++kt) { S[kt] = MFMA16(ktf[kt], vn, S[kt]); S[kt] = S[kt] * e4[kt]; }
    f32x4 X00 = z4, X01 = z4, X11 = z4;
#pragma unroll
    for (int s = 0; s < NS; ++s) { X00 = MFMA16(kf0[s], qf0[s], X00); X01 = MFMA16(kf0[s], qf1[s], X01); X11 = MFMA16(kf1[s], qf1[s], X11); }
    f32x4 o0 = z4, o1 = z4;
#pragma unroll
    for (int s = 0; s < NS; ++s) { o0 = MFMA16(qp0[s], sb[s], o0); o1 = MFMA16(qp1[s], sb[s], o1); }
#pragma unroll
    for (int r = 0; r < 4; ++r) if (4 * q + r > r16) { X00[r] = 0.f; X11[r] = 0.f; }
    const bf16x8 a0 = pack_frag(X00, z4), a1 = pack_frag(X01, X11);
    o0 = MFMA16(a0, vb, o0); o1 = MFMA16(a1, vb, o1);
    LAS float* ob = (LAS float*)(U + G::OFF_O);
#pragma unroll
    for (int r = 0; r < 4; ++r) { ob[(4 * q + r) * 68 + c] = o0[r]; ob[(16 + 4 * q + r) * 68 + c] = o1[r]; }
}

template <int MT>
__device__ __forceinline__ void chain_gh(LAS unsigned char* L, const MixP& C, const int h, const int b0, const bool smp, const int tid) {
    constexpr int K = (MT == 0) ? 32 : 64, KT = K / 16, NK = K / 4;
    typedef GHL<K> G;
    const int w = __builtin_amdgcn_readfirstlane(tid >> 6), lane = tid & 63;
    const int u1 = tid >> 7, t1 = tid & 31, kg = (tid >> 5) & 3;
    LAS float* cst = (LAS float*)(L + MIX_CONST_OFF);
    if (MT == 0) { cst[tid] = C.gla_wg[(tid >> 5) * 128 + h * 32 + (tid & 31)]; if (tid < 32) cst[512 + tid] = C.gla_b[h * 32 + tid]; }
    if (tid >= 64 && tid < 128) cst[600 + tid - 64] = ((MT == 0) ? C.gla_n : C.hg_n)[tid - 64];
    if (MT == 1) { if (tid < 64) cst[tid] = (C.l == 0) ? 0.f : sigmoid_f(C.lbl[256 + h * 64 + tid] - C.lbl[h * 64 + tid]); }
    LDS_BARRIER();
    const float* sin = (MT == 0) ? C.s_gla : C.s_hgrn;
    const size_t o_p = (MT == 0) ? O_GLAP : O_HGP, o_s = (MT == 0) ? O_GLAS : O_HGS;
    f32x4 S[KT];
#pragma unroll
    for (int kt = 0; kt < KT; ++kt) S[kt] = (f32x4){0.f, 0.f, 0.f, 0.f};
    const int nsc = smp ? 1 : TP / 128;
    v4u rw0, rw1, rw2, rw3, rw4, rw5;
#define GH_LOAD_RAW(SC) do { const bool valid_ = smp ? (t1 < TS) : true; \
        const int row_ = smp ? (MP + (b0 + u1) * TS + (valid_ ? t1 : 0)) : (b0 * TP + (SC) * 128 + u1 * 32 + t1); \
        const bf16* prow_ = C.P + (size_t)row_ * NINP; \
        if (MT == 0) { rw0 = *(const v4u*)(prow_ + PC_GQ + h * 32 + 8 * kg); rw1 = *(const v4u*)(prow_ + PC_GK + h * 32 + 8 * kg); rw2 = *(const v4u*)(prow_ + PC_LR); rw3 = *(const v4u*)(prow_ + PC_LR + 8); \
                       rw4 = *(const v4u*)(prow_ + PC_GV + h * 64 + 16 * kg); rw5 = *(const v4u*)(prow_ + PC_GV + h * 64 + 16 * kg + 8); } \
        else { rw0 = *(const v4u*)(prow_ + PC_RQ + h * 64 + 16 * kg); rw1 = *(const v4u*)(prow_ + PC_RQ + h * 64 + 16 * kg + 8); rw2 = *(const v4u*)(prow_ + PC_RF + h * 64 + 16 * kg); rw3 = *(const v4u*)(prow_ + PC_RF + h * 64 + 16 * kg + 8); \
               rw4 = *(const v4u*)(prow_ + PC_RI + h * 64 + 16 * kg); rw5 = *(const v4u*)(prow_ + PC_RI + h * 64 + 16 * kg + 8); } } while (0)
    GH_LOAD_RAW(0);
    for (int sc = 0; sc < nsc; ++sc) {
#pragma unroll 1
        for (int rep1 = 0; rep1 < MK_REP_S1; ++rep1) {
#if MK_REP_S1 > 1
            asm volatile("" : "+v"(rw0), "+v"(rw1), "+v"(rw2), "+v"(rw3), "+v"(rw4), "+v"(rw5));
#endif
            const bool valid = smp ? (t1 < TS) : true;
            LAS unsigned char* U = L + u1 * G::UNIT;
            float f[NK], kk[NK], qq[NK]; v4u vraw0 = rw4, vraw1 = rw5;
            if (MT == 0) {
                const v4u gq = rw0, gk = rw1, lr0 = rw2, lr1 = rw3;
                float lg[NK];
#pragma unroll
                for (int e = 0; e < NK; ++e) lg[e] = cst[512 + 8 * kg + e];
#pragma unroll
                for (int j = 0; j < 16; ++j) { const float lv = (j < 8) ? bfe(lr0, j) : bfe(lr1, j - 8);
                    const f32x4 w0 = *(const LAS f32x4*)(cst + j * 32 + 8 * kg), w1 = *(const LAS f32x4*)(cst + j * 32 + 8 * kg + 4);
                    lg[0] += lv * w0[0]; lg[1] += lv * w0[1]; lg[2] += lv * w0[2]; lg[3] += lv * w0[3]; lg[4] += lv * w1[0]; lg[5] += lv * w1[1]; lg[6] += lv * w1[2]; lg[7] += lv * w1[3]; }
#pragma unroll
                for (int e = 0; e < NK; ++e) { f[e] = __expf(logsigmoid_f(lg[e]) * (1.0f / 16.0f)); kk[e] = bfe(gk, e); qq[e] = bfe(gq, e) * 0.17677669529663687f; }
            } else {
                const v4u rq0 = rw0, rq1 = rw1, rf0 = rw2, rf1 = rw3;
#pragma unroll
                for (int e = 0; e < NK; ++e) { const float z = (e < 8) ? bfe(rf0, e) : bfe(rf1, e - 8), qv = (e < 8) ? bfe(rq0, e) : bfe(rq1, e - 8);
                    const float lb = cst[16 * kg + e], sg = sigmoid_f(z);
                    f[e] = lb + (1.f - lb) * sg; kk[e] = (1.f - lb) * (1.f - sg); qq[e] = qv; }
            }
            if (!valid) {
#pragma unroll
                for (int e = 0; e < NK; ++e) { f[e] = 1.f; kk[e] = 0.f; qq[e] = 0.f; }
                vraw0 = (v4u){0u, 0u, 0u, 0u}; vraw1 = vraw0;
            }
#pragma unroll
            for (int e8 = 0; e8 < NK; e8 += 8) gh_scan8(f[e8 + 0], f[e8 + 1], f[e8 + 2], f[e8 + 3], f[e8 + 4], f[e8 + 5], f[e8 + 6], f[e8 + 7]);
            float qt[NK], kt_[NK];
#pragma unroll
            for (int e = 0; e < NK; ++e) { qt[e] = qq[e] * f[e]; kt_[e] = kk[e] * __builtin_amdgcn_rcpf(fmaxf(f[e], 1e-30f)); }
#pragma unroll
            for (int e8 = 0; e8 < NK; e8 += 8) {
                v4u wq, wk;
                wq.x = cvtpk(qt[e8 + 0], qt[e8 + 1]); wq.y = cvtpk(qt[e8 + 2], qt[e8 + 3]); wq.z = cvtpk(qt[e8 + 4], qt[e8 + 5]); wq.w = cvtpk(qt[e8 + 6], qt[e8 + 7]);
                wk.x = cvtpk(kt_[e8 + 0], kt_[e8 + 1]); wk.y = cvtpk(kt_[e8 + 2], kt_[e8 + 3]); wk.z = cvtpk(kt_[e8 + 4], kt_[e8 + 5]); wk.w = cvtpk(kt_[e8 + 6], kt_[e8 + 7]);
                *(LAS v4u*)(U + G::OFF_Q + t1 * G::RS + (NK * kg + e8) * 2) = wq;
                *(LAS v4u*)(U + G::OFF_K + t1 * G::RS + (NK * kg + e8) * 2) = wk;
#pragma unroll
                for (int e = 0; e < 8; ++e) *(LAS unsigned short*)(U + G::OFF_KT + (NK * kg + e8 + e) * 80 + t1 * 2) = bfbits(wk, e);
            }
#pragma unroll
            for (int e = 0; e < 16; ++e) *(LAS unsigned short*)(U + G::OFF_VT + (16 * kg + e) * 80 + t1 * 2) = (e < 8) ? bfbits(vraw0, e) : bfbits(vraw1, e - 8);
            if (t1 == 31) {
#pragma unroll
                for (int e = 0; e < NK; ++e) *(LAS float*)(U + G::OFF_E + (NK * kg + e) * 4) = f[e];
            }
        }
        LDS_BARRIER();
        const int tok3 = tid >> 2, cq3 = tid & 3, u3 = tok3 >> 5, i3 = tok3 & 31;
        const bool valid3 = smp ? (i3 < TS) : true;
        const int row3 = smp ? (MP + (b0 + u3) * TS + (valid3 ? i3 : 0)) : (b0 * TP + sc * 128 + tok3);
        v4u gg0, gg1;
        { const bf16* grow = C.P + (size_t)row3 * NINP + ((MT == 0) ? PC_GR : PC_RG) + h * 64 + 16 * cq3; gg0 = *(const v4u*)grow; gg1 = *(const v4u*)(grow + 8); }
        GH_LOAD_RAW((sc + 1 < nsc) ? sc + 1 : sc);
        if (!smp) {
            if (w < 4) {
#pragma unroll 1
                for (int u = 0; u < 4; ++u) {
#ifdef MK_REP_S2GH
                    { f32x4 Sd[KT];
#pragma unroll
                      for (int kt = 0; kt < KT; ++kt) Sd[kt] = S[kt];
                      s2_gh_unit<K>(L + u * G::UNIT, Sd, w, lane);
#pragma unroll
                      for (int kt = 0; kt < KT; ++kt) asm volatile("" :: "v"(Sd[kt])); }
#endif
                    s2_gh_unit<K>(L + u * G::UNIT, S, w, lane);
                }
            }
        } else {
#pragma unroll 1
            for (int job = w; job < 16; job += 8) {
                const int u = job >> 2, cs = job & 3, q = lane >> 4, c = 16 * cs + (lane & 15);
                const size_t sb = ((size_t)(b0 + u) * 4 + h) * K * 64;
#pragma unroll
                for (int kt = 0; kt < KT; ++kt)
#pragma unroll
                    for (int r = 0; r < 4; ++r) S[kt][r] = sin[sb + (size_t)(16 * kt + 4 * q + r) * 64 + c];
                s2_gh_unit<K>(L + u * G::UNIT, S, cs, lane);
                float* so = C.out + o_s + (((size_t)C.l * BS + b0 + u) * 4 + h) * K * 64;
#pragma unroll
                for (int kt = 0; kt < KT; ++kt)
#pragma unroll
                    for (int r = 0; r < 4; ++r) so[(size_t)(16 * kt + 4 * q + r) * 64 + c] = S[kt][r];
            }
        }
        LDS_BARRIER();
#pragma unroll 1
        for (int rep3 = 0; rep3 < MK_REP_S3; ++rep3) {
#if MK_REP_S3 > 1
            asm volatile("" : "+v"(gg0), "+v"(gg1));
#endif
            const LAS float* ob = (const LAS float*)(L + u3 * G::UNIT + G::OFF_O) + i3 * 68 + 16 * cq3;
            f32x4 o[4]; float ss = 0.f;
#pragma unroll
            for (int j = 0; j < 4; ++j) { o[j] = *(const LAS f32x4*)(ob + 4 * j); ss += (o[j][0] * o[j][0] + o[j][1] * o[j][1]) + (o[j][2] * o[j][2] + o[j][3] * o[j][3]); }
            ss = quad_sum(ss);
            const float r = rsqrtf(ss * (1.0f / 64.0f) + 1e-6f);
            float res[16], nwv[16];
#pragma unroll
            for (int j = 0; j < 4; ++j) { const f32x4 t = *(const LAS f32x4*)(cst + 600 + 16 * cq3 + 4 * j); nwv[4 * j] = t[0]; nwv[4 * j + 1] = t[1]; nwv[4 * j + 2] = t[2]; nwv[4 * j + 3] = t[3]; }
#pragma unroll
            for (int e = 0; e < 16; ++e) { const float gv = (e < 8) ? bfe(gg0, e) : bfe(gg1, e - 8); res[e] = o[e >> 2][e & 3] * r * nwv[e] * gv; }
            if (valid3) {
                v4u w0, w1;
                w0.x = cvtpk(res[0], res[1]); w0.y = cvtpk(res[2], res[3]); w0.z = cvtpk(res[4], res[5]); w0.w = cvtpk(res[6], res[7]);
                w1.x = cvtpk(res[8], res[9]); w1.y = cvtpk(res[10], res[11]); w1.z = cvtpk(res[12], res[13]); w1.w = cvtpk(res[14], res[15]);
                bf16* mo = C.mixb + (size_t)row3 * D + ((MT == 0) ? MC_GLA : MC_HGRN) + h * 64 + 16 * cq3;
                *(v4u*)mo = w0; *(v4u*)(mo + 8) = w1;
            }
        }
    }
#undef GH_LOAD_RAW
    if (!smp && w < 4) {
        const int q = lane >> 4, c = 16 * w + (lane & 15);
        float* so = C.out + o_p + (((size_t)C.l * BP + b0) * 4 + h) * K * 64;
#pragma unroll
        for (int kt = 0; kt < KT; ++kt)
#pragma unroll
            for (int r = 0; r < 4; ++r) so[(size_t)(16 * kt + 4 * q + r) * 64 + c] = S[kt][r];
    }
    LDS_BARRIER();
}

namespace SL { constexpr int OFF_C = 0, OFF_B = 8704, OFF_BT = 17408, OFF_XT = 27648, OFF_TAB = 37888, OFF_Y = 39168, UNIT = 56064; }
static_assert(2 * SL::UNIT <= MIX_CONST_OFF, "SSD LDS map");

__device__ __forceinline__ void s2_ssd_unit(LAS unsigned char* U, f32x4 (&S)[8], const int hh, const int ps, const int lane, const float Dh) {
    const int q = lane >> 4, r16 = lane & 15, p = 16 * ps + r16;
    const f32x4 z4 = {0.f, 0.f, 0.f, 0.f};
    const LAS float* tab = (const LAS float*)(U + SL::OFF_TAB) + hh * 160;
    const LAS unsigned char* xrow = U + SL::OFF_XT + hh * 5120 + p * 80;
    bf16x8 btf[8];
#pragma unroll
    for (int nt = 0; nt < 8; ++nt) btf[nt] = frag16(U + SL::OFF_BT + (16 * nt + r16) * 80 + (8 * q) * 2);
    const v4u xn = *(const LAS v4u*)(xrow + (8 * q) * 2);
    const f32x4 w0 = *(const LAS f32x4*)(tab + 96 + 8 * q), w1 = *(const LAS f32x4*)(tab + 96 + 8 * q + 4);
    const float eL = tab[128];
    bf16x8 cp0[4], cp1[4];
#pragma unroll
    for (int s = 0; s < 4; ++s) { const LAS unsigned char* cr0 = U + SL::OFF_C + r16 * 272 + (32 * s + 4 * q) * 2; const LAS unsigned char* cr1 = cr0 + 16 * 272; cp0[s] = frag8x2(cr0, cr0 + 32); cp1[s] = frag8x2(cr1, cr1 + 32); }
    bf16x8 sb[4];
#pragma unroll
    for (int s = 0; s < 4; ++s) sb[s] = pack_frag(S[2 * s], S[2 * s + 1]);
    const f32x4 xa = {bfe(xn, 0) * w0[0], bfe(xn, 1) * w0[1], bfe(xn, 2) * w0[2], bfe(xn, 3) * w0[3]}, xc = {bfe(xn, 4) * w1[0], bfe(xn, 5) * w1[1], bfe(xn, 6) * w1[2], bfe(xn, 7) * w1[3]};
    const bf16x8 xh = pack_frag(xa, xc);
#pragma unroll
    for (int nt = 0; nt < 8; ++nt) S[nt] = MFMA16(btf[nt], xh, S[nt] * eL);
    f32x4 X00 = z4, X01 = z4, X11 = z4;
#pragma unroll
    for (int s = 0; s < 4; ++s) {
        const int nb = (32 * s + 8 * q) * 2;
        const bf16x8 b0 = frag16(U + SL::OFF_B + r16 * 272 + nb), b1 = frag16(U + SL::OFF_B + (16 + r16) * 272 + nb);
        const bf16x8 c0 = frag16(U + SL::OFF_C + r16 * 272 + nb), c1 = frag16(U + SL::OFF_C + (16 + r16) * 272 + nb);
        X00 = MFMA16(b0, c0, X00); X01 = MFMA16(b0, c1, X01); X11 = MFMA16(b1, c1, X11);
    }
    f32x4 y20 = z4, y21 = z4;
#pragma unroll
    for (int s = 0; s < 4; ++s) { y20 = MFMA16(cp0[s], sb[s], y20); y21 = MFMA16(cp1[s], sb[s], y21); }
    const float ci0 = tab[r16], ci1 = tab[16 + r16];
    const f32x4 cj0 = *(const LAS f32x4*)(tab + 4 * q), cj1 = *(const LAS f32x4*)(tab + 16 + 4 * q);
#pragma unroll
    for (int r = 0; r < 4; ++r) {
        X00[r] = (4 * q + r > r16) ? 0.f : X00[r] * __expf(fminf(ci0 - cj0[r], 0.f));
        X01[r] = X01[r] * __expf(fminf(ci1 - cj0[r], 0.f));
        X11[r] = (4 * q + r > r16) ? 0.f : X11[r] * __expf(fminf(ci1 - cj1[r], 0.f));
    }
    const bf16x8 a0 = pack_frag(X00, z4), a1 = pack_frag(X01, X11);
    bf16x8 xb; f32x4 ux0, ux1;
    { const v2u xl = *(const LAS v2u*)(xrow + (4 * q) * 2), xh_ = *(const LAS v2u*)(xrow + (16 + 4 * q) * 2);
      const f32x4 d0 = *(const LAS f32x4*)(tab + 64 + 4 * q), d1 = *(const LAS f32x4*)(tab + 64 + 16 + 4 * q);
      const f32x4 fa = {__builtin_bit_cast(float, xl.x << 16) * d0[0], __builtin_bit_cast(float, xl.x & 0xffff0000u) * d0[1], __builtin_bit_cast(float, xl.y << 16) * d0[2], __builtin_bit_cast(float, xl.y & 0xffff0000u) * d0[3]};
      const f32x4 fb = {__builtin_bit_cast(float, xh_.x << 16) * d1[0], __builtin_bit_cast(float, xh_.x & 0xffff0000u) * d1[1], __builtin_bit_cast(float, xh_.y << 16) * d1[2], __builtin_bit_cast(float, xh_.y & 0xffff0000u) * d1[3]};
      xb = pack_frag(fa, fb);
      ux0 = (f32x4){__builtin_bit_cast(float, xl.x << 16), __builtin_bit_cast(float, xl.x & 0xffff0000u), __builtin_bit_cast(float, xl.y << 16), __builtin_bit_cast(float, xl.y & 0xffff0000u)} * Dh;
      ux1 = (f32x4){__builtin_bit_cast(float, xh_.x << 16), __builtin_bit_cast(float, xh_.x & 0xffff0000u), __builtin_bit_cast(float, xh_.y << 16), __builtin_bit_cast(float, xh_.y & 0xffff0000u)} * Dh; }
    const f32x4 y10 = MFMA16(a0, xb, z4), y11 = MFMA16(a1, xb, z4);
    const f32x4 e0 = *(const LAS f32x4*)(tab + 32 + 4 * q), e1 = *(const LAS f32x4*)(tab + 32 + 16 + 4 * q);
    LAS float* yb = (LAS float*)(U + SL::OFF_Y);
#pragma unroll
    for (int r = 0; r < 4; ++r) { yb[(4 * q + r) * 132 + hh * 64 + p] = y10[r] + e0[r] * y20[r] + ux0[r]; yb[(16 + 4 * q + r) * 132 + hh * 64 + p] = y11[r] + e1[r] * y21[r] + ux1[r]; }
}

__device__ __forceinline__ void s2_ssd_state(LAS unsigned char* U, f32x4 (&S)[8], const int hh, const int ps, const int lane) {
    const int q = lane >> 4, r16 = lane & 15, p = 16 * ps + r16;
    const LAS float* tab = (const LAS float*)(U + SL::OFF_TAB) + hh * 160;
    const LAS unsigned char* xrow = U + SL::OFF_XT + hh * 5120 + p * 80;
    bf16x8 btf[8];
#pragma unroll
    for (int nt = 0; nt < 8; ++nt) btf[nt] = frag16(U + SL::OFF_BT + (16 * nt + r16) * 80 + (8 * q) * 2);
    const v4u xn = *(const LAS v4u*)(xrow + (8 * q) * 2);
    const f32x4 w0 = *(const LAS f32x4*)(tab + 96 + 8 * q), w1 = *(const LAS f32x4*)(tab + 96 + 8 * q + 4);
    const float eL = tab[128];
    const f32x4 xa = {bfe(xn, 0) * w0[0], bfe(xn, 1) * w0[1], bfe(xn, 2) * w0[2], bfe(xn, 3) * w0[3]}, xc = {bfe(xn, 4) * w1[0], bfe(xn, 5) * w1[1], bfe(xn, 6) * w1[2], bfe(xn, 7) * w1[3]};
    const bf16x8 xh = pack_frag(xa, xc);
#pragma unroll
    for (int nt = 0; nt < 8; ++nt) S[nt] = MFMA16(btf[nt], xh, S[nt] * eL);
}

__device__ __forceinline__ void conv_phase(const MixP& C, const int G, const int tid) {
    constexpr int NTASK = (M / 8) * 96;
    for (int task = blockIdx.x * NTHREADS + tid; task < NTASK; task += G * NTHREADS) {
        const int g8 = task / 96, bl = task - g8 * 96, ch0 = 8 * bl, row0 = 8 * g8;
        const bool smp = g8 >= MP / 8;
        const int bsm = smp ? g8 - MP / 8 : 0;
        const bool head = smp ? true : ((row0 & (TP - 1)) == 0);
        {
            v4u xr[11];
#pragma unroll
            for (int i = 0; i < 11; ++i) { int r = row0 - 3 + i; if (head && i < 3) r = row0; xr[i] = *(const v4u*)(C.P + (size_t)r * NINP + PC_XBC + ch0); }
            f32x4 st[3][2];
#pragma unroll
            for (int r = 0; r < 3; ++r) { st[r][0] = (f32x4){0.f, 0.f, 0.f, 0.f}; st[r][1] = st[r][0]; }
            if (smp) {
#pragma unroll
                for (int r = 0; r < 3; ++r) { st[r][0] = *(const f32x4*)(C.s_conv + ((size_t)bsm * 3 + r) * 768 + ch0); st[r][1] = *(const f32x4*)(C.s_conv + ((size_t)bsm * 3 + r) * 768 + ch0 + 4); }
            }
            float wt[4][8], bs[8];
#pragma unroll
            for (int j = 0; j < 4; ++j) { const f32x4 wa = *(const f32x4*)(C.conv_w + j * 768 + ch0), wb = *(const f32x4*)(C.conv_w + j * 768 + ch0 + 4);
#pragma unroll
                for (int c = 0; c < 4; ++c) { wt[j][c] = wa[c]; wt[j][4 + c] = wb[c]; } }
            { const f32x4 wa = *(const f32x4*)(C.conv_b + ch0), wb = *(const f32x4*)(C.conv_b + ch0 + 4);
#pragma unroll
              for (int c = 0; c < 4; ++c) { bs[c] = wa[c]; bs[4 + c] = wb[c]; } }
            float p3[8], p2[8], p1[8];
#pragma unroll
            for (int c = 0; c < 8; ++c) { p3[c] = head ? st[0][c >> 2][c & 3] : bfe(xr[0], c); p2[c] = head ? st[1][c >> 2][c & 3] : bfe(xr[1], c); p1[c] = head ? st[2][c >> 2][c & 3] : bfe(xr[2], c); }
#pragma unroll
            for (int et = 0; et < 8; ++et) {
                float val[8];
#pragma unroll
                for (int c = 0; c < 8; ++c) { const float cur = bfe(xr[et + 3], c);
                    val[c] = silu_f(bs[c] + wt[0][c] * p3[c] + wt[1][c] * p2[c] + wt[2][c] * p1[c] + wt[3][c] * cur); p3[c] = p2[c]; p2[c] = p1[c]; p1[c] = cur; }
                v4u wv; wv.x = cvtpk(val[0], val[1]); wv.y = cvtpk(val[2], val[3]); wv.z = cvtpk(val[4], val[5]); wv.w = cvtpk(val[6], val[7]);
                *(v4u*)(C.XC + (size_t)(row0 + et) * 768 + ch0) = wv;
            }
        }
    }
}

__device__ __forceinline__ void chain_ssd(LAS unsigned char* L, const MixP& C, const int g, const int b0, const int mode, const int sc0, const int tid) {
    const bool smp = (mode == 1);
    const int w = __builtin_amdgcn_readfirstlane(tid >> 6), lane = tid & 63;
    const int hh2 = w >> 2, ps = w & 3, h2 = 2 * g + hh2;
    const float A0 = -__expf(C.a_log[2 * g]), A1 = -__expf(C.a_log[2 * g + 1]), dtb0 = C.dt_b[2 * g], dtb1 = C.dt_b[2 * g + 1], D0 = C.ssm_d[2 * g], D1 = C.ssm_d[2 * g + 1];
    f32x4 S[8];
#pragma unroll
    for (int nt = 0; nt < 8; ++nt) S[nt] = (f32x4){0.f, 0.f, 0.f, 0.f};
    const int cu1 = tid >> 8, ct = tid & 255;
    const int tg1 = ct / 48, bl1 = ct - tg1 * 48, lc01 = 8 * bl1;
    const int ch01 = (bl1 < 16) ? 128 * g + lc01 : (bl1 < 32) ? 256 + 128 * g + (lc01 - 128) : 512 + 128 * g + (lc01 - 256);
    const int tbase = smp ? 0 : sc0 * 64 + cu1 * 32;
    const int rowbase = smp ? MP + (b0 + cu1) * TS : b0 * TP;
    v4u xr[8]; bf16 sdraw = 0;
    if (ct < 192) { const bf16* xsrc = C.XC + (size_t)(rowbase + (smp ? 0 : tbase + 8 * tg1)) * 768 + ch01;
#pragma unroll
        for (int et = 0; et < 8; ++et) xr[et] = *(const v4u*)(xsrc + (size_t)et * 768); }
    else { const int t1 = ct & 31, hh = (ct - 192) >> 5; const bool valid = smp ? (t1 < TS) : true;
        sdraw = C.P[(size_t)(rowbase + tbase + (valid ? t1 : 0)) * NINP + PC_DT + 2 * g + hh]; }
    const int tok3 = tid >> 3, c83 = tid & 7, u3 = tok3 >> 5, i3 = tok3 & 31;
    const bool valid3 = smp ? (i3 < TS) : true;
    const int row3 = smp ? (MP + (b0 + u3) * TS + (valid3 ? i3 : 0)) : (b0 * TP + sc0 * 64 + tok3);
    v4u zz0, zz1;
    { const bf16* zrow = C.P + (size_t)row3 * NINP + PC_SZ + 128 * g + 16 * c83; zz0 = *(const v4u*)zrow; zz1 = *(const v4u*)(zrow + 8); }
    LAS float* cst = (LAS float*)(L + MIX_CONST_OFF);
    if (tid < 128) cst[tid] = C.ssm_n[128 * g + tid];
    {
        LAS unsigned char* U = L + cu1 * SL::UNIT;
        if (ct < 192) {
            const int tg = tg1, bl = bl1, lc0 = lc01;
            const bool tok_ok = smp ? (tg == 0) : true;
            if (!tok_ok) {
#pragma unroll
                for (int et = 0; et < 8; ++et) xr[et] = (v4u){0u, 0u, 0u, 0u};
            }
            if (bl >= 16) {
                LAS unsigned char* rb = U + ((bl < 32) ? SL::OFF_B + (lc0 - 128) * 2 : SL::OFF_C + (lc0 - 256) * 2) + (8 * tg) * 272;
#pragma unroll
                for (int et = 0; et < 8; ++et) *(LAS v4u*)(rb + et * 272) = xr[et];
            }
            if (bl < 32) {
                LAS unsigned char* tb = U + ((bl < 16) ? SL::OFF_XT + lc0 * 80 : SL::OFF_BT + (lc0 - 128) * 80) + 16 * tg;
#pragma unroll
                for (int c = 0; c < 8; ++c) { v4u o;
#pragma unroll
                    for (int k = 0; k < 4; ++k) { const unsigned a = xr[2 * k][c >> 1], b = xr[2 * k + 1][c >> 1]; o[k] = (c & 1) ? ((a >> 16) | (b & 0xffff0000u)) : ((a & 0xffffu) | (b << 16)); }
                    *(LAS v4u*)(tb + c * 80) = o; }
            }
        } else {
            const int t1 = ct & 31, hh = (ct - 192) >> 5;
            const bool valid = smp ? (t1 < TS) : true;
            const float dt = valid ? softplus_f(bf2f(sdraw) + ((hh == 0) ? dtb0 : dtb1)) : 0.f;
            float c0 = dt * ((hh == 0) ? A0 : A1);
            c0 += dpp_sel<0x111, 0xf>(0.f, c0); c0 += dpp_sel<0x112, 0xf>(0.f, c0); c0 += dpp_sel<0x114, 0xf>(0.f, c0); c0 += dpp_sel<0x118, 0xf>(0.f, c0); c0 += dpp_bcast15(0.f, c0);
            const float cl = (lane & 32) ? __builtin_bit_cast(float, __builtin_amdgcn_readlane(__builtin_bit_cast(int, c0), 63)) : __builtin_bit_cast(float, __builtin_amdgcn_readlane(__builtin_bit_cast(int, c0), 31));
            LAS float* tab = (LAS float*)(U + SL::OFF_TAB) + hh * 160;
            tab[t1] = c0; tab[32 + t1] = __expf(c0); tab[64 + t1] = dt; tab[96 + t1] = dt * __expf(cl - c0);
            if (t1 == 31) tab[128] = __expf(cl);
        }
    }
    LDS_BARRIER();
    const int q2 = lane >> 4, p2 = 16 * ps + (lane & 15);
    float* dsp = C.DS + ((((size_t)(b0 * 2 + g) * (TP / 64) + sc0) * 2 + hh2) * 64 + p2) * 128;
    if (mode == 2) {
#pragma unroll 1
        for (int u = 0; u < 2; ++u) s2_ssd_state(L + u * SL::UNIT, S, hh2, ps, lane);
#pragma unroll
        for (int nt = 0; nt < 8; ++nt) *(f32x4*)(dsp + 16 * nt + 4 * q2) = S[nt];
        if (ps == 0 && lane == 0) C.ESC[((size_t)(b0 * 2 + g) * (TP / 64) + sc0) * 2 + hh2] = ((const LAS float*)(L + SL::OFF_TAB))[hh2 * 160 + 128] * ((const LAS float*)(L + SL::UNIT + SL::OFF_TAB))[hh2 * 160 + 128];
    } else if (mode == 3) {
#pragma unroll
        for (int nt = 0; nt < 8; ++nt) S[nt] = *(const f32x4*)(dsp + 16 * nt + 4 * q2);
#pragma unroll 1
        for (int u = 0; u < 2; ++u) s2_ssd_unit(L + u * SL::UNIT, S, hh2, ps, lane, (hh2 == 0) ? D0 : D1);
    } else {
#pragma unroll 1
        for (int u = 0; u < 2; ++u) {
            const float* sp = C.s_ssm + (((size_t)(b0 + u) * 4 + h2) * 64 + p2) * 128;
#pragma unroll
            for (int nt = 0; nt < 8; ++nt) S[nt] = *(const f32x4*)(sp + 16 * nt + 4 * q2);
            s2_ssd_unit(L + u * SL::UNIT, S, hh2, ps, lane, (hh2 == 0) ? D0 : D1);
            float* so = C.out + O_SSMS + ((((size_t)C.l * BS + b0 + u) * 4 + h2) * 64 + p2) * 128;
#pragma unroll
            for (int nt = 0; nt < 8; ++nt) *(f32x4*)(so + 16 * nt + 4 * q2) = S[nt];
        }
    }
    LDS_BARRIER();
    if (mode != 2) {
        const LAS float* yb = (const LAS float*)(L + u3 * SL::UNIT + SL::OFF_Y) + i3 * 132 + 16 * c83;
        float y[16]; float ss = 0.f;
#pragma unroll
        for (int j = 0; j < 4; ++j) { const f32x4 v = *(const LAS f32x4*)(yb + 4 * j);
#pragma unroll
            for (int e = 0; e < 4; ++e) { const int ee = 4 * j + e; const float zv = (ee < 8) ? bfe(zz0, ee) : bfe(zz1, ee - 8); y[ee] = v[e] * zv; ss += y[ee] * y[ee]; } }
        ss = oct_sum(ss);
        const float r = rsqrtf(ss * (1.0f / 128.0f) + 1e-6f);
        if (valid3) {
            float nwv[16];
#pragma unroll
            for (int j = 0; j < 4; ++j) { const f32x4 t = *(const LAS f32x4*)(cst + 16 * c83 + 4 * j); nwv[4 * j] = t[0]; nwv[4 * j + 1] = t[1]; nwv[4 * j + 2] = t[2]; nwv[4 * j + 3] = t[3]; }
            v4u w0, w1;
            w0.x = cvtpk(y[0] * r * nwv[0], y[1] * r * nwv[1]); w0.y = cvtpk(y[2] * r * nwv[2], y[3] * r * nwv[3]); w0.z = cvtpk(y[4] * r * nwv[4], y[5] * r * nwv[5]); w0.w = cvtpk(y[6] * r * nwv[6], y[7] * r * nwv[7]);
            w1.x = cvtpk(y[8] * r * nwv[8], y[9] * r * nwv[9]); w1.y = cvtpk(y[10] * r * nwv[10], y[11] * r * nwv[11]); w1.z = cvtpk(y[12] * r * nwv[12], y[13] * r * nwv[13]); w1.w = cvtpk(y[14] * r * nwv[14], y[15] * r * nwv[15]);
            bf16* mo = C.mixb + (size_t)row3 * D + MC_SSM + 128 * g + 16 * c83;
            *(v4u*)mo = w0; *(v4u*)(mo + 8) = w1;
        }
    }
    LDS_BARRIER();
}

__device__ __forceinline__ void ssd_scan(const MixP& C, const int wg, const int nwgs, const int tid) {
    constexpr int NSC = TP / 64, NQ = BP * 2 * 2 * 2048;
    const int per = (((NQ + nwgs - 1) / nwgs) + 63) & ~63;
    const int qi = wg * per + tid;
    if (tid < per && qi < NQ) {
        const int e = (qi & 2047) * 4, bgh = __builtin_amdgcn_readfirstlane(qi >> 11), hh = bgh & 1, bg = bgh >> 1;
        float* dp = C.DS + ((size_t)bg * NSC * 2 + hh) * 8192 + e;
        const float* ep = C.ESC + (size_t)bg * NSC * 2 + hh;
        f32x4 s = {0.f, 0.f, 0.f, 0.f};
#pragma unroll 1
        for (int h0 = 0; h0 < NSC; h0 += NSC / 2) {
            f32x4 d[NSC / 2]; float E[NSC / 2];
#pragma unroll
            for (int k = 0; k < NSC / 2; ++k) { d[k] = *(const f32x4*)(dp + (size_t)(h0 + k) * 2 * 8192); E[k] = ep[(h0 + k) * 2]; }
#pragma unroll
            for (int k = 0; k < NSC / 2; ++k) { *(f32x4*)(dp + (size_t)(h0 + k) * 2 * 8192) = s; s = s * E[k] + d[k]; }
        }
        const int b = bg >> 1, g = bg & 1;
        *(f32x4*)(C.out + O_SSMP + (((size_t)C.l * BP + b) * 4 + 2 * g + hh) * 8192 + e) = s;
    }
}

__device__ __forceinline__ void sub_barrier(unsigned* cnt, const unsigned nwg) {
    asm volatile("s_waitcnt vmcnt(0)" ::: "memory");
    __syncthreads();
    if (threadIdx.x == 0) {
        __builtin_amdgcn_fence(__ATOMIC_RELEASE, "agent");
        asm volatile("s_waitcnt vmcnt(0)" ::: "memory");
        (void)__hip_atomic_fetch_add(cnt, 1u, __ATOMIC_RELAXED, __HIP_MEMORY_SCOPE_AGENT);
        unsigned sp = 0;
        while (__hip_atomic_load(cnt, __ATOMIC_RELAXED, __HIP_MEMORY_SCOPE_AGENT) < nwg) { __builtin_amdgcn_s_sleep(2); if (++sp > (1u << 22)) break; }
        __builtin_amdgcn_fence(__ATOMIC_ACQUIRE, "agent");
        asm volatile("s_waitcnt vmcnt(0)" ::: "memory");
    }
    __syncthreads();
}
__device__ __forceinline__ void pool_item(LAS unsigned char* L, const MixP& C, const int tile, const int tid) {
    constexpr int DF_OFF = 40960, WT_OFF = 74752;
    const int m0 = tile * 64;
    {
        f32x4 wv[8];
#pragma unroll
        for (int i = 0; i < 8; ++i) { const int e4 = tid + NTHREADS * i; wv[i] = *(const f32x4*)(C.pool_w + (size_t)e4 * 4); }
#pragma unroll
        for (int i = 0; i < 8; ++i) { const int e4 = tid + NTHREADS * i, d0 = (e4 & 15) * 4, c = (e4 >> 4) & 63, g = e4 >> 10;
            LAS unsigned char* wp = L + WT_OFF + g * 9216 + d0 * 144 + c * 2;
            const unsigned p01 = cvtpk(wv[i][0], wv[i][1]), p23 = cvtpk(wv[i][2], wv[i][3]);
            *(LAS unsigned short*)(wp) = (unsigned short)(p01 & 0xffffu); *(LAS unsigned short*)(wp + 144) = (unsigned short)(p01 >> 16);
            *(LAS unsigned short*)(wp + 288) = (unsigned short)(p23 & 0xffffu); *(LAS unsigned short*)(wp + 432) = (unsigned short)(p23 >> 16); }
    }
    if (m0 < MP) {
        const int tt0 = m0 & (TP - 1);
#pragma unroll
        for (int idx = tid; idx < 79 * 32; idx += NTHREADS) {
            const int r = idx >> 5, c8 = idx & 31, tr = tt0 - 15 + r, trc = tr < 0 ? 0 : tr;
            const v4u ld = *(const v4u*)(C.P + (size_t)(m0 - tt0 + trc) * NINP + PC_PX + 8 * c8);
            *(LAS v4u*)(L + r * 512 + c8 * 16) = (tr >= 0) ? ld : (v4u){0u, 0u, 0u, 0u};
        }
        LDS_BARRIER();
        {
            const int c = tid & 255, th = tid >> 8, g = c >> 6, w = 2 << g, tA = 32 * th;
            const LAS unsigned short* col = (const LAS unsigned short*)L + c;
            float s = 0.f;
            for (int j = 1; j < w; ++j) s += bf2f(col[(tA + 15 - j) * 256]);
            for (int t = tA; t < tA + 32; ++t) {
                const float x = bf2f(col[(t + 15) * 256]); s += x;
                const int tt = tt0 + t, cnt = (tt + 1 < w) ? tt + 1 : w;
                *(LAS unsigned short*)(L + DF_OFF + t * 528 + c * 2) = (unsigned short)(cvtpk(s * __builtin_amdgcn_rcpf((float)cnt) - x, 0.f) & 0xffffu);
                s -= bf2f(col[(t + 16 - w) * 256]);
            }
        }
    } else {
#pragma unroll 1
        for (int task = tid; task < 8 * 256; task += NTHREADS) {
            const int bb = task >> 8, c = task & 255, g = c >> 6, w = 2 << g, bg = (m0 - MP) / TS + bb;
            float xs[23];
#pragma unroll
            for (int r = 0; r < 15; ++r) xs[r] = C.s_pool[((size_t)bg * 15 + r) * 256 + c];
            bf16 xraw[8];
#pragma unroll
            for (int t = 0; t < 8; ++t) xraw[t] = C.P[(size_t)(m0 + bb * TS + t) * NINP + PC_PX + c];
#pragma unroll
            for (int t = 0; t < 8; ++t) xs[15 + t] = bf2f(xraw[t]);
            const float rw = __builtin_amdgcn_rcpf((float)w);
#pragma unroll
            for (int t = 0; t < 8; ++t) { float s = 0.f;
#pragma unroll
                for (int j = 0; j < 16; ++j) s += (j < w) ? xs[15 + t - j] : 0.f;
                *(LAS unsigned short*)(L + DF_OFF + (bb * TS + t) * 528 + c * 2) = (unsigned short)(cvtpk(s * rw - xs[15 + t], 0.f) & 0xffffu); }
        }
    }
    LDS_BARRIER();
    {
        const int w8 = __builtin_amdgcn_readfirstlane(tid >> 6), lane = tid & 63, q = lane >> 4, r16 = lane & 15, g = w8 >> 1, dh = w8 & 1;
        f32x4 acc[2][4];
#pragma unroll
        for (int a = 0; a < 2; ++a)
#pragma unroll
            for (int b = 0; b < 4; ++b) acc[a][b] = (f32x4){0.f, 0.f, 0.f, 0.f};
#pragma unroll
        for (int ks = 0; ks < 2; ++ks) {
            bf16x8 wa[2], db[4];
#pragma unroll
            for (int a = 0; a < 2; ++a) wa[a] = frag16(L + WT_OFF + g * 9216 + (16 * (2 * dh + a) + r16) * 144 + (32 * ks + 8 * q) * 2);
#pragma unroll
            for (int b = 0; b < 4; ++b) db[b] = frag16(L + DF_OFF + (16 * b + r16) * 528 + (g * 64 + 32 * ks + 8 * q) * 2);
#pragma unroll
            for (int a = 0; a < 2; ++a)
#pragma unroll
                for (int b = 0; b < 4; ++b) acc[a][b] = MFMA16(wa[a], db[b], acc[a][b]);
        }
#pragma unroll
        for (int a = 0; a < 2; ++a) {
            const int d0 = g * 64 + 16 * (2 * dh + a) + 4 * q;
            const f32x4 sc = *(const f32x4*)(C.pool_scale + d0);
#pragma unroll
            for (int b = 0; b < 4; ++b) { const f32x4 v = acc[a][b] * sc; v2u o; o.x = cvtpk(v[0], v[1]); o.y = cvtpk(v[2], v[3]);
                *(v2u*)(C.mixb + (size_t)(m0 + 16 * b + r16) * D + MC_POOL + d0) = o; }
        }
    }
    LDS_BARRIER();
}

constexpr int N_CP_PP = BP * 15 * 32, N_CP_PS = BS * 15 * 32, N_CP_CP = BP * 3 * 96, N_CP_CS = BS * 3 * 96, N_CP = N_CP_PP + N_CP_PS + N_CP_CP + N_CP_CS;
__device__ __forceinline__ void copy_states(const MixP& C, const int wg, const int nwgs, const int tid) {
    const int l = C.l;
    for (int i = wg * NTHREADS + tid; i < N_CP; i += nwgs * NTHREADS) {
        const bf16* src = nullptr; const float* fsrc = nullptr; float* dst;
        if (i < N_CP_PP) { const int b = i / 480, rem = i % 480, r = rem >> 5, c = (rem & 31) * 8;
            src = C.P + (size_t)(b * TP + TP - 15 + r) * NINP + PC_PX + c; dst = C.out + O_POOLP + ((size_t)(l * BP + b) * 15 + r) * 256 + c; }
        else if (i < N_CP_PP + N_CP_PS) { const int j = i - N_CP_PP, b = j / 480, rem = j % 480, r = rem >> 5, c = (rem & 31) * 8;
            if (r < 7) fsrc = C.s_pool + ((size_t)b * 15 + 8 + r) * 256 + c; else src = C.P + (size_t)(MP + b * TS + (r - 7)) * NINP + PC_PX + c;
            dst = C.out + O_POOLS + ((size_t)(l * BS + b) * 15 + r) * 256 + c; }
        else if (i < N_CP_PP + N_CP_PS + N_CP_CP) { const int j = i - N_CP_PP - N_CP_PS, b = j / 288, rem = j % 288, r = rem / 96, c = (rem % 96) * 8;
            src = C.P + (size_t)(b * TP + TP - 3 + r) * NINP + PC_XBC + c; dst = C.out + O_CONVP + ((size_t)(l * BP + b) * 3 + r) * 768 + c; }
        else { const int j = i - N_CP_PP - N_CP_PS - N_CP_CP, b = j / 288, rem = j % 288, r = rem / 96, c = (rem % 96) * 8;
            src = C.P + (size_t)(MP + b * TS + 5 + r) * NINP + PC_XBC + c; dst = C.out + O_CONVS + ((size_t)(l * BS + b) * 3 + r) * 768 + c; }
        f32x4 v0, v1;
        if (src) { const v4u w = *(const v4u*)src; v0 = (f32x4){bfe(w, 0), bfe(w, 1), bfe(w, 2), bfe(w, 3)}; v1 = (f32x4){bfe(w, 4), bfe(w, 5), bfe(w, 6), bfe(w, 7)}; }
        else { v0 = *(const f32x4*)fsrc; v1 = *(const f32x4*)(fsrc + 4); }
        *(f32x4*)dst = v0; *(f32x4*)(dst + 4) = v1;
    }
}

constexpr int NGH = BP * 8, N_SSD_IT = BP * 2 * (TP / 64), N_IT_SMP_GH = (BS / 4) * 4, N_IT_SMP_SSD = (BS / 2) * 2, N_IT_POOL = M / 64;
constexpr int IT_M3 = N_SSD_IT, IT_SGLA = 2 * N_SSD_IT, IT_SHG = IT_SGLA + N_IT_SMP_GH, IT_SSSD = IT_SHG + N_IT_SMP_GH, IT_POOL = IT_SSSD + N_IT_SMP_SSD, IT_GHP = IT_POOL + N_IT_POOL, IT_END = IT_GHP + NGH;
constexpr int N_IT_PROMPT = NGH;
__device__ __forceinline__ void mixer_phase(unsigned char* ldsg, LAS unsigned char* ldsl, const MixP& C, int G, const int tid) {
    const int bx = blockIdx.x;
    const int ngh = (G >= 2 * NGH) ? NGH : 0;
    const int nw = G - ngh;
    int it, step, lim; bool synced;
#if defined(MK_SPIN_O) || defined(MK_SPIN_G)
    {
#ifdef MK_SPIN_O
        const bool spin = (bx >= ngh); const unsigned long long ticks = MK_SPIN_O;
#else
        const bool spin = (bx < ngh); const unsigned long long ticks = MK_SPIN_G;
#endif
        if (spin) { const unsigned long long t0 = __builtin_amdgcn_s_memrealtime(); while (__builtin_amdgcn_s_memrealtime() - t0 < ticks) __builtin_amdgcn_s_sleep(8); }
    }
#endif
    if (bx < ngh) { it = IT_GHP + bx; step = 1 << 30; lim = IT_END; synced = true; }
    else { it = bx - ngh; step = nw; lim = (ngh > 0) ? IT_GHP : IT_END; synced = false; copy_states(C, bx - ngh, nw, tid); }
    int rep_it = 0;
    constexpr int NFILL = 64, V_SYNC = N_SSD_IT + NFILL;
    for (int vi = it; vi < lim; vi += step) {
        it = vi;
        if (ngh > 0 && bx >= ngh) {
            if (vi < N_SSD_IT) it = vi;
            else if (vi < V_SYNC) it = IT_POOL + (vi - N_SSD_IT);
            else if (vi < V_SYNC + N_SSD_IT) it = IT_M3 + (vi - V_SYNC);
            else if (vi < V_SYNC + N_SSD_IT + N_IT_SMP_SSD) it = IT_SSSD + (vi - V_SYNC - N_SSD_IT);
            else if (vi < V_SYNC + N_SSD_IT + N_IT_SMP_SSD + (N_IT_POOL - NFILL)) it = IT_POOL + NFILL + (vi - (V_SYNC + N_SSD_IT + N_IT_SMP_SSD));
            else it = IT_SGLA + (vi - (V_SYNC + N_SSD_IT + N_IT_SMP_SSD + (N_IT_POOL - NFILL)));
        }
        if (!synced && ((ngh > 0) ? (vi >= V_SYNC) : (it >= IT_M3))) { sub_barrier(C.subc, (unsigned)nw); ssd_scan(C, bx - ngh, nw, tid); sub_barrier(C.subc + 64, (unsigned)nw); synced = true; }
        int tidl = tid; asm volatile("" : "+v"(tidl));
        int kind, a, b0, mode = 0, sc0 = 0; bool smp = true;
        if (it < IT_SGLA) { const int j = (it < IT_M3) ? it : it - IT_M3; kind = 2; mode = (it < IT_M3) ? 2 : 3; sc0 = j & (TP / 64 - 1); a = (j >> 5) & 1; b0 = j >> 6; }
        else if (it < IT_SHG) { const int j = it - IT_SGLA; kind = 0; a = j & 3; b0 = (j >> 2) * 4; }
        else if (it < IT_SSSD) { const int j = it - IT_SHG; kind = 1; a = j & 3; b0 = (j >> 2) * 4; }
        else if (it < IT_POOL) { const int j = it - IT_SSSD; kind = 2; mode = 1; a = j & 1; b0 = (j >> 1) * 2; }
        else if (it < IT_GHP) { kind = 3; a = it - IT_POOL; b0 = 0; }
        else { const int j = it - IT_GHP; smp = false; b0 = j >> 3; kind = ((j & 7) < 4) ? 0 : 1; a = j & 3; }
        if (kind == 0) {
#ifndef MK_NO_GLA
            chain_gh<0>(ldsl, C, a, b0, smp, tidl);
#endif
        } else if (kind == 1) {
#ifndef MK_NO_HGRN
            chain_gh<1>(ldsl, C, a, b0, smp, tidl);
#endif
        } else if (kind == 2) {
#ifndef MK_NO_SSD
            chain_ssd(ldsl, C, a, b0, mode, sc0, tidl);
#endif
        } else {
#ifndef MK_NO_POOL
            pool_item(ldsl, C, a, tidl);
#endif
        }
        int want = 1;
#ifdef MK_DUP_POOL
        if (kind == 3) want = 2;
#endif
#ifdef MK_DUP_SMPGH
        if (kind < 2 && smp) want = 2;
#endif
#ifdef MK_DUP_SMPSSD
        if (kind == 2 && mode == 1) want = 2;
#endif
#ifdef MK_DUP_GHP
        if (!smp) want = 2;
#endif
#ifdef MK_DUP_M3
        if (kind == 2 && mode == 3) want = 2;
#endif
        if (++rep_it < want) vi -= step; else rep_it = 0;
    }
    if (!synced) { sub_barrier(C.subc, (unsigned)nw); ssd_scan(C, bx - ngh, nw, tid); sub_barrier(C.subc + 64, (unsigned)nw); }
}

__device__ __forceinline__ void srg_phase(LAS unsigned char* L, const bf16* Aop, const bf16* Bt, const int K, bf16* xb, float* rowss, const float scale, const bool fin, const int G, const int tid) {
    const int w = __builtin_amdgcn_readfirstlane(tid >> 6), lane = tid & 63, q = lane >> 4, r16 = lane & 15, wm = w >> 1, wn = w & 1;
    const int lr = tid >> 3, lc = (tid & 7) * 8;
    const int nt = K / 128;
    for (int tile = blockIdx.x; tile < 256; tile += G) {
        const int tm = tile >> 4, tn = tile & 15;
        const bf16* ag = Aop + (size_t)(MP + 64 * tm + lr) * K + lc;
        const bf16* bg = Bt + (size_t)(64 * tn + lr) * K + lc;
        f32x4 acc0 = {0.f, 0.f, 0.f, 0.f}, acc1 = acc0;
        v4u ra[2][2], rb[2][2];
#pragma unroll
        for (int i = 0; i < 2; ++i) { ra[i][0] = *(const v4u*)(ag + i * 128); ra[i][1] = *(const v4u*)(ag + i * 128 + 64); rb[i][0] = *(const v4u*)(bg + i * 128); rb[i][1] = *(const v4u*)(bg + i * 128 + 64); }
        LAS unsigned char* wr0 = L + lr * 272 + lc * 2;
        const LAS unsigned char* fa = L + (16 * wm + r16) * 272 + (8 * q) * 2;
        const LAS unsigned char* fb = L + 17408 + (32 * wn + r16) * 272 + (8 * q) * 2;
#pragma unroll 1
        for (int t = 0; t < nt; t += 2) {
#pragma unroll
            for (int i = 0; i < 2; ++i) {
                LAS unsigned char* wb_ = wr0 + i * 34816;
                *(LAS v4u*)(wb_) = ra[i][0]; *(LAS v4u*)(wb_ + 128) = ra[i][1]; *(LAS v4u*)(wb_ + 17408) = rb[i][0]; *(LAS v4u*)(wb_ + 17408 + 128) = rb[i][1];
                { const int tn2 = (t + 2 + i < nt) ? t + 2 + i : i; const bf16* a2 = ag + (size_t)tn2 * 128; const bf16* b2 = bg + (size_t)tn2 * 128;
                  ra[i][0] = *(const v4u*)a2; ra[i][1] = *(const v4u*)(a2 + 64); rb[i][0] = *(const v4u*)b2; rb[i][1] = *(const v4u*)(b2 + 64); }
                LDS_BARRIER();
#pragma unroll
                for (int ks = 0; ks < 4; ++ks) {
                    const bf16x8 af = frag16(fa + i * 34816 + ks * 64), b0 = frag16(fb + i * 34816 + ks * 64), b1 = frag16(fb + i * 34816 + 16 * 272 + ks * 64);
                    acc0 = MFMA16(b0, af, acc0); acc1 = MFMA16(b1, af, acc1);
                }
            }
        }
        {
            const int row = MP + 64 * tm + 16 * wm + r16, col0 = 64 * tn + 32 * wn + 4 * q;
            bf16* px = xb + (size_t)row * D + col0;
            const v2u xa = *(const v2u*)px, xc = *(const v2u*)(px + 16);
            const float a0 = __builtin_bit_cast(float, xa.x << 16) + acc0[0] * scale, a1 = __builtin_bit_cast(float, xa.x & 0xffff0000u) + acc0[1] * scale, a2 = __builtin_bit_cast(float, xa.y << 16) + acc0[2] * scale, a3 = __builtin_bit_cast(float, xa.y & 0xffff0000u) + acc0[3] * scale;
            const float b0 = __builtin_bit_cast(float, xc.x << 16) + acc1[0] * scale, b1 = __builtin_bit_cast(float, xc.x & 0xffff0000u) + acc1[1] * scale, b2 = __builtin_bit_cast(float, xc.y << 16) + acc1[2] * scale, b3 = __builtin_bit_cast(float, xc.y & 0xffff0000u) + acc1[3] * scale;
            v2u wa, wb; wa.x = cvtpk(a0, a1); wa.y = cvtpk(a2, a3); wb.x = cvtpk(b0, b1); wb.y = cvtpk(b2, b3);
            *(v2u*)px = wa; *(v2u*)(px + 16) = wb;
            float ss = 0.f;
#pragma unroll
            for (int k = 0; k < 2; ++k) { const unsigned pa = wa[k], pb = wb[k]; const float r0 = __builtin_bit_cast(float, pa << 16), r1 = __builtin_bit_cast(float, pa & 0xffff0000u), r2 = __builtin_bit_cast(float, pb << 16), r3 = __builtin_bit_cast(float, pb & 0xffff0000u); ss += (r0 * r0 + r1 * r1) + (r2 * r2 + r3 * r3); }
            ss += __shfl_xor(ss, 16); ss += __shfl_xor(ss, 32);
            if (q == 0 && fin) unsafeAtomicAdd(rowss + row, ss);
        }
        LDS_BARRIER();
    }
}

__device__ __forceinline__ void final_phase(const Args& A, int wave, int lane, int G) {
    const int gw = blockIdx.x * NWAVES + wave, NGW = G * NWAVES;
    const float* rss = (const float*)(A.ws + WS_RSS) + (size_t)6 * M; const f32x4* gn = (const f32x4*)A.in[I_FINALN] + lane; const bf16* xb = (const bf16*)(A.ws + WS_XB);
    f32x4 g4[4];
#pragma unroll
    for (int j = 0; j < 4; ++j) g4[j] = gn[64 * j];
    for (int m0 = gw; m0 < M; m0 += 2 * NGW) {
        const int m1 = m0 + NGW; const bool two = m1 < M; const int m1c = two ? m1 : m0;
        const float q0 = rss[m0], q1 = rss[m1c];
        const v2u* x0 = (const v2u*)(xb + (size_t)m0 * D) + lane; const v2u* x1 = (const v2u*)(xb + (size_t)m1c * D) + lane;
        v2u w0[4], w1[4];
#pragma unroll
        for (int j = 0; j < 4; ++j) { w0[j] = x0[64 * j]; w1[j] = x1[64 * j]; }
        const float r0 = rsqrtf(q0 * (1.0f / 1024.0f) + 1e-6f), r1 = rsqrtf(q1 * (1.0f / 1024.0f) + 1e-6f);
        f32x4* y0 = (f32x4*)(A.out + (size_t)m0 * D) + lane; f32x4* y1 = (f32x4*)(A.out + (size_t)m1c * D) + lane;
#pragma unroll
        for (int j = 0; j < 4; ++j) { const v2u w = w0[j]; const f32x4 v = {__builtin_bit_cast(float, w.x << 16), __builtin_bit_cast(float, w.x & 0xffff0000u), __builtin_bit_cast(float, w.y << 16), __builtin_bit_cast(float, w.y & 0xffff0000u)};
            y0[64 * j] = v * r0 * g4[j]; }
        if (two) {
#pragma unroll
            for (int j = 0; j < 4; ++j) { const v2u w = w1[j]; const f32x4 v = {__builtin_bit_cast(float, w.x << 16), __builtin_bit_cast(float, w.x & 0xffff0000u), __builtin_bit_cast(float, w.y << 16), __builtin_bit_cast(float, w.y & 0xffff0000u)};
                y1[64 * j] = v * r1 * g4[j]; }
        }
    }
}

__device__ __forceinline__ void side_convert(const Args& A, LAS unsigned char* ldsl, const int tidv, const int first, const int G, const CvtList Lst) {
    const int wv = __builtin_amdgcn_readfirstlane(tidv >> 6);
    if (first > 0 && first < G) { if ((int)blockIdx.x >= first) convert_weights(A, ldsl, wv, tidv & 63, Lst, ((int)blockIdx.x - first) * NWAVES + wv, (G - first) * NWAVES); }
    else convert_weights(A, ldsl, wv, tidv & 63, Lst, (int)blockIdx.x * NWAVES + wv, G * NWAVES);
}
__device__ __forceinline__ int sub_of(int ph) { const int j = (ph - 1) & 7; return (j < 3) ? j : (j == 3 ? 7 : j - 1); }
__global__ void __launch_bounds__(NTHREADS, 2) mk_fwd(Args args) {
    extern __shared__ __attribute__((aligned(16))) unsigned char lds[];
    LAS unsigned char* ldsl = (LAS unsigned char*)lds;
    volatile LAS unsigned* MISC = (volatile LAS unsigned*)(ldsl + MISC_OFF);
    const int tid = threadIdx.x, lane = tid & 63, wave = __builtin_amdgcn_readfirstlane(tid >> 6), G = gridDim.x;
    unsigned char* ws = args.ws;
    gu32* ctl = (gu32*)(ws + WS_CTL);
    for (int u = tid; u < (LDS_BYTES - LDSCTL_OFF) / 4; u += NTHREADS) ((LAS unsigned*)(ldsl + LDSCTL_OFF))[u] = 0u;
    __syncthreads();
    const int lo = args.ph_lo, hi = args.ph_hi;
    XcdBarrier bar; bar.bar = (unsigned*)(ctl + CW_BAR); bar.x = 0; bar.st = nullptr;
    if (hi - lo > 1) bar = xcd_barrier_post((unsigned*)(ctl + CW_BAR), MISC + 8);

    bf16* xb = (bf16*)(ws + WS_XB); bf16* mixb = (bf16*)(ws + WS_MIX); bf16* hp = (bf16*)(ws + WS_HP);
    float* rss = (float*)(ws + WS_RSS);

    bool first = true;
    for (int si = 2 * lo; si < 2 * hi; ++si) {
        const int ph = si >> 1;
        if (si & 1) {
            bool dup = false;
#ifdef MK_DUP_P0
            dup = dup || (ph == 0);
#endif
#ifdef MK_DUP_MIX
            dup = dup || (ph >= 1 && ph < N_PHASES - 1 && sub_of(ph) == 3);
#endif
#ifdef MK_DUP_GU
            dup = dup || (ph >= 1 && ph < N_PHASES - 1 && (sub_of(ph) == 0 || sub_of(ph) == 5));
#endif
#ifdef MK_DUP_RESID
            dup = dup || (ph >= 1 && ph < N_PHASES - 1 && (sub_of(ph) == 1 || sub_of(ph) == 4 || sub_of(ph) == 6));
#endif
#ifdef MK_DUP_IN
            dup = dup || (ph >= 1 && ph < N_PHASES - 1 && sub_of(ph) == 2);
#endif
            if (!dup) continue;
        }
        if (!first) xcd_barrier(bar);
        first = false;
        int tidv = threadIdx.x; asm volatile("" : "+v"(tidv));
        if (ph == 0) {
#ifndef MK_NO_P0
            p0_prologue(args, ldsl, __builtin_amdgcn_readfirstlane(tidv >> 6), tidv & 63, G);
#endif
        }
        else if (ph == N_PHASES - 1) { final_phase(args, __builtin_amdgcn_readfirstlane(tidv >> 6), tidv & 63, G); }
        else {
            const int l = (ph - 1) / 8, s = sub_of(ph);
            CvtList side = {0, 0, 0, 0, 0, 0, 0, 0}; int side_first = 0;
            const unsigned char* wl = ws + WS_W + (size_t)l * W_LAYER;
            if (s == 0 || s == 5) {
                pg8::Gemm g{xb, (const bf16*)(wl + (s == 0 ? WO_GU1 : WO_GU2)), M, NGU, D}; pg8::StaticOrder S; S.init(M, NGU, G, (int)blockIdx.x);
                bool gdry = false;
#ifdef MK_DRY_GU
                gdry = (si & 1) == 0;
#endif
                pg8::EpiSwiGLU E{hp, FF, rss + (size_t)(3 * l + (s == 0 ? 0 : 2)) * M, gdry};
#ifndef MK_NO_G1
                pg8::gemm_phase<pg8::EpiSwiGLU, pg8::StaticOrder, PG8_ALIGN, PG8_SP2>(ldsl + RING_OFF, g, S, E, tidv);
#endif
                side = (l == 0) ? ((s == 0) ? CV_GU1_L0 : CV_GU2_L0) : ((s == 0) ? CV_GU1_L1 : CvtList{0, 0, 0, 0, 0, 0, 0, 0}); side_first = ((M / 256) * (NGU / 256)) % G;
            } else if (s == 1 || s == 4 || s == 6) {
                const bf16* Aop = (s == 4) ? mixb : hp; const int K = (s == 4) ? D : FF;
                const size_t wo = (s == 1) ? WO_D1 : (s == 4) ? WO_OUT : WO_D2;
                pg8::Gemm g{Aop, (const bf16*)(wl + wo), MP, D, K}; pg8::StaticOrder S; S.init(MP, D, G, (int)blockIdx.x);
                float* rso = rss + (size_t)(3 * l + (s == 1 ? 1 : (s == 4 ? 2 : 3))) * M;
                const float rscale = (s == 4) ? 1.0f : 0.5f;
                float esc = rscale; bool efin = true;
#ifdef MK_DUP_RESID
                esc = 0.5f * rscale; efin = (si & 1) != 0;
#endif
                pg8::EpiResid E{xb, rso, esc, efin};
#ifndef MK_NO_G2
                const bool srg_first = (blockIdx.x & 1) != 0;
                if (srg_first) srg_phase(ldsl + RING_OFF, Aop, (const bf16*)(wl + wo), K, xb, rso, esc, efin, G, tidv);
                pg8::gemm_phase<pg8::EpiResid, pg8::StaticOrder, PG8_ALIGN, PG8_SP2>(ldsl + RING_OFF, g, S, E, tidv);
                if (!srg_first)
#ifdef MK_DUP_SRG
                srg_phase(ldsl + RING_OFF, Aop, (const bf16*)(wl + wo), K, xb, rso, 0.5f * esc, false, G, tidv);
                srg_phase(ldsl + RING_OFF, Aop, (const bf16*)(wl + wo), K, xb, rso, 0.5f * esc, efin, G, tidv);
#else
                srg_phase(ldsl + RING_OFF, Aop, (const bf16*)(wl + wo), K, xb, rso, esc, efin, G, tidv);
#endif
#endif
            } else if (s == 2) {
                pg8::Gemm g{xb, (const bf16*)(wl + WO_IN), M, NINP, D}; pg8::StaticOrder S; S.init(M, NINP, G, (int)blockIdx.x);
                pg8::EpiProj E{hp, NINP, rss + (size_t)(3 * l + 1) * M};
#ifndef MK_NO_G3
                pg8::gemm_phase<pg8::EpiProj, pg8::StaticOrder, PG8_ALIGN, PG8_SP2>(ldsl + RING_OFF, g, S, E, tidv);
#endif
                side = (l == 0) ? CV_IN_L0 : CV_IN_L1; side_first = ((M / 256) * (NINP / 256)) % G;
            } else {
                MixP C;
                C.P = hp; C.mixb = mixb; C.out = args.out; C.l = l; C.XC = (bf16*)args.out;
                C.DS = args.out + 8388608; C.ESC = args.out + 16900000; C.subc = (unsigned*)(ctl + CW_SUB + 128 * l);
                C.s_pool = args.in[I_SPOOL] + (size_t)l * BS * 15 * 256; C.s_gla = args.in[I_SGLA] + (size_t)l * BS * 4 * 32 * 64; C.s_hgrn = args.in[I_SHGRN] + (size_t)l * BS * 4 * 64 * 64;
                C.s_ssm = args.in[I_SSSM] + (size_t)l * BS * 4 * 64 * 128; C.s_conv = args.in[I_SCONV] + (size_t)l * BS * 3 * 768;
                C.pool_w = args.in[I_POOLW] + (size_t)l * 4 * 64 * 64; C.pool_scale = args.in[I_POOLS] + l * 256; C.gla_wg = args.in[I_GLAWG] + l * 16 * 128; C.gla_b = args.in[I_GLAB] + l * 128;
                C.gla_n = args.in[I_GLAN] + l * 64; C.lbl = args.in[I_LBL]; C.hg_n = args.in[I_HGN] + l * 64; C.conv_w = args.in[I_CONVW] + l * 4 * 768; C.conv_b = args.in[I_CONVB] + l * 768;
                C.dt_b = args.in[I_DTB] + l * 4; C.a_log = args.in[I_ALOG] + l * 4; C.ssm_d = args.in[I_SSMD] + l * 4; C.ssm_n = args.in[I_SSMN] + l * 256;
#ifndef MK_NO_MIXER
                if (s == 7) conv_phase(C, G, tidv); else mixer_phase(lds + RING_OFF, ldsl + RING_OFF, C, G, tidv);
#endif
            }
            if (side.n0 + side.n1 > 0) side_convert(args, ldsl, tidv, side_first, G, side);
        }
    }
}

extern "C" void kernel_launch(void* const* d_in, const int* in_sizes, int n_in, void* d_out, int out_size, void* d_ws, size_t ws_size, hipStream_t stream) {
    static int grid = 0;
    if (grid == 0) {
        if (n_in != N_INPUTS || in_sizes[0] != MP * D || (size_t)out_size != O_END || ws_size < WS_END) {
            fprintf(stderr, "kernel_launch: shape mismatch: n_in %d, in0 %d, out %d, ws %zu (need %zu); nothing launched\n", n_in, n_in > 0 ? in_sizes[0] : -1, out_size, ws_size, (size_t)WS_END); grid = -1; return; }
        int dev = 0, cus = 0, per_cu = 0;
        if (hipGetDevice(&dev) != hipSuccess || hipDeviceGetAttribute(&cus, hipDeviceAttributeMultiprocessorCount, dev) != hipSuccess) { fprintf(stderr, "kernel_launch: device query failed\n"); grid = -1; return; }
        if (hipFuncSetAttribute((const void*)mk_fwd, hipFuncAttributeMaxDynamicSharedMemorySize, LDS_BYTES) != hipSuccess) { fprintf(stderr, "kernel_launch: hipFuncSetAttribute failed\n"); grid = -1; return; }
        if (hipOccupancyMaxActiveBlocksPerMultiprocessor(&per_cu, (const void*)mk_fwd, NTHREADS, LDS_BYTES) != hipSuccess || per_cu < 1) {
            fprintf(stderr, "kernel_launch: occupancy query reports %d workgroups per CU; nothing launched\n", per_cu); (void)hipGetLastError(); grid = -1; return; }
        grid = cus;
    }
    if (grid < 0) return;
    if (hipMemsetAsync((char*)d_ws + WS_CTL, 0, CTL_ZERO_BYTES, stream) != hipSuccess) { fprintf(stderr, "kernel_launch: hipMemsetAsync failed\n"); return; }
    Args a{};
    for (int i = 0; i < N_INPUTS; ++i) a.in[i] = (const float*)d_in[i];
    a.out = (float*)d_out; a.ws = (unsigned char*)d_ws;
    for (int li = 0; li < N_LAUNCHES; ++li) {
        a.ph_lo = (N_LAUNCHES == 1) ? 0 : li; a.ph_hi = (N_LAUNCHES == 1) ? N_PHASES : li + 1;
        hipLaunchKernelGGL(mk_fwd, dim3(grid), dim3(NTHREADS), LDS_BYTES, stream, a);
        const hipError_t le = hipPeekAtLastError();
        if (le != hipSuccess) { fprintf(stderr, "kernel_launch: launch %d failed: %s\n", li, hipGetErrorName(le)); break; }
    }
}
```

```cpp
#include <hip/hip_runtime.h>
#include <cstdio>
#include <cstdint>
namespace pg8 {
#define PG8_LAS __attribute__((address_space(3)))
typedef unsigned short bf16_t;
typedef short bf16x8 __attribute__((ext_vector_type(8)));
typedef float f32x4 __attribute__((ext_vector_type(4)));
typedef unsigned u32x4 __attribute__((ext_vector_type(4)));
constexpr int BM = 256, BK = 64, HALF = 128, HTB = HALF * BK * 2  , STAGE_BYTES = 8 * HTB, NXCD = 8, WGM = 8;

__host__ __device__ __forceinline__ int lds_byte(int r, int c) { const int st = (r >> 4) * 2 + (c >> 5), rr = r & 15, cc = c & 31, ob = rr * 64 + cc * 2; return st * 1024 + (ob ^ (((ob >> 9) & 1) << 5)); }
__host__ __device__ __forceinline__ void stage_rc(int b, int& R, int& C) { const int st = b / 1024, sb = b % 1024, swz = sb ^ (((sb >> 9) & 1) << 5); R = (st >> 1) * 16 + swz / 64; C = (st & 1) * 32 + (swz % 64) / 2; }
__host__ __device__ __forceinline__ int perm32(int rho) { const int n = rho >> 4, i = rho & 15; return 8 * (i >> 2) + 4 * n + (i & 3); }

struct Unit { int pm, pn; };
struct Gemm { const bf16_t* A; const bf16_t* Bt; int M, N, K; };

struct StaticOrder {
    int nM, nN, nwg, G, c;
    __host__ __device__ void init(int M, int N, int G_, int c_) { nM = M / BM; nN = N / BM; nwg = nM * nN; G = G_; c = c_; }
    __host__ __device__ bool next(int i, Unit& u) const {
        const long L = (long)i * G + c; if (L >= nwg) return false;
        int wgid = (int)L; { const int q = nwg / NXCD, r = nwg % NXCD, xcd = wgid % NXCD, off = wgid / NXCD; wgid = (xcd < r ? xcd * (q + 1) : r * (q + 1) + (xcd - r) * q) + off; }
        const int nig = WGM * nN, gid = wgid / nig, fm = gid * WGM, gsz = (nM - fm) < WGM ? (nM - fm) : WGM;
        u.pm = fm + ((wgid % nig) % gsz); u.pn = (wgid % nig) / gsz; return true;
    }
    __device__ __forceinline__ void a_ready(const Unit&) const {}
    __device__ __forceinline__ void done(const Unit&) const {}
};
__device__ __forceinline__ unsigned cvt_pk_bf16(float lo, float hi) { unsigned r; asm volatile("v_cvt_pk_bf16_f32 %0, %1, %2" : "=v"(r) : "v"(lo), "v"(hi)); return r; }
template <class Epi, class Sched, bool ALIGN_EPI = false, bool SP2 = false>
__device__ __forceinline__ void gemm_phase(PG8_LAS unsigned char* lds, const Gemm g, const Sched& S, const Epi& E, const int tid_in) {
    const int tid = tid_in, wid = __builtin_amdgcn_readfirstlane(tid >> 6), lane = tid & 63, wr = wid >> 2, wc = wid & 3, fr = lane & 15, fq = lane >> 4;
    const int K = g.K, nt = K / BK;
    unsigned voffA[2], voffB[2];
#pragma unroll
    for (int i = 0; i < 2; ++i) { int R, C; stage_rc(tid * 16 + i * 8192, R, C); const int Rb = Epi::PERM ? ((R & ~31) + perm32(R & 31)) : R;
        voffA[i] = (unsigned)(R * K + C) * 2u; voffB[i] = (unsigned)(Rb * K + C) * 2u; }
    const size_t kstep = (size_t)(BK * 2);
    const size_t hstep = (size_t)HALF * K * 2;
    const size_t tstep = 2 * hstep;
    const unsigned ldsw = (unsigned)wid * 1024u;
    const int aoff = lds_byte(wr * 64 + fr, fq * 8), boff = lds_byte(wc * 32 + fr, fq * 8);
#define PG8_SA(b, h) (((b) * 2 + (h)) * HTB)
#define PG8_SB(b, h) ((4 + (b) * 2 + (h)) * HTB)
#define PG8_STAGE(bufoff, gbase, voff) do { _Pragma("unroll") for (int _i = 0; _i < 2; ++_i) \
        __builtin_amdgcn_global_load_lds((const unsigned*)((const char*)(gbase) + (voff)[_i]), (PG8_LAS unsigned*)(lds + (bufoff) + ldsw + _i * 8192), 16, 0, 0); } while (0)
#define PG8_LDA(dst, b, h) do { _Pragma("unroll") for (int m = 0; m < 4; ++m) _Pragma("unroll") for (int k = 0; k < 2; ++k) dst[m][k] = *(const PG8_LAS bf16x8*)(lds + PG8_SA(b, h) + aoff + m * 2048 + k * 1024); } while (0)
#define PG8_LDB(dst, b, h) do { _Pragma("unroll") for (int n = 0; n < 2; ++n) _Pragma("unroll") for (int k = 0; k < 2; ++k) dst[n][k] = *(const PG8_LAS bf16x8*)(lds + PG8_SB(b, h) + boff + n * 2048 + k * 1024); } while (0)
#define PG8_MMA(ai, bj, At, Bt) do { __builtin_amdgcn_s_setprio(1); _Pragma("unroll") for (int m = 0; m < 4; ++m) _Pragma("unroll") for (int n = 0; n < 2; ++n) _Pragma("unroll") for (int k = 0; k < 2; ++k) \
        acc[ai][bj][m][n] = __builtin_amdgcn_mfma_f32_16x16x32_bf16(Bt[n][k], At[m][k], acc[ai][bj][m][n], 0, 0, 0); __builtin_amdgcn_s_setprio(0); } while (0)
#define PG8_WAIT_V(n) asm volatile("s_waitcnt vmcnt(" #n ")" ::: "memory")
#define PG8_WAIT_L(n) asm volatile("s_waitcnt lgkmcnt(" #n ")" ::: "memory")
#define PG8_BAR __builtin_amdgcn_s_barrier()
#define PG8_SCHED __builtin_amdgcn_sched_barrier(0)
    Unit cur, nxt; int ui = 0;
    if (!S.next(0, cur)) return;
    f32x4 acc[2][2][4][2];
#pragma unroll
    for (int a = 0; a < 2; ++a)
#pragma unroll
        for (int b = 0; b < 2; ++b)
#pragma unroll
            for (int m = 0; m < 4; ++m)
#pragma unroll
                for (int n = 0; n < 2; ++n) acc[a][b][m][n] = (f32x4){0.f, 0.f, 0.f, 0.f};
    bf16x8 At[4][2], B0[2][2], B1[2][2];
    const char* cA = (const char*)g.A + (size_t)cur.pm * tstep; const char* cB = (const char*)g.Bt + (size_t)cur.pn * tstep;
    S.a_ready(cur);
    if constexpr (SP2) {
        PG8_STAGE(PG8_SB(0, 0), cB, voffB); PG8_STAGE(PG8_SB(0, 1), cB + hstep, voffB); PG8_STAGE(PG8_SA(0, 0), cA, voffA); PG8_STAGE(PG8_SA(0, 1), cA + hstep, voffA);
        if (wr == 1) PG8_BAR;
        PG8_WAIT_V(2); PG8_BAR;
        PG8_STAGE(PG8_SB(1, 0), cB + kstep, voffB); PG8_STAGE(PG8_SA(1, 0), cA + kstep, voffA); PG8_STAGE(PG8_SB(1, 1), cB + hstep + kstep, voffB);
        PG8_WAIT_V(6); PG8_BAR;
    } else {
        PG8_STAGE(PG8_SB(0, 0), cB, voffB); PG8_STAGE(PG8_SA(0, 0), cA, voffA); PG8_STAGE(PG8_SB(0, 1), cB + hstep, voffB); PG8_STAGE(PG8_SA(0, 1), cA + hstep, voffA);
        if (wr == 1) PG8_BAR;
        PG8_WAIT_V(4); PG8_BAR;
        PG8_STAGE(PG8_SB(1, 0), cB + kstep, voffB); PG8_STAGE(PG8_SA(1, 0), cA + kstep, voffA); PG8_STAGE(PG8_SB(1, 1), cB + hstep + kstep, voffB);
        PG8_WAIT_V(6); PG8_BAR;
    }
    for (;;) {
        const bool has_next = S.next(ui + 1, nxt);
        const char* nA = has_next ? (const char*)g.A + (size_t)nxt.pm * tstep : cA; const char* nB = has_next ? (const char*)g.Bt + (size_t)nxt.pn * tstep : cB;
        for (int t = 0; t < nt; t += 2) {
            const bool last = (t == nt - 2);
            const char* a1 = cA + (size_t)(t + 1) * kstep;
            const char* a2 = last ? nA : cA + (size_t)(t + 2) * kstep; const char* b2 = last ? nB : cB + (size_t)(t + 2) * kstep;
            const char* a3 = a2 + kstep; const char* b3 = b2 + kstep;
            if (last && has_next) S.a_ready(nxt);
            if constexpr (SP2) {
            PG8_LDB(B0, 0, 0); PG8_LDB(B1, 0, 1); PG8_SCHED; PG8_LDA(At, 0, 0); PG8_STAGE(PG8_SA(1, 1), a1 + hstep, voffA);
            PG8_WAIT_V(8); PG8_WAIT_L(0); PG8_BAR; PG8_MMA(0, 0, At, B0); PG8_MMA(0, 1, At, B1); PG8_BAR; PG8_SCHED;
            PG8_LDA(At, 0, 1); PG8_STAGE(PG8_SB(0, 0), b2, voffB); PG8_STAGE(PG8_SB(0, 1), b2 + hstep, voffB); PG8_STAGE(PG8_SA(0, 0), a2, voffA);
            PG8_WAIT_V(8); PG8_WAIT_L(0); PG8_BAR; PG8_MMA(1, 0, At, B0); PG8_MMA(1, 1, At, B1); PG8_BAR; PG8_SCHED;
            PG8_LDB(B0, 1, 0); PG8_LDB(B1, 1, 1); PG8_SCHED; PG8_LDA(At, 1, 0); PG8_STAGE(PG8_SA(0, 1), a2 + hstep, voffA);
            PG8_WAIT_V(8); PG8_WAIT_L(0); PG8_BAR; PG8_MMA(0, 0, At, B0); PG8_MMA(0, 1, At, B1); PG8_BAR; PG8_SCHED;
            PG8_LDA(At, 1, 1); PG8_STAGE(PG8_SB(1, 0), b3, voffB); PG8_STAGE(PG8_SB(1, 1), b3 + hstep, voffB); PG8_STAGE(PG8_SA(1, 0), a3, voffA);
            PG8_WAIT_V(8); PG8_WAIT_L(0); PG8_BAR; PG8_MMA(1, 0, At, B0); PG8_MMA(1, 1, At, B1); PG8_BAR; PG8_SCHED;
            } else {
            PG8_LDB(B0, 0, 0); PG8_SCHED; PG8_LDA(At, 0, 0); PG8_STAGE(PG8_SA(1, 1), a1 + hstep, voffA);
            PG8_WAIT_L(8); PG8_BAR; PG8_WAIT_L(0); PG8_MMA(0, 0, At, B0); PG8_BAR; PG8_SCHED;
            PG8_LDB(B1, 0, 1); PG8_STAGE(PG8_SB(0, 0), b2, voffB);
            PG8_BAR; PG8_WAIT_L(0); PG8_MMA(0, 1, At, B1); PG8_BAR;
            PG8_LDA(At, 0, 1); PG8_STAGE(PG8_SA(0, 0), a2, voffA);
            PG8_BAR; PG8_WAIT_L(0); PG8_MMA(1, 0, At, B0); PG8_BAR; PG8_SCHED;
            PG8_STAGE(PG8_SB(0, 1), b2 + hstep, voffB);
            PG8_WAIT_V(6); PG8_BAR; PG8_MMA(1, 1, At, B1); PG8_BAR;
            PG8_LDB(B0, 1, 0); PG8_SCHED; PG8_LDA(At, 1, 0); PG8_STAGE(PG8_SA(0, 1), a2 + hstep, voffA);
            PG8_WAIT_L(8); PG8_BAR; PG8_WAIT_L(0); PG8_MMA(0, 0, At, B0); PG8_BAR; PG8_SCHED;
            PG8_LDB(B1, 1, 1); PG8_STAGE(PG8_SB(1, 0), b3, voffB);
            PG8_BAR; PG8_WAIT_L(0); PG8_MMA(0, 1, At, B1); PG8_BAR;
            PG8_LDA(At, 1, 1); PG8_STAGE(PG8_SA(1, 0), a3, voffA);
            PG8_BAR; PG8_WAIT_L(0); PG8_MMA(1, 0, At, B0); PG8_BAR; PG8_SCHED;
            PG8_STAGE(PG8_SB(1, 1), b3 + hstep, voffB);
            PG8_WAIT_V(6); PG8_BAR; PG8_MMA(1, 1, At, B1); PG8_BAR;
            }
        }
        if constexpr (ALIGN_EPI) { if (wr == 0) PG8_BAR; }
        if constexpr (!Epi::AFTER_DRAIN) { E(acc, cur, wr, wc, fr, fq); S.done(cur); }
        if (!has_next) break;
#pragma unroll
        for (int a = 0; a < 2; ++a)
#pragma unroll
            for (int b = 0; b < 2; ++b)
#pragma unroll
                for (int m = 0; m < 4; ++m)
#pragma unroll
                    for (int n = 0; n < 2; ++n) acc[a][b][m][n] = (f32x4){0.f, 0.f, 0.f, 0.f};
        cur = nxt; cA = nA; cB = nB; ++ui;
        if constexpr (ALIGN_EPI) { if (wr == 1) PG8_BAR; }
    }
    PG8_WAIT_V(0);
    if constexpr (!ALIGN_EPI) { if (wr == 0) PG8_BAR; }
    PG8_BAR;
    if constexpr (Epi::AFTER_DRAIN) { E.fused(acc, cur, wr, wc, fr, fq, lds, wid, lane); S.done(cur); }
#undef PG8_SA
#undef PG8_SB
#undef PG8_STAGE
#undef PG8_LDA
#undef PG8_LDB
#undef PG8_MMA
#undef PG8_WAIT_V
#undef PG8_WAIT_L
#undef PG8_BAR
#undef PG8_SCHED
}
}

#ifndef PG8_SP2
#define PG8_SP2 true
#endif
#ifndef PG8_ALIGN
#define PG8_ALIGN true
#endif
namespace pg8 {
constexpr float RMS_EPS = 1e-6f;
__device__ __forceinline__ float silu_f(float x) { return x * __builtin_amdgcn_rcpf(1.0f + __expf(-x)); }
typedef float f32x2n __attribute__((ext_vector_type(2)));
typedef __bf16 bf16x2n __attribute__((ext_vector_type(2)));
__device__ __forceinline__ unsigned cvt2_bf16(float lo, float hi) { const f32x2n v = {lo, hi}; return __builtin_bit_cast(unsigned, __builtin_convertvector(v, bf16x2n)); }

struct EpiSwiGLU {
    static constexpr bool PERM = true, AFTER_DRAIN = false;
    bf16_t* H; int ldh; const float* rowss; bool dry;
    __device__ __forceinline__ void operator()(const f32x4 (&acc)[2][2][4][2], const Unit& u, int wr, int wc, int fr, int fq) const {
        if (dry) { asm volatile("" :: "v"(acc[0][0][0][0]), "v"(acc[1][1][3][1])); return; }
        const int row0 = u.pm * BM + wr * 64 + fr, col0 = u.pn * HALF + wc * 32 + 8 * fq;
        float rs[2][4];
#pragma unroll
        for (int ai = 0; ai < 2; ++ai)
#pragma unroll
            for (int m = 0; m < 4; ++m) rs[ai][m] = rowss[row0 + ai * HALF + m * 16];
#pragma unroll
        for (int ai = 0; ai < 2; ++ai)
#pragma unroll
            for (int m = 0; m < 4; ++m) {
                const int row = row0 + ai * HALF + m * 16;
                const float ms = rs[ai][m] * (1.0f / 1024.0f) + RMS_EPS, c1 = -1.4426950408889634f * rsqrtf(ms);
                const f32x4 g0 = acc[ai][0][m][0], g1 = acc[ai][0][m][1], u0 = acc[ai][1][m][0], u1 = acc[ai][1][m][1];
                const f32x4 t0 = g0 * c1, t1 = g1 * c1; f32x4 e0, e1, i0, i1;
#pragma unroll
                for (int e = 0; e < 4; ++e) { e0[e] = __builtin_amdgcn_exp2f(t0[e]); e1[e] = __builtin_amdgcn_exp2f(t1[e]); }
                const f32x4 d0 = e0 * ms + ms, d1 = e1 * ms + ms;
#pragma unroll
                for (int e = 0; e < 4; ++e) { i0[e] = __builtin_amdgcn_rcpf(d0[e]); i1[e] = __builtin_amdgcn_rcpf(d1[e]); }
                const f32x4 h0 = (g0 * u0) * i0, h1 = (g1 * u1) * i1;
                u32x4 w; w.x = cvt2_bf16(h0[0], h0[1]); w.y = cvt2_bf16(h0[2], h0[3]); w.z = cvt2_bf16(h1[0], h1[1]); w.w = cvt2_bf16(h1[2], h1[3]);
                *(u32x4*)(H + (size_t)row * ldh + col0) = w;
            }
    }
};
struct EpiResid {
    static constexpr bool PERM = true, AFTER_DRAIN = false;
    bf16_t* xb; float* rowss; float scale; bool fin;
    __device__ __forceinline__ void operator()(const f32x4 (&acc)[2][2][4][2], const Unit& u, int wr, int wc, int fr, int fq) const {
        const int row0 = u.pm * BM + wr * 64 + fr, col0 = u.pn * BM + wc * 32 + 8 * fq;
        u32x4 xv[2][4][2];
#pragma unroll
        for (int ai = 0; ai < 2; ++ai)
#pragma unroll
            for (int m = 0; m < 4; ++m)
#pragma unroll
                for (int bj = 0; bj < 2; ++bj) xv[ai][m][bj] = *(const u32x4*)(xb + (size_t)(row0 + ai * HALF + m * 16) * 1024 + col0 + bj * HALF);
        float ssv[2][4];
#pragma unroll
        for (int ai = 0; ai < 2; ++ai)
#pragma unroll
            for (int m = 0; m < 4; ++m) {
                const int row = row0 + ai * HALF + m * 16;
                float ss = 0.f;
#pragma unroll
                for (int bj = 0; bj < 2; ++bj) {
                    const u32x4 xo = xv[ai][m][bj]; u32x4 w;
#pragma unroll
                    for (int k = 0; k < 4; ++k) {
                        const float a0 = __uint_as_float(xo[k] << 16) + acc[ai][bj][m][k >> 1][(k & 1) * 2] * scale, a1 = __uint_as_float(xo[k] & 0xffff0000u) + acc[ai][bj][m][k >> 1][(k & 1) * 2 + 1] * scale;
                        const unsigned p = cvt_pk_bf16(a0, a1); w[k] = p;
                        const float r0 = __uint_as_float(p << 16), r1 = __uint_as_float(p & 0xffff0000u); ss += r0 * r0 + r1 * r1;
                    }
                    *(u32x4*)(xb + (size_t)row * 1024 + col0 + bj * HALF) = w;
                }
                ssv[ai][m] = ss;
            }
#pragma unroll
        for (int ai = 0; ai < 2; ++ai)
#pragma unroll
            for (int m = 0; m < 4; ++m) ssv[ai][m] += __shfl_xor(ssv[ai][m], 16);
#pragma unroll
        for (int ai = 0; ai < 2; ++ai)
#pragma unroll
            for (int m = 0; m < 4; ++m) ssv[ai][m] += __shfl_xor(ssv[ai][m], 32);
        if (fq == 0 && fin) {
#pragma unroll
            for (int ai = 0; ai < 2; ++ai)
#pragma unroll
                for (int m = 0; m < 4; ++m) unsafeAtomicAdd(rowss + row0 + ai * HALF + m * 16, ssv[ai][m]);
        }
    }
};
struct EpiProj {
    static constexpr bool PERM = true, AFTER_DRAIN = false;
    bf16_t* P; int ldp; const float* rowss;
    __device__ __forceinline__ void operator()(const f32x4 (&acc)[2][2][4][2], const Unit& u, int wr, int wc, int fr, int fq) const {
        const int row0 = u.pm * BM + wr * 64 + fr, col0 = u.pn * BM + wc * 32 + 8 * fq;
        const bool act = (u.pn == 3) || (u.pn == 4) || (u.pn == 7) || (u.pn == 8);
        float rs[2][4];
#pragma unroll
        for (int ai = 0; ai < 2; ++ai)
#pragma unroll
            for (int m = 0; m < 4; ++m) rs[ai][m] = rowss[row0 + ai * HALF + m * 16];
#pragma unroll
        for (int ai = 0; ai < 2; ++ai)
#pragma unroll
            for (int m = 0; m < 4; ++m) {
                const int row = row0 + ai * HALF + m * 16;
                const float r = rsqrtf(rs[ai][m] * (1.0f / 1024.0f) + RMS_EPS);
#pragma unroll
                for (int bj = 0; bj < 2; ++bj) {
                    f32x4 a = acc[ai][bj][m][0] * r, b = acc[ai][bj][m][1] * r;
                    if (act) {
#pragma unroll
                        for (int e = 0; e < 4; ++e) { a[e] = silu_f(a[e]); b[e] = silu_f(b[e]); }
                    }
                    u32x4 w; w.x = cvt_pk_bf16(a[0], a[1]); w.y = cvt_pk_bf16(a[2], a[3]); w.z = cvt_pk_bf16(b[0], b[1]); w.w = cvt_pk_bf16(b[2], b[3]);
                    *(u32x4*)(P + (size_t)row * ldp + col0 + bj * HALF) = w;
                }
            }
    }
};
}

constexpr int NWAVES = 8, NTHREADS = 512;
#ifndef MK_N_LAUNCHES
#define MK_N_LAUNCHES 1
#endif
constexpr int N_PHASES = 18;
constexpr int N_LAUNCHES = MK_N_LAUNCHES;

constexpr int D = 1024, FF = 2816, NGU = 2 * FF, NIN = 3092, NINP = 3328, DEPTH = 2;
constexpr int BP = 8, TP = 2048, BS = 128, TS = 8, PAST_LEN = 16384;
constexpr int MP = BP * TP, MS = BS * TS, M = MP + MS;
static_assert(M % 256 == 0 && NGU % 256 == 0 && NINP % 256 == 0 && FF % 128 == 0, "GEMM tiling");
static_assert(DEPTH == 2, "the HGRN2 lower bounds (cumulative softmax over layers minus its first term) are written out for two layers: 0 and softmax(logits)[1] = sigmoid(l1 - l0)");
constexpr int PC_PX = 0, PC_GQ = 256, PC_GK = 384, PC_GV = 512, PC_GR = 768, PC_RQ = 1024, PC_RF = 1280, PC_RI = 1536, PC_RG = 1792, PC_SZ = 2048, PC_XBC = 2304, PC_LR = 3072, PC_DT = 3088;
constexpr int MC_POOL = 0, MC_GLA = 256, MC_HGRN = 512, MC_SSM = 768;
enum { I_XP = 0, I_XS, I_SPOOL, I_SGLA, I_SHGRN, I_SSSM, I_SCONV, I_F1N, I_F1G, I_F1U, I_F1D, I_MIXN, I_WIN, I_POOLW, I_POOLS, I_GLAWG, I_GLAB, I_GLAN,
       I_LBL, I_HGN, I_CONVW, I_CONVB, I_DTB, I_ALOG, I_SSMD, I_SSMN, I_WOUT, I_F2N, I_F2G, I_F2U, I_F2D, I_FINALN, N_INPUTS };
constexpr size_t O_YP = 0, O_YS = O_YP + (size_t)MP * D, O_POOLP = O_YS + (size_t)MS * D, O_POOLS = O_POOLP + (size_t)DEPTH * BP * 15 * 256,
    O_GLAP = O_POOLS + (size_t)DEPTH * BS * 15 * 256, O_GLAS = O_GLAP + (size_t)DEPTH * BP * 4 * 32 * 64, O_HGP = O_GLAS + (size_t)DEPTH * BS * 4 * 32 * 64,
    O_HGS = O_HGP + (size_t)DEPTH * BP * 4 * 64 * 64, O_SSMP = O_HGS + (size_t)DEPTH * BS * 4 * 64 * 64, O_SSMS = O_SSMP + (size_t)DEPTH * BP * 4 * 64 * 128,
    O_CONVP = O_SSMS + (size_t)DEPTH * BS * 4 * 64 * 128, O_CONVS = O_CONVP + (size_t)DEPTH * BP * 3 * 768, O_END = O_CONVS + (size_t)DEPTH * BS * 3 * 768;
static_assert(O_END == 35094528, "output size");

constexpr size_t KiB = 1024, MiB = 1u << 20;
constexpr size_t WS_CTL = 0, CTL_ZERO_BYTES = 1 * MiB;
constexpr size_t WS_RSS = 512 * KiB;
static_assert(WS_RSS + 7 * (size_t)M * 4 <= CTL_ZERO_BYTES, "rowss inside the memset region");
constexpr size_t WS_W = 1 * MiB, W_LAYER = 41 * MiB + 512 * KiB;
constexpr size_t WO_GU1 = 0, WO_D1 = 11 * MiB, WO_IN = 16 * MiB + 512 * KiB, WO_OUT = 23 * MiB, WO_GU2 = 25 * MiB, WO_D2 = 36 * MiB;
static_assert((size_t)NGU * D * 2 == 11 * MiB && (size_t)D * FF * 2 == 5 * MiB + 512 * KiB && (size_t)NINP * D * 2 == 6 * MiB + 512 * KiB && WO_D2 + 5 * MiB + 512 * KiB == W_LAYER, "weight map");
constexpr size_t WS_XB = WS_W + 2 * W_LAYER;
constexpr size_t WS_MIX = WS_XB + 34 * MiB;
constexpr size_t WS_HP = WS_MIX + 34 * MiB;
constexpr size_t WS_END = WS_HP + (size_t)M * NINP * 2;
static_assert((size_t)M * D * 2 == 34 * MiB && WS_END == 262 * MiB + 512 * KiB, "d_ws map");
constexpr int CW_BAR = 4096;
constexpr int CW_SUB = 8192;
constexpr int RING_OFF = 0, RING_BYTES = 131072;
constexpr int LDSCTL_OFF = RING_BYTES, MISC_OFF = LDSCTL_OFF + 320;
constexpr int LDS_BYTES = 147456;

#define GAS __attribute__((address_space(1)))
#define LAS __attribute__((address_space(3)))
typedef unsigned short bf16;
typedef unsigned v4u __attribute__((ext_vector_type(4)));
typedef unsigned v2u __attribute__((ext_vector_type(2)));
typedef float f32x4 __attribute__((ext_vector_type(4)));
typedef GAS unsigned gu32;
#define RLX_AGENT __ATOMIC_RELAXED, __HIP_MEMORY_SCOPE_AGENT
#define LDS_WAIT() asm volatile("s_waitcnt lgkmcnt(0)" ::: "memory")
#define VM_WAIT() asm volatile("s_waitcnt vmcnt(0)" ::: "memory")
#define LDS_BARRIER() asm volatile("s_waitcnt lgkmcnt(0)\n\ts_barrier" ::: "memory")
__device__ __forceinline__ unsigned f2bf(float f) { unsigned u = __builtin_bit_cast(unsigned, f); return (u + 0x7fffu + ((u >> 16) & 1u)) >> 16; }
__device__ __forceinline__ unsigned pk2(float lo, float hi) { return f2bf(lo) | (f2bf(hi) << 16); }
__device__ __forceinline__ float bf2f(bf16 b) { return __builtin_bit_cast(float, (unsigned)b << 16); }
__device__ __forceinline__ float sigmoid_f(float x) { return __builtin_amdgcn_rcpf(1.0f + __expf(-x)); }
__device__ __forceinline__ float silu_f(float x) { return x * __builtin_amdgcn_rcpf(1.0f + __expf(-x)); }
__device__ __forceinline__ float lse0_f(float x) { return 0.6931471805599453f * __builtin_amdgcn_logf(1.0f + __builtin_amdgcn_exp2f(-1.4426950408889634f * fabsf(x))); }
__device__ __forceinline__ float softplus_f(float x) { return fmaxf(x, 0.f) + lse0_f(x); }
__device__ __forceinline__ float logsigmoid_f(float x) { return fminf(x, 0.f) - lse0_f(x); }
typedef float f32x2v __attribute__((ext_vector_type(2)));
typedef __bf16 bf16x2v __attribute__((ext_vector_type(2)));
__device__ __forceinline__ unsigned cvtpk(float lo, float hi) { const f32x2v v = {lo, hi}; return __builtin_bit_cast(unsigned, __builtin_convertvector(v, bf16x2v)); }
#define XB_TMO      128
#define XB_XCNT(j)  (256  + 64 * (j))
#define XB_XSUB(j)  (1280 + 64 * (j))
#define XB_XGEN(j)  (2304 + 64 * (j))
#define XB_TOP      3328
#define XB_TOPGEN   3392
#define XCD_BAR_WORDS 3456
#define XB_SPIN_CAP (1u << 18)

__device__ __forceinline__ unsigned xb_ld(unsigned* p)              { return __hip_atomic_load(p, __ATOMIC_RELAXED, __HIP_MEMORY_SCOPE_AGENT); }
__device__ __forceinline__ unsigned xb_add(unsigned* p, unsigned v) { return __hip_atomic_fetch_add(p, v, __ATOMIC_RELAXED, __HIP_MEMORY_SCOPE_AGENT); }
__device__ __forceinline__ unsigned xb_xcc_id() { return (unsigned)__builtin_amdgcn_s_getreg((3 << 11) | 20) & 0xFu; }
#define XB_SPIN(cond, bar) do { unsigned _sp = 0; while (cond) { __builtin_amdgcn_s_sleep(1); \
    if ((++_sp & 255u) == 0u) { if (xb_ld(&(bar)[XB_TMO])) break; if (_sp > XB_SPIN_CAP) { atomicAdd(&(bar)[XB_TMO], 1u); break; } } } } while (0)

struct XcdBarrier {
    unsigned* bar; unsigned x;
    volatile LAS unsigned* st;
};

__device__ __forceinline__ XcdBarrier xcd_barrier_post(unsigned* bar, volatile LAS unsigned* st) {
    XcdBarrier b; b.bar = bar; b.x = xb_xcc_id(); b.st = st;
    if (threadIdx.x == 0) (void)xb_add(&bar[XB_XCNT(b.x)], 1u);
    return b;
}
__device__ __forceinline__ void xcd_barrier_complete(unsigned* bar, unsigned x, unsigned& nloc, unsigned& nx) {
    const unsigned G = gridDim.x * gridDim.y * gridDim.z;
    unsigned sum, cnt, mine, sp = 0u;
    for (;;) {
        sum = 0u; cnt = 0u; mine = 0u;
#pragma unroll
        for (unsigned j = 0; j < 16; ++j) { const unsigned c = xb_ld(&bar[XB_XCNT(j)]); sum += c; cnt += (c > 0u) ? 1u : 0u; mine = (j == x) ? c : mine; }
        if (sum == G) break;
        __builtin_amdgcn_s_sleep(1);
        if ((++sp & 255u) == 0u) { if (xb_ld(&bar[XB_TMO])) break; if (sp > XB_SPIN_CAP) { atomicAdd(&bar[XB_TMO], 1u); break; } }
    }
    nloc = mine > 0u ? mine : 1u; nx = cnt > 0u ? cnt : 1u;
}

__device__ __forceinline__ void xcd_barrier(const XcdBarrier& b) {
    asm volatile("s_waitcnt vmcnt(0)" ::: "memory");
    __syncthreads();
    if (threadIdx.x == 0) {
        unsigned* bar = b.bar;
        __builtin_amdgcn_s_waitcnt(0);
        unsigned nloc = b.st[0], nx = b.st[1];
        if (nloc == 0u) { xcd_barrier_complete(bar, b.x, nloc, nx); b.st[0] = nloc; b.st[1] = nx; }
        const unsigned old = xb_add(&bar[XB_XSUB(b.x)], 1u);
        const unsigned gen = old / nloc;
        if (old + 1u == (gen + 1u) * nloc) {
            __builtin_amdgcn_fence(__ATOMIC_RELEASE, "agent");
            asm volatile("s_waitcnt vmcnt(0)" ::: "memory");
            const unsigned og = xb_add(&bar[XB_TOP], 1u);
            const unsigned tg = og / nx;
            if (og + 1u == (tg + 1u) * nx) xb_add(&bar[XB_TOPGEN], 1u);
            else XB_SPIN(xb_ld(&bar[XB_TOPGEN]) == tg, bar);
            __builtin_amdgcn_fence(__ATOMIC_ACQUIRE, "agent");
            xb_add(&bar[XB_XGEN(b.x)], 1u);
            asm volatile("s_waitcnt vmcnt(0)" ::: "memory");
        } else {
            XB_SPIN(xb_ld(&bar[XB_XGEN(b.x)]) == gen, bar);
            __builtin_amdgcn_fence(__ATOMIC_ACQUIRE, "agent");
            asm volatile("s_waitcnt vmcnt(0)" ::: "memory");
        }
    }
    __syncthreads();
}

struct Args { const float* in[N_INPUTS]; float* out; unsigned char* ws; int ph_lo, ph_hi; };
static_assert(sizeof(Args) == 34 * 8 + 8, "Args has no holes");

__device__ __forceinline__ float wave_sum(float v) {
#pragma unroll
    for (int o = 1; o < 64; o <<= 1) v += __shfl_xor(v, o);
    return v;
}

template <int KIND>
__device__ __forceinline__ void p0_item(const float* W0, const float* W1, int K, int Nsrc, const float* gain, bf16* WT, LAS float* scr, int item, int nblk, int lane) {
    const int kb = item / nblk, nb = item % nblk, k0 = 64 * kb, n0 = 32 * nb;
    if (KIND == 2 && n0 >= 3072) {
        const int np = n0 + (lane & 31);
        int col = 0; bool valid = true;
        if (np < 3088) col = 1024 + (np - 3072); else if (np < NIN) col = np; else valid = false;
        float vv[32];
#pragma unroll
        for (int i = 0; i < 32; ++i) vv[i] = W0[(size_t)(k0 + 2 * i + (lane >> 5)) * Nsrc + col];
#pragma unroll
        for (int i = 0; i < 32; ++i) { const int kk = 2 * i + (lane >> 5); float v = valid ? vv[i] : 0.f; if (gain) v *= gain[k0 + kk]; scr[kk * 33 + (lane & 31)] = v; }
    } else {
        const float* W = W0; int col0 = n0;
        if (KIND == 0) { const int pn = n0 >> 8, bj = (n0 >> 7) & 1, jj = n0 & 127; W = bj ? W1 : W0; col0 = pn * 128 + jj; }
        if (KIND == 2) col0 = (n0 < 1024) ? n0 : n0 + 16;
        const int kr = lane >> 3, nq = lane & 7;
        f32x4 vv[8]; float gv[8];
#pragma unroll
        for (int i = 0; i < 8; ++i) vv[i] = *(const f32x4*)(W + (size_t)(k0 + 8 * i + kr) * Nsrc + col0 + 4 * nq);
#pragma unroll
        for (int i = 0; i < 8; ++i) gv[i] = gain ? gain[k0 + 8 * i + kr] : 1.0f;
#pragma unroll
        for (int i = 0; i < 8; ++i) { LAS float* sp = scr + (8 * i + kr) * 33 + 4 * nq; const f32x4 v = vv[i] * gv[i]; sp[0] = v[0]; sp[1] = v[1]; sp[2] = v[2]; sp[3] = v[3]; }
    }
    LDS_WAIT(); asm volatile("" ::: "memory");
    const int c = lane & 7;
#pragma unroll
    for (int j = 0; j < 4; ++j) { const int n = (lane >> 3) + 8 * j; const LAS float* s = scr + (8 * c) * 33 + n;
        v4u o; o.x = cvtpk(s[0 * 33], s[1 * 33]); o.y = cvtpk(s[2 * 33], s[3 * 33]); o.z = cvtpk(s[4 * 33], s[5 * 33]); o.w = cvtpk(s[6 * 33], s[7 * 33]);
        *(v4u*)(WT + (size_t)(n0 + n) * K + k0 + 8 * c) = o; }
    LDS_WAIT(); asm volatile("" ::: "memory");
}
constexpr int IT_GU = (D / 64) * (NGU / 32), IT_D = (FF / 64) * (D / 32), IT_IN = (D / 64) * (NINP / 32), IT_OUT = (D / 64) * (D / 32);
constexpr int IT_LAYER = 2 * IT_GU + 2 * IT_D + IT_IN + IT_OUT;

struct CvtList { int a0, n0, a1, n1, a2, n2, a3, n3; };
constexpr int R_GU1 = 0, R_D1 = IT_GU, R_IN = R_D1 + IT_D, R_OUT = R_IN + IT_IN, R_GU2 = R_OUT + IT_OUT, R_D2 = R_GU2 + IT_GU, N_LATE = IT_LAYER - R_OUT;
static_assert(R_D2 + IT_D == IT_LAYER && IT_GU == 2816 && IT_D == 1408 && IT_IN == 1664 && N_LATE == 4736, "conversion item map");
constexpr int G1A = 352, G1B = 864, G1C = IT_GU - G1A - G1B;
#ifndef MK_CVT_ALL_EARLY
constexpr CvtList CV_P0 = {R_GU1, IT_GU, R_IN, IT_IN, IT_LAYER + R_IN, IT_IN, IT_LAYER + R_GU1, G1A};
constexpr CvtList CV_GU1_L0 = {R_D1, IT_D, 0, 0, 0, 0, 0, 0};
constexpr CvtList CV_IN_L0 = {R_OUT, N_LATE, IT_LAYER + R_GU1 + G1A, G1B, 0, 0, 0, 0};
constexpr CvtList CV_GU2_L0 = {IT_LAYER + R_GU1 + G1A + G1B, G1C, 0, 0, 0, 0, 0, 0};
constexpr CvtList CV_GU1_L1 = {IT_LAYER + R_D1, IT_D, 0, 0, 0, 0, 0, 0};
constexpr CvtList CV_IN_L1 = {IT_LAYER + R_OUT, N_LATE, 0, 0, 0, 0, 0, 0};
#else
constexpr CvtList CV_P0 = {0, DEPTH * IT_LAYER, 0, 0, 0, 0, 0, 0};
constexpr CvtList CV_GU1_L0 = {0, 0, 0, 0, 0, 0, 0, 0}, CV_IN_L0 = CV_GU1_L0, CV_GU2_L0 = CV_GU1_L0, CV_GU1_L1 = CV_GU1_L0, CV_IN_L1 = CV_GU1_L0;
#endif
static_assert(G1C == 1600 && CV_P0.n0 + CV_P0.n1 + CV_P0.n2 + CV_P0.n3 + CV_GU1_L0.n0 + CV_IN_L0.n0 + CV_IN_L0.n1 + CV_GU2_L0.n0 + CV_GU1_L1.n0 + CV_IN_L1.n0 == DEPTH * IT_LAYER, "every weight item is converted exactly once");
struct CvtItem { const float* W; const float* gain; bf16* WT; int K, Nsrc, col0, k0, n0; bool spec; };
__device__ __forceinline__ CvtItem cvt_decode(const Args& A, const int it) {
    CvtItem c; const int l = it / IT_LAYER; int r = it % IT_LAYER;
    unsigned char* wl = A.ws + WS_W + (size_t)l * W_LAYER;
    int kind, nblk; const float* W0; const float* W1 = nullptr; c.gain = nullptr;
    if (r < IT_GU) { kind = 0; W0 = A.in[I_F1G] + (size_t)l * D * FF; W1 = A.in[I_F1U] + (size_t)l * D * FF; c.K = D; c.Nsrc = FF; c.gain = A.in[I_F1N] + l * D; c.WT = (bf16*)(wl + WO_GU1); nblk = NGU / 32; }
    else if ((r -= IT_GU) < IT_D) { kind = 1; W0 = A.in[I_F1D] + (size_t)l * D * FF; c.K = FF; c.Nsrc = D; c.WT = (bf16*)(wl + WO_D1); nblk = D / 32; }
    else if ((r -= IT_D) < IT_IN) { kind = 2; W0 = A.in[I_WIN] + (size_t)l * D * NIN; c.K = D; c.Nsrc = NIN; c.gain = A.in[I_MIXN] + l * D; c.WT = (bf16*)(wl + WO_IN); nblk = NINP / 32; }
    else if ((r -= IT_IN) < IT_OUT) { kind = 1; W0 = A.in[I_WOUT] + (size_t)l * D * D; c.K = D; c.Nsrc = D; c.WT = (bf16*)(wl + WO_OUT); nblk = D / 32; }
    else if ((r -= IT_OUT) < IT_GU) { kind = 0; W0 = A.in[I_F2G] + (size_t)l * D * FF; W1 = A.in[I_F2U] + (size_t)l * D * FF; c.K = D; c.Nsrc = FF; c.gain = A.in[I_F2N] + l * D; c.WT = (bf16*)(wl + WO_GU2); nblk = NGU / 32; }
    else { r -= IT_GU; kind = 1; W0 = A.in[I_F2D] + (size_t)l * D * FF; c.K = FF; c.Nsrc = D; c.WT = (bf16*)(wl + WO_D2); nblk = D / 32; }
    const int kb = r / nblk, nb = r % nblk; c.k0 = 64 * kb; c.n0 = 32 * nb; c.spec = (kind == 2) && (c.n0 >= 3072);
    c.W = W0; c.col0 = c.n0;
    if (kind == 0) { const int pn = c.n0 >> 8, bj = (c.n0 >> 7) & 1, jj = c.n0 & 127; c.W = bj ? W1 : W0; c.col0 = pn * 128 + jj; }
    if (kind == 2) c.col0 = (c.n0 < 1024) ? c.n0 : c.n0 + 16;
    return c;
}
__device__ __forceinline__ void cvt_load(const CvtItem& c, const int lane, f32x4 (&vv)[8], float (&gv)[8]) {
    const int kr = lane >> 3, nq = lane & 7;
    if (!c.spec) {
#pragma unroll
        for (int i = 0; i < 8; ++i) vv[i] = *(const f32x4*)(c.W + (size_t)(c.k0 + 8 * i + kr) * c.Nsrc + c.col0 + 4 * nq);
#pragma unroll
        for (int i = 0; i < 8; ++i) gv[i] = c.gain ? c.gain[c.k0 + 8 * i + kr] : 1.0f;
    }
}
__device__ __forceinline__ void cvt_finish(const CvtItem& c, const int lane, LAS float* scr, const f32x4 (&vv)[8], const float (&gv)[8]) {
    if (c.spec) {
        const int np = c.n0 + (lane & 31);
        int col = 0; bool valid = true;
        if (np < 3088) col = 1024 + (np - 3072); else if (np < NIN) col = np; else valid = false;
        float ev[32];
#pragma unroll
        for (int i = 0; i < 32; ++i) ev[i] = c.W[(size_t)(c.k0 + 2 * i + (lane >> 5)) * c.Nsrc + col];
#pragma unroll
        for (int i = 0; i < 32; ++i) { const int kk = 2 * i + (lane >> 5); float v = valid ? ev[i] : 0.f; if (c.gain) v *= c.gain[c.k0 + kk]; scr[kk * 33 + (lane & 31)] = v; }
    } else {
        const int kr = lane >> 3, nq = lane & 7;
#pragma unroll
        for (int i = 0; i < 8; ++i) { LAS float* sp = scr + (8 * i + kr) * 33 + 4 * nq; const f32x4 v = vv[i] * gv[i]; sp[0] = v[0]; sp[1] = v[1]; sp[2] = v[2]; sp[3] = v[3]; }
    }
    LDS_WAIT(); asm volatile("" ::: "memory");
    const int cc = lane & 7;
#pragma unroll
    for (int j = 0; j < 4; ++j) { const int n = (lane >> 3) + 8 * j; const LAS float* sr = scr + (8 * cc) * 33 + n;
        v4u o; o.x = cvtpk(sr[0 * 33], sr[1 * 33]); o.y = cvtpk(sr[2 * 33], sr[3 * 33]); o.z = cvtpk(sr[4 * 33], sr[5 * 33]); o.w = cvtpk(sr[6 * 33], sr[7 * 33]);
        *(v4u*)(c.WT + (size_t)(c.n0 + n) * c.K + c.k0 + 8 * cc) = o; }
    LDS_WAIT(); asm volatile("" ::: "memory");
}
__device__ __forceinline__ void convert_weights(const Args& A, LAS unsigned char* ldsl, int wave, int lane, const CvtList Lst, int gw, int NGW) {
    LAS float* scr = (LAS float*)(ldsl + RING_OFF + wave * 16384);
    const int e0 = Lst.n0, e1 = e0 + Lst.n1, e2 = e1 + Lst.n2, e3 = e2 + Lst.n3;
#define CVT_MAP(vi) (((vi) < e0) ? Lst.a0 + (vi) : ((vi) < e1) ? Lst.a1 + ((vi) - e0) : ((vi) < e2) ? Lst.a2 + ((vi) - e1) : Lst.a3 + ((vi) - e2))
    int vi = gw;
    if (vi >= e3) return;
    CvtItem cur = cvt_decode(A, CVT_MAP(vi));
    f32x4 va[8]; float ga[8];
    cvt_load(cur, lane, va, ga);
    for (;;) {
        const int vn = vi + NGW; const bool more = vn < e3;
        CvtItem nxt = cur; f32x4 vb[8]; float gb[8];
#pragma unroll
        for (int i = 0; i < 8; ++i) { vb[i] = va[i]; gb[i] = ga[i]; }
        if (more) { nxt = cvt_decode(A, CVT_MAP(vn)); cvt_load(nxt, lane, vb, gb); }
        cvt_finish(cur, lane, scr, va, ga);
        if (!more) break;
        cur = nxt; vi = vn;
#pragma unroll
        for (int i = 0; i < 8; ++i) { va[i] = vb[i]; ga[i] = gb[i]; }
    }
#undef CVT_MAP
}
__device__ __forceinline__ void p0_prologue(const Args& A, LAS unsigned char* ldsl, int wave, int lane, int G) {
    const int gw = blockIdx.x * NWAVES + wave, NGW = G * NWAVES;
    unsigned char* ws = A.ws;
    convert_weights(A, ldsl, wave, lane, CV_P0, gw, NGW);
    bf16* xb = (bf16*)(ws + WS_XB); float* rss = (float*)(ws + WS_RSS);
    for (int m0 = gw; m0 < M; m0 += 2 * NGW) {
        const int m1 = m0 + NGW; const bool two = m1 < M; const int m1c = two ? m1 : m0;
        const float* s0 = (m0 < MP) ? A.in[I_XP] + (size_t)m0 * D : A.in[I_XS] + (size_t)(m0 - MP) * D;
        const float* s1 = (m1c < MP) ? A.in[I_XP] + (size_t)m1c * D : A.in[I_XS] + (size_t)(m1c - MP) * D;
        f32x4 v[2][4];
#pragma unroll
        for (int j = 0; j < 4; ++j) { v[0][j] = ((const f32x4*)s0 + lane)[64 * j]; v[1][j] = ((const f32x4*)s1 + lane)[64 * j]; }
#pragma unroll
        for (int h = 0; h < 2; ++h) {
            const int m = h ? m1c : m0;
            v2u* bo = (v2u*)(xb + (size_t)m * D) + lane; float s = 0.f;
#pragma unroll
            for (int j = 0; j < 4; ++j) { v2u w; w.x = cvtpk(v[h][j].x, v[h][j].y); w.y = cvtpk(v[h][j].z, v[h][j].w); if (h == 0 || two) bo[64 * j] = w;
                const float r0 = __builtin_bit_cast(float, w.x << 16), r1 = __builtin_bit_cast(float, w.x & 0xffff0000u), r2 = __builtin_bit_cast(float, w.y << 16), r3 = __builtin_bit_cast(float, w.y & 0xffff0000u);
                s += (r0 * r0 + r1 * r1) + (r2 * r2 + r3 * r3); }
            s = wave_sum(s);
            if (lane == 0 && (h == 0 || two)) rss[m] = s;
        }
    }
}

#ifndef MK_REP_S1
#define MK_REP_S1 1
#endif
#ifndef MK_REP_S3
#define MK_REP_S3 1
#endif
#ifndef MK_REP_S2SMP
#define MK_REP_S2SMP 1
#endif
struct MixP {
    const bf16* P; bf16* mixb; float* out; int l; float* DS; float* ESC; unsigned* subc;
    bf16* XC;
    const float *s_pool, *s_gla, *s_hgrn, *s_ssm, *s_conv;
    const float *pool_w, *pool_scale, *gla_wg, *gla_b, *gla_n, *lbl, *hg_n, *conv_w, *conv_b, *dt_b, *a_log, *ssm_d, *ssm_n;
};
typedef short bf16x8 __attribute__((ext_vector_type(8)));
constexpr int MIX_CONST_OFF = 113664;
#define MFMA16(a, b, c) __builtin_amdgcn_mfma_f32_16x16x32_bf16((a), (b), (c), 0, 0, 0)
template <int CTRL> __device__ __forceinline__ float dpp_shr1(float x) { return __builtin_bit_cast(float, __builtin_amdgcn_update_dpp(0x3f800000, __builtin_bit_cast(int, x), CTRL, 0xf, 0xf, false)); }
template <int CTRL, int ROWMASK> __device__ __forceinline__ float dpp_sel(float oldv, float x) { return __builtin_bit_cast(float, __builtin_amdgcn_update_dpp(__builtin_bit_cast(int, oldv), __builtin_bit_cast(int, x), CTRL, ROWMASK, 0xf, false)); }
__device__ __forceinline__ float dpp_bcast15(float oldv, float x) { return dpp_sel<0x142, 0xa>(oldv, x); }
__device__ __forceinline__ float quad_sum(float v) { v += dpp_sel<0xB1, 0xf>(0.f, v); v += dpp_sel<0x4E, 0xf>(0.f, v); return v; }
__device__ __forceinline__ float oct_sum(float v) { v = quad_sum(v); v += dpp_sel<0x141, 0xf>(0.f, v); return v; }
__device__ __forceinline__ bf16x8 frag16(const LAS unsigned char* p) { return *(const LAS bf16x8*)p; }
__device__ __forceinline__ bf16x8 frag8x2(const LAS unsigned char* p0, const LAS unsigned char* p1) { const v2u a = *(const LAS v2u*)p0, b = *(const LAS v2u*)p1; v4u w; w.x = a.x; w.y = a.y; w.z = b.x; w.w = b.y; return __builtin_bit_cast(bf16x8, w); }
__device__ __forceinline__ bf16x8 pack_frag(const f32x4 a, const f32x4 b) { v4u w; w.x = cvtpk(a[0], a[1]); w.y = cvtpk(a[2], a[3]); w.z = cvtpk(b[0], b[1]); w.w = cvtpk(b[2], b[3]); return __builtin_bit_cast(bf16x8, w); }
__device__ __forceinline__ float bfe(const v4u w, const int e) { const unsigned x = w[e >> 1]; return __builtin_bit_cast(float, (e & 1) ? (x & 0xffff0000u) : (x << 16)); }
__device__ __forceinline__ float bfe2(const v2u w, const int e) { const unsigned x = w[e >> 1]; return __builtin_bit_cast(float, (e & 1) ? (x & 0xffff0000u) : (x << 16)); }
__device__ __forceinline__ unsigned short bfbits(const v4u w, const int e) { const unsigned x = w[e >> 1]; return (unsigned short)((e & 1) ? (x >> 16) : (x & 0xffffu)); }

#define GH_SCAN_STEP(CTRL) "v_mul_f32_dpp %0, %0, %0 " CTRL "\n\tv_mul_f32_dpp %1, %1, %1 " CTRL "\n\tv_mul_f32_dpp %2, %2, %2 " CTRL "\n\tv_mul_f32_dpp %3, %3, %3 " CTRL "\n\t" \
                           "v_mul_f32_dpp %4, %4, %4 " CTRL "\n\tv_mul_f32_dpp %5, %5, %5 " CTRL "\n\tv_mul_f32_dpp %6, %6, %6 " CTRL "\n\tv_mul_f32_dpp %7, %7, %7 " CTRL "\n\t"
__device__ __forceinline__ void gh_scan8(float& a, float& b, float& c, float& d, float& e, float& f, float& g, float& h) {
    asm volatile("s_nop 1\n\t"
                 GH_SCAN_STEP("row_shr:1 row_mask:0xf bank_mask:0xf") GH_SCAN_STEP("row_shr:2 row_mask:0xf bank_mask:0xf") GH_SCAN_STEP("row_shr:4 row_mask:0xf bank_mask:0xf")
                 GH_SCAN_STEP("row_shr:8 row_mask:0xf bank_mask:0xf") GH_SCAN_STEP("row_bcast:15 row_mask:0xa bank_mask:0xf") "s_nop 1"
                 : "+v"(a), "+v"(b), "+v"(c), "+v"(d), "+v"(e), "+v"(f), "+v"(g), "+v"(h));
}
#undef GH_SCAN_STEP
template <int K> struct GHL { static constexpr int RS = K * 2 + 16, OFF_Q = 0, OFF_K = 32 * RS, OFF_KT = 64 * RS, OFF_VT = OFF_KT + K * 80, OFF_E = OFF_VT + 64 * 80, OFF_O = OFF_E + K * 4, UNIT = OFF_O + 32 * 272; };
static_assert(GHL<64>::UNIT == 28416 && 4 * GHL<64>::UNIT <= MIX_CONST_OFF, "GLA/HGRN LDS map");

template <int K>
__device__ __forceinline__ void s2_gh_unit(LAS unsigned char* U, f32x4 (&S)[K / 16], const int cs, const int lane) {
    typedef GHL<K> G; constexpr int NS = K / 32, KT = K / 16;
    const int q = lane >> 4, r16 = lane & 15, c = 16 * cs + r16;
    const f32x4 z4 = {0.f, 0.f, 0.f, 0.f};
    const LAS unsigned char* vrow = U + G::OFF_VT + c * 80;
    bf16x8 kf0[NS], kf1[NS], qf0[NS], qf1[NS], qp0[NS], qp1[NS], ktf[KT]; f32x4 e4[KT];
#pragma unroll
    for (int kt = 0; kt < KT; ++kt) { ktf[kt] = frag16(U + G::OFF_KT + (16 * kt + r16) * 80 + (8 * q) * 2); e4[kt] = *(const LAS f32x4*)(U + G::OFF_E + (16 * kt + 4 * q) * 4); }
    const bf16x8 vn = frag16(vrow + (8 * q) * 2);
#pragma unroll
    for (int s = 0; s < NS; ++s) {
        const LAS unsigned char* qr0 = U + G::OFF_Q + r16 * G::RS + (32 * s + 4 * q) * 2; const LAS unsigned char* qr1 = qr0 + 16 * G::RS;
        qp0[s] = frag8x2(qr0, qr0 + 32); qp1[s] = frag8x2(qr1, qr1 + 32);
    }
#pragma unroll
    for (int s = 0; s < NS; ++s) {
        const int kb = (32 * s + 8 * q) * 2;
        kf0[s] = frag16(U + G::OFF_K + r16 * G::RS + kb); kf1[s] = frag16(U + G::OFF_K + (16 + r16) * G::RS + kb);
        qf0[s] = frag16(U + G::OFF_Q + r16 * G::RS + kb); qf1[s] = frag16(U + G::OFF_Q + (16 + r16) * G::RS + kb);
    }
    const bf16x8 vb = frag8x2(vrow + (4 * q) * 2, vrow + (16 + 4 * q) * 2);
    bf16x8 sb[NS];
#pragma unroll
    for (int s = 0; s < NS; ++s) sb[s] = pack_frag(S[2 * s], S[2 * s + 1]);
#pragma unroll
    for (int kt = 0; kt < KT; ++kt) { S[kt] = MFMA16(ktf[kt], vn, S[kt]); S[kt] = S[kt] * e4[kt]; }
    f32x4 X00 = z4, X01 = z4, X11 = z4;
#pragma unroll
    for (int s = 0; s < NS; ++s) { X00 = MFMA16(kf0[s], qf0[s], X00); X01 = MFMA16(kf0[s], qf1[s], X01); X11 = MFMA16(kf1[s], qf1[s], X11); }
    f32x4 o0 = z4, o1 = z4;
#pragma unroll
    for (int s = 0; s < NS; ++s) { o0 = MFMA16(qp0[s], sb[s], o0); o1 = MFMA16(qp1[s], sb[s], o1); }
#pragma unroll
    for (int r = 0; r < 4; ++r) if (4 * q + r > r16) { X00[r] = 0.f; X11[r] = 0.f; }
    const bf16x8 a0 = pack_frag(X00, z4), a1 = pack_frag(X01, X11);
    o0 = MFMA16(a0, vb, o0); o1 = MFMA16(a1, vb, o1);
    LAS float* ob = (LAS float*)(U + G::OFF_O);
#pragma unroll
    for (int r = 0; r < 4; ++r) { ob[(4 * q + r) * 68 + c] = o0[r]; ob[(16 + 4 * q + r) * 68 + c] = o1[r]; }
}

template <int MT>
__device__ __forceinline__ void chain_gh(LAS unsigned char* L, const MixP& C, const int h, const int b0, const bool smp, const int tid) {
    constexpr int K = (MT == 0) ? 32 : 64, KT = K / 16, NK = K / 4;
    typedef GHL<K> G;
    const int w = __builtin_amdgcn_readfirstlane(tid >> 6), lane = tid & 63;
    const int u1 = tid >> 7, t1 = tid & 31, kg = (tid >> 5) & 3;
    LAS float* cst = (LAS float*)(L + MIX_CONST_OFF);
    if (MT == 0) { cst[tid] = C.gla_wg[(tid >> 5) * 128 + h * 32 + (tid & 31)]; if (tid < 32) cst[512 + tid] = C.gla_b[h * 32 + tid]; }
    if (tid >= 64 && tid < 128) cst[600 + tid - 64] = ((MT == 0) ? C.gla_n : C.hg_n)[tid - 64];
    if (MT == 1) { if (tid < 64) cst[tid] = (C.l == 0) ? 0.f : sigmoid_f(C.lbl[256 + h * 64 + tid] - C.lbl[h * 64 + tid]); }
    LDS_BARRIER();
    const float* sin = (MT == 0) ? C.s_gla : C.s_hgrn;
    const size_t o_p = (MT == 0) ? O_GLAP : O_HGP, o_s = (MT == 0) ? O_GLAS : O_HGS;
    f32x4 S[KT];
#pragma unroll
    for (int kt = 0; kt < KT; ++kt) S[kt] = (f32x4){0.f, 0.f, 0.f, 0.f};
    const int nsc = smp ? 1 : TP / 128;
    v4u rw0, rw1, rw2, rw3, rw4, rw5;
#define GH_LOAD_RAW(SC) do { const bool valid_ = smp ? (t1 < TS) : true; \
        const int row_ = smp ? (MP + (b0 + u1) * TS + (valid_ ? t1 : 0)) : (b0 * TP + (SC) * 128 + u1 * 32 + t1); \
        const bf16* prow_ = C.P + (size_t)row_ * NINP; \
        if (MT == 0) { rw0 = *(const v4u*)(prow_ + PC_GQ + h * 32 + 8 * kg); rw1 = *(const v4u*)(prow_ + PC_GK + h * 32 + 8 * kg); rw2 = *(const v4u*)(prow_ + PC_LR); rw3 = *(const v4u*)(prow_ + PC_LR + 8); \
                       rw4 = *(const v4u*)(prow_ + PC_GV + h * 64 + 16 * kg); rw5 = *(const v4u*)(prow_ + PC_GV + h * 64 + 16 * kg + 8); } \
        else { rw0 = *(const v4u*)(prow_ + PC_RQ + h * 64 + 16 * kg); rw1 = *(const v4u*)(prow_ + PC_RQ + h * 64 + 16 * kg + 8); rw2 = *(const v4u*)(prow_ + PC_RF + h * 64 + 16 * kg); rw3 = *(const v4u*)(prow_ + PC_RF + h * 64 + 16 * kg + 8); \
               rw4 = *(const v4u*)(prow_ + PC_RI + h * 64 + 16 * kg); rw5 = *(const v4u*)(prow_ + PC_RI + h * 64 + 16 * kg + 8); } } while (0)
    GH_LOAD_RAW(0);
    for (int sc = 0; sc < nsc; ++sc) {
#pragma unroll 1
        for (int rep1 = 0; rep1 < MK_REP_S1; ++rep1) {
#if MK_REP_S1 > 1
            asm volatile("" : "+v"(rw0), "+v"(rw1), "+v"(rw2), "+v"(rw3), "+v"(rw4), "+v"(rw5));
#endif
            const bool valid = smp ? (t1 < TS) : true;
            LAS unsigned char* U = L + u1 * G::UNIT;
            float f[NK], kk[NK], qq[NK]; v4u vraw0 = rw4, vraw1 = rw5;
            if (MT == 0) {
                const v4u gq = rw0, gk = rw1, lr0 = rw2, lr1 = rw3;
                float lg[NK];
#pragma unroll
                for (int e = 0; e < NK; ++e) lg[e] = cst[512 + 8 * kg + e];
#pragma unroll
                for (int j = 0; j < 16; ++j) { const float lv = (j < 8) ? bfe(lr0, j) : bfe(lr1, j - 8);
                    const f32x4 w0 = *(const LAS f32x4*)(cst + j * 32 + 8 * kg), w1 = *(const LAS f32x4*)(cst + j * 32 + 8 * kg + 4);
                    lg[0] += lv * w0[0]; lg[1] += lv * w0[1]; lg[2] += lv * w0[2]; lg[3] += lv * w0[3]; lg[4] += lv * w1[0]; lg[5] += lv * w1[1]; lg[6] += lv * w1[2]; lg[7] += lv * w1[3]; }
#pragma unroll
                for (int e = 0; e < NK; ++e) { f[e] = __expf(logsigmoid_f(lg[e]) * (1.0f / 16.0f)); kk[e] = bfe(gk, e); qq[e] = bfe(gq, e) * 0.17677669529663687f; }
            } else {
                const v4u rq0 = rw0, rq1 = rw1, rf0 = rw2, rf1 = rw3;
#pragma unroll
                for (int e = 0; e < NK; ++e) { const float z = (e < 8) ? bfe(rf0, e) : bfe(rf1, e - 8), qv = (e < 8) ? bfe(rq0, e) : bfe(rq1, e - 8);
                    const float lb = cst[16 * kg + e], sg = sigmoid_f(z);
                    f[e] = lb + (1.f - lb) * sg; kk[e] = (1.f - lb) * (1.f - sg); qq[e] = qv; }
            }
            if (!valid) {
#pragma unroll
                for (int e = 0; e < NK; ++e) { f[e] = 1.f; kk[e] = 0.f; qq[e] = 0.f; }
                vraw0 = (v4u){0u, 0u, 0u, 0u}; vraw1 = vraw0;
            }
#pragma unroll
            for (int e8 = 0; e8 < NK; e8 += 8) gh_scan8(f[e8 + 0], f[e8 + 1], f[e8 + 2], f[e8 + 3], f[e8 + 4], f[e8 + 5], f[e8 + 6], f[e8 + 7]);
            float qt[NK], kt_[NK];
#pragma unroll
            for (int e = 0; e < NK; ++e) { qt[e] = qq[e] * f[e]; kt_[e] = kk[e] * __builtin_amdgcn_rcpf(fmaxf(f[e], 1e-30f)); }
#pragma unroll
            for (int e8 = 0; e8 < NK; e8 += 8) {
                v4u wq, wk;
                wq.x = cvtpk(qt[e8 + 0], qt[e8 + 1]); wq.y = cvtpk(qt[e8 + 2], qt[e8 + 3]); wq.z = cvtpk(qt[e8 + 4], qt[e8 + 5]); wq.w = cvtpk(qt[e8 + 6], qt[e8 + 7]);
                wk.x = cvtpk(kt_[e8 + 0], kt_[e8 + 1]); wk.y = cvtpk(kt_[e8 + 2], kt_[e8 + 3]); wk.z = cvtpk(kt_[e8 + 4], kt_[e8 + 5]); wk.w = cvtpk(kt_[e8 + 6], kt_[e8 + 7]);
                *(LAS v4u*)(U + G::OFF_Q + t1 * G::RS + (NK * kg + e8) * 2) = wq;
                *(LAS v4u*)(U + G::OFF_K + t1 * G::RS + (NK * kg + e8) * 2) = wk;
#pragma unroll
                for (int e = 0; e < 8; ++e) *(LAS unsigned short*)(U + G::OFF_KT + (NK * kg + e8 + e) * 80 + t1 * 2) = bfbits(wk, e);
            }
#pragma unroll
            for (int e = 0; e < 16; ++e) *(LAS unsigned short*)(U + G::OFF_VT + (16 * kg + e) * 80 + t1 * 2) = (e < 8) ? bfbits(vraw0, e) : bfbits(vraw1, e - 8);
            if (t1 == 31) {
#pragma unroll
                for (int e = 0; e < NK; ++e) *(LAS float*)(U + G::OFF_E + (NK * kg + e) * 4) = f[e];
            }
        }
        LDS_BARRIER();
        const int tok3 = tid >> 2, cq3 = tid & 3, u3 = tok3 >> 5, i3 = tok3 & 31;
        const bool valid3 = smp ? (i3 < TS) : true;
        const int row3 = smp ? (MP + (b0 + u3) * TS + (valid3 ? i3 : 0)) : (b0 * TP + sc * 128 + tok3);
        v4u gg0, gg1;
        { const bf16* grow = C.P + (size_t)row3 * NINP + ((MT == 0) ? PC_GR : PC_RG) + h * 64 + 16 * cq3; gg0 = *(const v4u*)grow; gg1 = *(const v4u*)(grow + 8); }
        GH_LOAD_RAW((sc + 1 < nsc) ? sc + 1 : sc);
        if (!smp) {
            if (w < 4) {
#pragma unroll 1
                for (int u = 0; u < 4; ++u) {
#ifdef MK_REP_S2GH
                    { f32x4 Sd[KT];
#pragma unroll
                      for (int kt = 0; kt < KT; ++kt) Sd[kt] = S[kt];
                      s2_gh_unit<K>(L + u * G::UNIT, Sd, w, lane);
#pragma unroll
                      for (int kt = 0; kt < KT; ++kt) asm volatile("" :: "v"(Sd[kt])); }
#endif
                    s2_gh_unit<K>(L + u * G::UNIT, S, w, lane);
                }
            }
        } else {
#pragma unroll 1
            for (int job = w; job < 16; job += 8) {
                const int u = job >> 2, cs = job & 3, q = lane >> 4, c = 16 * cs + (lane & 15);
                const size_t sb = ((size_t)(b0 + u) * 4 + h) * K * 64;
#pragma unroll
                for (int kt = 0; kt < KT; ++kt)
#pragma unroll
                    for (int r = 0; r < 4; ++r) S[kt][r] = sin[sb + (size_t)(16 * kt + 4 * q + r) * 64 + c];
                s2_gh_unit<K>(L + u * G::UNIT, S, cs, lane);
                float* so = C.out + o_s + (((size_t)C.l * BS + b0 + u) * 4 + h) * K * 64;
#pragma unroll
                for (int kt = 0; kt < KT; ++kt)
#pragma unroll
                    for (int r = 0; r < 4; ++r) so[(size_t)(16 * kt + 4 * q + r) * 64 + c] = S[kt][r];
            }
        }
        LDS_BARRIER();
#pragma unroll 1
        for (int rep3 = 0; rep3 < MK_REP_S3; ++rep3) {
#if MK_REP_S3 > 1
            asm volatile("" : "+v"(gg0), "+v"(gg1));
#endif
            const LAS float* ob = (const LAS float*)(L + u3 * G::UNIT + G::OFF_O) + i3 * 68 + 16 * cq3;
            f32x4 o[4]; float ss = 0.f;
#pragma unroll
            for (int j = 0; j < 4; ++j) { o[j] = *(const LAS f32x4*)(ob + 4 * j); ss += (o[j][0] * o[j][0] + o[j][1] * o[j][1]) + (o[j][2] * o[j][2] + o[j][3] * o[j][3]); }
            ss = quad_sum(ss);
            const float r = rsqrtf(ss * (1.0f / 64.0f) + 1e-6f);
            float res[16], nwv[16];
#pragma unroll
            for (int j = 0; j < 4; ++j) { const f32x4 t = *(const LAS f32x4*)(cst + 600 + 16 * cq3 + 4 * j); nwv[4 * j] = t[0]; nwv[4 * j + 1] = t[1]; nwv[4 * j + 2] = t[2]; nwv[4 * j + 3] = t[3]; }
#pragma unroll
            for (int e = 0; e < 16; ++e) { const float gv = (e < 8) ? bfe(gg0, e) : bfe(gg1, e - 8); res[e] = o[e >> 2][e & 3] * r * nwv[e] * gv; }
            if (valid3) {
                v4u w0, w1;
                w0.x = cvtpk(res[0], res[1]); w0.y = cvtpk(res[2], res[3]); w0.z = cvtpk(res[4], res[5]); w0.w = cvtpk(res[6], res[7]);
                w1.x = cvtpk(res[8], res[9]); w1.y = cvtpk(res[10], res[11]); w1.z = cvtpk(res[12], res[13]); w1.w = cvtpk(res[14], res[15]);
                bf16* mo = C.mixb + (size_t)row3 * D + ((MT == 0) ? MC_GLA : MC_HGRN) + h * 64 + 16 * cq3;
                *(v4u*)mo = w0; *(v4u*)(mo + 8) = w1;
            }
        }
    }
#undef GH_LOAD_RAW
    if (!smp && w < 4) {
        const int q = lane >> 4, c = 16 * w + (lane & 15);
        float* so = C.out + o_p + (((size_t)C.l * BP + b0) * 4 + h) * K * 64;
#pragma unroll
        for (int kt = 0; kt < KT; ++kt)
#pragma unroll
            for (int r = 0; r < 4; ++r) so[(size_t)(16 * kt + 4 * q + r) * 64 + c] = S[kt][r];
    }
    LDS_BARRIER();
}

namespace SL { constexpr int OFF_C = 0, OFF_B = 8704, OFF_BT = 17408, OFF_XT = 27648, OFF_TAB = 37888, OFF_Y = 39168, UNIT = 56064; }
static_assert(2 * SL::UNIT <= MIX_CONST_OFF, "SSD LDS map");

__device__ __forceinline__ void s2_ssd_unit(LAS unsigned char* U, f32x4 (&S)[8], const int hh, const int ps, const int lane, const float Dh) {
    const int q = lane >> 4, r16 = lane & 15, p = 16 * ps + r16;
    const f32x4 z4 = {0.f, 0.f, 0.f, 0.f};
    const LAS float* tab = (const LAS float*)(U + SL::OFF_TAB) + hh * 160;
    const LAS unsigned char* xrow = U + SL::OFF_XT + hh * 5120 + p * 80;
    bf16x8 btf[8];
#pragma unroll
    for (int nt = 0; nt < 8; ++nt) btf[nt] = frag16(U + SL::OFF_BT + (16 * nt + r16) * 80 + (8 * q) * 2);
    const v4u xn = *(const LAS v4u*)(xrow + (8 * q) * 2);
    const f32x4 w0 = *(const LAS f32x4*)(tab + 96 + 8 * q), w1 = *(const LAS f32x4*)(tab + 96 + 8 * q + 4);
    const float eL = tab[128];
    bf16x8 cp0[4], cp1[4];
#pragma unroll
    for (int s = 0; s < 4; ++s) { const LAS unsigned char* cr0 = U + SL::OFF_C + r16 * 272 + (32 * s + 4 * q) * 2; const LAS unsigned char* cr1 = cr0 + 16 * 272; cp0[s] = frag8x2(cr0, cr0 + 32); cp1[s] = frag8x2(cr1, cr1 + 32); }
    bf16x8 sb[4];
#pragma unroll
    for (int s = 0; s < 4; ++s) sb[s] = pack_frag(S[2 * s], S[2 * s + 1]);
    const f32x4 xa = {bfe(xn, 0) * w0[0], bfe(xn, 1) * w0[1], bfe(xn, 2) * w0[2], bfe(xn, 3) * w0[3]}, xc = {bfe(xn, 4) * w1[0], bfe(xn, 5) * w1[1], bfe(xn, 6) * w1[2], bfe(xn, 7) * w1[3]};
    const bf16x8 xh = pack_frag(xa, xc);
#pragma unroll
    for (int nt = 0; nt < 8; ++nt) S[nt] = MFMA16(btf[nt], xh, S[nt] * eL);
    f32x4 X00 = z4, X01 = z4, X11 = z4;
#pragma unroll
    for (int s = 0; s < 4; ++s) {
        const int nb = (32 * s + 8 * q) * 2;
        const bf16x8 b0 = frag16(U + SL::OFF_B + r16 * 272 + nb), b1 = frag16(U + SL::OFF_B + (16 + r16) * 272 + nb);
        const bf16x8 c0 = frag16(U + SL::OFF_C + r16 * 272 + nb), c1 = frag16(U + SL::OFF_C + (16 + r16) * 272 + nb);
        X00 = MFMA16(b0, c0, X00); X01 = MFMA16(b0, c1, X01); X11 = MFMA16(b1, c1, X11);
    }
    f32x4 y20 = z4, y21 = z4;
#pragma unroll
    for (int s = 0; s < 4; ++s) { y20 = MFMA16(cp0[s], sb[s], y20); y21 = MFMA16(cp1[s], sb[s], y21); }
    const float ci0 = tab[r16], ci1 = tab[16 + r16];
    const f32x4 cj0 = *(const LAS f32x4*)(tab + 4 * q), cj1 = *(const LAS f32x4*)(tab + 16 + 4 * q);
#pragma unroll
    for (int r = 0; r < 4; ++r) {
        X00[r] = (4 * q + r > r16) ? 0.f : X00[r] * __expf(fminf(ci0 - cj0[r], 0.f));
        X01[r] = X01[r] * __expf(fminf(ci1 - cj0[r], 0.f));
        X11[r] = (4 * q + r > r16) ? 0.f : X11[r] * __expf(fminf(ci1 - cj1[r], 0.f));
    }
    const bf16x8 a0 = pack_frag(X00, z4), a1 = pack_frag(X01, X11);
    bf16x8 xb; f32x4 ux0, ux1;
    { const v2u xl = *(const LAS v2u*)(xrow + (4 * q) * 2), xh_ = *(const LAS v2u*)(xrow + (16 + 4 * q) * 2);
      const f32x4 d0 = *(const LAS f32x4*)(tab + 64 + 4 * q), d1 = *(const LAS f32x4*)(tab + 64 + 16 + 4 * q);
      const f32x4 fa = {__builtin_bit_cast(float, xl.x << 16) * d0[0], __builtin_bit_cast(float, xl.x & 0xffff0000u) * d0[1], __builtin_bit_cast(float, xl.y << 16) * d0[2], __builtin_bit_cast(float, xl.y & 0xffff0000u) * d0[3]};
      const f32x4 fb = {__builtin_bit_cast(float, xh_.x << 16) * d1[0], __builtin_bit_cast(float, xh_.x & 0xffff0000u) * d1[1], __builtin_bit_cast(float, xh_.y << 16) * d1[2], __builtin_bit_cast(float, xh_.y & 0xffff0000u) * d1[3]};
      xb = pack_frag(fa, fb);
      ux0 = (f32x4){__builtin_bit_cast(float, xl.x << 16), __builtin_bit_cast(float, xl.x & 0xffff0000u), __builtin_bit_cast(float, xl.y << 16), __builtin_bit_cast(float, xl.y & 0xffff0000u)} * Dh;
      ux1 = (f32x4){__builtin_bit_cast(float, xh_.x << 16), __builtin_bit_cast(float, xh_.x & 0xffff0000u), __builtin_bit_cast(float, xh_.y << 16), __builtin_bit_cast(float, xh_.y & 0xffff0000u)} * Dh; }
    const f32x4 y10 = MFMA16(a0, xb, z4), y11 = MFMA16(a1, xb, z4);
    const f32x4 e0 = *(const LAS f32x4*)(tab + 32 + 4 * q), e1 = *(const LAS f32x4*)(tab + 32 + 16 + 4 * q);
    LAS float* yb = (LAS float*)(U + SL::OFF_Y);
#pragma unroll
    for (int r = 0; r < 4; ++r) { yb[(4 * q + r) * 132 + hh * 64 + p] = y10[r] + e0[r] * y20[r] + ux0[r]; yb[(16 + 4 * q + r) * 132 + hh * 64 + p] = y11[r] + e1[r] * y21[r] + ux1[r]; }
}

__device__ __forceinline__ void s2_ssd_state(LAS unsigned char* U, f32x4 (&S)[8], const int hh, const int ps, const int lane) {
    const int q = lane >> 4, r16 = lane & 15, p = 16 * ps + r16;
    const LAS float* tab = (const LAS float*)(U + SL::OFF_TAB) + hh * 160;
    const LAS unsigned char* xrow = U + SL::OFF_XT + hh * 5120 + p * 80;
    bf16x8 btf[8];
#pragma unroll
    for (int nt = 0; nt < 8; ++nt) btf[nt] = frag16(U + SL::OFF_BT + (16 * nt + r16) * 80 + (8 * q) * 2);
    const v4u xn = *(const LAS v4u*)(xrow + (8 * q) * 2);
    const f32x4 w0 = *(const LAS f32x4*)(tab + 96 + 8 * q), w1 = *(const LAS f32x4*)(tab + 96 + 8 * q + 4);
    const float eL = tab[128];
    const f32x4 xa = {bfe(xn, 0) * w0[0], bfe(xn, 1) * w0[1], bfe(xn, 2) * w0[2], bfe(xn, 3) * w0[3]}, xc = {bfe(xn, 4) * w1[0], bfe(xn, 5) * w1[1], bfe(xn, 6) * w1[2], bfe(xn, 7) * w1[3]};
    const bf16x8 xh = pack_frag(xa, xc);
#pragma unroll
    for (int nt = 0; nt < 8; ++nt) S[nt] = MFMA16(btf[nt], xh, S[nt] * eL);
}

__device__ __forceinline__ void conv_phase(const MixP& C, const int G, const int tid) {
    constexpr int NTASK = (M / 8) * 96;
    for (int task = blockIdx.x * NTHREADS + tid; task < NTASK; task += G * NTHREADS) {
        const int g8 = task / 96, bl = task - g8 * 96, ch0 = 8 * bl, row0 = 8 * g8;
        const bool smp = g8 >= MP / 8;
        const int bsm = smp ? g8 - MP / 8 : 0;
        const bool head = smp ? true : ((row0 & (TP - 1)) == 0);
        {
            v4u xr[11];
#pragma unroll
            for (int i = 0; i < 11; ++i) { int r = row0 - 3 + i; if (head && i < 3) r = row0; xr[i] = *(const v4u*)(C.P + (size_t)r * NINP + PC_XBC + ch0); }
            f32x4 st[3][2];
#pragma unroll
            for (int r = 0; r < 3; ++r) { st[r][0] = (f32x4){0.f, 0.f, 0.f, 0.f}; st[r][1] = st[r][0]; }
            if (smp) {
#pragma unroll
                for (int r = 0; r < 3; ++r) { st[r][0] = *(const f32x4*)(C.s_conv + ((size_t)bsm * 3 + r) * 768 + ch0); st[r][1] = *(const f32x4*)(C.s_conv + ((size_t)bsm * 3 + r) * 768 + ch0 + 4); }
            }
            float wt[4][8], bs[8];
#pragma unroll
            for (int j = 0; j < 4; ++j) { const f32x4 wa = *(const f32x4*)(C.conv_w + j * 768 + ch0), wb = *(const f32x4*)(C.conv_w + j * 768 + ch0 + 4);
#pragma unroll
                for (int c = 0; c < 4; ++c) { wt[j][c] = wa[c]; wt[j][4 + c] = wb[c]; } }
            { const f32x4 wa = *(const f32x4*)(C.conv_b + ch0), wb = *(const f32x4*)(C.conv_b + ch0 + 4);
#pragma unroll
              for (int c = 0; c < 4; ++c) { bs[c] = wa[c]; bs[4 + c] = wb[c]; } }
            float p3[8], p2[8], p1[8];
#pragma unroll
            for (int c = 0; c < 8; ++c) { p3[c] = head ? st[0][c >> 2][c & 3] : bfe(xr[0], c); p2[c] = head ? st[1][c >> 2][c & 3] : bfe(xr[1], c); p1[c] = head ? st[2][c >> 2][c & 3] : bfe(xr[2], c); }
#pragma unroll
            for (int et = 0; et < 8; ++et) {
                float val[8];
#pragma unroll
                for (int c = 0; c < 8; ++c) { const float cur = bfe(xr[et + 3], c);
                    val[c] = silu_f(bs[c] + wt[0][c] * p3[c] + wt[1][c] * p2[c] + wt[2][c] * p1[c] + wt[3][c] * cur); p3[c] = p2[c]; p2[c] = p1[c]; p1[c] = cur; }
                v4u wv; wv.x = cvtpk(val[0], val[1]); wv.y = cvtpk(val[2], val[3]); wv.z = cvtpk(val[4], val[5]); wv.w = cvtpk(val[6], val[7]);
                *(v4u*)(C.XC + (size_t)(row0 + et) * 768 + ch0) = wv;
            }
        }
    }
}

__device__ __forceinline__ void chain_ssd(LAS unsigned char* L, const MixP& C, const int g, const int b0, const int mode, const int sc0, const int tid) {
    const bool smp = (mode == 1);
    const int w = __builtin_amdgcn_readfirstlane(tid >> 6), lane = tid & 63;
    const int hh2 = w >> 2, ps = w & 3, h2 = 2 * g + hh2;
    const float A0 = -__expf(C.a_log[2 * g]), A1 = -__expf(C.a_log[2 * g + 1]), dtb0 = C.dt_b[2 * g], dtb1 = C.dt_b[2 * g + 1], D0 = C.ssm_d[2 * g], D1 = C.ssm_d[2 * g + 1];
    f32x4 S[8];
#pragma unroll
    for (int nt = 0; nt < 8; ++nt) S[nt] = (f32x4){0.f, 0.f, 0.f, 0.f};
    const int cu1 = tid >> 8, ct = tid & 255;
    const int tg1 = ct / 48, bl1 = ct - tg1 * 48, lc01 = 8 * bl1;
    const int ch01 = (bl1 < 16) ? 128 * g + lc01 : (bl1 < 32) ? 256 + 128 * g + (lc01 - 128) : 512 + 128 * g + (lc01 - 256);
    const int tbase = smp ? 0 : sc0 * 64 + cu1 * 32;
    const int rowbase = smp ? MP + (b0 + cu1) * TS : b0 * TP;
    v4u xr[8]; bf16 sdraw = 0;
    if (ct < 192) { const bf16* xsrc = C.XC + (size_t)(rowbase + (smp ? 0 : tbase + 8 * tg1)) * 768 + ch01;
#pragma unroll
        for (int et = 0; et < 8; ++et) xr[et] = *(const v4u*)(xsrc + (size_t)et * 768); }
    else { const int t1 = ct & 31, hh = (ct - 192) >> 5; const bool valid = smp ? (t1 < TS) : true;
        sdraw = C.P[(size_t)(rowbase + tbase + (valid ? t1 : 0)) * NINP + PC_DT + 2 * g + hh]; }
    const int tok3 = tid >> 3, c83 = tid & 7, u3 = tok3 >> 5, i3 = tok3 & 31;
    const bool valid3 = smp ? (i3 < TS) : true;
    const int row3 = smp ? (MP + (b0 + u3) * TS + (valid3 ? i3 : 0)) : (b0 * TP + sc0 * 64 + tok3);
    v4u zz0, zz1;
    { const bf16* zrow = C.P + (size_t)row3 * NINP + PC_SZ + 128 * g + 16 * c83; zz0 = *(const v4u*)zrow; zz1 = *(const v4u*)(zrow + 8); }
    LAS float* cst = (LAS float*)(L + MIX_CONST_OFF);
    if (tid < 128) cst[tid] = C.ssm_n[128 * g + tid];
    {
        LAS unsigned char* U = L + cu1 * SL::UNIT;
        if (ct < 192) {
            const int tg = tg1, bl = bl1, lc0 = lc01;
            const bool tok_ok = smp ? (tg == 0) : true;
            if (!tok_ok) {
#pragma unroll
                for (int et = 0; et < 8; ++et) xr[et] = (v4u){0u, 0u, 0u, 0u};
            }
            if (bl >= 16) {
                LAS unsigned char* rb = U + ((bl < 32) ? SL::OFF_B + (lc0 - 128) * 2 : SL::OFF_C + (lc0 - 256) * 2) + (8 * tg) * 272;
#pragma unroll
                for (int et = 0; et < 8; ++et) *(LAS v4u*)(rb + et * 272) = xr[et];
            }
            if (bl < 32) {
                LAS unsigned char* tb = U + ((bl < 16) ? SL::OFF_XT + lc0 * 80 : SL::OFF_BT + (lc0 - 128) * 80) + 16 * tg;
#pragma unroll
                for (int c = 0; c < 8; ++c) { v4u o;
#pragma unroll
                    for (int k = 0; k < 4; ++k) { const unsigned a = xr[2 * k][c >> 1], b = xr[2 * k + 1][c >> 1]; o[k] = (c & 1) ? ((a >> 16) | (b & 0xffff0000u)) : ((a & 0xffffu) | (b << 16)); }
                    *(LAS v4u*)(tb + c * 80) = o; }
            }
        } else {
            const int t1 = ct & 31, hh = (ct - 192) >> 5;
            const bool valid = smp ? (t1 < TS) : true;
            const float dt = valid ? softplus_f(bf2f(sdraw) + ((hh == 0) ? dtb0 : dtb1)) : 0.f;
            float c0 = dt * ((hh == 0) ? A0 : A1);
            c0 += dpp_sel<0x111, 0xf>(0.f, c0); c0 += dpp_sel<0x112, 0xf>(0.f, c0); c0 += dpp_sel<0x114, 0xf>(0.f, c0); c0 += dpp_sel<0x118, 0xf>(0.f, c0); c0 += dpp_bcast15(0.f, c0);
            const float cl = (lane & 32) ? __builtin_bit_cast(float, __builtin_amdgcn_readlane(__builtin_bit_cast(int, c0), 63)) : __builtin_bit_cast(float, __builtin_amdgcn_readlane(__builtin_bit_cast(int, c0), 31));
            LAS float* tab = (LAS float*)(U + SL::OFF_TAB) + hh * 160;
            tab[t1] = c0; tab[32 + t1] = __expf(c0); tab[64 + t1] = dt; tab[96 + t1] = dt * __expf(cl - c0);
            if (t1 == 31) tab[128] = __expf(cl);
        }
    }
    LDS_BARRIER();
    const int q2 = lane >> 4, p2 = 16 * ps + (lane & 15);
    float* dsp = C.DS + ((((size_t)(b0 * 2 + g) * (TP / 64) + sc0) * 2 + hh2) * 64 + p2) * 128;
    if (mode == 2) {
#pragma unroll 1
        for (int u = 0; u < 2; ++u) s2_ssd_state(L + u * SL::UNIT, S, hh2, ps, lane);
#pragma unroll
        for (int nt = 0; nt < 8; ++nt) *(f32x4*)(dsp + 16 * nt + 4 * q2) = S[nt];
        if (ps == 0 && lane == 0) C.ESC[((size_t)(b0 * 2 + g) * (TP / 64) + sc0) * 2 + hh2] = ((const LAS float*)(L + SL::OFF_TAB))[hh2 * 160 + 128] * ((const LAS float*)(L + SL::UNIT + SL::OFF_TAB))[hh2 * 160 + 128];
    } else if (mode == 3) {
#pragma unroll
        for (int nt = 0; nt < 8; ++nt) S[nt] = *(const f32x4*)(dsp + 16 * nt + 4 * q2);
#pragma unroll 1
        for (int u = 0; u < 2; ++u) s2_ssd_unit(L + u * SL::UNIT, S, hh2, ps, lane, (hh2 == 0) ? D0 : D1);
    } else {
#pragma unroll 1
        for (int u = 0; u < 2; ++u) {
            const float* sp = C.s_ssm + (((size_t)(b0 + u) * 4 + h2) * 64 + p2) * 128;
#pragma unroll
            for (int nt = 0; nt < 8; ++nt) S[nt] = *(const f32x4*)(sp + 16 * nt + 4 * q2);
            s2_ssd_unit(L + u * SL::UNIT, S, hh2, ps, lane, (hh2 == 0) ? D0 : D1);
            float* so = C.out + O_SSMS + ((((size_t)C.l * BS + b0 + u) * 4 + h2) * 64 + p2) * 128;
#pragma unroll
            for (int nt = 0; nt < 8; ++nt) *(f32x4*)(so + 16 * nt + 4 * q2) = S[nt];
        }
    }
    LDS_BARRIER();
    if (mode != 2) {
        const LAS float* yb = (const LAS float*)(L + u3 * SL::UNIT + SL::OFF_Y) + i3 * 132 + 16 * c83;
        float y[16]; float ss = 0.f;
#pragma unroll
        for (int j = 0; j < 4; ++j) { const f32x4 v = *(const LAS f32x4*)(yb + 4 * j);
#pragma unroll
            for (int e = 0; e < 4; ++e) { const int ee = 4 * j + e; const float zv = (ee < 8) ? bfe(zz0, ee) : bfe(zz1, ee - 8); y[ee] = v[e] * zv; ss += y[ee] * y[ee]; } }
        ss = oct_sum(ss);
        const float r = rsqrtf(ss * (1.0f / 128.0f) + 1e-6f);
        if (valid3) {
            float nwv[16];
#pragma unroll
            for (int j = 0; j < 4; ++j) { const f32x4 t = *(const LAS f32x4*)(cst + 16 * c83 + 4 * j); nwv[4 * j] = t[0]; nwv[4 * j + 1] = t[1]; nwv[4 * j + 2] = t[2]; nwv[4 * j + 3] = t[3]; }
            v4u w0, w1;
            w0.x = cvtpk(y[0] * r * nwv[0], y[1] * r * nwv[1]); w0.y = cvtpk(y[2] * r * nwv[2], y[3] * r * nwv[3]); w0.z = cvtpk(y[4] * r * nwv[4], y[5] * r * nwv[5]); w0.w = cvtpk(y[6] * r * nwv[6], y[7] * r * nwv[7]);
            w1.x = cvtpk(y[8] * r * nwv[8], y[9] * r * nwv[9]); w1.y = cvtpk(y[10] * r * nwv[10], y[11] * r * nwv[11]); w1.z = cvtpk(y[12] * r * nwv[12], y[13] * r * nwv[13]); w1.w = cvtpk(y[14] * r * nwv[14], y[15] * r * nwv[15]);
            bf16* mo = C.mixb + (size_t)row3 * D + MC_SSM + 128 * g + 16 * c83;
            *(v4u*)mo = w0; *(v4u*)(mo + 8) = w1;
        }
    }
    LDS_BARRIER();
}

__device__ __forceinline__ void ssd_scan(const MixP& C, const int wg, const int nwgs, const int tid) {
    constexpr int NSC = TP / 64, NQ = BP * 2 * 2 * 2048;
    const int per = (((NQ + nwgs - 1) / nwgs) + 63) & ~63;
    const int qi = wg * per + tid;
    if (tid < per && qi < NQ) {
        const int e = (qi & 2047) * 4, bgh = __builtin_amdgcn_readfirstlane(qi >> 11), hh = bgh & 1, bg = bgh >> 1;
        float* dp = C.DS + ((size_t)bg * NSC * 2 + hh) * 8192 + e;
        const float* ep = C.ESC + (size_t)bg * NSC * 2 + hh;
        f32x4 s = {0.f, 0.f, 0.f, 0.f};
#pragma unroll 1
        for (int h0 = 0; h0 < NSC; h0 += NSC / 2) {
            f32x4 d[NSC / 2]; float E[NSC / 2];
#pragma unroll
            for (int k = 0; k < NSC / 2; ++k) { d[k] = *(const f32x4*)(dp + (size_t)(h0 + k) * 2 * 8192); E[k] = ep[(h0 + k) * 2]; }
#pragma unroll
            for (int k = 0; k < NSC / 2; ++k) { *(f32x4*)(dp + (size_t)(h0 + k) * 2 * 8192) = s; s = s * E[k] + d[k]; }
        }
        const int b = bg >> 1, g = bg & 1;
        *(f32x4*)(C.out + O_SSMP + (((size_t)C.l * BP + b) * 4 + 2 * g + hh) * 8192 + e) = s;
    }
}

__device__ __forceinline__ void sub_arrive(unsigned* cnt) {
    asm volatile("s_waitcnt vmcnt(0)" ::: "memory");
    __syncthreads();
    if (threadIdx.x == 0) {
        __builtin_amdgcn_fence(__ATOMIC_RELEASE, "agent");
        asm volatile("s_waitcnt vmcnt(0)" ::: "memory");
        (void)__hip_atomic_fetch_add(cnt, 1u, __ATOMIC_RELAXED, __HIP_MEMORY_SCOPE_AGENT);
    }
}
__device__ __forceinline__ void sub_wait(unsigned* cnt, const unsigned nwg) {
    if (threadIdx.x == 0) {
        unsigned sp = 0;
        while (__hip_atomic_load(cnt, __ATOMIC_RELAXED, __HIP_MEMORY_SCOPE_AGENT) < nwg) { __builtin_amdgcn_s_sleep(2); if (++sp > (1u << 22)) break; }
        __builtin_amdgcn_fence(__ATOMIC_ACQUIRE, "agent");
        asm volatile("s_waitcnt vmcnt(0)" ::: "memory");
    }
    __syncthreads();
}
__device__ __forceinline__ void sub_barrier(unsigned* cnt, const unsigned nwg) {
    asm volatile("s_waitcnt vmcnt(0)" ::: "memory");
    __syncthreads();
    if (threadIdx.x == 0) {
        __builtin_amdgcn_fence(__ATOMIC_RELEASE, "agent");
        asm volatile("s_waitcnt vmcnt(0)" ::: "memory");
        (void)__hip_atomic_fetch_add(cnt, 1u, __ATOMIC_RELAXED, __HIP_MEMORY_SCOPE_AGENT);
        unsigned sp = 0;
        while (__hip_atomic_load(cnt, __ATOMIC_RELAXED, __HIP_MEMORY_SCOPE_AGENT) < nwg) { __builtin_amdgcn_s_sleep(2); if (++sp > (1u << 22)) break; }
        __builtin_amdgcn_fence(__ATOMIC_ACQUIRE, "agent");
        asm volatile("s_waitcnt vmcnt(0)" ::: "memory");
    }
    __syncthreads();
}
__device__ __forceinline__ void pool_item(LAS unsigned char* L, const MixP& C, const int tile, const int tid) {
    constexpr int DF_OFF = 40960, WT_OFF = 74752;
    const int m0 = tile * 64;
    {
        f32x4 wv[8];
#pragma unroll
        for (int i = 0; i < 8; ++i) { const int e4 = tid + NTHREADS * i; wv[i] = *(const f32x4*)(C.pool_w + (size_t)e4 * 4); }
#pragma unroll
        for (int i = 0; i < 8; ++i) { const int e4 = tid + NTHREADS * i, d0 = (e4 & 15) * 4, c = (e4 >> 4) & 63, g = e4 >> 10;
            LAS unsigned char* wp = L + WT_OFF + g * 9216 + d0 * 144 + c * 2;
            const unsigned p01 = cvtpk(wv[i][0], wv[i][1]), p23 = cvtpk(wv[i][2], wv[i][3]);
            *(LAS unsigned short*)(wp) = (unsigned short)(p01 & 0xffffu); *(LAS unsigned short*)(wp + 144) = (unsigned short)(p01 >> 16);
            *(LAS unsigned short*)(wp + 288) = (unsigned short)(p23 & 0xffffu); *(LAS unsigned short*)(wp + 432) = (unsigned short)(p23 >> 16); }
    }
    if (m0 < MP) {
        const int tt0 = m0 & (TP - 1);
#pragma unroll
        for (int idx = tid; idx < 79 * 32; idx += NTHREADS) {
            const int r = idx >> 5, c8 = idx & 31, tr = tt0 - 15 + r, trc = tr < 0 ? 0 : tr;
            const v4u ld = *(const v4u*)(C.P + (size_t)(m0 - tt0 + trc) * NINP + PC_PX + 8 * c8);
            *(LAS v4u*)(L + r * 512 + c8 * 16) = (tr >= 0) ? ld : (v4u){0u, 0u, 0u, 0u};
        }
        LDS_BARRIER();
        {
            const int c = tid & 255, th = tid >> 8, g = c >> 6, w = 2 << g, tA = 32 * th;
            const LAS unsigned short* col = (const LAS unsigned short*)L + c;
            float s = 0.f;
            for (int j = 1; j < w; ++j) s += bf2f(col[(tA + 15 - j) * 256]);
            for (int t = tA; t < tA + 32; ++t) {
                const float x = bf2f(col[(t + 15) * 256]); s += x;
                const int tt = tt0 + t, cnt = (tt + 1 < w) ? tt + 1 : w;
                *(LAS unsigned short*)(L + DF_OFF + t * 528 + c * 2) = (unsigned short)(cvtpk(s * __builtin_amdgcn_rcpf((float)cnt) - x, 0.f) & 0xffffu);
                s -= bf2f(col[(t + 16 - w) * 256]);
            }
        }
    } else {
#pragma unroll 1
        for (int task = tid; task < 8 * 256; task += NTHREADS) {
            const int bb = task >> 8, c = task & 255, g = c >> 6, w = 2 << g, bg = (m0 - MP) / TS + bb;
            float xs[23];
#pragma unroll
            for (int r = 0; r < 15; ++r) xs[r] = C.s_pool[((size_t)bg * 15 + r) * 256 + c];
            bf16 xraw[8];
#pragma unroll
            for (int t = 0; t < 8; ++t) xraw[t] = C.P[(size_t)(m0 + bb * TS + t) * NINP + PC_PX + c];
#pragma unroll
            for (int t = 0; t < 8; ++t) xs[15 + t] = bf2f(xraw[t]);
            const float rw = __builtin_amdgcn_rcpf((float)w);
#pragma unroll
            for (int t = 0; t < 8; ++t) { float s = 0.f;
#pragma unroll
                for (int j = 0; j < 16; ++j) s += (j < w) ? xs[15 + t - j] : 0.f;
                *(LAS unsigned short*)(L + DF_OFF + (bb * TS + t) * 528 + c * 2) = (unsigned short)(cvtpk(s * rw - xs[15 + t], 0.f) & 0xffffu); }
        }
    }
    LDS_BARRIER();
    {
        const int w8 = __builtin_amdgcn_readfirstlane(tid >> 6), lane = tid & 63, q = lane >> 4, r16 = lane & 15, g = w8 >> 1, dh = w8 & 1;
        f32x4 acc[2][4];
#pragma unroll
        for (int a = 0; a < 2; ++a)
#pragma unroll
            for (int b = 0; b < 4; ++b) acc[a][b] = (f32x4){0.f, 0.f, 0.f, 0.f};
#pragma unroll
        for (int ks = 0; ks < 2; ++ks) {
            bf16x8 wa[2], db[4];
#pragma unroll
            for (int a = 0; a < 2; ++a) wa[a] = frag16(L + WT_OFF + g * 9216 + (16 * (2 * dh + a) + r16) * 144 + (32 * ks + 8 * q) * 2);
#pragma unroll
            for (int b = 0; b < 4; ++b) db[b] = frag16(L + DF_OFF + (16 * b + r16) * 528 + (g * 64 + 32 * ks + 8 * q) * 2);
#pragma unroll
            for (int a = 0; a < 2; ++a)
#pragma unroll
                for (int b = 0; b < 4; ++b) acc[a][b] = MFMA16(wa[a], db[b], acc[a][b]);
        }
#pragma unroll
        for (int a = 0; a < 2; ++a) {
            const int d0 = g * 64 + 16 * (2 * dh + a) + 4 * q;
            const f32x4 sc = *(const f32x4*)(C.pool_scale + d0);
#pragma unroll
            for (int b = 0; b < 4; ++b) { const f32x4 v = acc[a][b] * sc; v2u o; o.x = cvtpk(v[0], v[1]); o.y = cvtpk(v[2], v[3]);
                *(v2u*)(C.mixb + (size_t)(m0 + 16 * b + r16) * D + MC_POOL + d0) = o; }
        }
    }
    LDS_BARRIER();
}

constexpr int N_CP_PP = BP * 15 * 32, N_CP_PS = BS * 15 * 32, N_CP_CP = BP * 3 * 96, N_CP_CS = BS * 3 * 96, N_CP = N_CP_PP + N_CP_PS + N_CP_CP + N_CP_CS;
__device__ __forceinline__ void copy_states(const MixP& C, const int wg, const int nwgs, const int tid) {
    const int l = C.l;
    for (int i = wg * NTHREADS + tid; i < N_CP; i += nwgs * NTHREADS) {
        const bf16* src = nullptr; const float* fsrc = nullptr; float* dst;
        if (i < N_CP_PP) { const int b = i / 480, rem = i % 480, r = rem >> 5, c = (rem & 31) * 8;
            src = C.P + (size_t)(b * TP + TP - 15 + r) * NINP + PC_PX + c; dst = C.out + O_POOLP + ((size_t)(l * BP + b) * 15 + r) * 256 + c; }
        else if (i < N_CP_PP + N_CP_PS) { const int j = i - N_CP_PP, b = j / 480, rem = j % 480, r = rem >> 5, c = (rem & 31) * 8;
            if (r < 7) fsrc = C.s_pool + ((size_t)b * 15 + 8 + r) * 256 + c; else src = C.P + (size_t)(MP + b * TS + (r - 7)) * NINP + PC_PX + c;
            dst = C.out + O_POOLS + ((size_t)(l * BS + b) * 15 + r) * 256 + c; }
        else if (i < N_CP_PP + N_CP_PS + N_CP_CP) { const int j = i - N_CP_PP - N_CP_PS, b = j / 288, rem = j % 288, r = rem / 96, c = (rem % 96) * 8;
            src = C.P + (size_t)(b * TP + TP - 3 + r) * NINP + PC_XBC + c; dst = C.out + O_CONVP + ((size_t)(l * BP + b) * 3 + r) * 768 + c; }
        else { const int j = i - N_CP_PP - N_CP_PS - N_CP_CP, b = j / 288, rem = j % 288, r = rem / 96, c = (rem % 96) * 8;
            src = C.P + (size_t)(MP + b * TS + 5 + r) * NINP + PC_XBC + c; dst = C.out + O_CONVS + ((size_t)(l * BS + b) * 3 + r) * 768 + c; }
        f32x4 v0, v1;
        if (src) { const v4u w = *(const v4u*)src; v0 = (f32x4){bfe(w, 0), bfe(w, 1), bfe(w, 2), bfe(w, 3)}; v1 = (f32x4){bfe(w, 4), bfe(w, 5), bfe(w, 6), bfe(w, 7)}; }
        else { v0 = *(const f32x4*)fsrc; v1 = *(const f32x4*)(fsrc + 4); }
        *(f32x4*)dst = v0; *(f32x4*)(dst + 4) = v1;
    }
}

constexpr int NGH = BP * 8, N_SSD_IT = BP * 2 * (TP / 64), N_IT_SMP_GH = (BS / 4) * 4, N_IT_SMP_SSD = (BS / 2) * 2, N_IT_POOL = M / 64;
constexpr int IT_M3 = N_SSD_IT, IT_SGLA = 2 * N_SSD_IT, IT_SHG = IT_SGLA + N_IT_SMP_GH, IT_SSSD = IT_SHG + N_IT_SMP_GH, IT_POOL = IT_SSSD + N_IT_SMP_SSD, IT_GHP = IT_POOL + N_IT_POOL, IT_END = IT_GHP + NGH;
constexpr int N_IT_PROMPT = NGH;
__device__ __forceinline__ void mixer_phase(unsigned char* ldsg, LAS unsigned char* ldsl, const MixP& C, int G, const int tid) {
    const int bx = blockIdx.x;
    const int ngh = (G >= 2 * NGH) ? NGH : 0;
    const int nw = G - ngh;
    int it, step, lim; bool synced;
#if defined(MK_SPIN_O) || defined(MK_SPIN_G)
    {
#ifdef MK_SPIN_O
        const bool spin = (bx >= ngh); const unsigned long long ticks = MK_SPIN_O;
#else
        const bool spin = (bx < ngh); const unsigned long long ticks = MK_SPIN_G;
#endif
        if (spin) { const unsigned long long t0 = __builtin_amdgcn_s_memrealtime(); while (__builtin_amdgcn_s_memrealtime() - t0 < ticks) __builtin_amdgcn_s_sleep(8); }
    }
#endif
    if (bx < ngh) { it = IT_GHP + bx; step = 1 << 30; lim = IT_END; synced = true; }
    else { it = bx - ngh; step = nw; lim = (ngh > 0) ? IT_GHP : IT_END; synced = false; copy_states(C, bx - ngh, nw, tid); }
    int rep_it = 0;
    constexpr int NFILL = 64, V_A = N_SSD_IT + NFILL, V_B = V_A + 192, V_C = V_B + 192, V_D = V_C + N_SSD_IT;
    static_assert(V_D + 208 == IT_GHP && N_IT_SMP_SSD == 128 && N_IT_POOL == 272 && 2 * N_IT_SMP_GH == 256, "SSD-side item list");
    const bool olist = (ngh > 0 && bx >= ngh);
    int sstate = olist ? 0 : 3;
    for (int vi = it; vi < lim; vi += step) {
        it = vi;
        if (olist) {
            if (vi < N_SSD_IT) it = vi;
            else if (vi < V_A) it = IT_POOL + (vi - N_SSD_IT);
            else if (vi < V_A + N_IT_SMP_SSD) it = IT_SSSD + (vi - V_A);
            else if (vi < V_B) it = IT_POOL + NFILL + (vi - V_A - N_IT_SMP_SSD);
            else if (vi < V_B + 144) it = IT_POOL + 128 + (vi - V_B);
            else if (vi < V_C) it = IT_SGLA + (vi - V_B - 144);
            else if (vi < V_D) it = IT_M3 + (vi - V_C);
            else it = IT_SGLA + 48 + (vi - V_D);
            if (sstate == 0 && vi >= V_A) { sub_arrive(C.subc); sstate = 1; }
            if (sstate == 1 && vi >= V_B) { sub_wait(C.subc, (unsigned)nw); ssd_scan(C, bx - ngh, nw, tid); sub_arrive(C.subc + 64); sstate = 2; }
            if (sstate == 2 && vi >= V_C) { sub_wait(C.subc + 64, (unsigned)nw); sstate = 3; synced = true; }
        }
        if (!olist && !synced && it >= IT_M3) { sub_barrier(C.subc, (unsigned)nw); ssd_scan(C, bx - ngh, nw, tid); sub_barrier(C.subc + 64, (unsigned)nw); synced = true; }
        int tidl = tid; asm volatile("" : "+v"(tidl));
        int kind, a, b0, mode = 0, sc0 = 0; bool smp = true;
        if (it < IT_SGLA) { const int j = (it < IT_M3) ? it : it - IT_M3; kind = 2; mode = (it < IT_M3) ? 2 : 3; sc0 = j & (TP / 64 - 1); a = (j >> 5) & 1; b0 = j >> 6; }
        else if (it < IT_SHG) { const int j = it - IT_SGLA; kind = 0; a = j & 3; b0 = (j >> 2) * 4; }
        else if (it < IT_SSSD) { const int j = it - IT_SHG; kind = 1; a = j & 3; b0 = (j >> 2) * 4; }
        else if (it < IT_POOL) { const int j = it - IT_SSSD; kind = 2; mode = 1; a = j & 1; b0 = (j >> 1) * 2; }
        else if (it < IT_GHP) { kind = 3; a = it - IT_POOL; b0 = 0; }
        else { const int j = it - IT_GHP; smp = false; b0 = j >> 3; kind = ((j & 7) < 4) ? 0 : 1; a = j & 3; }
        if (kind == 0) {
#ifndef MK_NO_GLA
            chain_gh<0>(ldsl, C, a, b0, smp, tidl);
#endif
        } else if (kind == 1) {
#ifndef MK_NO_HGRN
            chain_gh<1>(ldsl, C, a, b0, smp, tidl);
#endif
        } else if (kind == 2) {
#ifndef MK_NO_SSD
            chain_ssd(ldsl, C, a, b0, mode, sc0, tidl);
#endif
        } else {
#ifndef MK_NO_POOL
            pool_item(ldsl, C, a, tidl);
#endif
        }
        int want = 1;
#ifdef MK_DUP_POOL
        if (kind == 3) want = 2;
#endif
#ifdef MK_DUP_SMPGH
        if (kind < 2 && smp) want = 2;
#endif
#ifdef MK_DUP_SMPSSD
        if (kind == 2 && mode == 1) want = 2;
#endif
#ifdef MK_DUP_GHP
        if (!smp) want = 2;
#endif
#ifdef MK_DUP_M3
        if (kind == 2 && mode == 3) want = 2;
#endif
        if (++rep_it < want) vi -= step; else rep_it = 0;
    }
    if (olist) {
        if (sstate == 0) { sub_arrive(C.subc); sstate = 1; }
        if (sstate == 1) { sub_wait(C.subc, (unsigned)nw); ssd_scan(C, bx - ngh, nw, tid); sub_arrive(C.subc + 64); sstate = 2; }
        if (sstate == 2) { sub_wait(C.subc + 64, (unsigned)nw); }
    } else if (!synced) { sub_barrier(C.subc, (unsigned)nw); ssd_scan(C, bx - ngh, nw, tid); sub_barrier(C.subc + 64, (unsigned)nw); }
}

__device__ __forceinline__ void srg_phase(LAS unsigned char* L, const bf16* Aop, const bf16* Bt, const int K, bf16* xb, float* rowss, const float scale, const bool fin, const int G, const int tid) {
    const int w = __builtin_amdgcn_readfirstlane(tid >> 6), lane = tid & 63, q = lane >> 4, r16 = lane & 15, wm = w >> 1, wn = w & 1;
    const int lr = tid >> 3, lc = (tid & 7) * 8;
    const int nt = K / 128;
    for (int tile = blockIdx.x; tile < 256; tile += G) {
        const int tm = tile >> 4, tn = tile & 15;
        const bf16* ag = Aop + (size_t)(MP + 64 * tm + lr) * K + lc;
        const bf16* bg = Bt + (size_t)(64 * tn + lr) * K + lc;
        f32x4 acc0 = {0.f, 0.f, 0.f, 0.f}, acc1 = acc0;
        v4u ra[2][2], rb[2][2];
#pragma unroll
        for (int i = 0; i < 2; ++i) { ra[i][0] = *(const v4u*)(ag + i * 128); ra[i][1] = *(const v4u*)(ag + i * 128 + 64); rb[i][0] = *(const v4u*)(bg + i * 128); rb[i][1] = *(const v4u*)(bg + i * 128 + 64); }
        LAS unsigned char* wr0 = L + lr * 272 + lc * 2;
        const LAS unsigned char* fa = L + (16 * wm + r16) * 272 + (8 * q) * 2;
        const LAS unsigned char* fb = L + 17408 + (32 * wn + r16) * 272 + (8 * q) * 2;
#pragma unroll 1
        for (int t = 0; t < nt; t += 2) {
#pragma unroll
            for (int i = 0; i < 2; ++i) {
                LAS unsigned char* wb_ = wr0 + i * 34816;
                *(LAS v4u*)(wb_) = ra[i][0]; *(LAS v4u*)(wb_ + 128) = ra[i][1]; *(LAS v4u*)(wb_ + 17408) = rb[i][0]; *(LAS v4u*)(wb_ + 17408 + 128) = rb[i][1];
                { const int tn2 = (t + 2 + i < nt) ? t + 2 + i : i; const bf16* a2 = ag + (size_t)tn2 * 128; const bf16* b2 = bg + (size_t)tn2 * 128;
                  ra[i][0] = *(const v4u*)a2; ra[i][1] = *(const v4u*)(a2 + 64); rb[i][0] = *(const v4u*)b2; rb[i][1] = *(const v4u*)(b2 + 64); }
                LDS_BARRIER();
#pragma unroll
                for (int ks = 0; ks < 4; ++ks) {
                    const bf16x8 af = frag16(fa + i * 34816 + ks * 64), b0 = frag16(fb + i * 34816 + ks * 64), b1 = frag16(fb + i * 34816 + 16 * 272 + ks * 64);
                    acc0 = MFMA16(b0, af, acc0); acc1 = MFMA16(b1, af, acc1);
                }
            }
        }
        {
            const int row = MP + 64 * tm + 16 * wm + r16, col0 = 64 * tn + 32 * wn + 4 * q;
            bf16* px = xb + (size_t)row * D + col0;
            const v2u xa = *(const v2u*)px, xc = *(const v2u*)(px + 16);
            const float a0 = __builtin_bit_cast(float, xa.x << 16) + acc0[0] * scale, a1 = __builtin_bit_cast(float, xa.x & 0xffff0000u) + acc0[1] * scale, a2 = __builtin_bit_cast(float, xa.y << 16) + acc0[2] * scale, a3 = __builtin_bit_cast(float, xa.y & 0xffff0000u) + acc0[3] * scale;
            const float b0 = __builtin_bit_cast(float, xc.x << 16) + acc1[0] * scale, b1 = __builtin_bit_cast(float, xc.x & 0xffff0000u) + acc1[1] * scale, b2 = __builtin_bit_cast(float, xc.y << 16) + acc1[2] * scale, b3 = __builtin_bit_cast(float, xc.y & 0xffff0000u) + acc1[3] * scale;
            v2u wa, wb; wa.x = cvtpk(a0, a1); wa.y = cvtpk(a2, a3); wb.x = cvtpk(b0, b1); wb.y = cvtpk(b2, b3);
            *(v2u*)px = wa; *(v2u*)(px + 16) = wb;
            float ss = 0.f;
#pragma unroll
            for (int k = 0; k < 2; ++k) { const unsigned pa = wa[k], pb = wb[k]; const float r0 = __builtin_bit_cast(float, pa << 16), r1 = __builtin_bit_cast(float, pa & 0xffff0000u), r2 = __builtin_bit_cast(float, pb << 16), r3 = __builtin_bit_cast(float, pb & 0xffff0000u); ss += (r0 * r0 + r1 * r1) + (r2 * r2 + r3 * r3); }
            ss += __shfl_xor(ss, 16); ss += __shfl_xor(ss, 32);
            if (q == 0 && fin) unsafeAtomicAdd(rowss + row, ss);
        }
        LDS_BARRIER();
    }
}

__device__ __forceinline__ void final_phase(const Args& A, int wave, int lane, int G) {
    const int gw = blockIdx.x * NWAVES + wave, NGW = G * NWAVES;
    const float* rss = (const float*)(A.ws + WS_RSS) + (size_t)6 * M; const f32x4* gn = (const f32x4*)A.in[I_FINALN] + lane; const bf16* xb = (const bf16*)(A.ws + WS_XB);
    f32x4 g4[4];
#pragma unroll
    for (int j = 0; j < 4; ++j) g4[j] = gn[64 * j];
    for (int m0 = gw; m0 < M; m0 += 2 * NGW) {
        const int m1 = m0 + NGW; const bool two = m1 < M; const int m1c = two ? m1 : m0;
        const float q0 = rss[m0], q1 = rss[m1c];
        const v2u* x0 = (const v2u*)(xb + (size_t)m0 * D) + lane; const v2u* x1 = (const v2u*)(xb + (size_t)m1c * D) + lane;
        v2u w0[4], w1[4];
#pragma unroll
        for (int j = 0; j < 4; ++j) { w0[j] = x0[64 * j]; w1[j] = x1[64 * j]; }
        const float r0 = rsqrtf(q0 * (1.0f / 1024.0f) + 1e-6f), r1 = rsqrtf(q1 * (1.0f / 1024.0f) + 1e-6f);
        f32x4* y0 = (f32x4*)(A.out + (size_t)m0 * D) + lane; f32x4* y1 = (f32x4*)(A.out + (size_t)m1c * D) + lane;
#pragma unroll
        for (int j = 0; j < 4; ++j) { const v2u w = w0[j]; const f32x4 v = {__builtin_bit_cast(float, w.x << 16), __builtin_bit_cast(float, w.x & 0xffff0000u), __builtin_bit_cast(float, w.y << 16), __builtin_bit_cast(float, w.y & 0xffff0000u)};
            y0[64 * j] = v * r0 * g4[j]; }
        if (two) {
#pragma unroll
            for (int j = 0; j < 4; ++j) { const v2u w = w1[j]; const f32x4 v = {__builtin_bit_cast(float, w.x << 16), __builtin_bit_cast(float, w.x & 0xffff0000u), __builtin_bit_cast(float, w.y << 16), __builtin_bit_cast(float, w.y & 0xffff0000u)};
                y1[64 * j] = v * r1 * g4[j]; }
        }
    }
}

__device__ __forceinline__ void side_convert(const Args& A, LAS unsigned char* ldsl, const int tidv, const int first, const int G, const CvtList Lst) {
    const int wv = __builtin_amdgcn_readfirstlane(tidv >> 6);
    if (first > 0 && first < G) { if ((int)blockIdx.x >= first) convert_weights(A, ldsl, wv, tidv & 63, Lst, ((int)blockIdx.x - first) * NWAVES + wv, (G - first) * NWAVES); }
    else convert_weights(A, ldsl, wv, tidv & 63, Lst, (int)blockIdx.x * NWAVES + wv, G * NWAVES);
}
__device__ __forceinline__ int sub_of(int ph) { const int j = (ph - 1) & 7; return (j < 3) ? j : (j == 3 ? 7 : j - 1); }
__global__ void __launch_bounds__(NTHREADS, 2) mk_fwd(Args args) {
    extern __shared__ __attribute__((aligned(16))) unsigned char lds[];
    LAS unsigned char* ldsl = (LAS unsigned char*)lds;
    volatile LAS unsigned* MISC = (volatile LAS unsigned*)(ldsl + MISC_OFF);
    const int tid = threadIdx.x, lane = tid & 63, wave = __builtin_amdgcn_readfirstlane(tid >> 6), G = gridDim.x;
    unsigned char* ws = args.ws;
    gu32* ctl = (gu32*)(ws + WS_CTL);
    for (int u = tid; u < (LDS_BYTES - LDSCTL_OFF) / 4; u += NTHREADS) ((LAS unsigned*)(ldsl + LDSCTL_OFF))[u] = 0u;
    __syncthreads();
    const int lo = args.ph_lo, hi = args.ph_hi;
    XcdBarrier bar; bar.bar = (unsigned*)(ctl + CW_BAR); bar.x = 0; bar.st = nullptr;
    if (hi - lo > 1) bar = xcd_barrier_post((unsigned*)(ctl + CW_BAR), MISC + 8);

    bf16* xb = (bf16*)(ws + WS_XB); bf16* mixb = (bf16*)(ws + WS_MIX); bf16* hp = (bf16*)(ws + WS_HP);
    float* rss = (float*)(ws + WS_RSS);

    bool first = true;
    for (int si = 2 * lo; si < 2 * hi; ++si) {
        const int ph = si >> 1;
        if (si & 1) {
            bool dup = false;
#ifdef MK_DUP_P0
            dup = dup || (ph == 0);
#endif
#ifdef MK_DUP_MIX
            dup = dup || (ph >= 1 && ph < N_PHASES - 1 && sub_of(ph) == 3);
#endif
#ifdef MK_DUP_GU
            dup = dup || (ph >= 1 && ph < N_PHASES - 1 && (sub_of(ph) == 0 || sub_of(ph) == 5));
#endif
#ifdef MK_DUP_RESID
            dup = dup || (ph >= 1 && ph < N_PHASES - 1 && (sub_of(ph) == 1 || sub_of(ph) == 4 || sub_of(ph) == 6));
#endif
#ifdef MK_DUP_IN
            dup = dup || (ph >= 1 && ph < N_PHASES - 1 && sub_of(ph) == 2);
#endif
            if (!dup) continue;
        }
        if (!first) xcd_barrier(bar);
        first = false;
        int tidv = threadIdx.x; asm volatile("" : "+v"(tidv));
        if (ph == 0) {
#ifndef MK_NO_P0
            p0_prologue(args, ldsl, __builtin_amdgcn_readfirstlane(tidv >> 6), tidv & 63, G);
#endif
        }
        else if (ph == N_PHASES - 1) { final_phase(args, __builtin_amdgcn_readfirstlane(tidv >> 6), tidv & 63, G); }
        else {
            const int l = (ph - 1) / 8, s = sub_of(ph);
            CvtList side = {0, 0, 0, 0, 0, 0, 0, 0}; int side_first = 0;
            const unsigned char* wl = ws + WS_W + (size_t)l * W_LAYER;
            if (s == 0 || s == 5) {
                pg8::Gemm g{xb, (const bf16*)(wl + (s == 0 ? WO_GU1 : WO_GU2)), M, NGU, D}; pg8::StaticOrder S; S.init(M, NGU, G, (int)blockIdx.x);
                bool gdry = false;
#ifdef MK_DRY_GU
                gdry = (si & 1) == 0;
#endif
                pg8::EpiSwiGLU E{hp, FF, rss + (size_t)(3 * l + (s == 0 ? 0 : 2)) * M, gdry};
#ifndef MK_NO_G1
                pg8::gemm_phase<pg8::EpiSwiGLU, pg8::StaticOrder, PG8_ALIGN, PG8_SP2>(ldsl + RING_OFF, g, S, E, tidv);
#endif
                side = (l == 0) ? ((s == 0) ? CV_GU1_L0 : CV_GU2_L0) : ((s == 0) ? CV_GU1_L1 : CvtList{0, 0, 0, 0, 0, 0, 0, 0}); side_first = ((M / 256) * (NGU / 256)) % G;
            } else if (s == 1 || s == 4 || s == 6) {
                const bf16* Aop = (s == 4) ? mixb : hp; const int K = (s == 4) ? D : FF;
                const size_t wo = (s == 1) ? WO_D1 : (s == 4) ? WO_OUT : WO_D2;
                pg8::Gemm g{Aop, (const bf16*)(wl + wo), MP, D, K}; pg8::StaticOrder S; S.init(MP, D, G, (int)blockIdx.x);
                float* rso = rss + (size_t)(3 * l + (s == 1 ? 1 : (s == 4 ? 2 : 3))) * M;
                const float rscale = (s == 4) ? 1.0f : 0.5f;
                float esc = rscale; bool efin = true;
#ifdef MK_DUP_RESID
                esc = 0.5f * rscale; efin = (si & 1) != 0;
#endif
                pg8::EpiResid E{xb, rso, esc, efin};
#ifndef MK_NO_G2
                const bool srg_first = (blockIdx.x & 1) != 0;
                if (srg_first) srg_phase(ldsl + RING_OFF, Aop, (const bf16*)(wl + wo), K, xb, rso, esc, efin, G, tidv);
                pg8::gemm_phase<pg8::EpiResid, pg8::StaticOrder, PG8_ALIGN, PG8_SP2>(ldsl + RING_OFF, g, S, E, tidv);
                if (!srg_first)
#ifdef MK_DUP_SRG
                srg_phase(ldsl + RING_OFF, Aop, (const bf16*)(wl + wo), K, xb, rso, 0.5f * esc, false, G, tidv);
                srg_phase(ldsl + RING_OFF, Aop, (const bf16*)(wl + wo), K, xb, rso, 0.5f * esc, efin, G, tidv);
#else
                srg_phase(ldsl + RING_OFF, Aop, (const bf16*)(wl + wo), K, xb, rso, esc, efin, G, tidv);
#endif
#endif
            } else if (s == 2) {
                pg8::Gemm g{xb, (const bf16*)(wl + WO_IN), M, NINP, D}; pg8::StaticOrder S; S.init(M, NINP, G, (int)blockIdx.x);
                pg8::EpiProj E{hp, NINP, rss + (size_t)(3 * l + 1) * M};
#ifndef MK_NO_G3
                pg8::gemm_phase<pg8::EpiProj, pg8::StaticOrder, PG8_ALIGN, PG8_SP2>(ldsl + RING_OFF, g, S, E, tidv);
#endif
                side = (l == 0) ? CV_IN_L0 : CV_IN_L1; side_first = ((M / 256) * (NINP / 256)) % G;
            } else {
                MixP C;
                C.P = hp; C.mixb = mixb; C.out = args.out; C.l = l; C.XC = (bf16*)args.out;
                C.DS = args.out + 8388608; C.ESC = args.out + 16900000; C.subc = (unsigned*)(ctl + CW_SUB + 128 * l);
                C.s_pool = args.in[I_SPOOL] + (size_t)l * BS * 15 * 256; C.s_gla = args.in[I_SGLA] + (size_t)l * BS * 4 * 32 * 64; C.s_hgrn = args.in[I_SHGRN] + (size_t)l * BS * 4 * 64 * 64;
                C.s_ssm = args.in[I_SSSM] + (size_t)l * BS * 4 * 64 * 128; C.s_conv = args.in[I_SCONV] + (size_t)l * BS * 3 * 768;
                C.pool_w = args.in[I_POOLW] + (size_t)l * 4 * 64 * 64; C.pool_scale = args.in[I_POOLS] + l * 256; C.gla_wg = args.in[I_GLAWG] + l * 16 * 128; C.gla_b = args.in[I_GLAB] + l * 128;
                C.gla_n = args.in[I_GLAN] + l * 64; C.lbl = args.in[I_LBL]; C.hg_n = args.in[I_HGN] + l * 64; C.conv_w = args.in[I_CONVW] + l * 4 * 768; C.conv_b = args.in[I_CONVB] + l * 768;
                C.dt_b = args.in[I_DTB] + l * 4; C.a_log = args.in[I_ALOG] + l * 4; C.ssm_d = args.in[I_SSMD] + l * 4; C.ssm_n = args.in[I_SSMN] + l * 256;
#ifndef MK_NO_MIXER
                if (s == 7) conv_phase(C, G, tidv); else mixer_phase(lds + RING_OFF, ldsl + RING_OFF, C, G, tidv);
#endif
            }
            if (side.n0 + side.n1 > 0) side_convert(args, ldsl, tidv, side_first, G, side);
        }
    }
}

extern "C" void kernel_launch(void* const* d_in, const int* in_sizes, int n_in, void* d_out, int out_size, void* d_ws, size_t ws_size, hipStream_t stream) {
    static int grid = 0;
    if (grid == 0) {
        if (n_in != N_INPUTS || in_sizes[0] != MP * D || (size_t)out_size != O_END || ws_size < WS_END) {
            fprintf(stderr, "kernel_launch: shape mismatch: n_in %d, in0 %d, out %d, ws %zu (need %zu); nothing launched\n", n_in, n_in > 0 ? in_sizes[0] : -1, out_size, ws_size, (size_t)WS_END); grid = -1; return; }
        int dev = 0, cus = 0, per_cu = 0;
        if (hipGetDevice(&dev) != hipSuccess || hipDeviceGetAttribute(&cus, hipDeviceAttributeMultiprocessorCount, dev) != hipSuccess) { fprintf(stderr, "kernel_launch: device query failed\n"); grid = -1; return; }
        if (hipFuncSetAttribute((const void*)mk_fwd, hipFuncAttributeMaxDynamicSharedMemorySize, LDS_BYTES) != hipSuccess) { fprintf(stderr, "kernel_launch: hipFuncSetAttribute failed\n"); grid = -1; return; }
        if (hipOccupancyMaxActiveBlocksPerMultiprocessor(&per_cu, (const void*)mk_fwd, NTHREADS, LDS_BYTES) != hipSuccess || per_cu < 1) {
            fprintf(stderr, "kernel_launch: occupancy query reports %d workgroups per CU; nothing launched\n", per_cu); (void)hipGetLastError(); grid = -1; return; }
        grid = cus;
    }
    if (grid < 0) return;
    if (hipMemsetAsync((char*)d_ws + WS_CTL, 0, CTL_ZERO_BYTES, stream) != hipSuccess) { fprintf(stderr, "kernel_launch: hipMemsetAsync failed\n"); return; }
    Args a{};
    for (int i = 0; i < N_INPUTS; ++i) a.in[i] = (const float*)d_in[i];
    a.out = (float*)d_out; a.ws = (unsigned char*)d_ws;
    for (int li = 0; li < N_LAUNCHES; ++li) {
        a.ph_lo = (N_LAUNCHES == 1) ? 0 : li; a.ph_hi = (N_LAUNCHES == 1) ? N_PHASES : li + 1;
        hipLaunchKernelGGL(mk_fwd, dim3(grid), dim3(NTHREADS), LDS_BYTES, stream, a);
        const hipError_t le = hipPeekAtLastError();
        if (le != hipSuccess) { fprintf(stderr, "kernel_launch: launch %d failed: %s\n", li, hipGetErrorName(le)); break; }
    }
}
```
